# Optimizing an MI355X kernel written in HIP

```python
import math
import jax, jax.numpy as jnp
from jax import lax
import numpy as np

D_MODEL = 1024
BATCH = 32
SEQ = 2048
DEPTH = 1

MIX_WIDTH = D_MODEL
DIFF_WIDTH = MIX_WIDTH // 2
GLA_WIDTH = MIX_WIDTH - DIFF_WIDTH
DIFF_HEADS = 4
DIFF_HEAD_DIM = DIFF_WIDTH // (2 * DIFF_HEADS)
Q_BLOCK = 128
ROPE_THETA = 10000.0
GLA_HEADS = 4
GLA_DV = GLA_WIDTH // GLA_HEADS
GLA_DK = GLA_DV // 2
GLA_GATE_RANK = 16
GLA_GATE_TAU = 16.0
GLA_CHUNK = 64
PEER_HEADS = 8
PEER_TOPK = 16
PEER_NKEYS = 128
PEER_N_EXPERTS = PEER_NKEYS * PEER_NKEYS
PEER_QDIM = 256
PEER_TOKEN_BLOCK = 128
EPS = 1e-6

DIFF_Q_COLS = DIFF_HEADS * 2 * DIFF_HEAD_DIM
DIFF_K_COLS = DIFF_HEADS * 2 * DIFF_HEAD_DIM
DIFF_V_COLS = DIFF_HEADS * 2 * DIFF_HEAD_DIM
GLA_Q_COLS = GLA_HEADS * GLA_DK
GLA_K_COLS = GLA_HEADS * GLA_DK
GLA_V_COLS = GLA_HEADS * GLA_DV
GLA_R_COLS = GLA_HEADS * GLA_DV
GLA_G_COLS = GLA_GATE_RANK
IN_COLS = (DIFF_Q_COLS + DIFF_K_COLS + DIFF_V_COLS + GLA_Q_COLS + GLA_K_COLS
           + GLA_V_COLS + GLA_R_COLS + GLA_G_COLS)

kernel_name = "hybrid_diffattn_gla_peer_adaln"


def rmsnorm(x, g):
    xf = x.astype(jnp.float32)
    y = xf * lax.rsqrt(jnp.mean(xf * xf, axis=-1, keepdims=True) + EPS)
    return (y * g.astype(jnp.float32)).astype(x.dtype)


def rope_cos_sin(positions, dim):
    inv_freq = ROPE_THETA ** (-jnp.arange(0, dim, 2, dtype=jnp.float32) / dim)
    ang = positions.astype(jnp.float32)[..., None] * inv_freq
    return jnp.cos(ang), jnp.sin(ang)


def apply_rope(x, cos, sin):
    x1, x2 = jnp.split(x, 2, axis=-1)
    cos = cos.astype(x.dtype)
    sin = sin.astype(x.dtype)
    return jnp.concatenate([x1 * cos - x2 * sin, x2 * cos + x1 * sin], axis=-1)


def diff_attention(q, k, v, qn_g, kn_g, lam_q1, lam_k1, lam_q2, lam_k2, subln_g, positions, lambda_init):
    B, S, H, _, d = q.shape
    nb = S // Q_BLOCK
    q = rmsnorm(q, qn_g)
    k = rmsnorm(k, kn_g)
    cos, sin = rope_cos_sin(positions, d)
    cos = cos[:, :, None, None, :]
    sin = sin[:, :, None, None, :]
    q = apply_rope(q, cos, sin)
    k = apply_rope(k, cos, sin)
    lam = (jnp.exp(jnp.sum(lam_q1.astype(jnp.float32) * lam_k1.astype(jnp.float32)))
           - jnp.exp(jnp.sum(lam_q2.astype(jnp.float32) * lam_k2.astype(jnp.float32)))
           + lambda_init)
    scale = d ** -0.5
    qb = q.reshape(B, nb, Q_BLOCK, H, 2, d).transpose(1, 0, 3, 4, 2, 5)
    kt = k.transpose(0, 2, 3, 1, 4)
    vt = v.transpose(0, 2, 1, 3)
    key_pos = jnp.arange(S)

    def block(args):
        qblk, i = args
        s = jnp.einsum('bhmqd,bhmkd->bhmqk', qblk, kt,
                       preferred_element_type=jnp.float32) * scale
        q_pos = i * Q_BLOCK + jnp.arange(Q_BLOCK)
        mask = key_pos[None, :] <= q_pos[:, None]
        p = jax.nn.softmax(jnp.where(mask, s, -jnp.inf), axis=-1)
        w = p[:, :, 0] - lam * p[:, :, 1]
        return jnp.einsum('bhqk,bhke->bhqe', w.astype(vt.dtype), vt)

    o = lax.map(block, (qb, jnp.arange(nb)))
    o = o.transpose(1, 0, 3, 2, 4).reshape(B, S, H, 2 * d)
    o = rmsnorm(o, subln_g) * (1.0 - lambda_init)
    return o.reshape(B, S, H * 2 * d)


def gla(q, k, v, r, g_low, w_gate2, b_gate, norm_g):
    B, S, H, dk = q.shape
    dv = v.shape[-1]
    C = GLA_CHUNK
    nc = S // C
    log_a = jax.nn.log_sigmoid((g_low @ w_gate2 + b_gate).astype(jnp.float32)) / GLA_GATE_TAU
    log_a = log_a.reshape(B, S, H, dk)

    def chunks(t):
        return t.reshape(B, nc, C, H, t.shape[-1]).transpose(0, 3, 1, 2, 4).astype(jnp.float32)

    qc = chunks(q) * (dk ** -0.5)
    kc = chunks(k)
    vc = chunks(v)
    bc = jnp.cumsum(chunks(log_a), axis=3)
    b_last = bc[:, :, :, -1:]
    b_mid = bc[:, :, :, C // 2:C // 2 + 1]
    a = jnp.einsum('bhncd,bhnjd->bhncj', qc * jnp.exp(bc - b_mid), kc * jnp.exp(b_mid - bc))
    causal = jnp.tril(jnp.ones((C, C), dtype=bool))
    a = jnp.where(causal, a, 0.0)
    o = jnp.einsum('bhncj,bhnje->bhnce', a, vc)
    ds = jnp.einsum('bhncd,bhnce->bhnde', kc * jnp.exp(b_last - bc), vc)
    decay = jnp.exp(b_last[:, :, :, 0])

    def step(state, inp):
        dec, dsn = inp
        return dec[..., None] * state + dsn, state

    s0 = jnp.zeros((B, H, dk, dv), jnp.float32)
    _, s_prev = lax.scan(step, s0, (jnp.moveaxis(decay, 2, 0), jnp.moveaxis(ds, 2, 0)))
    s_prev = jnp.moveaxis(s_prev, 0, 2)
    o = o + jnp.einsum('bhncd,bhnde->bhnce', qc * jnp.exp(bc), s_prev)
    o = o.transpose(0, 2, 3, 1, 4).reshape(B, S, H, dv)
    o = rmsnorm(o, norm_g).reshape(B, S, H * dv)
    return (o * jax.nn.silu(r.astype(jnp.float32))).astype(q.dtype)


def peer(h, w_query, b_query, keys1, keys2, expert_u, expert_v):
    B, S, D = h.shape
    tokens = h.reshape(-1, PEER_TOKEN_BLOCK, D)
    half = PEER_QDIM // 2

    def block(xb):
        T = xb.shape[0]
        q = (xb @ w_query + b_query).reshape(T, PEER_HEADS, PEER_QDIM)
        s1 = jnp.einsum('thd,kd->thk', q[..., :half], keys1)
        s2 = jnp.einsum('thd,kd->thk', q[..., half:], keys2)
        v1, i1 = lax.top_k(s1, PEER_TOPK)
        v2, i2 = lax.top_k(s2, PEER_TOPK)
        cand = (v1[..., :, None] + v2[..., None, :]).reshape(T, PEER_HEADS, PEER_TOPK * PEER_TOPK)
        cidx = (i1[..., :, None] * PEER_NKEYS + i2[..., None, :]).reshape(T, PEER_HEADS, PEER_TOPK * PEER_TOPK)
        sc, pos = lax.top_k(cand, PEER_TOPK)
        eidx = jnp.take_along_axis(cidx, pos, axis=-1)
        g = jax.nn.softmax(sc.astype(jnp.float32), axis=-1)
        u = expert_u[eidx]
        act = jax.nn.gelu(jnp.einsum('thkd,td->thk', u, xb).astype(jnp.float32), approximate=False) * g
        return jnp.einsum('thk,thkd->td', act.astype(xb.dtype), expert_v[eidx])

    return lax.map(block, tokens).reshape(B, S, D)


def in_proj_offsets():
    sizes = [DIFF_Q_COLS, DIFF_K_COLS, DIFF_V_COLS, GLA_Q_COLS, GLA_K_COLS, GLA_V_COLS, GLA_R_COLS]
    offs = []
    acc = 0
    for s in sizes:
        acc += s
        offs.append(acc)
    return offs


def setup_inputs(seed: int = 0) -> dict:
    key = jax.random.key(seed)
    ks = jax.random.split(key, 26)
    f32 = jnp.float32
    L, D = DEPTH, D_MODEL

    def nrm(k, shape, scale):
        return jax.random.normal(k, shape, f32) * scale

    x = jax.random.normal(ks[0], (BATCH, SEQ, D), f32)
    c = jax.random.normal(ks[1], (BATCH, D), f32)
    positions = (jnp.arange(SEQ, dtype=jnp.int32)[None, :]
                 + jax.random.randint(ks[2], (BATCH, 1), 0, 1024, dtype=jnp.int32))
    return {
        "x": x,
        "c": c,
        "positions": positions,
        "w_ada": nrm(ks[3], (L, D, 6 * D), D ** -0.5),
        "b_ada": nrm(ks[4], (L, 6 * D), 0.01),
        "norm1_g": 1.0 + nrm(ks[5], (L, D), 0.02),
        "w_in": nrm(ks[6], (L, D, IN_COLS), D ** -0.5),
        "qn_g": 1.0 + nrm(ks[7], (L, DIFF_HEAD_DIM), 0.02),
        "kn_g": 1.0 + nrm(ks[8], (L, DIFF_HEAD_DIM), 0.02),
        "lam_q1": nrm(ks[9], (L, DIFF_HEAD_DIM), 0.1),
        "lam_k1": nrm(ks[10], (L, DIFF_HEAD_DIM), 0.1),
        "lam_q2": nrm(ks[11], (L, DIFF_HEAD_DIM), 0.1),
        "lam_k2": nrm(ks[12], (L, DIFF_HEAD_DIM), 0.1),
        "diff_norm_g": 1.0 + nrm(ks[13], (L, 2 * DIFF_HEAD_DIM), 0.02),
        "w_gate2": nrm(ks[14], (L, GLA_GATE_RANK, GLA_HEADS * GLA_DK), GLA_GATE_RANK ** -0.5),
        "b_gate": nrm(ks[15], (L, GLA_HEADS * GLA_DK), 0.01),
        "gla_norm_g": 1.0 + nrm(ks[16], (L, GLA_DV), 0.02),
        "w_out": nrm(ks[17], (L, MIX_WIDTH, D), MIX_WIDTH ** -0.5),
        "norm2_g": 1.0 + nrm(ks[18], (L, D), 0.02),
        "w_query": nrm(ks[19], (L, D, PEER_HEADS * PEER_QDIM), D ** -0.5),
        "b_query": nrm(ks[20], (L, PEER_HEADS * PEER_QDIM), 0.01),
        "peer_keys1": nrm(ks[21], (L, PEER_NKEYS, PEER_QDIM // 2), (PEER_QDIM // 2) ** -0.5),
        "peer_keys2": nrm(ks[22], (L, PEER_NKEYS, PEER_QDIM // 2), (PEER_QDIM // 2) ** -0.5),
        "expert_u": nrm(ks[23], (L, PEER_N_EXPERTS, D), D ** -0.5),
        "expert_v": nrm(ks[24], (L, PEER_N_EXPERTS, D), PEER_HEADS ** -0.5),
    }


def reference(x, c, positions, w_ada, b_ada, norm1_g, w_in, qn_g, kn_g, lam_q1, lam_k1, lam_q2, lam_k2,
              diff_norm_g, w_gate2, b_gate, gla_norm_g, w_out, norm2_g, w_query, b_query,
              peer_keys1, peer_keys2, expert_u, expert_v):
    B, S, D = x.shape
    offs = in_proj_offsets()
    for l in range(DEPTH):
        mod = jax.nn.silu(c) @ w_ada[l] + b_ada[l]
        sh1, sc1, gt1, sh2, sc2, gt2 = [m[:, None, :] for m in jnp.split(mod, 6, axis=-1)]

        h = rmsnorm(x, norm1_g[l]) * (1.0 + sc1) + sh1
        proj = h @ w_in[l]
        dq, dk, dv, gq, gk, gv, gr, gg = jnp.split(proj, offs, axis=-1)
        lambda_init = 0.8 - 0.6 * math.exp(-0.3 * l)
        y_diff = diff_attention(
            dq.reshape(B, S, DIFF_HEADS, 2, DIFF_HEAD_DIM),
            dk.reshape(B, S, DIFF_HEADS, 2, DIFF_HEAD_DIM),
            dv.reshape(B, S, DIFF_HEADS, 2 * DIFF_HEAD_DIM),
            qn_g[l], kn_g[l], lam_q1[l], lam_k1[l], lam_q2[l], lam_k2[l], diff_norm_g[l],
            positions, lambda_init)
        y_gla = gla(
            gq.reshape(B, S, GLA_HEADS, GLA_DK),
            gk.reshape(B, S, GLA_HEADS, GLA_DK),
            gv.reshape(B, S, GLA_HEADS, GLA_DV),
            gr, gg, w_gate2[l], b_gate[l], gla_norm_g[l])
        mixed = jnp.concatenate([y_diff, y_gla], axis=-1) @ w_out[l]
        x = x + gt1 * mixed

        h2 = rmsnorm(x, norm2_g[l]) * (1.0 + sc2) + sh2
        x = x + gt2 * peer(h2, w_query[l], b_query[l], peer_keys1[l], peer_keys2[l], expert_u[l], expert_v[l])
    return x
```

```cpp
#include <hip/hip_runtime.h>
#include <hip/hip_bf16.h>
#include <cstdio>
#include <cstdint>
#include <cmath>
namespace pg8 {
#define PG8_LAS __attribute__((address_space(3)))
typedef unsigned short bf16_t;
typedef short bf16x8 __attribute__((ext_vector_type(8)));
typedef float f32x4 __attribute__((ext_vector_type(4)));
typedef unsigned u32x4 __attribute__((ext_vector_type(4)));
constexpr int BM = 256, BK = 64, HALF = 128, HTB = HALF * BK * 2  , STAGE_BYTES = 8 * HTB, NXCD = 8, WGM = 8;

__host__ __device__ __forceinline__ int lds_byte(int r, int c) { const int st = (r >> 4) * 2 + (c >> 5), rr = r & 15, cc = c & 31, ob = rr * 64 + cc * 2; return st * 1024 + (ob ^ (((ob >> 9) & 1) << 5)); }
__host__ __device__ __forceinline__ void stage_rc(int b, int& R, int& C) { const int st = b / 1024, sb = b % 1024, swz = sb ^ (((sb >> 9) & 1) << 5); R = (st >> 1) * 16 + swz / 64; C = (st & 1) * 32 + (swz % 64) / 2; }
__host__ __device__ __forceinline__ int perm32(int rho) { const int n = rho >> 4, i = rho & 15; return 8 * (i >> 2) + 4 * n + (i & 3); }

struct Unit { int pm, pn; };
struct Gemm { const bf16_t* A; const bf16_t* Bt; int M, N, K; };

struct StaticOrder {
    int nM, nN, nwg, G, c;
    __host__ __device__ void init(int M, int N, int G_, int c_) { nM = M / BM; nN = N / BM; nwg = nM * nN; G = G_; c = c_; }
    __host__ __device__ bool next(int i, Unit& u) const {
        const long L = (long)i * G + c; if (L >= nwg) return false;
        int wgid = (int)L; { const int q = nwg / NXCD, r = nwg % NXCD, xcd = wgid % NXCD, off = wgid / NXCD; wgid = (xcd < r ? xcd * (q + 1) : r * (q + 1) + (xcd - r) * q) + off; }
        const int nig = WGM * nN, gid = wgid / nig, fm = gid * WGM, gsz = (nM - fm) < WGM ? (nM - fm) : WGM;
        u.pm = fm + ((wgid % nig) % gsz); u.pn = (wgid % nig) / gsz; return true;
    }
    __device__ __forceinline__ void a_ready(const Unit&) const {}
    __device__ __forceinline__ void done(const Unit&) const {}
};

__device__ __forceinline__ unsigned cvt_pk_bf16(float lo, float hi) { unsigned r; asm volatile("v_cvt_pk_bf16_f32 %0, %1, %2" : "=v"(r) : "v"(lo), "v"(hi)); return r; }
typedef float f32x2 __attribute__((ext_vector_type(2)));
__device__ __forceinline__ f32x2 gelu_pk(f32x2 v) {
    const f32x2 av = __builtin_elementwise_abs(v), d = av * 0.2316418882f + 1.0f;
    f32x2 t; t.x = __builtin_amdgcn_rcpf(d.x); t.y = __builtin_amdgcn_rcpf(d.y);
    f32x2 q = t * 0.5307027145f + (-0.7265760135f); q = q * t + 0.7107068705f; q = q * t + (-0.142248368f); q = q * t + 0.127414796f; q = q * t;
    const f32x2 s = (v * v) * (-0.72134752044f);
    f32x2 e; e.x = __builtin_amdgcn_exp2f(s.x); e.y = __builtin_amdgcn_exp2f(s.y);
    const f32x2 m = v * (q * e), r = v - m;
    f32x2 o; o.x = v.x < 0.f ? m.x : r.x; o.y = v.y < 0.f ? m.y : r.y; return o;
}

template <int ACT  > struct EpiBf16 {
    static constexpr bool PERM = true, AFTER_DRAIN = false; static_assert(ACT == 0 || ACT == 1, "EpiBf16: ACT is 0 (none) or 1 (gelu_pk)");
    bf16_t* O; int ldc; const float* bias; int split_cols; size_t split_stride; float scale0;
    __device__ __forceinline__ void operator()(const f32x4 (&acc)[2][2][4][2], const Unit& u, int wr, int wc, int fr, int fq) const {
        const int row0 = u.pm * BM + wr * 64 + fr; int colt = u.pn * BM; bf16_t* base = O;
        float sc = 1.f; if (split_cols) { const int t = colt / split_cols; base += (size_t)t * split_stride; colt -= t * split_cols; if (t == 0) sc = scale0; }
        const int col0 = colt + wc * 32 + 8 * fq, bcol0 = u.pn * BM + wc * 32 + 8 * fq;
        f32x4 bv[2][2];
#pragma unroll
        for (int bj = 0; bj < 2; ++bj)
#pragma unroll
            for (int n = 0; n < 2; ++n) bv[bj][n] = bias ? *(const f32x4*)(bias + bcol0 + bj * HALF + 4 * n) : (f32x4){0.f, 0.f, 0.f, 0.f};
#pragma unroll
        for (int ai = 0; ai < 2; ++ai)
#pragma unroll
            for (int m = 0; m < 4; ++m) { bf16_t* rowp = base + (size_t)(row0 + ai * HALF + m * 16) * ldc + col0;
#pragma unroll
                for (int bj = 0; bj < 2; ++bj) { f32x4 v0 = acc[ai][bj][m][0] + bv[bj][0], v1 = acc[ai][bj][m][1] + bv[bj][1];
                    if (ACT == 1) { f32x2 a = gelu_pk((f32x2){v0[0], v0[1]}), b = gelu_pk((f32x2){v0[2], v0[3]}), c = gelu_pk((f32x2){v1[0], v1[1]}), d = gelu_pk((f32x2){v1[2], v1[3]});
                        v0 = (f32x4){a.x, a.y, b.x, b.y}; v1 = (f32x4){c.x, c.y, d.x, d.y}; }
                    v0 = v0 * sc; v1 = v1 * sc; u32x4 w; w.x = cvt_pk_bf16(v0[0], v0[1]); w.y = cvt_pk_bf16(v0[2], v0[3]); w.z = cvt_pk_bf16(v1[0], v1[1]); w.w = cvt_pk_bf16(v1[2], v1[3]);
                    *(u32x4*)(rowp + bj * HALF) = w; } }
    }
};
struct EpiResid {
    static constexpr bool PERM = false, AFTER_DRAIN = false;
    const float* x; const float* gate; float* out;
    __device__ __forceinline__ void operator()(const f32x4 (&acc)[2][2][4][2], const Unit& u, int wr, int wc, int fr, int fq) const {
        const int b = (u.pm * BM) >> 11;
        const int col0 = u.pn * BM + wc * 32 + 4 * fq;
        f32x4 gv[2][2];
#pragma unroll
        for (int bj = 0; bj < 2; ++bj)
#pragma unroll
            for (int n = 0; n < 2; ++n) gv[bj][n] = *(const f32x4*)(gate + (size_t)b * 6144 + col0 + bj * HALF + n * 16);
#pragma unroll
        for (int ai = 0; ai < 2; ++ai)
#pragma unroll
            for (int m = 0; m < 4; ++m) { const size_t off = (size_t)(u.pm * BM + ai * HALF + wr * 64 + m * 16 + fr) * 1024 + col0;
#pragma unroll
                for (int bj = 0; bj < 2; ++bj)
#pragma unroll
                    for (int n = 0; n < 2; ++n) { const f32x4 xv = *(const f32x4*)(x + off + bj * HALF + n * 16);
                        *(f32x4*)(out + off + bj * HALF + n * 16) = xv + gv[bj][n] * acc[ai][bj][m][n]; } }
    }
};
template <class Epi, class Sched, bool ALIGN_EPI = false, bool SP2 = false>
__device__ __forceinline__ void gemm_phase(PG8_LAS unsigned char* lds, const Gemm g, const Sched& S, const Epi& E) {
    const int tid = threadIdx.x, wid = __builtin_amdgcn_readfirstlane(tid >> 6), lane = tid & 63, wr = wid >> 2, wc = wid & 3, fr = lane & 15, fq = lane >> 4;
    const int K = g.K, nt = K / BK;
    unsigned voffA[2], voffB[2];
#pragma unroll
    for (int i = 0; i < 2; ++i) { int R, C; stage_rc(tid * 16 + i * 8192, R, C); const int Rb = Epi::PERM ? ((R & ~31) + perm32(R & 31)) : R;
        voffA[i] = (unsigned)(R * K + C) * 2u; voffB[i] = (unsigned)(Rb * K + C) * 2u; }
    const size_t kstep = (size_t)(BK * 2);
    const size_t hstep = (size_t)HALF * K * 2;
    const size_t tstep = 2 * hstep;
    const unsigned ldsw = (unsigned)wid * 1024u;
    const int aoff = lds_byte(wr * 64 + fr, fq * 8), boff = lds_byte(wc * 32 + fr, fq * 8);
#define PG8_SA(b, h) (((b) * 2 + (h)) * HTB)
#define PG8_SB(b, h) ((4 + (b) * 2 + (h)) * HTB)
#define PG8_STAGE(bufoff, gbase, voff) do { _Pragma("unroll") for (int _i = 0; _i < 2; ++_i) \
        __builtin_amdgcn_global_load_lds((const unsigned*)((const char*)(gbase) + (voff)[_i]), (PG8_LAS unsigned*)(lds + (bufoff) + ldsw + _i * 8192), 16, 0, 0); } while (0)
#define PG8_LDA(dst, b, h) do { _Pragma("unroll") for (int m = 0; m < 4; ++m) _Pragma("unroll") for (int k = 0; k < 2; ++k) dst[m][k] = *(const PG8_LAS bf16x8*)(lds + PG8_SA(b, h) + aoff + m * 2048 + k * 1024); } while (0)
#define PG8_LDB(dst, b, h) do { _Pragma("unroll") for (int n = 0; n < 2; ++n) _Pragma("unroll") for (int k = 0; k < 2; ++k) dst[n][k] = *(const PG8_LAS bf16x8*)(lds + PG8_SB(b, h) + boff + n * 2048 + k * 1024); } while (0)
#define PG8_MMA(ai, bj, At, Bt) do { __builtin_amdgcn_s_setprio(1); _Pragma("unroll") for (int m = 0; m < 4; ++m) _Pragma("unroll") for (int n = 0; n < 2; ++n) _Pragma("unroll") for (int k = 0; k < 2; ++k) \
        acc[ai][bj][m][n] = __builtin_amdgcn_mfma_f32_16x16x32_bf16(Bt[n][k], At[m][k], acc[ai][bj][m][n], 0, 0, 0); __builtin_amdgcn_s_setprio(0); } while (0)
#define PG8_WAIT_V(n) asm volatile("s_waitcnt vmcnt(" #n ")" ::: "memory")
#define PG8_WAIT_L(n) asm volatile("s_waitcnt lgkmcnt(" #n ")" ::: "memory")
#define PG8_BAR __builtin_amdgcn_s_barrier()
#define PG8_SCHED __builtin_amdgcn_sched_barrier(0)
    Unit cur, nxt; int ui = 0;
    if (!S.next(0, cur)) return;
    f32x4 acc[2][2][4][2];
#pragma unroll
    for (int a = 0; a < 2; ++a)
#pragma unroll
        for (int b = 0; b < 2; ++b)
#pragma unroll
            for (int m = 0; m < 4; ++m)
#pragma unroll
                for (int n = 0; n < 2; ++n) acc[a][b][m][n] = (f32x4){0.f, 0.f, 0.f, 0.f};
    bf16x8 At[4][2], B0[2][2], B1[2][2];
    const char* cA = (const char*)g.A + (size_t)cur.pm * tstep; const char* cB = (const char*)g.Bt + (size_t)cur.pn * tstep;
    S.a_ready(cur);
    if constexpr (SP2) {
        PG8_STAGE(PG8_SB(0, 0), cB, voffB); PG8_STAGE(PG8_SB(0, 1), cB + hstep, voffB); PG8_STAGE(PG8_SA(0, 0), cA, voffA); PG8_STAGE(PG8_SA(0, 1), cA + hstep, voffA);
        if (wr == 1) PG8_BAR;
        PG8_WAIT_V(2); PG8_BAR;
        PG8_STAGE(PG8_SB(1, 0), cB + kstep, voffB); PG8_STAGE(PG8_SA(1, 0), cA + kstep, voffA); PG8_STAGE(PG8_SB(1, 1), cB + hstep + kstep, voffB);
        PG8_WAIT_V(6); PG8_BAR;
    } else {
        PG8_STAGE(PG8_SB(0, 0), cB, voffB); PG8_STAGE(PG8_SA(0, 0), cA, voffA); PG8_STAGE(PG8_SB(0, 1), cB + hstep, voffB); PG8_STAGE(PG8_SA(0, 1), cA + hstep, voffA);
        if (wr == 1) PG8_BAR;
        PG8_WAIT_V(4); PG8_BAR;
        PG8_STAGE(PG8_SB(1, 0), cB + kstep, voffB); PG8_STAGE(PG8_SA(1, 0), cA + kstep, voffA); PG8_STAGE(PG8_SB(1, 1), cB + hstep + kstep, voffB);
        PG8_WAIT_V(6); PG8_BAR;
    }
    for (;;) {
        const bool has_next = S.next(ui + 1, nxt);
        const char* nA = has_next ? (const char*)g.A + (size_t)nxt.pm * tstep : cA; const char* nB = has_next ? (const char*)g.Bt + (size_t)nxt.pn * tstep : cB;
        for (int t = 0; t < nt; t += 2) {
            const bool last = (t == nt - 2);
            const char* a1 = cA + (size_t)(t + 1) * kstep;
            const char* a2 = last ? nA : cA + (size_t)(t + 2) * kstep; const char* b2 = last ? nB : cB + (size_t)(t + 2) * kstep;
            const char* a3 = a2 + kstep; const char* b3 = b2 + kstep;
            if (last && has_next) S.a_ready(nxt);
            if constexpr (SP2) {
            PG8_LDB(B0, 0, 0); PG8_LDB(B1, 0, 1); PG8_SCHED; PG8_LDA(At, 0, 0); PG8_STAGE(PG8_SA(1, 1), a1 + hstep, voffA);
            PG8_WAIT_V(8); PG8_WAIT_L(0); PG8_BAR; PG8_MMA(0, 0, At, B0); PG8_MMA(0, 1, At, B1); PG8_BAR; PG8_SCHED;
            PG8_LDA(At, 0, 1); PG8_STAGE(PG8_SB(0, 0), b2, voffB); PG8_STAGE(PG8_SB(0, 1), b2 + hstep, voffB); PG8_STAGE(PG8_SA(0, 0), a2, voffA);
            PG8_WAIT_V(8); PG8_WAIT_L(0); PG8_BAR; PG8_MMA(1, 0, At, B0); PG8_MMA(1, 1, At, B1); PG8_BAR; PG8_SCHED;
            PG8_LDB(B0, 1, 0); PG8_LDB(B1, 1, 1); PG8_SCHED; PG8_LDA(At, 1, 0); PG8_STAGE(PG8_SA(0, 1), a2 + hstep, voffA);
            PG8_WAIT_V(8); PG8_WAIT_L(0); PG8_BAR; PG8_MMA(0, 0, At, B0); PG8_MMA(0, 1, At, B1); PG8_BAR; PG8_SCHED;
            PG8_LDA(At, 1, 1); PG8_STAGE(PG8_SB(1, 0), b3, voffB); PG8_STAGE(PG8_SB(1, 1), b3 + hstep, voffB); PG8_STAGE(PG8_SA(1, 0), a3, voffA);
            PG8_WAIT_V(8); PG8_WAIT_L(0); PG8_BAR; PG8_MMA(1, 0, At, B0); PG8_MMA(1, 1, At, B1); PG8_BAR; PG8_SCHED;
            } else {
            PG8_LDB(B0, 0, 0); PG8_SCHED; PG8_LDA(At, 0, 0); PG8_STAGE(PG8_SA(1, 1), a1 + hstep, voffA);
            PG8_WAIT_L(8); PG8_BAR; PG8_WAIT_L(0); PG8_MMA(0, 0, At, B0); PG8_BAR; PG8_SCHED;
            PG8_LDB(B1, 0, 1); PG8_STAGE(PG8_SB(0, 0), b2, voffB);
            PG8_BAR; PG8_WAIT_L(0); PG8_MMA(0, 1, At, B1); PG8_BAR;
            PG8_LDA(At, 0, 1); PG8_STAGE(PG8_SA(0, 0), a2, voffA);
            PG8_BAR; PG8_WAIT_L(0); PG8_MMA(1, 0, At, B0); PG8_BAR; PG8_SCHED;
            PG8_STAGE(PG8_SB(0, 1), b2 + hstep, voffB);
            PG8_WAIT_V(6); PG8_BAR; PG8_MMA(1, 1, At, B1); PG8_BAR;
            PG8_LDB(B0, 1, 0); PG8_SCHED; PG8_LDA(At, 1, 0); PG8_STAGE(PG8_SA(0, 1), a2 + hstep, voffA);
            PG8_WAIT_L(8); PG8_BAR; PG8_WAIT_L(0); PG8_MMA(0, 0, At, B0); PG8_BAR; PG8_SCHED;
            PG8_LDB(B1, 1, 1); PG8_STAGE(PG8_SB(1, 0), b3, voffB);
            PG8_BAR; PG8_WAIT_L(0); PG8_MMA(0, 1, At, B1); PG8_BAR;
            PG8_LDA(At, 1, 1); PG8_STAGE(PG8_SA(1, 0), a3, voffA);
            PG8_BAR; PG8_WAIT_L(0); PG8_MMA(1, 0, At, B0); PG8_BAR; PG8_SCHED;
            PG8_STAGE(PG8_SB(1, 1), b3 + hstep, voffB);
            PG8_WAIT_V(6); PG8_BAR; PG8_MMA(1, 1, At, B1); PG8_BAR;
            }
        }
        if constexpr (ALIGN_EPI) { if (wr == 0) PG8_BAR; }
        if constexpr (!Epi::AFTER_DRAIN) { E(acc, cur, wr, wc, fr, fq); S.done(cur); }
        if (!has_next) break;
#pragma unroll
        for (int a = 0; a < 2; ++a)
#pragma unroll
            for (int b = 0; b < 2; ++b)
#pragma unroll
                for (int m = 0; m < 4; ++m)
#pragma unroll
                    for (int n = 0; n < 2; ++n) acc[a][b][m][n] = (f32x4){0.f, 0.f, 0.f, 0.f};
        cur = nxt; cA = nA; cB = nB; ++ui;
        if constexpr (ALIGN_EPI) { if (wr == 1) PG8_BAR; }
    }
    PG8_WAIT_V(0);
    if constexpr (!ALIGN_EPI) { if (wr == 0) PG8_BAR; }
    PG8_BAR;
    if constexpr (Epi::AFTER_DRAIN) { E.fused(acc, cur, wr, wc, fr, fq, lds, wid, lane); S.done(cur); }
#undef PG8_SA
#undef PG8_SB
#undef PG8_STAGE
#undef PG8_LDA
#undef PG8_LDB
#undef PG8_MMA
#undef PG8_WAIT_V
#undef PG8_WAIT_L
#undef PG8_BAR
#undef PG8_SCHED
}
}
#define GAS __attribute__((address_space(1)))
#define LAS __attribute__((address_space(3)))
typedef unsigned short bf16;
typedef unsigned v4u __attribute__((ext_vector_type(4)));
typedef float f32x4 __attribute__((ext_vector_type(4)));
typedef short bf16x8 __attribute__((ext_vector_type(8)));
typedef GAS unsigned gu32;
typedef GAS unsigned long long gu64;
#define RLX_AGENT __ATOMIC_RELAXED, __HIP_MEMORY_SCOPE_AGENT
#define LDS_WAIT() asm volatile("s_waitcnt lgkmcnt(0)" ::: "memory")
#define VM_WAIT() asm volatile("s_waitcnt vmcnt(0)" ::: "memory")
__device__ __forceinline__ unsigned long long rt() { return __builtin_amdgcn_s_memrealtime(); }
__device__ __forceinline__ unsigned f2bf(float f) { unsigned u = __builtin_bit_cast(unsigned, f); return (u + 0x7fffu + ((u >> 16) & 1u)) >> 16; }
__device__ __forceinline__ unsigned pk2(float lo, float hi) { return f2bf(lo) | (f2bf(hi) << 16); }

#define XB_TMO      128
#define XB_XCNT(j)  (256  + 64 * (j))
#define XB_XSUB(j)  (1280 + 64 * (j))
#define XB_XGEN(j)  (2304 + 64 * (j))
#define XB_TOP      3328
#define XB_TOPGEN   3392
#define XCD_BAR_WORDS 3456
#define XB_SPIN_CAP (1u << 18)

__device__ __forceinline__ unsigned xb_ld(unsigned* p)              { return __hip_atomic_load(p, __ATOMIC_RELAXED, __HIP_MEMORY_SCOPE_AGENT); }
__device__ __forceinline__ unsigned xb_add(unsigned* p, unsigned v) { return __hip_atomic_fetch_add(p, v, __ATOMIC_RELAXED, __HIP_MEMORY_SCOPE_AGENT); }
__device__ __forceinline__ unsigned xb_xcc_id() { return (unsigned)__builtin_amdgcn_s_getreg((3 << 11) | 20) & 0xFu; }
#define XB_SPIN(cond, bar) do { unsigned _sp = 0; while (cond) { __builtin_amdgcn_s_sleep(1); \
    if ((++_sp & 255u) == 0u) { if (xb_ld(&(bar)[XB_TMO])) break; if (_sp > XB_SPIN_CAP) { atomicAdd(&(bar)[XB_TMO], 1u); break; } } } } while (0)

struct XcdBarrier {
    unsigned* bar; unsigned x;
    volatile LAS unsigned* st;
};

__device__ __forceinline__ XcdBarrier xcd_barrier_post(unsigned* bar, volatile LAS unsigned* st) {
    XcdBarrier b; b.bar = bar; b.x = xb_xcc_id(); b.st = st;
    if (threadIdx.x == 0) (void)xb_add(&bar[XB_XCNT(b.x)], 1u);
    return b;
}
__device__ __forceinline__ void xcd_barrier_complete(unsigned* bar, unsigned x, unsigned& nloc, unsigned& nx) {
    const unsigned G = gridDim.x * gridDim.y * gridDim.z;
    unsigned sum, cnt, mine, sp = 0u;
    for (;;) {
        sum = 0u; cnt = 0u; mine = 0u;
#pragma unroll
        for (unsigned j = 0; j < 16; ++j) { const unsigned c = xb_ld(&bar[XB_XCNT(j)]); sum += c; cnt += (c > 0u) ? 1u : 0u; mine = (j == x) ? c : mine; }
        if (sum == G) break;
        __builtin_amdgcn_s_sleep(1);
        if ((++sp & 255u) == 0u) { if (xb_ld(&bar[XB_TMO])) break; if (sp > XB_SPIN_CAP) { atomicAdd(&bar[XB_TMO], 1u); break; } }
    }
    nloc = mine > 0u ? mine : 1u; nx = cnt > 0u ? cnt : 1u;
}

__device__ __forceinline__ void xcd_barrier(const XcdBarrier& b) {
    asm volatile("s_waitcnt vmcnt(0)" ::: "memory");
    __syncthreads();
    if (threadIdx.x == 0) {
        unsigned* bar = b.bar;
        __builtin_amdgcn_s_waitcnt(0);
        unsigned nloc = b.st[0], nx = b.st[1];
        if (nloc == 0u) { xcd_barrier_complete(bar, b.x, nloc, nx); b.st[0] = nloc; b.st[1] = nx; }
        const unsigned old = xb_add(&bar[XB_XSUB(b.x)], 1u);
        const unsigned gen = old / nloc;
        if (old + 1u == (gen + 1u) * nloc) {
            __builtin_amdgcn_fence(__ATOMIC_RELEASE, "agent");
            asm volatile("s_waitcnt vmcnt(0)" ::: "memory");
            const unsigned og = xb_add(&bar[XB_TOP], 1u);
            const unsigned tg = og / nx;
            if (og + 1u == (tg + 1u) * nx) xb_add(&bar[XB_TOPGEN], 1u);
            else XB_SPIN(xb_ld(&bar[XB_TOPGEN]) == tg, bar);
            __builtin_amdgcn_fence(__ATOMIC_ACQUIRE, "agent");
            xb_add(&bar[XB_XGEN(b.x)], 1u);
            asm volatile("s_waitcnt vmcnt(0)" ::: "memory");
        } else {
            XB_SPIN(xb_ld(&bar[XB_XGEN(b.x)]) == gen, bar);
            __builtin_amdgcn_fence(__ATOMIC_ACQUIRE, "agent");
            asm volatile("s_waitcnt vmcnt(0)" ::: "memory");
        }
    }
    __syncthreads();
}

typedef float f32x16 __attribute__((ext_vector_type(16)));
typedef short v4i16_t __attribute__((ext_vector_type(4)));
typedef float f32x2_t __attribute__((ext_vector_type(2)));
typedef __bf16 bf16x2_t __attribute__((ext_vector_type(2)));
typedef int i32x4 __attribute__((ext_vector_type(4)));
typedef unsigned u32x2 __attribute__((ext_vector_type(2)));

constexpr int NWAVES = 8, NTHR = 512;
constexpr int BATCH = 32, SEQ = 2048, DM = 1024, NTOK = BATCH * SEQ;
constexpr int NIN = 3088, NPROJ = 3328, NQP = 2048, NMOD = 6144;
constexpr int C_DQ = 0, C_DK = 512, C_DV = 1024, C_GQ = 1536, C_GK = 1792, C_GV = 2048, C_GR = 2560, C_GG = 3072;
constexpr int NEXP = 16384;
constexpr float RMS_EPS = 1e-6f;
constexpr float LAMBDA_INIT = 0.2f;
constexpr float QSCALE = 0.125f * 1.4426950408889634f;

constexpr size_t MiB = 1u << 20;
constexpr size_t WS_CTL = 0, CTL_ZERO_BYTES = 1 * MiB;
constexpr size_t WS_WIN_T = 2 * MiB;
constexpr size_t WS_WOUT_T = 10 * MiB;
constexpr size_t WS_WQ_T = 12 * MiB;
constexpr size_t WS_KEYS = 16 * MiB;
constexpr size_t WS_MOD = 17 * MiB;
constexpr size_t WS_COS = 32 * MiB;
constexpr size_t WS_SIN = 40 * MiB;
constexpr size_t WS_EU = 64 * MiB;
constexpr size_t WS_EV = 96 * MiB;
constexpr size_t WS_H = 128 * MiB;
constexpr size_t WS_PROJ = 256 * MiB;
constexpr size_t WS_Y = 672 * MiB;
constexpr size_t WS_EIDX = 800 * MiB;
constexpr size_t WS_EG = 832 * MiB;
constexpr size_t WS_END = 864 * MiB;
constexpr int CW_TMO = 0, CW_Q = 64, CW_BAR = 4096;

constexpr int LDS_BYTES = 163840;
constexpr int MISC_OFF = LDS_BYTES - 256;

struct Ctx {
    LAS unsigned char* lds;
    volatile LAS unsigned* MISC;
    gu32* ctl;
    int tid, lane, wave, vcu, G;
    const float* in[25];
    float* out; unsigned char* ws;
};

__device__ __forceinline__ float wave_sum(float v) {
#pragma unroll
    for (int o = 1; o < 64; o <<= 1) v += __shfl_xor(v, o);
    return v;
}
__device__ __forceinline__ unsigned cvtpk(float lo, float hi) { f32x2_t v = {lo, hi}; bf16x2_t b = __builtin_convertvector(v, bf16x2_t); return __builtin_bit_cast(unsigned, b); }
__device__ __forceinline__ float bf_lo(unsigned w) { return __uint_as_float(w << 16); }
__device__ __forceinline__ float bf_hi(unsigned w) { return __uint_as_float(w & 0xffff0000u); }
__device__ __forceinline__ int crow(int r, int hi) { return (r & 3) + 8 * (r >> 2) + 4 * hi; }
__device__ __forceinline__ float pair_max(float m) { auto rr = __builtin_amdgcn_permlane32_swap(__float_as_uint(m), __float_as_uint(m), false, false); return fmaxf(__uint_as_float(rr[0]), __uint_as_float(rr[1])); }
__device__ __forceinline__ float pair_sum(float m) { auto rr = __builtin_amdgcn_permlane32_swap(__float_as_uint(m), __float_as_uint(m), false, false); return __uint_as_float(rr[0]) + __uint_as_float(rr[1]); }
__device__ __forceinline__ int pair_maxi(int m) { auto rr = __builtin_amdgcn_permlane32_swap((unsigned)m, (unsigned)m, false, false); const int a = (int)rr[0], b = (int)rr[1]; return a > b ? a : b; }
__device__ __forceinline__ v4i16_t tr16(LAS const unsigned char* p) { return __builtin_amdgcn_ds_read_tr16_b64_v4i16((LAS v4i16_t*)p); }
__device__ __forceinline__ bf16x8 mk8(v4i16_t a, v4i16_t b) { return (bf16x8){a[0], a[1], a[2], a[3], b[0], b[1], b[2], b[3]}; }
#define MFMA32(a, b, c) __builtin_amdgcn_mfma_f32_32x32x16_bf16((a), (b), (c), 0, 0, 0)

__device__ __forceinline__ void p0_transpose_item(const float* W, int K, int ldw, int nblk, bf16* WT, LAS float* scr, int item, int lane) {
    const int kb = item / nblk, nb = item % nblk, k0 = 64 * kb, n0 = 32 * nb;
#pragma unroll 8
    for (int i = 0; i < 32; ++i) { const int kk = 2 * i + (lane >> 5); scr[kk * 33 + (lane & 31)] = W[(size_t)(k0 + kk) * ldw + n0 + (lane & 31)]; }
    LDS_WAIT(); asm volatile("" ::: "memory");
    const int c = lane & 7;
#pragma unroll
    for (int j = 0; j < 4; ++j) { const int n = (lane >> 3) + 8 * j; const LAS float* s = scr + (8 * c) * 33 + n;
        v4u o; o.x = pk2(s[0 * 33], s[1 * 33]); o.y = pk2(s[2 * 33], s[3 * 33]); o.z = pk2(s[4 * 33], s[5 * 33]); o.w = pk2(s[6 * 33], s[7 * 33]);
        *(GAS v4u*)(WT + (size_t)(n0 + n) * K + k0 + 8 * c) = o; }
    LDS_WAIT(); asm volatile("" ::: "memory");
}

__device__ __forceinline__ void mod_gemv(Ctx& C) {
    const float* cc = C.in[1]; const float* w_ada = C.in[3]; const float* b_ada = C.in[4]; float* mod = (float*)(C.ws + WS_MOD);
    LAS float* sc = (LAS float*)C.lds;
    LAS float* red = (LAS float*)(C.lds + 32768);
    const int col0 = C.vcu * 32, col = C.tid & 31, ks = C.tid >> 5;
    float acc[32];
#pragma unroll
    for (int i = 0; i < 32; ++i) acc[i] = 0.f;
    for (int kt = 0; kt < 4; ++kt) {
        for (int idx = C.tid; idx < 8192; idx += NTHR) { const int kk = idx >> 5, b = idx & 31; const float v = cc[b * 1024 + kt * 256 + kk]; sc[idx] = v / (1.f + __expf(-v)); }
        __syncthreads();
#pragma unroll 4
        for (int k2 = 0; k2 < 16; ++k2) { const int k = ks * 16 + k2; const float w = w_ada[(size_t)(kt * 256 + k) * NMOD + col0 + col];
#pragma unroll
            for (int b4 = 0; b4 < 8; ++b4) { const f32x4 f = *(const LAS f32x4*)(sc + k * 32 + 4 * b4);
                acc[4 * b4 + 0] += w * f.x; acc[4 * b4 + 1] += w * f.y; acc[4 * b4 + 2] += w * f.z; acc[4 * b4 + 3] += w * f.w; } }
        __syncthreads();
    }
#pragma unroll
    for (int b = 0; b < 32; ++b) red[(ks * 32 + b) * 32 + col] = acc[b];
    __syncthreads();
#pragma unroll
    for (int oo = 0; oo < 2; ++oo) { const int o = C.tid + oo * NTHR, c_ = o & 31, b = o >> 5; float s = 0.f;
#pragma unroll
        for (int k = 0; k < 16; ++k) s += red[(k * 32 + b) * 32 + c_];
        mod[b * NMOD + col0 + c_] = s + b_ada[col0 + c_]; }
    __syncthreads();
}

__device__ __forceinline__ void phase0(Ctx& C) {
    if (C.vcu < 192) mod_gemv(C);
    bf16* WinT = (bf16*)(C.ws + WS_WIN_T); bf16* WoutT = (bf16*)(C.ws + WS_WOUT_T); bf16* WqT = (bf16*)(C.ws + WS_WQ_T);
    const float* w_in = C.in[6];
    {
        LAS float* scr = (LAS float*)(C.lds + C.wave * 16384);
        const int gw = C.vcu * NWAVES + C.wave, NGW = C.G * NWAVES;
        constexpr int I_IN = 16 * 96, I_OUT = 16 * 32, I_Q = 16 * 64;
        for (int it = gw; it < I_IN + I_OUT + I_Q; it += NGW) {
            int r = it;
            if (r < I_IN) { p0_transpose_item(w_in, 1024, NIN, 96, WinT, scr, r, C.lane); continue; } r -= I_IN;
            if (r < I_OUT) { p0_transpose_item(C.in[17], 1024, 1024, 32, WoutT, scr, r, C.lane); continue; } r -= I_OUT;
            p0_transpose_item(C.in[19], 1024, 2048, 64, WqT, scr, r, C.lane);
        }
    }
    const int gt = C.vcu * NTHR + C.tid, NGT = C.G * NTHR;
    {
        const float* wg2 = C.in[14];
        for (int it = gt; it < 256 * 128; it += NGT) { const int j = it >> 7, kc = it & 127; float g[16];
#pragma unroll
            for (int r = 0; r < 16; ++r) g[r] = wg2[r * 256 + j];
            float o[8];
#pragma unroll
            for (int i = 0; i < 8; ++i) { const float* wr = w_in + (size_t)(8 * kc + i) * NIN + 3072; float s = 0.f;
#pragma unroll
                for (int r4 = 0; r4 < 4; ++r4) { const f32x4 w4 = *(const f32x4*)(wr + 4 * r4); s += w4.x * g[4 * r4] + w4.y * g[4 * r4 + 1] + w4.z * g[4 * r4 + 2] + w4.w * g[4 * r4 + 3]; }
                o[i] = s; }
            v4u ov; ov.x = pk2(o[0], o[1]); ov.y = pk2(o[2], o[3]); ov.z = pk2(o[4], o[5]); ov.w = pk2(o[6], o[7]);
            *(GAS v4u*)(WinT + (size_t)(3072 + j) * 1024 + 8 * kc) = ov; }
    }
    {
        bf16* KB = (bf16*)(C.ws + WS_KEYS);
        for (int it = gt; it < 4096; it += NGT) { const float* src = (it < 2048 ? C.in[21] : C.in[22]) + (size_t)(it & 2047) * 8;
            const f32x4 a = *(const f32x4*)src, b = *(const f32x4*)(src + 4);
            v4u ov; ov.x = pk2(a.x, a.y); ov.y = pk2(a.z, a.w); ov.z = pk2(b.x, b.y); ov.w = pk2(b.z, b.w);
            *(GAS v4u*)(KB + (size_t)it * 8) = ov; }
    }
    {
        const float* eu = C.in[23]; const float* ev = C.in[24]; bf16* EU = (bf16*)(C.ws + WS_EU); bf16* EV = (bf16*)(C.ws + WS_EV);
        constexpr int NI = NEXP * 1024 / 8;
        for (int it = gt; it < 2 * NI; it += NGT) { const bool second = it >= NI; const int i2 = second ? it - NI : it;
            const float* src = (second ? ev : eu) + (size_t)i2 * 8; bf16* dst = (second ? EV : EU) + (size_t)i2 * 8;
            const f32x4 a = *(const f32x4*)src, b = *(const f32x4*)(src + 4);
            v4u ov; ov.x = pk2(a.x, a.y); ov.y = pk2(a.z, a.w); ov.z = pk2(b.x, b.y); ov.w = pk2(b.z, b.w);
            *(GAS v4u*)dst = ov; }
    }
}

__device__ __forceinline__ void norm_mod_row(const float* xrow, const float* g, const float* sc, const float* sh, bf16* orow, int lane) {
    const GAS f32x4* xr = (const GAS f32x4*)xrow + lane;
    f32x4 v[4]; float s = 0.f;
#pragma unroll
    for (int j = 0; j < 4; ++j) { v[j] = xr[64 * j]; s += (v[j].x * v[j].x + v[j].y * v[j].y) + (v[j].z * v[j].z + v[j].w * v[j].w); }
    const float rinv = 1.0f / sqrtf(wave_sum(s) * (1.f / 1024.f) + RMS_EPS);
    GAS unsigned long long* o8 = (GAS unsigned long long*)orow + lane;
#pragma unroll
    for (int j = 0; j < 4; ++j) { const f32x4 g4 = ((const f32x4*)g)[64 * j + lane], s4 = ((const f32x4*)sc)[64 * j + lane], h4 = ((const f32x4*)sh)[64 * j + lane];
        const f32x4 y = v[j] * rinv * g4 * (s4 + 1.0f) + h4;
        o8[64 * j] = (unsigned long long)cvtpk(y.x, y.y) | ((unsigned long long)cvtpk(y.z, y.w) << 32); }
}
__device__ __forceinline__ void phase1(Ctx& C) {
    const float* x = C.in[0]; const int* pos = (const int*)C.in[2]; const float* g = C.in[5]; const float* mod = (const float*)(C.ws + WS_MOD);
    bf16* H = (bf16*)(C.ws + WS_H); float* COS = (float*)(C.ws + WS_COS); float* SIN = (float*)(C.ws + WS_SIN);
    const int gw = C.vcu * NWAVES + C.wave, NGW = C.G * NWAVES;
    const float invf = __builtin_amdgcn_exp2f(-(float)(C.lane & 31) * 0.41524101186092029f);
    for (int m = gw; m < NTOK; m += NGW) { const int b = m >> 11;
        norm_mod_row(x + (size_t)m * DM, g, mod + b * NMOD + 1024, mod + b * NMOD, H + (size_t)m * DM, C.lane);
        if (C.lane < 32) { const float ang = (float)pos[m] * invf; const double rev = (double)ang * 0.15915494309189535; const float fr = (float)(rev - floor(rev));
            COS[(size_t)m * 32 + C.lane] = __builtin_amdgcn_cosf(fr); SIN[(size_t)m * 32 + C.lane] = __builtin_amdgcn_sinf(fr); } }
}
__device__ __forceinline__ void phase5(Ctx& C) {
    const float* x1 = C.out; const float* g = C.in[18]; const float* mod = (const float*)(C.ws + WS_MOD); bf16* H = (bf16*)(C.ws + WS_H);
    const int gw = C.vcu * NWAVES + C.wave, NGW = C.G * NWAVES;
    for (int m = gw; m < NTOK; m += NGW) { const int b = m >> 11;
        norm_mod_row(x1 + (size_t)m * DM, g, mod + b * NMOD + 4 * 1024, mod + b * NMOD + 3 * 1024, H + (size_t)m * DM, C.lane); }
}

__device__ __forceinline__ void phase2b(Ctx& C) {
    bf16* PROJ = (bf16*)(C.ws + WS_PROJ); const float* COS = (const float*)(C.ws + WS_COS); const float* SIN = (const float*)(C.ws + WS_SIN);
    const float* qn = C.in[7]; const float* kn = C.in[8];
    const int gw = C.vcu * NWAVES + C.wave, NGW = C.G * NWAVES, lane = C.lane;
    const int grp = lane >> 2, qd = lane & 3;
    float gain[16];
#pragma unroll
    for (int i = 0; i < 16; ++i) gain[i] = (grp < 8 ? qn : kn)[16 * qd + i] * (grp < 8 ? QSCALE : 1.0f);
    const float sgn = (qd < 2) ? -1.f : 1.f;
    for (int m = gw; m < NTOK; m += NGW) {
        GAS v4u* p = (GAS v4u*)(PROJ + (size_t)m * NPROJ + 16 * lane);
        const v4u w0 = p[0], w1 = p[1];
        float xv[16];
        xv[0] = bf_lo(w0.x); xv[1] = bf_hi(w0.x); xv[2] = bf_lo(w0.y); xv[3] = bf_hi(w0.y); xv[4] = bf_lo(w0.z); xv[5] = bf_hi(w0.z); xv[6] = bf_lo(w0.w); xv[7] = bf_hi(w0.w);
        xv[8] = bf_lo(w1.x); xv[9] = bf_hi(w1.x); xv[10] = bf_lo(w1.y); xv[11] = bf_hi(w1.y); xv[12] = bf_lo(w1.z); xv[13] = bf_hi(w1.z); xv[14] = bf_lo(w1.w); xv[15] = bf_hi(w1.w);
        float ss = 0.f;
#pragma unroll
        for (int i = 0; i < 16; ++i) ss += xv[i] * xv[i];
        ss += __shfl_xor(ss, 1); ss += __shfl_xor(ss, 2);
        const float rinv = 1.0f / sqrtf(ss * (1.f / 64.f) + RMS_EPS);
        const f32x4* cp = (const f32x4*)(COS + (size_t)m * 32 + 16 * (qd & 1)); const f32x4* sp = (const f32x4*)(SIN + (size_t)m * 32 + 16 * (qd & 1));
        float cs[16], sn[16];
#pragma unroll
        for (int i = 0; i < 4; ++i) { const f32x4 c4 = cp[i], s4 = sp[i]; cs[4 * i] = c4.x; cs[4 * i + 1] = c4.y; cs[4 * i + 2] = c4.z; cs[4 * i + 3] = c4.w; sn[4 * i] = s4.x; sn[4 * i + 1] = s4.y; sn[4 * i + 2] = s4.z; sn[4 * i + 3] = s4.w; }
        float y[16];
#pragma unroll
        for (int i = 0; i < 16; ++i) { const float v = xv[i] * rinv * gain[i]; const float pv = __shfl_xor(v, 2); y[i] = v * cs[i] + sgn * pv * sn[i]; }
        v4u o0, o1;
        o0.x = cvtpk(y[0], y[1]); o0.y = cvtpk(y[2], y[3]); o0.z = cvtpk(y[4], y[5]); o0.w = cvtpk(y[6], y[7]);
        o1.x = cvtpk(y[8], y[9]); o1.y = cvtpk(y[10], y[11]); o1.z = cvtpk(y[12], y[13]); o1.w = cvtpk(y[14], y[15]);
        p[0] = o0; p[1] = o1;
    }
}

constexpr int AT_KP = 144, AT_VP = 320;
constexpr int AT_K1 = 64 * AT_KP, AT_V = 2 * 64 * AT_KP, AT_STG = AT_V + 64 * AT_VP;
constexpr int AT_XP = 129;

__device__ __forceinline__ void attn_unit(Ctx& C, int bh, int qb, float lam) {
    const int b = bh >> 2, h = bh & 3;
    const int tid = C.tid, lane = C.lane, w = C.wave, r32 = lane & 31, hi = lane >> 5, mp = w >> 2, wq = w & 3;
    const bf16* P = (const bf16*)(C.ws + WS_PROJ) + (size_t)(b * SEQ) * NPROJ;
    const int NT = 2 * qb + 2;
    const int krow = tid >> 3, kch = tid & 7, vrow = tid >> 4, vch = tid & 15;
    const bf16* gk = P + (size_t)krow * NPROJ + C_DK + h * 128 + 8 * kch;
    const bf16* gv = P + (size_t)vrow * NPROJ + C_DV + h * 128 + 8 * vch;
    v4u sk0, sk1, sv0, sv1;
#define AT_LOAD(t) do { const size_t o_ = (size_t)(t) * 64 * NPROJ; sk0 = *(const GAS v4u*)(gk + o_); sk1 = *(const GAS v4u*)(gk + o_ + 64); \
        sv0 = *(const GAS v4u*)(gv + o_); sv1 = *(const GAS v4u*)(gv + o_ + (size_t)32 * NPROJ); } while (0)
#define AT_STORE(s) do { LAS unsigned char* bs_ = C.lds + (s) * AT_STG; *(LAS v4u*)(bs_ + krow * AT_KP + kch * 16) = sk0; *(LAS v4u*)(bs_ + AT_K1 + krow * AT_KP + kch * 16) = sk1; \
        *(LAS v4u*)(bs_ + AT_V + vrow * AT_VP + vch * 16) = sv0; *(LAS v4u*)(bs_ + AT_V + (vrow + 32) * AT_VP + vch * 16) = sv1; } while (0)
    AT_LOAD(0);
    const int qrow = qb * 128 + wq * 32 + r32;
    bf16x8 qf[4];
#pragma unroll
    for (int kk = 0; kk < 4; ++kk) qf[kk] = *(const GAS bf16x8*)(P + (size_t)qrow * NPROJ + C_DQ + h * 128 + mp * 64 + 16 * kk + 8 * hi);
    f32x16 o[4];
#pragma unroll
    for (int e = 0; e < 4; ++e)
#pragma unroll
        for (int r = 0; r < 16; ++r) o[e][r] = 0.f;
    float mrun = -1e30f, lrun = 0.f;
    AT_STORE(0);
    __syncthreads();
    const int trbase = ((lane & 15) >> 2) * AT_VP + (16 * ((lane >> 4) & 1) + 4 * (lane & 3)) * 2;
    for (int t = 0; t < NT; ++t) {
        if (t + 1 < NT) AT_LOAD(t + 1);
        const LAS unsigned char* base = C.lds + (t & 1) * AT_STG;
        f32x16 p0, p1;
#pragma unroll
        for (int r = 0; r < 16; ++r) { p0[r] = 0.f; p1[r] = 0.f; }
        const LAS unsigned char* kb_ = base + mp * AT_K1 + r32 * AT_KP + hi * 16;
#pragma unroll
        for (int kk = 0; kk < 4; ++kk) { const bf16x8 a0 = *(const LAS bf16x8*)(kb_ + kk * 32), a1 = *(const LAS bf16x8*)(kb_ + 32 * AT_KP + kk * 32);
            p0 = MFMA32(a0, qf[kk], p0); p1 = MFMA32(a1, qf[kk], p1); }
        if (t >= 2 * qb) {
#pragma unroll
            for (int r = 0; r < 16; ++r) { const int key = 64 * t + crow(r, hi); if (key > qrow) p0[r] = -1e30f; if (key + 32 > qrow) p1[r] = -1e30f; }
        }
        float mx = fmaxf(p0[0], p1[0]);
#pragma unroll
        for (int r = 1; r < 16; ++r) mx = fmaxf(mx, fmaxf(p0[r], p1[r]));
        mx = pair_max(mx);
        const float mnew = fmaxf(mrun, mx), alpha = __builtin_amdgcn_exp2f(mrun - mnew); mrun = mnew;
        float rs = 0.f;
#pragma unroll
        for (int r = 0; r < 16; ++r) { p0[r] = __builtin_amdgcn_exp2f(p0[r] - mnew); p1[r] = __builtin_amdgcn_exp2f(p1[r] - mnew); rs += p0[r] + p1[r]; }
        lrun = lrun * alpha + rs;
#pragma unroll
        for (int e = 0; e < 4; ++e)
#pragma unroll
            for (int r = 0; r < 16; ++r) o[e][r] *= alpha;
        bf16x8 pw[4];
        { v4u t0, t1, t2, t3;
          t0.x = cvtpk(p0[0], p0[1]); t0.y = cvtpk(p0[2], p0[3]); t0.z = cvtpk(p0[4], p0[5]); t0.w = cvtpk(p0[6], p0[7]);
          t1.x = cvtpk(p0[8], p0[9]); t1.y = cvtpk(p0[10], p0[11]); t1.z = cvtpk(p0[12], p0[13]); t1.w = cvtpk(p0[14], p0[15]);
          t2.x = cvtpk(p1[0], p1[1]); t2.y = cvtpk(p1[2], p1[3]); t2.z = cvtpk(p1[4], p1[5]); t2.w = cvtpk(p1[6], p1[7]);
          t3.x = cvtpk(p1[8], p1[9]); t3.y = cvtpk(p1[10], p1[11]); t3.z = cvtpk(p1[12], p1[13]); t3.w = cvtpk(p1[14], p1[15]);
          pw[0] = __builtin_bit_cast(bf16x8, t0); pw[1] = __builtin_bit_cast(bf16x8, t1); pw[2] = __builtin_bit_cast(bf16x8, t2); pw[3] = __builtin_bit_cast(bf16x8, t3); }
        const LAS unsigned char* vb_ = base + AT_V + trbase + (4 * hi) * AT_VP;
#pragma unroll
        for (int e = 0; e < 4; ++e)
#pragma unroll
            for (int s = 0; s < 4; ++s) { const LAS unsigned char* a_ = vb_ + (16 * s) * AT_VP + e * 64;
                const v4i16_t lo = tr16(a_), hi4 = tr16(a_ + 8 * AT_VP);
                o[e] = MFMA32(mk8(lo, hi4), pw[s], o[e]); }
        if (t + 1 < NT) AT_STORE((t + 1) & 1);
        __syncthreads();
    }
    lrun = pair_sum(lrun);
    const float linv = 1.0f / lrun;
    LAS float* xch = (LAS float*)C.lds;
    if (mp == 1) {
#pragma unroll
        for (int e = 0; e < 4; ++e)
#pragma unroll
            for (int r = 0; r < 16; ++r) xch[(wq * 32 + r32) * AT_XP + 32 * e + crow(r, hi)] = o[e][r] * linv;
    }
    __syncthreads();
    if (mp == 0) {
        const float* sg = C.in[13];
        float ss = 0.f;
#pragma unroll
        for (int e = 0; e < 4; ++e)
#pragma unroll
            for (int r = 0; r < 16; ++r) { const float v = o[e][r] * linv - lam * xch[(wq * 32 + r32) * AT_XP + 32 * e + crow(r, hi)]; o[e][r] = v; ss += v * v; }
        ss = pair_sum(ss);
        const float rinv = (1.0f - LAMBDA_INIT) / sqrtf(ss * (1.f / 128.f) + RMS_EPS);
        bf16* Y = (bf16*)(C.ws + WS_Y) + (size_t)(b * SEQ + qrow) * DM + h * 128;
#pragma unroll
        for (int e = 0; e < 4; ++e)
#pragma unroll
            for (int g = 0; g < 4; ++g) { const int ec = 32 * e + 8 * g + 4 * hi; const f32x4 g4 = *(const f32x4*)(sg + ec);
                u32x2 ov; ov.x = cvtpk(o[e][4 * g] * rinv * g4.x, o[e][4 * g + 1] * rinv * g4.y); ov.y = cvtpk(o[e][4 * g + 2] * rinv * g4.z, o[e][4 * g + 3] * rinv * g4.w);
                *(GAS u32x2*)(Y + ec) = ov; }
    }
    __syncthreads();
#undef AT_LOAD
#undef AT_STORE
}

constexpr int GL_BC = 0;
constexpr int GL_QE = 17408, GL_KE = GL_QE + 9216, GL_QS = GL_KE + 9216, GL_AM = GL_QS + 9216;
constexpr int GL_KD = GL_AM + 9216;
constexpr int GL_V = GL_KD + 12288;
constexpr int GL_SB = GL_V + 20480;
constexpr int GL_O = GL_SB + 20480;
constexpr int GL_SM = GL_O + 33792;
constexpr int GL_END = GL_SM + 768 + 2048;
static_assert(GL_END <= MISC_OFF, "GLA LDS map");

__device__ __forceinline__ void gla_unit(Ctx& C, int bh) {
    const int b = bh >> 2, h = bh & 3;
    const int tid = C.tid, lane = C.lane, w = C.wave, r32 = lane & 31, hi = lane >> 5;
    const bf16* P = (const bf16*)(C.ws + WS_PROJ) + (size_t)(b * SEQ) * NPROJ;
    bf16* Y = (bf16*)(C.ws + WS_Y) + (size_t)(b * SEQ) * DM + 512 + h * 128;
    LAS unsigned char* L = C.lds;
    LAS float* BC = (LAS float*)(L + GL_BC); LAS float* BMID = (LAS float*)(L + GL_SM); LAS float* BLAST = BMID + 64; LAS float* DEC = BMID + 128; LAS float* SEG = BMID + 192;
    LAS float* OI = (LAS float*)(L + GL_O);
    const float bg = C.in[15][h * 64 + (tid & 63)];
    const int db = w & 1, eb = w >> 1;
    f32x16 S;
#pragma unroll
    for (int r = 0; r < 16; ++r) S[r] = 0.f;
    const int trq = (lane & 15) >> 2, trc = 16 * ((lane >> 4) & 1) + 4 * (lane & 3);
    for (int n = 0; n < 32; ++n) {
        const bf16* Pn = P + (size_t)(n * 64) * NPROJ;
        {   const int d = tid & 63, seg = tid >> 6; float pre[8];
#pragma unroll
            for (int i = 0; i < 8; ++i) { const unsigned short raw = *(const GAS unsigned short*)(Pn + (size_t)(8 * seg + i) * NPROJ + C_GG + h * 64 + d); pre[i] = __uint_as_float((unsigned)raw << 16); }
            float run = 0.f;
#pragma unroll
            for (int i = 0; i < 8; ++i) { const float z = pre[i] + bg; const float ls = fminf(z, 0.f) - log1pf(__expf(-fabsf(z))); run += ls * (1.f / 16.f); pre[i] = run; }
            SEG[seg * 64 + d] = run;
            __syncthreads();
            float off = 0.f;
#pragma unroll
            for (int s = 0; s < 8; ++s) off += (s < seg) ? SEG[s * 64 + d] : 0.f;
#pragma unroll
            for (int i = 0; i < 8; ++i) { const float v = pre[i] + off; BC[(8 * seg + i) * 68 + d] = v;
                if (8 * seg + i == 32) BMID[d] = v;
                if (8 * seg + i == 63) { BLAST[d] = v; DEC[d] = __expf(v); } }
            __syncthreads();
        }
        {   const int c = tid >> 3, d8 = tid & 7;
            const v4u qw = *(const GAS v4u*)(Pn + (size_t)c * NPROJ + C_GQ + h * 64 + 8 * d8), kw = *(const GAS v4u*)(Pn + (size_t)c * NPROJ + C_GK + h * 64 + 8 * d8);
            const unsigned qa[4] = {qw.x, qw.y, qw.z, qw.w}, ka[4] = {kw.x, kw.y, kw.z, kw.w};
            const f32x4 bc0 = *(const LAS f32x4*)(BC + c * 68 + 8 * d8), bc1 = *(const LAS f32x4*)(BC + c * 68 + 8 * d8 + 4);
            const f32x4 bm0 = *(const LAS f32x4*)(BMID + 8 * d8), bm1 = *(const LAS f32x4*)(BMID + 8 * d8 + 4);
            const f32x4 bl0 = *(const LAS f32x4*)(BLAST + 8 * d8), bl1 = *(const LAS f32x4*)(BLAST + 8 * d8 + 4);
            const float bcv[8] = {bc0.x, bc0.y, bc0.z, bc0.w, bc1.x, bc1.y, bc1.z, bc1.w}, bmv[8] = {bm0.x, bm0.y, bm0.z, bm0.w, bm1.x, bm1.y, bm1.z, bm1.w}, blv[8] = {bl0.x, bl0.y, bl0.z, bl0.w, bl1.x, bl1.y, bl1.z, bl1.w};
            float qe[8], ke[8], qs[8], kd[8];
#pragma unroll
            for (int i = 0; i < 8; ++i) { const float q = ((i & 1) ? bf_hi(qa[i >> 1]) : bf_lo(qa[i >> 1])) * 0.125f, k = (i & 1) ? bf_hi(ka[i >> 1]) : bf_lo(ka[i >> 1]);
                qe[i] = q * __expf(bcv[i] - bmv[i]); ke[i] = k * __expf(bmv[i] - bcv[i]); qs[i] = q * __expf(bcv[i]); kd[i] = k * __expf(blv[i] - bcv[i]); }
            v4u o_;
            o_.x = cvtpk(qe[0], qe[1]); o_.y = cvtpk(qe[2], qe[3]); o_.z = cvtpk(qe[4], qe[5]); o_.w = cvtpk(qe[6], qe[7]); *(LAS v4u*)(L + GL_QE + c * 144 + d8 * 16) = o_;
            o_.x = cvtpk(ke[0], ke[1]); o_.y = cvtpk(ke[2], ke[3]); o_.z = cvtpk(ke[4], ke[5]); o_.w = cvtpk(ke[6], ke[7]); *(LAS v4u*)(L + GL_KE + c * 144 + d8 * 16) = o_;
            o_.x = cvtpk(qs[0], qs[1]); o_.y = cvtpk(qs[2], qs[3]); o_.z = cvtpk(qs[4], qs[5]); o_.w = cvtpk(qs[6], qs[7]); *(LAS v4u*)(L + GL_QS + c * 144 + d8 * 16) = o_;
            o_.x = cvtpk(kd[0], kd[1]); o_.y = cvtpk(kd[2], kd[3]); o_.z = cvtpk(kd[4], kd[5]); o_.w = cvtpk(kd[6], kd[7]); *(LAS v4u*)(L + GL_KD + c * 192 + d8 * 16) = o_;
#pragma unroll
            for (int i = 0; i < 2; ++i) { const int idx = tid + i * NTHR, row = idx >> 4, ch = idx & 15;
                *(LAS v4u*)(L + GL_V + row * 320 + ch * 16) = *(const GAS v4u*)(Pn + (size_t)row * NPROJ + C_GV + h * 128 + 8 * ch); }
#pragma unroll
            for (int r = 0; r < 16; ++r) *(LAS unsigned short*)(L + GL_SB + (32 * db + crow(r, hi)) * 320 + (32 * eb + r32) * 2) = (unsigned short)(cvtpk(S[r], 0.f) & 0xffffu);
            __syncthreads();
        }
        if (w < 4) {
            const int cb = w & 1, jb = w >> 1; f32x16 a;
#pragma unroll
            for (int r = 0; r < 16; ++r) a[r] = 0.f;
#pragma unroll
            for (int kk = 0; kk < 4; ++kk) { const bf16x8 fa = *(const LAS bf16x8*)(L + GL_QE + (32 * cb + r32) * 144 + (16 * kk + 8 * hi) * 2), fb = *(const LAS bf16x8*)(L + GL_KE + (32 * jb + r32) * 144 + (16 * kk + 8 * hi) * 2);
                a = MFMA32(fa, fb, a); }
#pragma unroll
            for (int r = 0; r < 16; ++r) { const int cc = 32 * cb + crow(r, hi), jj = 32 * jb + r32; const float v = (jj <= cc) ? a[r] : 0.f;
                *(LAS unsigned short*)(L + GL_AM + cc * 144 + jj * 2) = (unsigned short)(cvtpk(v, 0.f) & 0xffffu); }
        }
        {
#pragma unroll
            for (int r = 0; r < 16; ++r) S[r] *= DEC[32 * db + crow(r, hi)];
#pragma unroll
            for (int kk = 0; kk < 4; ++kk) { const LAS unsigned char* pa = L + GL_KD + (16 * kk + 8 * hi + trq) * 192 + (32 * db + trc) * 2; const LAS unsigned char* pb = L + GL_V + (16 * kk + 8 * hi + trq) * 320 + (32 * eb + trc) * 2;
                const bf16x8 fa = mk8(tr16(pa), tr16(pa + 4 * 192)), fb = mk8(tr16(pb), tr16(pb + 4 * 320));
                S = MFMA32(fa, fb, S); }
        }
        __syncthreads();
        {   const int cb = w & 1; f32x16 a;
#pragma unroll
            for (int r = 0; r < 16; ++r) a[r] = 0.f;
#pragma unroll
            for (int kk = 0; kk < 4; ++kk) { const bf16x8 fa = *(const LAS bf16x8*)(L + GL_AM + (32 * cb + r32) * 144 + (16 * kk + 8 * hi) * 2);
                const LAS unsigned char* pb = L + GL_V + (16 * kk + 8 * hi + trq) * 320 + (32 * eb + trc) * 2;
                a = MFMA32(fa, mk8(tr16(pb), tr16(pb + 4 * 320)), a); }
#pragma unroll
            for (int kk = 0; kk < 4; ++kk) { const bf16x8 fa = *(const LAS bf16x8*)(L + GL_QS + (32 * cb + r32) * 144 + (16 * kk + 8 * hi) * 2);
                const LAS unsigned char* pb = L + GL_SB + (16 * kk + 8 * hi + trq) * 320 + (32 * eb + trc) * 2;
                a = MFMA32(fa, mk8(tr16(pb), tr16(pb + 4 * 320)), a); }
#pragma unroll
            for (int r = 0; r < 16; ++r) OI[(32 * cb + crow(r, hi)) * 132 + 32 * eb + r32] = a[r];
        }
        __syncthreads();
        {   const int c = tid >> 3, e8 = tid & 7; float ov[16];
#pragma unroll
            for (int i = 0; i < 4; ++i) { const f32x4 t4 = *(const LAS f32x4*)(OI + c * 132 + 16 * e8 + 4 * i); ov[4 * i] = t4.x; ov[4 * i + 1] = t4.y; ov[4 * i + 2] = t4.z; ov[4 * i + 3] = t4.w; }
            float ss = 0.f;
#pragma unroll
            for (int i = 0; i < 16; ++i) ss += ov[i] * ov[i];
            ss += __shfl_xor(ss, 1); ss += __shfl_xor(ss, 2); ss += __shfl_xor(ss, 4);
            const float rinv = 1.0f / sqrtf(ss * (1.f / 128.f) + RMS_EPS);
            const GAS v4u* rp = (const GAS v4u*)(Pn + (size_t)c * NPROJ + C_GR + h * 128 + 16 * e8);
            const v4u r0 = rp[0], r1 = rp[1]; const unsigned ra[8] = {r0.x, r0.y, r0.z, r0.w, r1.x, r1.y, r1.z, r1.w};
            const float* gg = C.in[16] + 16 * e8; float y[16];
#pragma unroll
            for (int i = 0; i < 16; ++i) { const float rv = (i & 1) ? bf_hi(ra[i >> 1]) : bf_lo(ra[i >> 1]); y[i] = ov[i] * rinv * gg[i] * (rv / (1.f + __expf(-rv))); }
            v4u o0, o1;
            o0.x = cvtpk(y[0], y[1]); o0.y = cvtpk(y[2], y[3]); o0.z = cvtpk(y[4], y[5]); o0.w = cvtpk(y[6], y[7]);
            o1.x = cvtpk(y[8], y[9]); o1.y = cvtpk(y[10], y[11]); o1.z = cvtpk(y[12], y[13]); o1.w = cvtpk(y[14], y[15]);
            GAS v4u* yp = (GAS v4u*)(Y + (size_t)(n * 64 + c) * DM + 16 * e8); yp[0] = o0; yp[1] = o1;
        }
    }
    __syncthreads();
}

__device__ __forceinline__ void phase3(Ctx& C) {
    float lam;
    {   const float a = C.in[9][C.lane] * C.in[10][C.lane], b2 = C.in[11][C.lane] * C.in[12][C.lane];
        lam = __expf(wave_sum(a)) - __expf(wave_sum(b2)) + LAMBDA_INIT; }
    constexpr int NITEM = 128 + 2048;
    for (;;) {
        if (C.tid == 0) C.MISC[0] = __hip_atomic_fetch_add(C.ctl + CW_Q, 1u, __ATOMIC_RELAXED, __HIP_MEMORY_SCOPE_AGENT);
        __syncthreads();
        const int item = (int)C.MISC[0];
        __syncthreads();
        if (item >= NITEM) break;
        if (item < 128) gla_unit(C, item);
        else { const int idx = item - 128; attn_unit(C, idx & 127, 15 - (idx >> 7), lam); }
    }
}

constexpr int PK_P = 272;
constexpr int PK_BYTES = 128 * PK_P;
template <int N> __device__ __forceinline__ void top16_pair(float (&v)[N], float (&out)[16]) {
#pragma unroll
    for (int k = 0; k < 16; ++k) {
        float m = v[0];
#pragma unroll
        for (int i = 1; i < N; ++i) m = fmaxf(m, v[i]);
        m = pair_max(m); out[k] = m;
#pragma unroll
        for (int i = 0; i < N; ++i) v[i] = (v[i] == m) ? -INFINITY : v[i];
    }
}

__device__ __forceinline__ void peer_scores(Ctx& C, int t0) {
    const int lane = C.lane, w = C.wave, r32 = lane & 31, hi = lane >> 5;
    const bf16* QP = (const bf16*)(C.ws + WS_PROJ);
    int* EIDX = (int*)(C.ws + WS_EIDX); float* EG = (float*)(C.ws + WS_EG);
#pragma unroll 1
    for (int tb = 0; tb < 2; ++tb) {
        const int t = t0 + 32 * tb + r32;
        float tv[2][16];
#pragma unroll 1
        for (int half = 0; half < 2; ++half) {
            bf16x8 qf[8];
#pragma unroll
            for (int kk = 0; kk < 8; ++kk) qf[kk] = *(const GAS bf16x8*)(QP + (size_t)t * NQP + w * 256 + half * 128 + 16 * kk + 8 * hi);
            float sv[64];
#pragma unroll
            for (int kb = 0; kb < 4; ++kb) { f32x16 s;
#pragma unroll
                for (int r = 0; r < 16; ++r) s[r] = 0.f;
#pragma unroll
                for (int kk = 0; kk < 8; ++kk) { const bf16x8 a = *(const LAS bf16x8*)(C.lds + half * PK_BYTES + (32 * kb + r32) * PK_P + (16 * kk + 8 * hi) * 2); s = MFMA32(a, qf[kk], s); }
#pragma unroll
                for (int r = 0; r < 16; ++r) sv[16 * kb + r] = __uint_as_float((__float_as_uint(s[r]) & ~127u) | (unsigned)(32 * kb + crow(r, hi))); }
            float to[16];
            top16_pair<64>(sv, to);
            if (half == 0) {
#pragma unroll
                for (int i = 0; i < 16; ++i) tv[0][i] = to[i];
            } else {
#pragma unroll
                for (int i = 0; i < 16; ++i) tv[1][i] = to[i];
            }
        }
        float cv[25]; int ce[25];
#define PEER_CAND(k, a0, b0, a1, b1) do { const float s0_ = tv[0][a0] + tv[1][b0], s1_ = tv[0][a1] + tv[1][b1]; \
            const int e0_ = (int)(((__float_as_uint(tv[0][a0]) & 127u) << 7) | (__float_as_uint(tv[1][b0]) & 127u)), e1_ = (int)(((__float_as_uint(tv[0][a1]) & 127u) << 7) | (__float_as_uint(tv[1][b1]) & 127u)); \
            const float s_ = hi ? s1_ : s0_; ce[k] = hi ? e1_ : e0_; cv[k] = __uint_as_float((__float_as_uint(s_) & ~63u) | (unsigned)(hi ? 25 + (k) : (k))); } while (0)
        PEER_CAND(0, 0, 0, 2, 1);
        PEER_CAND(1, 0, 1, 2, 2);
        PEER_CAND(2, 0, 2, 2, 3);
        PEER_CAND(3, 0, 3, 2, 4);
        PEER_CAND(4, 0, 4, 3, 0);
        PEER_CAND(5, 0, 5, 3, 1);
        PEER_CAND(6, 0, 6, 3, 2);
        PEER_CAND(7, 0, 7, 3, 3);
        PEER_CAND(8, 0, 8, 4, 0);
        PEER_CAND(9, 0, 9, 4, 1);
        PEER_CAND(10, 0, 10, 4, 2);
        PEER_CAND(11, 0, 11, 5, 0);
        PEER_CAND(12, 0, 12, 5, 1);
        PEER_CAND(13, 0, 13, 6, 0);
        PEER_CAND(14, 0, 14, 6, 1);
        PEER_CAND(15, 0, 15, 7, 0);
        PEER_CAND(16, 1, 0, 7, 1);
        PEER_CAND(17, 1, 1, 8, 0);
        PEER_CAND(18, 1, 2, 9, 0);
        PEER_CAND(19, 1, 3, 10, 0);
        PEER_CAND(20, 1, 4, 11, 0);
        PEER_CAND(21, 1, 5, 12, 0);
        PEER_CAND(22, 1, 6, 13, 0);
        PEER_CAND(23, 1, 7, 14, 0);
        PEER_CAND(24, 2, 0, 15, 0);
#undef PEER_CAND
        float selv[16]; int sele[16];
#pragma unroll
        for (int k = 0; k < 16; ++k) {
            float m = cv[0];
#pragma unroll
            for (int i = 1; i < 25; ++i) m = fmaxf(m, cv[i]);
            m = pair_max(m); selv[k] = m; int se = -1;
#pragma unroll
            for (int i = 0; i < 25; ++i) { const bool hit = (cv[i] == m); se = hit ? ce[i] : se; cv[i] = hit ? -INFINITY : cv[i]; }
            sele[k] = pair_maxi(se);
        }
        float ex[16], sum = 0.f;
#pragma unroll
        for (int k = 0; k < 16; ++k) { ex[k] = __expf(selv[k] - selv[0]); sum += ex[k]; }
        const float inv = 1.0f / sum;
        if (hi == 0) { GAS i32x4* p = (GAS i32x4*)(EIDX + (size_t)t * 128 + w * 16);
#pragma unroll
            for (int i = 0; i < 4; ++i) p[i] = (i32x4){sele[4 * i], sele[4 * i + 1], sele[4 * i + 2], sele[4 * i + 3]}; }
        else { GAS f32x4* p = (GAS f32x4*)(EG + (size_t)t * 128 + w * 16);
#pragma unroll
            for (int i = 0; i < 4; ++i) p[i] = (f32x4){ex[4 * i] * inv, ex[4 * i + 1] * inv, ex[4 * i + 2] * inv, ex[4 * i + 3] * inv}; }
    }
}

__device__ __forceinline__ float dot8(v4u u, v4u h, float acc) {
    acc += bf_lo(u.x) * bf_lo(h.x) + bf_hi(u.x) * bf_hi(h.x);
    acc += bf_lo(u.y) * bf_lo(h.y) + bf_hi(u.y) * bf_hi(h.y);
    acc += bf_lo(u.z) * bf_lo(h.z) + bf_hi(u.z) * bf_hi(h.z);
    acc += bf_lo(u.w) * bf_lo(h.w) + bf_hi(u.w) * bf_hi(h.w);
    return acc;
}

__device__ __forceinline__ void peer_gather_token(Ctx& C, int t) {
    const int lane = C.lane;
    const bf16* H = (const bf16*)(C.ws + WS_H); const bf16* EU = (const bf16*)(C.ws + WS_EU); const bf16* EV = (const bf16*)(C.ws + WS_EV);
    const int* EIDX = (const int*)(C.ws + WS_EIDX); const float* EG = (const float*)(C.ws + WS_EG);
    const v4u hA = *(const GAS v4u*)(H + (size_t)t * DM + 8 * lane), hB = *(const GAS v4u*)(H + (size_t)t * DM + 512 + 8 * lane);
    float acc[16];
#pragma unroll
    for (int i = 0; i < 16; ++i) acc[i] = 0.f;
#pragma unroll 1
    for (int half = 0; half < 2; ++half) {
        const int ereg = *(const GAS int*)(EIDX + (size_t)t * 128 + 64 * half + lane); const float greg = *(const GAS float*)(EG + (size_t)t * 128 + 64 * half + lane);
        float dots = 0.f;
#pragma unroll 1
        for (int bt = 0; bt < 8; ++bt) {
            v4u uA[8], uB[8];
#pragma unroll
            for (int i = 0; i < 8; ++i) { const int e = __builtin_amdgcn_readlane(ereg, bt * 8 + i); const bf16* row = EU + (size_t)e * DM; uA[i] = *(const GAS v4u*)(row + 8 * lane); uB[i] = *(const GAS v4u*)(row + 512 + 8 * lane); }
#pragma unroll
            for (int i = 0; i < 8; ++i) { float d = dot8(uA[i], hA, 0.f); d = dot8(uB[i], hB, d); d = wave_sum(d); dots = (lane == bt * 8 + i) ? d : dots; }
        }
        const float act = 0.5f * dots * (1.0f + erff(dots * 0.70710678118654752f)) * greg;
#pragma unroll 1
        for (int bt = 0; bt < 8; ++bt) {
            v4u vA[8], vB[8];
#pragma unroll
            for (int i = 0; i < 8; ++i) { const int e = __builtin_amdgcn_readlane(ereg, bt * 8 + i); const bf16* row = EV + (size_t)e * DM; vA[i] = *(const GAS v4u*)(row + 8 * lane); vB[i] = *(const GAS v4u*)(row + 512 + 8 * lane); }
#pragma unroll
            for (int i = 0; i < 8; ++i) { const float a = __int_as_float(__builtin_amdgcn_readlane(__float_as_int(act), bt * 8 + i));
                acc[0] += a * bf_lo(vA[i].x); acc[1] += a * bf_hi(vA[i].x); acc[2] += a * bf_lo(vA[i].y); acc[3] += a * bf_hi(vA[i].y);
                acc[4] += a * bf_lo(vA[i].z); acc[5] += a * bf_hi(vA[i].z); acc[6] += a * bf_lo(vA[i].w); acc[7] += a * bf_hi(vA[i].w);
                acc[8] += a * bf_lo(vB[i].x); acc[9] += a * bf_hi(vB[i].x); acc[10] += a * bf_lo(vB[i].y); acc[11] += a * bf_hi(vB[i].y);
                acc[12] += a * bf_lo(vB[i].z); acc[13] += a * bf_hi(vB[i].z); acc[14] += a * bf_lo(vB[i].w); acc[15] += a * bf_hi(vB[i].w); }
        }
    }
    const int b = t >> 11; const float* gt2 = (const float*)(C.ws + WS_MOD) + (size_t)b * NMOD + 5 * 1024;
    float* orow = C.out + (size_t)t * DM;
#pragma unroll
    for (int hb = 0; hb < 2; ++hb)
#pragma unroll
        for (int q = 0; q < 2; ++q) { const int col = 512 * hb + 8 * lane + 4 * q; const f32x4 x1 = *(const GAS f32x4*)(orow + col), g4 = *(const f32x4*)(gt2 + col);
            const f32x4 a4 = {acc[8 * hb + 4 * q], acc[8 * hb + 4 * q + 1], acc[8 * hb + 4 * q + 2], acc[8 * hb + 4 * q + 3]};
            *(GAS f32x4*)(orow + col) = x1 + g4 * a4; }
}

__device__ __forceinline__ void phase7(Ctx& C) {
    {
        const bf16* KB = (const bf16*)(C.ws + WS_KEYS);
        for (int idx = C.tid; idx < 2 * 128 * 16; idx += NTHR) { const int set = idx >> 11, row = (idx >> 4) & 127, ch = idx & 15;
            *(LAS v4u*)(C.lds + set * PK_BYTES + row * PK_P + ch * 16) = *(const GAS v4u*)(KB + (size_t)set * 16384 + row * 128 + ch * 8); }
        __syncthreads();
    }
    for (int tile = C.vcu; tile < NTOK / 64; tile += C.G) {
        const int t0 = tile * 64;
        peer_scores(C, t0);
        VM_WAIT(); __syncthreads();
#pragma unroll 1
        for (int ti = 0; ti < 8; ++ti) peer_gather_token(C, t0 + 8 * C.wave + ti);
    }
}

constexpr int NPHASE = 9;
struct Args { const void* in[25]; float* out; unsigned char* ws; int ph_lo, ph_hi, li, pad; };

__global__ void __launch_bounds__(NTHR, 2) fwd_kernel(Args args) {
    extern __shared__ __attribute__((aligned(16))) unsigned char lds[];
    Ctx C;
    C.lds = (LAS unsigned char*)lds; C.MISC = (volatile LAS unsigned*)(C.lds + MISC_OFF);
    C.tid = threadIdx.x; C.lane = C.tid & 63; C.wave = __builtin_amdgcn_readfirstlane(C.tid >> 6);
    C.G = gridDim.x; { const int bx = blockIdx.x; C.vcu = (C.G % 8 == 0) ? (bx % 8) * (C.G / 8) + bx / 8 : bx; }
    C.ws = args.ws; C.out = args.out; C.ctl = (gu32*)(args.ws + WS_CTL);
#pragma unroll
    for (int i = 0; i < 25; ++i) C.in[i] = (const float*)args.in[i];
    if (C.tid < 64) ((LAS unsigned*)(C.lds + MISC_OFF))[C.tid] = 0u;
    __syncthreads();
    const int lo = args.ph_lo, hi = args.ph_hi;
    const bool multi = (hi - lo) > 1;
    XcdBarrier bar; bar.bar = (unsigned*)(C.ctl + CW_BAR); bar.x = 0; bar.st = nullptr;
    if (multi) bar = xcd_barrier_post((unsigned*)(C.ctl + CW_BAR), C.MISC + 8);
#ifndef PH_MASK
#define PH_MASK 0x1ff
#endif
#define IN(k) (((PH_MASK >> (k)) & 1) && lo <= (k) && (k) < hi)
#define SEAM(k) do { if (IN(k) && IN((k) + 1)) xcd_barrier(bar); } while (0)
    if (IN(0)) { phase0(C); } SEAM(0);
    if (IN(1)) { phase1(C); } SEAM(1);
    if (IN(2)) { pg8::Gemm g{(const pg8::bf16_t*)(C.ws + WS_H), (const pg8::bf16_t*)(C.ws + WS_WIN_T), NTOK, NPROJ, DM}; pg8::StaticOrder S; S.init(NTOK, NPROJ, C.G, (int)blockIdx.x);
        pg8::EpiBf16<0> E{(pg8::bf16_t*)(C.ws + WS_PROJ), NPROJ, nullptr, 0, 0, 1.f};
        pg8::gemm_phase<pg8::EpiBf16<0>, pg8::StaticOrder, true, true>(C.lds, g, S, E); } SEAM(2);
    if (IN(3)) { phase2b(C); } SEAM(3);
    if (IN(4)) { phase3(C); } SEAM(4);
    if (IN(5)) { pg8::Gemm g{(const pg8::bf16_t*)(C.ws + WS_Y), (const pg8::bf16_t*)(C.ws + WS_WOUT_T), NTOK, DM, DM}; pg8::StaticOrder S; S.init(NTOK, DM, C.G, (int)blockIdx.x);
        pg8::EpiResid E{C.in[0], (const float*)(C.ws + WS_MOD) + 2 * 1024, C.out};
        pg8::gemm_phase<pg8::EpiResid, pg8::StaticOrder, true, true>(C.lds, g, S, E); } SEAM(5);
    if (IN(6)) { phase5(C); } SEAM(6);
    if (IN(7)) { pg8::Gemm g{(const pg8::bf16_t*)(C.ws + WS_H), (const pg8::bf16_t*)(C.ws + WS_WQ_T), NTOK, NQP, DM}; pg8::StaticOrder S; S.init(NTOK, NQP, C.G, (int)blockIdx.x);
        pg8::EpiBf16<0> E{(pg8::bf16_t*)(C.ws + WS_PROJ), NQP, C.in[20], 0, 0, 1.f};
        pg8::gemm_phase<pg8::EpiBf16<0>, pg8::StaticOrder, true, true>(C.lds, g, S, E); } SEAM(7);
    if (IN(8)) { phase7(C); }
#undef IN
#undef SEAM
}

#ifndef MK_N_LAUNCHES
#define MK_N_LAUNCHES 1
#endif
extern "C" void kernel_launch(void* const* d_in, const int* in_sizes, int n_in, void* d_out, int out_size, void* d_ws, size_t ws_size, hipStream_t stream) {
    static int grid = 0;
    if (grid == 0) {
        if (n_in != 25 || in_sizes[0] != NTOK * DM || out_size != NTOK * DM || ws_size < WS_END) { fprintf(stderr, "kernel_launch: unexpected shapes (n_in %d, in0 %d, out %d, ws %zu)\n", n_in, n_in > 0 ? in_sizes[0] : -1, out_size, ws_size); grid = -1; return; }
        int dev = 0, cus = 0, per_cu = 0;
        if (hipGetDevice(&dev) != hipSuccess || hipDeviceGetAttribute(&cus, hipDeviceAttributeMultiprocessorCount, dev) != hipSuccess) { grid = -1; return; }
        if (hipFuncSetAttribute((const void*)fwd_kernel, hipFuncAttributeMaxDynamicSharedMemorySize, LDS_BYTES) != hipSuccess) { fprintf(stderr, "kernel_launch: hipFuncSetAttribute failed\n"); grid = -1; return; }
        if (hipOccupancyMaxActiveBlocksPerMultiprocessor(&per_cu, (const void*)fwd_kernel, NTHR, LDS_BYTES) != hipSuccess || per_cu < 1) fprintf(stderr, "kernel_launch: occupancy query says %d per CU\n", per_cu);
        (void)hipGetLastError();
        grid = cus;
    }
    if (grid < 0) return;
    if (hipMemsetAsync((char*)d_ws + WS_CTL, 0, CTL_ZERO_BYTES, stream) != hipSuccess) return;
    Args a{};
    for (int i = 0; i < 25; ++i) a.in[i] = d_in[i];
    a.out = (float*)d_out; a.ws = (unsigned char*)d_ws;
    if (MK_N_LAUNCHES == 1) { a.ph_lo = 0; a.ph_hi = NPHASE; a.li = 0; hipLaunchKernelGGL(fwd_kernel, dim3(grid), dim3(NTHR), LDS_BYTES, stream, a); }
    else for (int p = 0; p < NPHASE; ++p) { a.ph_lo = p; a.ph_hi = p + 1; a.li = p; hipLaunchKernelGGL(fwd_kernel, dim3(grid), dim3(NTHR), LDS_BYTES, stream, a); }
}
```

```cpp
#include <hip/hip_runtime.h>
#include <hip/hip_bf16.h>
#include <cstdio>
#include <cstdint>
#include <cmath>
namespace pg8 {
#define PG8_LAS __attribute__((address_space(3)))
typedef unsigned short bf16_t;
typedef short bf16x8 __attribute__((ext_vector_type(8)));
typedef float f32x4 __attribute__((ext_vector_type(4)));
typedef unsigned u32x4 __attribute__((ext_vector_type(4)));
constexpr int BM = 256, BK = 64, HALF = 128, HTB = HALF * BK * 2  , STAGE_BYTES = 8 * HTB, NXCD = 8, WGM = 8;

__host__ __device__ __forceinline__ int lds_byte(int r, int c) { const int st = (r >> 4) * 2 + (c >> 5), rr = r & 15, cc = c & 31, ob = rr * 64 + cc * 2; return st * 1024 + (ob ^ (((ob >> 9) & 1) << 5)); }
__host__ __device__ __forceinline__ void stage_rc(int b, int& R, int& C) { const int st = b / 1024, sb = b % 1024, swz = sb ^ (((sb >> 9) & 1) << 5); R = (st >> 1) * 16 + swz / 64; C = (st & 1) * 32 + (swz % 64) / 2; }
__host__ __device__ __forceinline__ int perm32(int rho) { const int n = rho >> 4, i = rho & 15; return 8 * (i >> 2) + 4 * n + (i & 3); }

struct Unit { int pm, pn; };
struct Gemm { const bf16_t* A; const bf16_t* Bt; int M, N, K; };

struct StaticOrder {
    int nM, nN, nwg, G, c;
    __host__ __device__ void init(int M, int N, int G_, int c_) { nM = M / BM; nN = N / BM; nwg = nM * nN; G = G_; c = c_; }
    __host__ __device__ bool next(int i, Unit& u) const {
        const long L = (long)i * G + c; if (L >= nwg) return false;
        int wgid = (int)L; { const int q = nwg / NXCD, r = nwg % NXCD, xcd = wgid % NXCD, off = wgid / NXCD; wgid = (xcd < r ? xcd * (q + 1) : r * (q + 1) + (xcd - r) * q) + off; }
        const int nig = WGM * nN, gid = wgid / nig, fm = gid * WGM, gsz = (nM - fm) < WGM ? (nM - fm) : WGM;
        u.pm = fm + ((wgid % nig) % gsz); u.pn = (wgid % nig) / gsz; return true;
    }
    __device__ __forceinline__ void a_ready(const Unit&) const {}
    __device__ __forceinline__ void done(const Unit&) const {}
};

__device__ __forceinline__ unsigned cvt_pk_bf16(float lo, float hi) { unsigned r; asm volatile("v_cvt_pk_bf16_f32 %0, %1, %2" : "=v"(r) : "v"(lo), "v"(hi)); return r; }
typedef float f32x2 __attribute__((ext_vector_type(2)));
__device__ __forceinline__ f32x2 gelu_pk(f32x2 v) {
    const f32x2 av = __builtin_elementwise_abs(v), d = av * 0.2316418882f + 1.0f;
    f32x2 t; t.x = __builtin_amdgcn_rcpf(d.x); t.y = __builtin_amdgcn_rcpf(d.y);
    f32x2 q = t * 0.5307027145f + (-0.7265760135f); q = q * t + 0.7107068705f; q = q * t + (-0.142248368f); q = q * t + 0.127414796f; q = q * t;
    const f32x2 s = (v * v) * (-0.72134752044f);
    f32x2 e; e.x = __builtin_amdgcn_exp2f(s.x); e.y = __builtin_amdgcn_exp2f(s.y);
    const f32x2 m = v * (q * e), r = v - m;
    f32x2 o; o.x = v.x < 0.f ? m.x : r.x; o.y = v.y < 0.f ? m.y : r.y; return o;
}

template <int ACT  > struct EpiBf16 {
    static constexpr bool PERM = true, AFTER_DRAIN = false; static_assert(ACT == 0 || ACT == 1, "EpiBf16: ACT is 0 (none) or 1 (gelu_pk)");
    bf16_t* O; int ldc; const float* bias; int split_cols; size_t split_stride; float scale0;
    __device__ __forceinline__ void operator()(const f32x4 (&acc)[2][2][4][2], const Unit& u, int wr, int wc, int fr, int fq) const {
        const int row0 = u.pm * BM + wr * 64 + fr; int colt = u.pn * BM; bf16_t* base = O;
        float sc = 1.f; if (split_cols) { const int t = colt / split_cols; base += (size_t)t * split_stride; colt -= t * split_cols; if (t == 0) sc = scale0; }
        const int col0 = colt + wc * 32 + 8 * fq, bcol0 = u.pn * BM + wc * 32 + 8 * fq;
        f32x4 bv[2][2];
#pragma unroll
        for (int bj = 0; bj < 2; ++bj)
#pragma unroll
            for (int n = 0; n < 2; ++n) bv[bj][n] = bias ? *(const f32x4*)(bias + bcol0 + bj * HALF + 4 * n) : (f32x4){0.f, 0.f, 0.f, 0.f};
#pragma unroll
        for (int ai = 0; ai < 2; ++ai)
#pragma unroll
            for (int m = 0; m < 4; ++m) { bf16_t* rowp = base + (size_t)(row0 + ai * HALF + m * 16) * ldc + col0;
#pragma unroll
                for (int bj = 0; bj < 2; ++bj) { f32x4 v0 = acc[ai][bj][m][0] + bv[bj][0], v1 = acc[ai][bj][m][1] + bv[bj][1];
                    if (ACT == 1) { f32x2 a = gelu_pk((f32x2){v0[0], v0[1]}), b = gelu_pk((f32x2){v0[2], v0[3]}), c = gelu_pk((f32x2){v1[0], v1[1]}), d = gelu_pk((f32x2){v1[2], v1[3]});
                        v0 = (f32x4){a.x, a.y, b.x, b.y}; v1 = (f32x4){c.x, c.y, d.x, d.y}; }
                    v0 = v0 * sc; v1 = v1 * sc; u32x4 w; w.x = cvt_pk_bf16(v0[0], v0[1]); w.y = cvt_pk_bf16(v0[2], v0[3]); w.z = cvt_pk_bf16(v1[0], v1[1]); w.w = cvt_pk_bf16(v1[2], v1[3]);
                    *(u32x4*)(rowp + bj * HALF) = w; } }
    }
};
struct EpiResid {
    static constexpr bool PERM = false, AFTER_DRAIN = false;
    const float* x; const float* gate; float* out;
    __device__ __forceinline__ void operator()(const f32x4 (&acc)[2][2][4][2], const Unit& u, int wr, int wc, int fr, int fq) const {
        const int b = (u.pm * BM) >> 11;
        const int col0 = u.pn * BM + wc * 32 + 4 * fq;
        f32x4 gv[2][2];
#pragma unroll
        for (int bj = 0; bj < 2; ++bj)
#pragma unroll
            for (int n = 0; n < 2; ++n) gv[bj][n] = *(const f32x4*)(gate + (size_t)b * 6144 + col0 + bj * HALF + n * 16);
#pragma unroll
        for (int ai = 0; ai < 2; ++ai)
#pragma unroll
            for (int m = 0; m < 4; ++m) { const size_t off = (size_t)(u.pm * BM + ai * HALF + wr * 64 + m * 16 + fr) * 1024 + col0;
#pragma unroll
                for (int bj = 0; bj < 2; ++bj)
#pragma unroll
                    for (int n = 0; n < 2; ++n) { const f32x4 xv = *(const f32x4*)(x + off + bj * HALF + n * 16);
                        *(f32x4*)(out + off + bj * HALF + n * 16) = xv + gv[bj][n] * acc[ai][bj][m][n]; } }
    }
};
struct EpiResidBf16 {
    static constexpr bool PERM = true, AFTER_DRAIN = false;
    const float* x; const float* gate; bf16_t* out;
    __device__ __forceinline__ void operator()(const f32x4 (&acc)[2][2][4][2], const Unit& u, int wr, int wc, int fr, int fq) const {
        const int b = (u.pm * BM) >> 11;
        const int col0 = u.pn * BM + wc * 32 + 8 * fq;
        f32x4 gv[2][2];
#pragma unroll
        for (int bj = 0; bj < 2; ++bj)
#pragma unroll
            for (int n = 0; n < 2; ++n) gv[bj][n] = *(const f32x4*)(gate + (size_t)b * 6144 + col0 + bj * HALF + 4 * n);
#pragma unroll
        for (int ai = 0; ai < 2; ++ai)
#pragma unroll
            for (int m = 0; m < 4; ++m) { const size_t off = (size_t)(u.pm * BM + ai * HALF + wr * 64 + m * 16 + fr) * 1024 + col0;
#pragma unroll
                for (int bj = 0; bj < 2; ++bj) { const f32x4 x0 = *(const f32x4*)(x + off + bj * HALF), x1 = *(const f32x4*)(x + off + bj * HALF + 4);
                    const f32x4 v0 = x0 + gv[bj][0] * acc[ai][bj][m][0], v1 = x1 + gv[bj][1] * acc[ai][bj][m][1];
                    u32x4 w; w.x = cvt_pk_bf16(v0[0], v0[1]); w.y = cvt_pk_bf16(v0[2], v0[3]); w.z = cvt_pk_bf16(v1[0], v1[1]); w.w = cvt_pk_bf16(v1[2], v1[3]);
                    *(u32x4*)(out + off + bj * HALF) = w; } }
    }
};
template <class Epi, class Sched, bool ALIGN_EPI = false, bool SP2 = false>
__device__ __forceinline__ void gemm_phase(PG8_LAS unsigned char* lds, const Gemm g, const Sched& S, const Epi& E) {
    const int tid = threadIdx.x, wid = __builtin_amdgcn_readfirstlane(tid >> 6), lane = tid & 63, wr = wid >> 2, wc = wid & 3, fr = lane & 15, fq = lane >> 4;
    const int K = g.K, nt = K / BK;
    unsigned voffA[2], voffB[2];
#pragma unroll
    for (int i = 0; i < 2; ++i) { int R, C; stage_rc(tid * 16 + i * 8192, R, C); const int Rb = Epi::PERM ? ((R & ~31) + perm32(R & 31)) : R;
        voffA[i] = (unsigned)(R * K + C) * 2u; voffB[i] = (unsigned)(Rb * K + C) * 2u; }
    const size_t kstep = (size_t)(BK * 2);
    const size_t hstep = (size_t)HALF * K * 2;
    const size_t tstep = 2 * hstep;
    const unsigned ldsw = (unsigned)wid * 1024u;
    const int aoff = lds_byte(wr * 64 + fr, fq * 8), boff = lds_byte(wc * 32 + fr, fq * 8);
#define PG8_SA(b, h) (((b) * 2 + (h)) * HTB)
#define PG8_SB(b, h) ((4 + (b) * 2 + (h)) * HTB)
#define PG8_STAGE(bufoff, gbase, voff) do { _Pragma("unroll") for (int _i = 0; _i < 2; ++_i) \
        __builtin_amdgcn_global_load_lds((const unsigned*)((const char*)(gbase) + (voff)[_i]), (PG8_LAS unsigned*)(lds + (bufoff) + ldsw + _i * 8192), 16, 0, 0); } while (0)
#define PG8_LDA(dst, b, h) do { _Pragma("unroll") for (int m = 0; m < 4; ++m) _Pragma("unroll") for (int k = 0; k < 2; ++k) dst[m][k] = *(const PG8_LAS bf16x8*)(lds + PG8_SA(b, h) + aoff + m * 2048 + k * 1024); } while (0)
#define PG8_LDB(dst, b, h) do { _Pragma("unroll") for (int n = 0; n < 2; ++n) _Pragma("unroll") for (int k = 0; k < 2; ++k) dst[n][k] = *(const PG8_LAS bf16x8*)(lds + PG8_SB(b, h) + boff + n * 2048 + k * 1024); } while (0)
#define PG8_MMA(ai, bj, At, Bt) do { __builtin_amdgcn_s_setprio(1); _Pragma("unroll") for (int m = 0; m < 4; ++m) _Pragma("unroll") for (int n = 0; n < 2; ++n) _Pragma("unroll") for (int k = 0; k < 2; ++k) \
        acc[ai][bj][m][n] = __builtin_amdgcn_mfma_f32_16x16x32_bf16(Bt[n][k], At[m][k], acc[ai][bj][m][n], 0, 0, 0); __builtin_amdgcn_s_setprio(0); } while (0)
#define PG8_WAIT_V(n) asm volatile("s_waitcnt vmcnt(" #n ")" ::: "memory")
#define PG8_WAIT_L(n) asm volatile("s_waitcnt lgkmcnt(" #n ")" ::: "memory")
#define PG8_BAR __builtin_amdgcn_s_barrier()
#define PG8_SCHED __builtin_amdgcn_sched_barrier(0)
    Unit cur, nxt; int ui = 0;
    if (!S.next(0, cur)) return;
    f32x4 acc[2][2][4][2];
#pragma unroll
    for (int a = 0; a < 2; ++a)
#pragma unroll
        for (int b = 0; b < 2; ++b)
#pragma unroll
            for (int m = 0; m < 4; ++m)
#pragma unroll
                for (int n = 0; n < 2; ++n) acc[a][b][m][n] = (f32x4){0.f, 0.f, 0.f, 0.f};
    bf16x8 At[4][2], B0[2][2], B1[2][2];
    const char* cA = (const char*)g.A + (size_t)cur.pm * tstep; const char* cB = (const char*)g.Bt + (size_t)cur.pn * tstep;
    S.a_ready(cur);
    if constexpr (SP2) {
        PG8_STAGE(PG8_SB(0, 0), cB, voffB); PG8_STAGE(PG8_SB(0, 1), cB + hstep, voffB); PG8_STAGE(PG8_SA(0, 0), cA, voffA); PG8_STAGE(PG8_SA(0, 1), cA + hstep, voffA);
        if (wr == 1) PG8_BAR;
        PG8_WAIT_V(2); PG8_BAR;
        PG8_STAGE(PG8_SB(1, 0), cB + kstep, voffB); PG8_STAGE(PG8_SA(1, 0), cA + kstep, voffA); PG8_STAGE(PG8_SB(1, 1), cB + hstep + kstep, voffB);
        PG8_WAIT_V(6); PG8_BAR;
    } else {
        PG8_STAGE(PG8_SB(0, 0), cB, voffB); PG8_STAGE(PG8_SA(0, 0), cA, voffA); PG8_STAGE(PG8_SB(0, 1), cB + hstep, voffB); PG8_STAGE(PG8_SA(0, 1), cA + hstep, voffA);
        if (wr == 1) PG8_BAR;
        PG8_WAIT_V(4); PG8_BAR;
        PG8_STAGE(PG8_SB(1, 0), cB + kstep, voffB); PG8_STAGE(PG8_SA(1, 0), cA + kstep, voffA); PG8_STAGE(PG8_SB(1, 1), cB + hstep + kstep, voffB);
        PG8_WAIT_V(6); PG8_BAR;
    }
    for (;;) {
        const bool has_next = S.next(ui + 1, nxt);
        const char* nA = has_next ? (const char*)g.A + (size_t)nxt.pm * tstep : cA; const char* nB = has_next ? (const char*)g.Bt + (size_t)nxt.pn * tstep : cB;
        for (int t = 0; t < nt; t += 2) {
            const bool last = (t == nt - 2);
            const char* a1 = cA + (size_t)(t + 1) * kstep;
            const char* a2 = last ? nA : cA + (size_t)(t + 2) * kstep; const char* b2 = last ? nB : cB + (size_t)(t + 2) * kstep;
            const char* a3 = a2 + kstep; const char* b3 = b2 + kstep;
            if (last && has_next) S.a_ready(nxt);
            if constexpr (SP2) {
            PG8_LDB(B0, 0, 0); PG8_LDB(B1, 0, 1); PG8_SCHED; PG8_LDA(At, 0, 0); PG8_STAGE(PG8_SA(1, 1), a1 + hstep, voffA);
            PG8_WAIT_V(8); PG8_WAIT_L(0); PG8_BAR; PG8_MMA(0, 0, At, B0); PG8_MMA(0, 1, At, B1); PG8_BAR; PG8_SCHED;
            PG8_LDA(At, 0, 1); PG8_STAGE(PG8_SB(0, 0), b2, voffB); PG8_STAGE(PG8_SB(0, 1), b2 + hstep, voffB); PG8_STAGE(PG8_SA(0, 0), a2, voffA);
            PG8_WAIT_V(8); PG8_WAIT_L(0); PG8_BAR; PG8_MMA(1, 0, At, B0); PG8_MMA(1, 1, At, B1); PG8_BAR; PG8_SCHED;
            PG8_LDB(B0, 1, 0); PG8_LDB(B1, 1, 1); PG8_SCHED; PG8_LDA(At, 1, 0); PG8_STAGE(PG8_SA(0, 1), a2 + hstep, voffA);
            PG8_WAIT_V(8); PG8_WAIT_L(0); PG8_BAR; PG8_MMA(0, 0, At, B0); PG8_MMA(0, 1, At, B1); PG8_BAR; PG8_SCHED;
            PG8_LDA(At, 1, 1); PG8_STAGE(PG8_SB(1, 0), b3, voffB); PG8_STAGE(PG8_SB(1, 1), b3 + hstep, voffB); PG8_STAGE(PG8_SA(1, 0), a3, voffA);
            PG8_WAIT_V(8); PG8_WAIT_L(0); PG8_BAR; PG8_MMA(1, 0, At, B0); PG8_MMA(1, 1, At, B1); PG8_BAR; PG8_SCHED;
            } else {
            PG8_LDB(B0, 0, 0); PG8_SCHED; PG8_LDA(At, 0, 0); PG8_STAGE(PG8_SA(1, 1), a1 + hstep, voffA);
            PG8_WAIT_L(8); PG8_BAR; PG8_WAIT_L(0); PG8_MMA(0, 0, At, B0); PG8_BAR; PG8_SCHED;
            PG8_LDB(B1, 0, 1); PG8_STAGE(PG8_SB(0, 0), b2, voffB);
            PG8_BAR; PG8_WAIT_L(0); PG8_MMA(0, 1, At, B1); PG8_BAR;
            PG8_LDA(At, 0, 1); PG8_STAGE(PG8_SA(0, 0), a2, voffA);
            PG8_BAR; PG8_WAIT_L(0); PG8_MMA(1, 0, At, B0); PG8_BAR; PG8_SCHED;
            PG8_STAGE(PG8_SB(0, 1), b2 + hstep, voffB);
            PG8_WAIT_V(6); PG8_BAR; PG8_MMA(1, 1, At, B1); PG8_BAR;
            PG8_LDB(B0, 1, 0); PG8_SCHED; PG8_LDA(At, 1, 0); PG8_STAGE(PG8_SA(0, 1), a2 + hstep, voffA);
            PG8_WAIT_L(8); PG8_BAR; PG8_WAIT_L(0); PG8_MMA(0, 0, At, B0); PG8_BAR; PG8_SCHED;
            PG8_LDB(B1, 1, 1); PG8_STAGE(PG8_SB(1, 0), b3, voffB);
            PG8_BAR; PG8_WAIT_L(0); PG8_MMA(0, 1, At, B1); PG8_BAR;
            PG8_LDA(At, 1, 1); PG8_STAGE(PG8_SA(1, 0), a3, voffA);
            PG8_BAR; PG8_WAIT_L(0); PG8_MMA(1, 0, At, B0); PG8_BAR; PG8_SCHED;
            PG8_STAGE(PG8_SB(1, 1), b3 + hstep, voffB);
            PG8_WAIT_V(6); PG8_BAR; PG8_MMA(1, 1, At, B1); PG8_BAR;
            }
        }
        if constexpr (ALIGN_EPI) { if (wr == 0) PG8_BAR; }
        if constexpr (!Epi::AFTER_DRAIN) { E(acc, cur, wr, wc, fr, fq); S.done(cur); }
        if (!has_next) break;
#pragma unroll
        for (int a = 0; a < 2; ++a)
#pragma unroll
            for (int b = 0; b < 2; ++b)
#pragma unroll
                for (int m = 0; m < 4; ++m)
#pragma unroll
                    for (int n = 0; n < 2; ++n) acc[a][b][m][n] = (f32x4){0.f, 0.f, 0.f, 0.f};
        cur = nxt; cA = nA; cB = nB; ++ui;
        if constexpr (ALIGN_EPI) { if (wr == 1) PG8_BAR; }
    }
    PG8_WAIT_V(0);
    if constexpr (!ALIGN_EPI) { if (wr == 0) PG8_BAR; }
    PG8_BAR;
    if constexpr (Epi::AFTER_DRAIN) { E.fused(acc, cur, wr, wc, fr, fq, lds, wid, lane); S.done(cur); }
#undef PG8_SA
#undef PG8_SB
#undef PG8_STAGE
#undef PG8_LDA
#undef PG8_LDB
#undef PG8_MMA
#undef PG8_WAIT_V
#undef PG8_WAIT_L
#undef PG8_BAR
#undef PG8_SCHED
}

typedef int i32x4 __attribute__((ext_vector_type(4)));
struct EpiI8Bf16 {
    static constexpr bool PERM = true, AFTER_DRAIN = false;
    bf16_t* O; int ldc; const float* rs; const float* cs; const float* bias;
    __device__ __forceinline__ void operator()(const i32x4 (&acc)[2][2][4][2], const Unit& u, int wr, int wc, int fr, int fq) const {
        const int row0 = u.pm * BM + wr * 64 + fr, col0 = u.pn * BM + wc * 32 + 8 * fq;
        f32x4 cv[2][2], bv[2][2];
#pragma unroll
        for (int bj = 0; bj < 2; ++bj)
#pragma unroll
            for (int n = 0; n < 2; ++n) { cv[bj][n] = *(const f32x4*)(cs + col0 + bj * HALF + 4 * n); bv[bj][n] = bias ? *(const f32x4*)(bias + col0 + bj * HALF + 4 * n) : (f32x4){0.f, 0.f, 0.f, 0.f}; }
#pragma unroll
        for (int ai = 0; ai < 2; ++ai)
#pragma unroll
            for (int m = 0; m < 4; ++m) { const int row = row0 + ai * HALF + m * 16; const float r = rs[row]; bf16_t* rowp = O + (size_t)row * ldc + col0;
#pragma unroll
                for (int bj = 0; bj < 2; ++bj) { const i32x4 a0 = acc[ai][bj][m][0], a1 = acc[ai][bj][m][1];
                    const f32x4 v0 = (f32x4){(float)a0[0], (float)a0[1], (float)a0[2], (float)a0[3]} * cv[bj][0] * r + bv[bj][0], v1 = (f32x4){(float)a1[0], (float)a1[1], (float)a1[2], (float)a1[3]} * cv[bj][1] * r + bv[bj][1];
                    u32x4 w; w.x = cvt_pk_bf16(v0[0], v0[1]); w.y = cvt_pk_bf16(v0[2], v0[3]); w.z = cvt_pk_bf16(v1[0], v1[1]); w.w = cvt_pk_bf16(v1[2], v1[3]);
                    *(u32x4*)(rowp + bj * HALF) = w; } }
    }
};
template <class Epi, class Sched, bool ALIGN_EPI = false, bool SP2 = false>
__device__ __forceinline__ void gemm_phase_i8(PG8_LAS unsigned char* lds, const Gemm g, const Sched& S, const Epi& E) {
    const int tid = threadIdx.x, wid = __builtin_amdgcn_readfirstlane(tid >> 6), lane = tid & 63, wr = wid >> 2, wc = wid & 3, fr = lane & 15, fq = lane >> 4;
    const int K = g.K, nt = K / BK;
    unsigned voffA[2], voffB[2];
#pragma unroll
    for (int i = 0; i < 2; ++i) { int R, C; stage_rc(tid * 16 + i * 8192, R, C); const int Rb = Epi::PERM ? ((R & ~31) + perm32(R & 31)) : R;
        voffA[i] = (unsigned)(R * K + C) * 2u; voffB[i] = (unsigned)(Rb * K + C) * 2u; }
    const size_t kstep = (size_t)(BK * 2);
    const size_t hstep = (size_t)HALF * K * 2;
    const size_t tstep = 2 * hstep;
    const unsigned ldsw = (unsigned)wid * 1024u;
    const int aoff = lds_byte(wr * 64 + fr, fq * 8), boff = lds_byte(wc * 32 + fr, fq * 8);
#define PG8_SA(b, h) (((b) * 2 + (h)) * HTB)
#define PG8_SB(b, h) ((4 + (b) * 2 + (h)) * HTB)
#define PG8_STAGE(bufoff, gbase, voff) do { _Pragma("unroll") for (int _i = 0; _i < 2; ++_i) \
        __builtin_amdgcn_global_load_lds((const unsigned*)((const char*)(gbase) + (voff)[_i]), (PG8_LAS unsigned*)(lds + (bufoff) + ldsw + _i * 8192), 16, 0, 0); } while (0)
#define PG8_LDA(dst, b, h) do { _Pragma("unroll") for (int m = 0; m < 4; ++m) _Pragma("unroll") for (int k = 0; k < 2; ++k) dst[m][k] = *(const PG8_LAS bf16x8*)(lds + PG8_SA(b, h) + aoff + m * 2048 + k * 1024); } while (0)
#define PG8_LDB(dst, b, h) do { _Pragma("unroll") for (int n = 0; n < 2; ++n) _Pragma("unroll") for (int k = 0; k < 2; ++k) dst[n][k] = *(const PG8_LAS bf16x8*)(lds + PG8_SB(b, h) + boff + n * 2048 + k * 1024); } while (0)
#define PG8_MMA(ai, bj, At, Bt) do { __builtin_amdgcn_s_setprio(1); _Pragma("unroll") for (int m = 0; m < 4; ++m) _Pragma("unroll") for (int n = 0; n < 2; ++n) _Pragma("unroll") for (int k = 0; k < 2; ++k) \
        acc[ai][bj][m][n] = __builtin_amdgcn_mfma_i32_16x16x64_i8(__builtin_bit_cast(i32x4, Bt[n][k]), __builtin_bit_cast(i32x4, At[m][k]), acc[ai][bj][m][n], 0, 0, 0); __builtin_amdgcn_s_setprio(0); } while (0)
#define PG8_WAIT_V(n) asm volatile("s_waitcnt vmcnt(" #n ")" ::: "memory")
#define PG8_WAIT_L(n) asm volatile("s_waitcnt lgkmcnt(" #n ")" ::: "memory")
#define PG8_BAR __builtin_amdgcn_s_barrier()
#define PG8_SCHED __builtin_amdgcn_sched_barrier(0)
    Unit cur, nxt; int ui = 0;
    if (!S.next(0, cur)) return;
    i32x4 acc[2][2][4][2];
#pragma unroll
    for (int a = 0; a < 2; ++a)
#pragma unroll
        for (int b = 0; b < 2; ++b)
#pragma unroll
            for (int m = 0; m < 4; ++m)
#pragma unroll
                for (int n = 0; n < 2; ++n) acc[a][b][m][n] = (i32x4){0, 0, 0, 0};
    bf16x8 At[4][2], B0[2][2], B1[2][2];
    const char* cA = (const char*)g.A + (size_t)cur.pm * tstep; const char* cB = (const char*)g.Bt + (size_t)cur.pn * tstep;
    S.a_ready(cur);
    if constexpr (SP2) {
        PG8_STAGE(PG8_SB(0, 0), cB, voffB); PG8_STAGE(PG8_SB(0, 1), cB + hstep, voffB); PG8_STAGE(PG8_SA(0, 0), cA, voffA); PG8_STAGE(PG8_SA(0, 1), cA + hstep, voffA);
        if (wr == 1) PG8_BAR;
        PG8_WAIT_V(2); PG8_BAR;
        PG8_STAGE(PG8_SB(1, 0), cB + kstep, voffB); PG8_STAGE(PG8_SA(1, 0), cA + kstep, voffA); PG8_STAGE(PG8_SB(1, 1), cB + hstep + kstep, voffB);
        PG8_WAIT_V(6); PG8_BAR;
    } else {
        PG8_STAGE(PG8_SB(0, 0), cB, voffB); PG8_STAGE(PG8_SA(0, 0), cA, voffA); PG8_STAGE(PG8_SB(0, 1), cB + hstep, voffB); PG8_STAGE(PG8_SA(0, 1), cA + hstep, voffA);
        if (wr == 1) PG8_BAR;
        PG8_WAIT_V(4); PG8_BAR;
        PG8_STAGE(PG8_SB(1, 0), cB + kstep, voffB); PG8_STAGE(PG8_SA(1, 0), cA + kstep, voffA); PG8_STAGE(PG8_SB(1, 1), cB + hstep + kstep, voffB);
        PG8_WAIT_V(6); PG8_BAR;
    }
    for (;;) {
        const bool has_next = S.next(ui + 1, nxt);
        const char* nA = has_next ? (const char*)g.A + (size_t)nxt.pm * tstep : cA; const char* nB = has_next ? (const char*)g.Bt + (size_t)nxt.pn * tstep : cB;
        for (int t = 0; t < nt; t += 2) {
            const bool last = (t == nt - 2);
            const char* a1 = cA + (size_t)(t + 1) * kstep;
            const char* a2 = last ? nA : cA + (size_t)(t + 2) * kstep; const char* b2 = last ? nB : cB + (size_t)(t + 2) * kstep;
            const char* a3 = a2 + kstep; const char* b3 = b2 + kstep;
            if (last && has_next) S.a_ready(nxt);
            if constexpr (SP2) {
            PG8_LDB(B0, 0, 0); PG8_LDB(B1, 0, 1); PG8_SCHED; PG8_LDA(At, 0, 0); PG8_STAGE(PG8_SA(1, 1), a1 + hstep, voffA);
            PG8_WAIT_V(8); PG8_WAIT_L(0); PG8_BAR; PG8_MMA(0, 0, At, B0); PG8_MMA(0, 1, At, B1); PG8_BAR; PG8_SCHED;
            PG8_LDA(At, 0, 1); PG8_STAGE(PG8_SB(0, 0), b2, voffB); PG8_STAGE(PG8_SB(0, 1), b2 + hstep, voffB); PG8_STAGE(PG8_SA(0, 0), a2, voffA);
            PG8_WAIT_V(8); PG8_WAIT_L(0); PG8_BAR; PG8_MMA(1, 0, At, B0); PG8_MMA(1, 1, At, B1); PG8_BAR; PG8_SCHED;
            PG8_LDB(B0, 1, 0); PG8_LDB(B1, 1, 1); PG8_SCHED; PG8_LDA(At, 1, 0); PG8_STAGE(PG8_SA(0, 1), a2 + hstep, voffA);
            PG8_WAIT_V(8); PG8_WAIT_L(0); PG8_BAR; PG8_MMA(0, 0, At, B0); PG8_MMA(0, 1, At, B1); PG8_BAR; PG8_SCHED;
            PG8_LDA(At, 1, 1); PG8_STAGE(PG8_SB(1, 0), b3, voffB); PG8_STAGE(PG8_SB(1, 1), b3 + hstep, voffB); PG8_STAGE(PG8_SA(1, 0), a3, voffA);
            PG8_WAIT_V(8); PG8_WAIT_L(0); PG8_BAR; PG8_MMA(1, 0, At, B0); PG8_MMA(1, 1, At, B1); PG8_BAR; PG8_SCHED;
            } else {
            PG8_LDB(B0, 0, 0); PG8_SCHED; PG8_LDA(At, 0, 0); PG8_STAGE(PG8_SA(1, 1), a1 + hstep, voffA);
            PG8_WAIT_L(8); PG8_BAR; PG8_WAIT_L(0); PG8_MMA(0, 0, At, B0); PG8_BAR; PG8_SCHED;
            PG8_LDB(B1, 0, 1); PG8_STAGE(PG8_SB(0, 0), b2, voffB);
            PG8_BAR; PG8_WAIT_L(0); PG8_MMA(0, 1, At, B1); PG8_BAR;
            PG8_LDA(At, 0, 1); PG8_STAGE(PG8_SA(0, 0), a2, voffA);
            PG8_BAR; PG8_WAIT_L(0); PG8_MMA(1, 0, At, B0); PG8_BAR; PG8_SCHED;
            PG8_STAGE(PG8_SB(0, 1), b2 + hstep, voffB);
            PG8_WAIT_V(6); PG8_BAR; PG8_MMA(1, 1, At, B1); PG8_BAR;
            PG8_LDB(B0, 1, 0); PG8_SCHED; PG8_LDA(At, 1, 0); PG8_STAGE(PG8_SA(0, 1), a2 + hstep, voffA);
            PG8_WAIT_L(8); PG8_BAR; PG8_WAIT_L(0); PG8_MMA(0, 0, At, B0); PG8_BAR; PG8_SCHED;
            PG8_LDB(B1, 1, 1); PG8_STAGE(PG8_SB(1, 0), b3, voffB);
            PG8_BAR; PG8_WAIT_L(0); PG8_MMA(0, 1, At, B1); PG8_BAR;
            PG8_LDA(At, 1, 1); PG8_STAGE(PG8_SA(1, 0), a3, voffA);
            PG8_BAR; PG8_WAIT_L(0); PG8_MMA(1, 0, At, B0); PG8_BAR; PG8_SCHED;
            PG8_STAGE(PG8_SB(1, 1), b3 + hstep, voffB);
            PG8_WAIT_V(6); PG8_BAR; PG8_MMA(1, 1, At, B1); PG8_BAR;
            }
        }
        if constexpr (ALIGN_EPI) { if (wr == 0) PG8_BAR; }
        if constexpr (!Epi::AFTER_DRAIN) { E(acc, cur, wr, wc, fr, fq); S.done(cur); }
        if (!has_next) break;
#pragma unroll
        for (int a = 0; a < 2; ++a)
#pragma unroll
            for (int b = 0; b < 2; ++b)
#pragma unroll
                for (int m = 0; m < 4; ++m)
#pragma unroll
                    for (int n = 0; n < 2; ++n) acc[a][b][m][n] = (i32x4){0, 0, 0, 0};
        cur = nxt; cA = nA; cB = nB; ++ui;
        if constexpr (ALIGN_EPI) { if (wr == 1) PG8_BAR; }
    }
    PG8_WAIT_V(0);
    if constexpr (!ALIGN_EPI) { if (wr == 0) PG8_BAR; }
    PG8_BAR;
    if constexpr (Epi::AFTER_DRAIN) { E.fused(acc, cur, wr, wc, fr, fq, lds, wid, lane); S.done(cur); }
#undef PG8_SA
#undef PG8_SB
#undef PG8_STAGE
#undef PG8_LDA
#undef PG8_LDB
#undef PG8_MMA
#undef PG8_WAIT_V
#undef PG8_WAIT_L
#undef PG8_BAR
#undef PG8_SCHED
}

}
#define GAS __attribute__((address_space(1)))
#define LAS __attribute__((address_space(3)))
typedef unsigned short bf16;
typedef unsigned v4u __attribute__((ext_vector_type(4)));
typedef float f32x4 __attribute__((ext_vector_type(4)));
typedef short bf16x8 __attribute__((ext_vector_type(8)));
typedef GAS unsigned gu32;
typedef GAS unsigned long long gu64;
#define RLX_AGENT __ATOMIC_RELAXED, __HIP_MEMORY_SCOPE_AGENT
#define LDS_WAIT() asm volatile("s_waitcnt lgkmcnt(0)" ::: "memory")
#define VM_WAIT() asm volatile("s_waitcnt vmcnt(0)" ::: "memory")
__device__ __forceinline__ unsigned long long rt() { return __builtin_amdgcn_s_memrealtime(); }
__device__ __forceinline__ unsigned f2bf(float f) { unsigned u = __builtin_bit_cast(unsigned, f); return (u + 0x7fffu + ((u >> 16) & 1u)) >> 16; }
__device__ __forceinline__ unsigned pk2(float lo, float hi) { return f2bf(lo) | (f2bf(hi) << 16); }

#define XB_TMO      128
#define XB_XCNT(j)  (256  + 64 * (j))
#define XB_XSUB(j)  (1280 + 64 * (j))
#define XB_XGEN(j)  (2304 + 64 * (j))
#define XB_TOP      3328
#define XB_TOPGEN   3392
#define XCD_BAR_WORDS 3456
#define XB_SPIN_CAP (1u << 18)

__device__ __forceinline__ unsigned xb_ld(unsigned* p)              { return __hip_atomic_load(p, __ATOMIC_RELAXED, __HIP_MEMORY_SCOPE_AGENT); }
__device__ __forceinline__ unsigned xb_add(unsigned* p, unsigned v) { return __hip_atomic_fetch_add(p, v, __ATOMIC_RELAXED, __HIP_MEMORY_SCOPE_AGENT); }
__device__ __forceinline__ unsigned xb_xcc_id() { return (unsigned)__builtin_amdgcn_s_getreg((3 << 11) | 20) & 0xFu; }
#define XB_SPIN(cond, bar) do { unsigned _sp = 0; while (cond) { __builtin_amdgcn_s_sleep(1); \
    if ((++_sp & 255u) == 0u) { if (xb_ld(&(bar)[XB_TMO])) break; if (_sp > XB_SPIN_CAP) { atomicAdd(&(bar)[XB_TMO], 1u); break; } } } } while (0)

struct XcdBarrier {
    unsigned* bar; unsigned x;
    volatile LAS unsigned* st;
};

__device__ __forceinline__ XcdBarrier xcd_barrier_post(unsigned* bar, volatile LAS unsigned* st) {
    XcdBarrier b; b.bar = bar; b.x = xb_xcc_id(); b.st = st;
    if (threadIdx.x == 0) (void)xb_add(&bar[XB_XCNT(b.x)], 1u);
    return b;
}
__device__ __forceinline__ void xcd_barrier_complete(unsigned* bar, unsigned x, unsigned& nloc, unsigned& nx) {
    const unsigned G = gridDim.x * gridDim.y * gridDim.z;
    unsigned sum, cnt, mine, sp = 0u;
    for (;;) {
        sum = 0u; cnt = 0u; mine = 0u;
#pragma unroll
        for (unsigned j = 0; j < 16; ++j) { const unsigned c = xb_ld(&bar[XB_XCNT(j)]); sum += c; cnt += (c > 0u) ? 1u : 0u; mine = (j == x) ? c : mine; }
        if (sum == G) break;
        __builtin_amdgcn_s_sleep(1);
        if ((++sp & 255u) == 0u) { if (xb_ld(&bar[XB_TMO])) break; if (sp > XB_SPIN_CAP) { atomicAdd(&bar[XB_TMO], 1u); break; } }
    }
    nloc = mine > 0u ? mine : 1u; nx = cnt > 0u ? cnt : 1u;
}

__device__ __forceinline__ void xcd_barrier(const XcdBarrier& b) {
    asm volatile("s_waitcnt vmcnt(0)" ::: "memory");
    __syncthreads();
    if (threadIdx.x == 0) {
        unsigned* bar = b.bar;
        __builtin_amdgcn_s_waitcnt(0);
        unsigned nloc = b.st[0], nx = b.st[1];
        if (nloc == 0u) { xcd_barrier_complete(bar, b.x, nloc, nx); b.st[0] = nloc; b.st[1] = nx; }
        const unsigned old = xb_add(&bar[XB_XSUB(b.x)], 1u);
        const unsigned gen = old / nloc;
        if (old + 1u == (gen + 1u) * nloc) {
            __builtin_amdgcn_fence(__ATOMIC_RELEASE, "agent");
            asm volatile("s_waitcnt vmcnt(0)" ::: "memory");
            const unsigned og = xb_add(&bar[XB_TOP], 1u);
            const unsigned tg = og / nx;
            if (og + 1u == (tg + 1u) * nx) xb_add(&bar[XB_TOPGEN], 1u);
            else XB_SPIN(xb_ld(&bar[XB_TOPGEN]) == tg, bar);
            __builtin_amdgcn_fence(__ATOMIC_ACQUIRE, "agent");
            xb_add(&bar[XB_XGEN(b.x)], 1u);
            asm volatile("s_waitcnt vmcnt(0)" ::: "memory");
        } else {
            XB_SPIN(xb_ld(&bar[XB_XGEN(b.x)]) == gen, bar);
            __builtin_amdgcn_fence(__ATOMIC_ACQUIRE, "agent");
            asm volatile("s_waitcnt vmcnt(0)" ::: "memory");
        }
    }
    __syncthreads();
}

typedef float f32x16 __attribute__((ext_vector_type(16)));
typedef short v4i16_t __attribute__((ext_vector_type(4)));
typedef float f32x2_t __attribute__((ext_vector_type(2)));
typedef __bf16 bf16x2_t __attribute__((ext_vector_type(2)));
typedef int i32x4 __attribute__((ext_vector_type(4)));
typedef unsigned u32x2 __attribute__((ext_vector_type(2)));

constexpr int NWAVES = 8, NTHR = 512;
constexpr int BATCH = 32, SEQ = 2048, DM = 1024, NTOK = BATCH * SEQ;
constexpr int NIN = 3088, NPROJ = 3328, NQP = 2048, NMOD = 6144;
constexpr int C_DQ = 0, C_DK = 512, C_DV = 1024, C_GQ = 1536, C_GK = 1792, C_GV = 2048, C_GR = 2560, C_GG = 3072;
constexpr int NEXP = 16384;
constexpr float RMS_EPS = 1e-6f;
constexpr float LAMBDA_INIT = 0.2f;
constexpr float QSCALE = 0.125f * 1.4426950408889634f;

constexpr size_t MiB = 1u << 20;
constexpr size_t WS_CTL = 0, CTL_ZERO_BYTES = 1 * MiB;
constexpr size_t WS_WIN_T = 2 * MiB;
constexpr size_t WS_WOUT_T = 10 * MiB;
constexpr size_t WS_WQ_T = 12 * MiB;
constexpr size_t WS_KEYS = 16 * MiB;
constexpr size_t WS_MOD = 17 * MiB;
constexpr size_t WS_WEFF = 18 * MiB;
constexpr size_t WS_CS = 19 * MiB;
constexpr size_t WS_RS1 = 20 * MiB;
constexpr size_t WS_RS2 = 21 * MiB;
constexpr size_t WS_CSQ = 19 * MiB + 16384;
constexpr size_t WS_COS = 32 * MiB;
constexpr size_t WS_SIN = 40 * MiB;
constexpr size_t WS_EU = 64 * MiB;
constexpr size_t WS_EV = 80 * MiB;
constexpr size_t WS_ES = 96 * MiB;
constexpr size_t WS_H = 128 * MiB;
constexpr size_t WS_PROJ = 256 * MiB;
constexpr size_t WS_PD = 256 * MiB;
constexpr size_t WS_X1 = 512 * MiB;
constexpr size_t WS_Y = 864 * MiB;
constexpr size_t WS_ACT = 768 * MiB;
constexpr size_t WS_EIDX = 800 * MiB;
constexpr size_t WS_EG = 832 * MiB;
constexpr size_t WS_END = 992 * MiB;
constexpr int CW_TMO = 0, CW_Q = 64, CW_RANK = 1024, CW_BAR = 4096, CW_WMAX = 32768;

constexpr int LDS_BYTES = 163840;
constexpr int MISC_OFF = LDS_BYTES - 256;

struct Args { const void* in[25]; float* out; unsigned char* ws; int ph_lo, ph_hi, li, pad; };
struct Ctx {
    LAS unsigned char* lds;
    volatile LAS unsigned* MISC;
    gu32* ctl;
    int tid, lane, wave, vcu, G;
    int sx, sj;
    float* out; unsigned char* ws;
};

__device__ __forceinline__ float wave_sum(float v) {
#pragma unroll
    for (int o = 1; o < 64; o <<= 1) v += __shfl_xor(v, o);
    return v;
}
__device__ __forceinline__ float wave_sum_fast(float x) {
    x += __int_as_float(__builtin_amdgcn_update_dpp(0, __float_as_int(x), 0xb1, 0xf, 0xf, false));
    x += __int_as_float(__builtin_amdgcn_update_dpp(0, __float_as_int(x), 0x4e, 0xf, 0xf, false));
    x += __int_as_float(__builtin_amdgcn_update_dpp(0, __float_as_int(x), 0x124, 0xf, 0xf, false));
    x += __int_as_float(__builtin_amdgcn_update_dpp(0, __float_as_int(x), 0x128, 0xf, 0xf, false));
    { auto r = __builtin_amdgcn_permlane16_swap(__float_as_uint(x), __float_as_uint(x), false, false); x = __uint_as_float(r[0]) + __uint_as_float(r[1]); }
    { auto r = __builtin_amdgcn_permlane32_swap(__float_as_uint(x), __float_as_uint(x), false, false); x = __uint_as_float(r[0]) + __uint_as_float(r[1]); }
    return x;
}
__device__ __forceinline__ unsigned cvtpk(float lo, float hi) { f32x2_t v = {lo, hi}; bf16x2_t b = __builtin_convertvector(v, bf16x2_t); return __builtin_bit_cast(unsigned, b); }
__device__ __forceinline__ float bf_lo(unsigned w) { return __uint_as_float(w << 16); }
__device__ __forceinline__ float bf_hi(unsigned w) { return __uint_as_float(w & 0xffff0000u); }
__device__ __forceinline__ int crow(int r, int hi) { return (r & 3) + 8 * (r >> 2) + 4 * hi; }
__device__ __forceinline__ float pair_max(float m) { auto rr = __builtin_amdgcn_permlane32_swap(__float_as_uint(m), __float_as_uint(m), false, false); return fmaxf(__uint_as_float(rr[0]), __uint_as_float(rr[1])); }
__device__ __forceinline__ float pair_sum(float m) { auto rr = __builtin_amdgcn_permlane32_swap(__float_as_uint(m), __float_as_uint(m), false, false); return __uint_as_float(rr[0]) + __uint_as_float(rr[1]); }
__device__ __forceinline__ int pair_maxi(int m) { auto rr = __builtin_amdgcn_permlane32_swap((unsigned)m, (unsigned)m, false, false); const int a = (int)rr[0], b = (int)rr[1]; return a > b ? a : b; }
__device__ __forceinline__ v4i16_t tr16(LAS const unsigned char* p) { return __builtin_amdgcn_ds_read_tr16_b64_v4i16((LAS v4i16_t*)p); }
__device__ __forceinline__ bf16x8 mk8(v4i16_t a, v4i16_t b) { return (bf16x8){a[0], a[1], a[2], a[3], b[0], b[1], b[2], b[3]}; }
#define MFMA32(a, b, c) __builtin_amdgcn_mfma_f32_32x32x16_bf16((a), (b), (c), 0, 0, 0)

__device__ __forceinline__ void p0_transpose_item(const float* W, int K, int ldw, int nblk, bf16* WT, LAS float* scr, int item, int lane) {
    const int kb = item / nblk, nb = item % nblk, k0 = 64 * kb, n0 = 32 * nb;
#pragma unroll 8
    for (int i = 0; i < 32; ++i) { const int kk = 2 * i + (lane >> 5); scr[kk * 33 + (lane & 31)] = W[(size_t)(k0 + kk) * ldw + n0 + (lane & 31)]; }
    LDS_WAIT(); asm volatile("" ::: "memory");
    const int c = lane & 7;
#pragma unroll
    for (int j = 0; j < 4; ++j) { const int n = (lane >> 3) + 8 * j; const LAS float* s = scr + (8 * c) * 33 + n;
        v4u o; o.x = pk2(s[0 * 33], s[1 * 33]); o.y = pk2(s[2 * 33], s[3 * 33]); o.z = pk2(s[4 * 33], s[5 * 33]); o.w = pk2(s[6 * 33], s[7 * 33]);
        *(GAS v4u*)(WT + (size_t)(n0 + n) * K + k0 + 8 * c) = o; }
    LDS_WAIT(); asm volatile("" ::: "memory");
}

__device__ __forceinline__ void mod_gemv(Ctx& C, const Args& A) {
    const float* cc = ((const float*)A.in[1]); const float* w_ada = ((const float*)A.in[3]); const float* b_ada = ((const float*)A.in[4]); float* mod = (float*)(C.ws + WS_MOD);
    LAS float* sc = (LAS float*)C.lds;
    LAS float* red = (LAS float*)(C.lds + 32768);
    const int col0 = C.vcu * 32, col = C.tid & 31, ks = C.tid >> 5;
    float acc[32];
#pragma unroll
    for (int i = 0; i < 32; ++i) acc[i] = 0.f;
    for (int kt = 0; kt < 4; ++kt) {
        for (int idx = C.tid; idx < 8192; idx += NTHR) { const int kk = idx >> 5, b = idx & 31; const float v = cc[b * 1024 + kt * 256 + kk]; sc[idx] = v / (1.f + __expf(-v)); }
        __syncthreads();
#pragma unroll 4
        for (int k2 = 0; k2 < 16; ++k2) { const int k = ks * 16 + k2; const float w = w_ada[(size_t)(kt * 256 + k) * NMOD + col0 + col];
#pragma unroll
            for (int b4 = 0; b4 < 8; ++b4) { const f32x4 f = *(const LAS f32x4*)(sc + k * 32 + 4 * b4);
                acc[4 * b4 + 0] += w * f.x; acc[4 * b4 + 1] += w * f.y; acc[4 * b4 + 2] += w * f.z; acc[4 * b4 + 3] += w * f.w; } }
        __syncthreads();
    }
#pragma unroll
    for (int b = 0; b < 32; ++b) red[(ks * 32 + b) * 32 + col] = acc[b];
    __syncthreads();
#pragma unroll
    for (int oo = 0; oo < 2; ++oo) { const int o = C.tid + oo * NTHR, c_ = o & 31, b = o >> 5; float s = 0.f;
#pragma unroll
        for (int k = 0; k < 16; ++k) s += red[(k * 32 + b) * 32 + c_];
        mod[b * NMOD + col0 + c_] = s + b_ada[col0 + c_]; }
    __syncthreads();
}

__device__ __forceinline__ void phase0(Ctx& C, const Args& A) {
    if (C.vcu < 192) mod_gemv(C, A);
    bf16* WoutT = (bf16*)(C.ws + WS_WOUT_T);
    const float* w_in = ((const float*)A.in[6]);
    unsigned* wmax = (unsigned*)(C.ctl + CW_WMAX);
    {
        LAS float* scr = (LAS float*)(C.lds + C.wave * 16384);
        const int gw = C.vcu * NWAVES + C.wave, NGW = C.G * NWAVES;
        constexpr int I_OUT = 16 * 32;
        for (int it = gw; it < I_OUT; it += NGW) p0_transpose_item(((const float*)A.in[17]), 1024, 1024, 32, WoutT, scr, it, C.lane);
    }
    const int gt = C.vcu * NTHR + C.tid, NGT = C.G * NTHR;
    {
        for (int it = gt; it < 16 * 3072; it += NGT) { const int kb = it / 3072, n = it - kb * 3072; float mx = 0.f;
#pragma unroll 8
            for (int k = 0; k < 64; ++k) mx = fmaxf(mx, fabsf(w_in[(size_t)(64 * kb + k) * NIN + n]));
            atomicMax(wmax + n, __float_as_uint(mx)); }
        const float* w_q = ((const float*)A.in[19]);
        for (int it = gt; it < 16 * 2048; it += NGT) { const int kb = it >> 11, n = it & 2047; float mx = 0.f;
#pragma unroll 8
            for (int k = 0; k < 64; ++k) mx = fmaxf(mx, fabsf(w_q[(size_t)(64 * kb + k) * NQP + n]));
            atomicMax(wmax + NPROJ + n, __float_as_uint(mx)); }
    }
    {
        const float* wg2 = ((const float*)A.in[14]); float* WE = (float*)(C.ws + WS_WEFF);
        for (int it = gt; it < 256 * 128; it += NGT) { const int j = it >> 7, kc = it & 127; float g[16];
#pragma unroll
            for (int r = 0; r < 16; ++r) g[r] = wg2[r * 256 + j];
            float o[8], mx = 0.f;
#pragma unroll
            for (int i = 0; i < 8; ++i) { const float* wr = w_in + (size_t)(8 * kc + i) * NIN + 3072; float s_ = 0.f;
#pragma unroll
                for (int r4 = 0; r4 < 4; ++r4) { const f32x4 w4 = *(const f32x4*)(wr + 4 * r4); s_ += w4.x * g[4 * r4] + w4.y * g[4 * r4 + 1] + w4.z * g[4 * r4 + 2] + w4.w * g[4 * r4 + 3]; }
                o[i] = s_; mx = fmaxf(mx, fabsf(s_)); }
            *(f32x4*)(WE + (size_t)j * 1024 + 8 * kc) = (f32x4){o[0], o[1], o[2], o[3]}; *(f32x4*)(WE + (size_t)j * 1024 + 8 * kc + 4) = (f32x4){o[4], o[5], o[6], o[7]};
            atomicMax(wmax + 3072 + j, __float_as_uint(mx)); }
    }
    {
        bf16* KB = (bf16*)(C.ws + WS_KEYS);
        for (int it = gt; it < 4096; it += NGT) { const float* src = (it < 2048 ? ((const float*)A.in[21]) : ((const float*)A.in[22])) + (size_t)(it & 2047) * 8;
            const f32x4 a = *(const f32x4*)src, b = *(const f32x4*)(src + 4);
            v4u ov; ov.x = pk2(a.x, a.y); ov.y = pk2(a.z, a.w); ov.z = pk2(b.x, b.y); ov.w = pk2(b.z, b.w);
            *(GAS v4u*)(KB + (size_t)it * 8) = ov; }
    }
    {
        const float* eu = ((const float*)A.in[23]); const float* ev = ((const float*)A.in[24]);
        unsigned char* E8 = C.ws + WS_EU; float* ES = (float*)(C.ws + WS_ES);
        const int gw = C.vcu * NWAVES + C.wave, NGW = C.G * NWAVES;
        f32x4 nv[4];
        { const int row = gw < 2 * NEXP ? gw : 0; const float* src = (row < NEXP ? eu + (size_t)row * 1024 : ev + (size_t)(row - NEXP) * 1024) + 16 * C.lane;
#pragma unroll
          for (int i = 0; i < 4; ++i) nv[i] = *(const f32x4*)(src + 4 * i); }
        for (int row = gw; row < 2 * NEXP; row += NGW) {
            f32x4 v[4]; float mx = 0.f;
#pragma unroll
            for (int i = 0; i < 4; ++i) v[i] = nv[i];
            { const int rn = row + NGW < 2 * NEXP ? row + NGW : row; const float* src = (rn < NEXP ? eu + (size_t)rn * 1024 : ev + (size_t)(rn - NEXP) * 1024) + 16 * C.lane;
#pragma unroll
              for (int i = 0; i < 4; ++i) nv[i] = *(const f32x4*)(src + 4 * i); }
#pragma unroll
            for (int i = 0; i < 4; ++i) mx = fmaxf(mx, fmaxf(fmaxf(fabsf(v[i].x), fabsf(v[i].y)), fmaxf(fabsf(v[i].z), fabsf(v[i].w))));
            mx = fmaxf(mx, __int_as_float(__builtin_amdgcn_update_dpp(0, __float_as_int(mx), 0xb1, 0xf, 0xf, false)));
            mx = fmaxf(mx, __int_as_float(__builtin_amdgcn_update_dpp(0, __float_as_int(mx), 0x4e, 0xf, 0xf, false)));
            mx = fmaxf(mx, __int_as_float(__builtin_amdgcn_update_dpp(0, __float_as_int(mx), 0x124, 0xf, 0xf, false)));
            mx = fmaxf(mx, __int_as_float(__builtin_amdgcn_update_dpp(0, __float_as_int(mx), 0x128, 0xf, 0xf, false)));
            { auto r = __builtin_amdgcn_permlane16_swap(__float_as_uint(mx), __float_as_uint(mx), false, false); mx = fmaxf(__uint_as_float(r[0]), __uint_as_float(r[1])); }
            { auto r = __builtin_amdgcn_permlane32_swap(__float_as_uint(mx), __float_as_uint(mx), false, false); mx = fmaxf(__uint_as_float(r[0]), __uint_as_float(r[1])); }
            const bool isu = true;
            const float top = 127.f;
            const float sc = mx > 0.f ? top / mx : 1.f, inv = mx > 0.f ? mx / top : 1.f;
            v4u ov;
#pragma unroll
            for (int i = 0; i < 4; ++i) {
                if (isu) { const int b0 = (int)rintf(v[i].x * sc), b1 = (int)rintf(v[i].y * sc), b2 = (int)rintf(v[i].z * sc), b3 = (int)rintf(v[i].w * sc);
                    ov[i] = (unsigned)(b0 & 0xff) | ((unsigned)(b1 & 0xff) << 8) | ((unsigned)(b2 & 0xff) << 16) | ((unsigned)(b3 & 0xff) << 24); }
                else { int w = __builtin_amdgcn_cvt_pk_fp8_f32(v[i].x * sc, v[i].y * sc, 0, false); w = __builtin_amdgcn_cvt_pk_fp8_f32(v[i].z * sc, v[i].w * sc, w, true); ov[i] = (unsigned)w; } }
            *(GAS v4u*)(E8 + (size_t)(row >= NEXP ? 1 : 0) * (16u << 20) + (size_t)(C.lane >> 3) * (2u << 20) + (size_t)(row & (NEXP - 1)) * 128 + 16 * (C.lane & 7)) = ov;
            if (C.lane == 0) ES[row] = inv;
        }
    }
}

__device__ __forceinline__ void phase0b(Ctx& C, const Args& A) {
    const float* w_in = ((const float*)A.in[6]); const float* WE = (const float*)(C.ws + WS_WEFF); const unsigned* wmax = (const unsigned*)(C.ctl + CW_WMAX);
    unsigned char* W8 = C.ws + WS_WIN_T; float* CS = (float*)(C.ws + WS_CS);
    const int gt = C.vcu * NTHR + C.tid, NGT = C.G * NTHR;
    for (int n = gt; n < NPROJ; n += NGT) { const float mx = __uint_as_float(__hip_atomic_load(wmax + n, __ATOMIC_RELAXED, __HIP_MEMORY_SCOPE_AGENT)); CS[n] = mx > 0.f ? mx * (1.f / 127.f) : 1.f; }
    for (int it = gt; it < 64 * 3072; it += NGT) { const int kb = it / 3072, n = it - kb * 3072;
        const float mx = __uint_as_float(__hip_atomic_load(wmax + n, __ATOMIC_RELAXED, __HIP_MEMORY_SCOPE_AGENT)); const float sc = mx > 0.f ? 127.f / mx : 1.f;
        v4u ov;
#pragma unroll
        for (int q = 0; q < 4; ++q) { int b_[4];
#pragma unroll
            for (int i = 0; i < 4; ++i) b_[i] = (int)rintf(w_in[(size_t)(16 * kb + 4 * q + i) * NIN + n] * sc);
            ov[q] = (unsigned)(b_[0] & 0xff) | ((unsigned)(b_[1] & 0xff) << 8) | ((unsigned)(b_[2] & 0xff) << 16) | ((unsigned)(b_[3] & 0xff) << 24); }
        *(GAS v4u*)(W8 + (size_t)n * 1024 + 16 * kb) = ov; }
    {   const float* w_q = ((const float*)A.in[19]); unsigned char* Q8 = C.ws + WS_WQ_T; float* CSQ = (float*)(C.ws + WS_CSQ);
        for (int n = gt; n < NQP; n += NGT) { const float mx = __uint_as_float(__hip_atomic_load(wmax + NPROJ + n, __ATOMIC_RELAXED, __HIP_MEMORY_SCOPE_AGENT)); CSQ[n] = mx > 0.f ? mx * (1.f / 127.f) : 1.f; }
        for (int it = gt; it < 64 * 2048; it += NGT) { const int kb = it >> 11, n = it & 2047;
            const float mx = __uint_as_float(__hip_atomic_load(wmax + NPROJ + n, __ATOMIC_RELAXED, __HIP_MEMORY_SCOPE_AGENT)); const float sc = mx > 0.f ? 127.f / mx : 1.f;
            v4u ov;
#pragma unroll
            for (int q = 0; q < 4; ++q) { int b_[4];
#pragma unroll
                for (int i = 0; i < 4; ++i) b_[i] = (int)rintf(w_q[(size_t)(16 * kb + 4 * q + i) * NQP + n] * sc);
                ov[q] = (unsigned)(b_[0] & 0xff) | ((unsigned)(b_[1] & 0xff) << 8) | ((unsigned)(b_[2] & 0xff) << 16) | ((unsigned)(b_[3] & 0xff) << 24); }
            *(GAS v4u*)(Q8 + (size_t)n * 1024 + 16 * kb) = ov; }
    }
    for (int it = gt; it < 256 * 64; it += NGT) { const int j = it >> 6, kb = it & 63;
        const float mx = __uint_as_float(__hip_atomic_load(wmax + 3072 + j, __ATOMIC_RELAXED, __HIP_MEMORY_SCOPE_AGENT)); const float sc = mx > 0.f ? 127.f / mx : 1.f;
        v4u ov;
#pragma unroll
        for (int q = 0; q < 4; ++q) { const f32x4 w4 = *(const f32x4*)(WE + (size_t)j * 1024 + 16 * kb + 4 * q);
            const int b0 = (int)rintf(w4.x * sc), b1 = (int)rintf(w4.y * sc), b2 = (int)rintf(w4.z * sc), b3 = (int)rintf(w4.w * sc);
            ov[q] = (unsigned)(b0 & 0xff) | ((unsigned)(b1 & 0xff) << 8) | ((unsigned)(b2 & 0xff) << 16) | ((unsigned)(b3 & 0xff) << 24); }
        *(GAS v4u*)(W8 + (size_t)(3072 + j) * 1024 + 16 * kb) = ov; }
}

template <bool XBF, bool OUT8> __device__ __forceinline__ void norm_mod_rows32(const float* X, const float* g, const float* sc, const float* sh, bf16* O, float* RS, int row0, int rstride, int lane,
                                                                   const int* pos, float* COS, float* SIN, float invf) {
    f32x4 gs[4], hs[4];
#pragma unroll
    for (int j = 0; j < 4; ++j) { const int cidx = 128 * (j >> 1) + 2 * lane + (j & 1); const f32x4 g4 = ((const f32x4*)g)[cidx], s4 = ((const f32x4*)sc)[cidx]; gs[j] = g4 * (s4 + 1.0f); hs[j] = ((const f32x4*)sh)[cidx]; }
    f32x4 nx[4], ny[4], nz[4];
#define NM_LOAD(dst, r) do { if (!XBF) { _Pragma("unroll") for (int j = 0; j < 4; ++j) dst[j] = ((const GAS f32x4*)(X + (size_t)(r) * DM))[128 * (j >> 1) + 2 * lane + (j & 1)]; } \
        else { _Pragma("unroll") for (int hf_ = 0; hf_ < 2; ++hf_) { const v4u w_ = ((const GAS v4u*)((const bf16*)X + (size_t)(r) * DM))[64 * hf_ + lane]; \
            dst[2 * hf_] = (f32x4){bf_lo(w_.x), bf_hi(w_.x), bf_lo(w_.y), bf_hi(w_.y)}; dst[2 * hf_ + 1] = (f32x4){bf_lo(w_.z), bf_hi(w_.z), bf_lo(w_.w), bf_hi(w_.w)}; } } } while (0)
    NM_LOAD(nx, row0); NM_LOAD(ny, row0 + rstride); NM_LOAD(nz, row0 + 2 * rstride);
#pragma unroll 1
    for (int i = 0; i < 32; ++i) {
        const int m = row0 + i * rstride, mn = row0 + (i < 29 ? i + 3 : 31) * rstride;
        f32x4 v[4];
#pragma unroll
        for (int j = 0; j < 4; ++j) { v[j] = nx[j]; nx[j] = ny[j]; ny[j] = nz[j]; }
        NM_LOAD(nz, mn);
        float s = 0.f;
#pragma unroll
        for (int j = 0; j < 4; ++j) s += (v[j].x * v[j].x + v[j].y * v[j].y) + (v[j].z * v[j].z + v[j].w * v[j].w);
        const float rinv = 1.0f / sqrtf(wave_sum_fast(s) * (1.f / 1024.f) + RMS_EPS);
        if (!OUT8) {
            GAS v4u* o16 = (GAS v4u*)(O + (size_t)m * DM) + lane;
#pragma unroll
            for (int hf = 0; hf < 2; ++hf) { const f32x4 y0 = v[2 * hf] * rinv * gs[2 * hf] + hs[2 * hf], y1 = v[2 * hf + 1] * rinv * gs[2 * hf + 1] + hs[2 * hf + 1];
                o16[64 * hf] = (v4u){cvtpk(y0.x, y0.y), cvtpk(y0.z, y0.w), cvtpk(y1.x, y1.y), cvtpk(y1.z, y1.w)}; }
        } else {
            f32x4 y[4]; float mx = 0.f;
#pragma unroll
            for (int j = 0; j < 4; ++j) { y[j] = v[j] * rinv * gs[j] + hs[j]; mx = fmaxf(mx, fmaxf(fmaxf(fabsf(y[j].x), fabsf(y[j].y)), fmaxf(fabsf(y[j].z), fabsf(y[j].w)))); }
            mx = fmaxf(mx, __int_as_float(__builtin_amdgcn_update_dpp(0, __float_as_int(mx), 0xb1, 0xf, 0xf, false)));
            mx = fmaxf(mx, __int_as_float(__builtin_amdgcn_update_dpp(0, __float_as_int(mx), 0x4e, 0xf, 0xf, false)));
            mx = fmaxf(mx, __int_as_float(__builtin_amdgcn_update_dpp(0, __float_as_int(mx), 0x124, 0xf, 0xf, false)));
            mx = fmaxf(mx, __int_as_float(__builtin_amdgcn_update_dpp(0, __float_as_int(mx), 0x128, 0xf, 0xf, false)));
            { auto r = __builtin_amdgcn_permlane16_swap(__float_as_uint(mx), __float_as_uint(mx), false, false); mx = fmaxf(__uint_as_float(r[0]), __uint_as_float(r[1])); }
            { auto r = __builtin_amdgcn_permlane32_swap(__float_as_uint(mx), __float_as_uint(mx), false, false); mx = fmaxf(__uint_as_float(r[0]), __uint_as_float(r[1])); }
            const float qs = mx > 0.f ? 127.f / mx : 1.f;
            GAS u32x2* o8 = (GAS u32x2*)((unsigned char*)O + (size_t)m * DM) + lane;
#pragma unroll
            for (int hf = 0; hf < 2; ++hf) { u32x2 w;
#pragma unroll
                for (int q = 0; q < 2; ++q) { const f32x4 yy = y[2 * hf + q]; const int b0 = (int)rintf(yy.x * qs), b1 = (int)rintf(yy.y * qs), b2 = (int)rintf(yy.z * qs), b3 = (int)rintf(yy.w * qs);
                    w[q] = (unsigned)(b0 & 0xff) | ((unsigned)(b1 & 0xff) << 8) | ((unsigned)(b2 & 0xff) << 16) | ((unsigned)(b3 & 0xff) << 24); }
                o8[64 * hf] = w; }
            if (lane == 0) RS[m] = mx > 0.f ? mx * (1.f / 127.f) : 1.f;
        }
    }
#undef NM_LOAD
}
__device__ __forceinline__ void phase1(Ctx& C, const Args& A) {
    const float* x = ((const float*)A.in[0]); const int* pos = (const int*)((const float*)A.in[2]); const float* g = ((const float*)A.in[5]); const float* mod = (const float*)(C.ws + WS_MOD);
    bf16* H = (bf16*)(C.ws + WS_H); float* COS = (float*)(C.ws + WS_COS); float* SIN = (float*)(C.ws + WS_SIN);
    const int gw = C.vcu * NWAVES + C.wave, NGW = C.G * NWAVES;
    const float invf = __builtin_amdgcn_exp2f(-(float)(C.lane & 31) * 0.41524101186092029f);
    for (int ch = gw; ch < NTOK / 32; ch += NGW) { const int b = ch >> 6;
        norm_mod_rows32<false, true>(x, g, mod + b * NMOD + 1024, mod + b * NMOD, H, (float*)(C.ws + WS_RS1), 2048 * b + (ch & 63), 64, C.lane, pos, COS, SIN, invf); }
}
__device__ __forceinline__ void phase5(Ctx& C, const Args& A) {
    const float* x1 = (const float*)(C.ws + WS_X1); const float* g = ((const float*)A.in[18]); const float* mod = (const float*)(C.ws + WS_MOD); bf16* H = (bf16*)(C.ws + WS_H);
    const int gw = C.vcu * NWAVES + C.wave, NGW = C.G * NWAVES;
    for (int ch = gw; ch < NTOK / 32; ch += NGW) { const int b = ch >> 6;
        norm_mod_rows32<true, true>(x1, g, mod + b * NMOD + 4 * 1024, mod + b * NMOD + 3 * 1024, H, (float*)(C.ws + WS_RS2), 2048 * b + (ch & 63), 64, C.lane, nullptr, nullptr, nullptr, 0.f); }
}

__device__ __forceinline__ void phase2b(Ctx& C, const Args& A) {
    bf16* PROJ = (bf16*)(C.ws + WS_PROJ); const int* pos = (const int*)A.in[2];
    const float* qn = ((const float*)A.in[7]); const float* kn = ((const float*)A.in[8]);
    const int gw = C.vcu * NWAVES + C.wave, NGW = C.G * NWAVES, lane = C.lane;
    const int grp = lane >> 2, qd = lane & 3;
    float gain[16];
#pragma unroll
    for (int i = 0; i < 16; ++i) gain[i] = (grp < 8 ? qn : kn)[16 * qd + i] * (grp < 8 ? QSCALE : 1.0f);
    const float sgn = (qd < 2) ? -1.f : 1.f;
    float invf[16];
#pragma unroll
    for (int i = 0; i < 16; ++i) invf[i] = __builtin_amdgcn_exp2f(-(float)(16 * (qd & 1) + i) * 0.41524101186092029f);
    v4u n0, n1; int npos;
    { const int m0 = gw < NTOK ? gw : 0; const GAS v4u* p = (const GAS v4u*)(PROJ + (size_t)m0 * NPROJ + 16 * lane); n0 = p[0]; n1 = p[1]; npos = pos[m0]; }
    for (int m = gw; m < NTOK; m += NGW) {
        GAS v4u* p = (GAS v4u*)(PROJ + (size_t)m * NPROJ + 16 * lane);
        const v4u w0 = n0, w1 = n1; const int ipos = npos;
        { const int mn = m + NGW < NTOK ? m + NGW : m; const GAS v4u* pn = (const GAS v4u*)(PROJ + (size_t)mn * NPROJ + 16 * lane); n0 = pn[0]; n1 = pn[1]; npos = pos[mn]; }
        float xv[16];
        xv[0] = bf_lo(w0.x); xv[1] = bf_hi(w0.x); xv[2] = bf_lo(w0.y); xv[3] = bf_hi(w0.y); xv[4] = bf_lo(w0.z); xv[5] = bf_hi(w0.z); xv[6] = bf_lo(w0.w); xv[7] = bf_hi(w0.w);
        xv[8] = bf_lo(w1.x); xv[9] = bf_hi(w1.x); xv[10] = bf_lo(w1.y); xv[11] = bf_hi(w1.y); xv[12] = bf_lo(w1.z); xv[13] = bf_hi(w1.z); xv[14] = bf_lo(w1.w); xv[15] = bf_hi(w1.w);
        float ss = 0.f;
#pragma unroll
        for (int i = 0; i < 16; ++i) ss += xv[i] * xv[i];
        ss += __int_as_float(__builtin_amdgcn_update_dpp(0, __float_as_int(ss), 0xb1, 0xf, 0xf, false)); ss += __int_as_float(__builtin_amdgcn_update_dpp(0, __float_as_int(ss), 0x4e, 0xf, 0xf, false));
        const float rinv = 1.0f / sqrtf(ss * (1.f / 64.f) + RMS_EPS);
        const float fpos = (float)ipos;
        float cs[16], sn[16];
#pragma unroll
        for (int i = 0; i < 16; ++i) { const float ang = fpos * invf[i]; const float fr = __builtin_amdgcn_fractf(ang * 0.15915494309189535f);
            cs[i] = __builtin_amdgcn_cosf(fr); sn[i] = __builtin_amdgcn_sinf(fr); }
        float y[16];
#pragma unroll
        for (int i = 0; i < 16; ++i) { const float v = xv[i] * rinv * gain[i]; const float pv = __int_as_float(__builtin_amdgcn_update_dpp(0, __float_as_int(v), 0x4e, 0xf, 0xf, false)); y[i] = v * cs[i] + sgn * pv * sn[i]; }
        v4u o0, o1;
        o0.x = cvtpk(y[0], y[1]); o0.y = cvtpk(y[2], y[3]); o0.z = cvtpk(y[4], y[5]); o0.w = cvtpk(y[6], y[7]);
        o1.x = cvtpk(y[8], y[9]); o1.y = cvtpk(y[10], y[11]); o1.z = cvtpk(y[12], y[13]); o1.w = cvtpk(y[14], y[15]);
        p[0] = o0; p[1] = o1;
    }
}

constexpr int AT_KP = 144, AT_VP = 320;
constexpr int AT_K1 = 64 * AT_KP, AT_V = 2 * 64 * AT_KP, AT_STG = AT_V + 64 * AT_VP;
constexpr int AT_XP = 129;
constexpr int AT_YST = 66048, AT_YP = 272;
static_assert(4 * AT_STG <= MISC_OFF && 128 * AT_XP * 4 <= AT_YST && AT_YST + 128 * AT_YP <= 4 * AT_STG, "attention LDS map");

template <int ABL> __device__ __forceinline__ void attn_unit(Ctx& C, const Args& A, int bh, int qb, float lam) {
    const int b = bh >> 2, h = bh & 3;
    int tid_ = C.tid; asm volatile("" : "+v"(tid_));
    const int tid = tid_, lane = tid & 63, w = C.wave, r32 = lane & 31, hi = lane >> 5, mp = w >> 2, wq = w & 3;
    const bf16* P = (const bf16*)(C.ws + WS_PROJ) + (size_t)(b * SEQ) * NPROJ;
    const int NT = 2 * qb + 2;
    const int krow = tid >> 3, kch = tid & 7, vrow = tid >> 4, vch = tid & 15;
    const bf16* gk = P + (size_t)krow * NPROJ + C_DK + h * 128 + 8 * kch;
    const bf16* gv = P + (size_t)vrow * NPROJ + C_DV + h * 128 + 8 * vch;
    v4u skA0, skA1, svA0, svA1, skB0, skB1, svB0, svB1;
#define AT_LOAD(t, S) do { const size_t o_ = (size_t)(t) * 64 * NPROJ; sk##S##0 = *(const GAS v4u*)(gk + o_); sk##S##1 = *(const GAS v4u*)(gk + o_ + 64); \
        sv##S##0 = *(const GAS v4u*)(gv + o_); sv##S##1 = *(const GAS v4u*)(gv + o_ + (size_t)32 * NPROJ); } while (0)
#define AT_STORE(s, S) do { LAS unsigned char* bs_ = C.lds + (s) * AT_STG; *(LAS v4u*)(bs_ + krow * AT_KP + kch * 16) = sk##S##0; *(LAS v4u*)(bs_ + AT_K1 + krow * AT_KP + kch * 16) = sk##S##1; \
        *(LAS v4u*)(bs_ + AT_V + vrow * AT_VP + vch * 16) = sv##S##0; *(LAS v4u*)(bs_ + AT_V + (vrow + 32) * AT_VP + vch * 16) = sv##S##1; } while (0)
    AT_LOAD(0, A);
    AT_LOAD(1, B);
    const int qrow = qb * 128 + wq * 32 + r32;
    bf16x8 qf[4];
#pragma unroll
    for (int kk = 0; kk < 4; ++kk) qf[kk] = *(const GAS bf16x8*)(P + (size_t)qrow * NPROJ + C_DQ + h * 128 + mp * 64 + 16 * kk + 8 * hi);
    f32x16 o[4];
#pragma unroll
    for (int e = 0; e < 4; ++e)
#pragma unroll
        for (int r = 0; r < 16; ++r) o[e][r] = 0.f;
    float mrun = -1e30f, lrun = 0.f;
    AT_STORE(0, A); AT_STORE(1, B);
    if (2 < NT) { AT_LOAD(2, A); AT_LOAD(3, B); }
    __syncthreads();
    const int trbase = ((lane & 15) >> 2) * AT_VP + (16 * ((lane >> 4) & 1) + 4 * (lane & 3)) * 2;
#define AT_QKSM(t, stg, PW) do { \
        const LAS unsigned char* base = C.lds + (stg) * AT_STG; \
        f32x16 p0, p1; \
        _Pragma("unroll") for (int r = 0; r < 16; ++r) { p0[r] = 0.f; p1[r] = 0.f; } \
        const LAS unsigned char* kb_ = base + mp * AT_K1 + r32 * AT_KP + hi * 16; \
        bf16x8 ka_[4], kb2_[4]; \
        _Pragma("unroll") for (int kk = 0; kk < 4; ++kk) { ka_[kk] = *(const LAS bf16x8*)(kb_ + kk * 32); kb2_[kk] = *(const LAS bf16x8*)(kb_ + 32 * AT_KP + kk * 32); } \
        __builtin_amdgcn_s_setprio(1); \
        _Pragma("unroll") for (int kk = 0; kk < 4; ++kk) { p0 = MFMA32(ka_[kk], qf[kk], p0); p1 = MFMA32(kb2_[kk], qf[kk], p1); } \
        __builtin_amdgcn_s_setprio(0); \
        if ((t) >= 2 * qb) { \
            _Pragma("unroll") for (int r = 0; r < 16; ++r) { const int key = 64 * (t) + crow(r, hi); if (key > qrow) p0[r] = -1e30f; if (key + 32 > qrow) p1[r] = -1e30f; } } \
        float mx = fmaxf(p0[0], p1[0]); \
        _Pragma("unroll") for (int r = 1; r < 16; ++r) mx = fmaxf(mx, fmaxf(p0[r], p1[r])); \
        mx = pair_max(mx); \
        const float mnew = fmaxf(mrun, mx); \
        if (__any(mnew > mrun)) { const float alpha = __builtin_amdgcn_exp2f(mrun - mnew); mrun = mnew; lrun *= alpha; \
            _Pragma("unroll") for (int e = 0; e < 4; ++e) _Pragma("unroll") for (int r = 0; r < 16; ++r) o[e][r] *= alpha; } \
        float rs = 0.f; \
        _Pragma("unroll") for (int r = 0; r < 16; ++r) { p0[r] = __builtin_amdgcn_exp2f(p0[r] - mrun); p1[r] = __builtin_amdgcn_exp2f(p1[r] - mrun); rs += p0[r] + p1[r]; } \
        lrun += rs; \
        { v4u t0, t1, t2, t3; \
          t0.x = cvtpk(p0[0], p0[1]); t0.y = cvtpk(p0[2], p0[3]); t0.z = cvtpk(p0[4], p0[5]); t0.w = cvtpk(p0[6], p0[7]); \
          t1.x = cvtpk(p0[8], p0[9]); t1.y = cvtpk(p0[10], p0[11]); t1.z = cvtpk(p0[12], p0[13]); t1.w = cvtpk(p0[14], p0[15]); \
          t2.x = cvtpk(p1[0], p1[1]); t2.y = cvtpk(p1[2], p1[3]); t2.z = cvtpk(p1[4], p1[5]); t2.w = cvtpk(p1[6], p1[7]); \
          t3.x = cvtpk(p1[8], p1[9]); t3.y = cvtpk(p1[10], p1[11]); t3.z = cvtpk(p1[12], p1[13]); t3.w = cvtpk(p1[14], p1[15]); \
          PW[0] = __builtin_bit_cast(bf16x8, t0); PW[1] = __builtin_bit_cast(bf16x8, t1); PW[2] = __builtin_bit_cast(bf16x8, t2); PW[3] = __builtin_bit_cast(bf16x8, t3); } \
    } while (0)
#define AT_PV(stage, PW) do { const LAS unsigned char* vb_ = C.lds + (stage) * AT_STG + AT_V + trbase + (4 * hi) * AT_VP; \
        _Pragma("unroll") for (int e = 0; e < 4; ++e) { \
            v4i16_t lo[4], hi4[4]; \
            _Pragma("unroll") for (int s = 0; s < 4; ++s) { const LAS unsigned char* a_ = vb_ + (16 * s) * AT_VP + e * 64; lo[s] = tr16(a_); hi4[s] = tr16(a_ + 8 * AT_VP); } \
            __builtin_amdgcn_s_setprio(1); \
            _Pragma("unroll") for (int s = 0; s < 4; ++s) o[e] = MFMA32(mk8(lo[s], hi4[s]), PW[s], o[e]); \
            __builtin_amdgcn_s_setprio(0); \
            __builtin_amdgcn_sched_barrier(0); \
        } } while (0)
    bf16x8 pw[4];
    for (int t = 0; t < NT; t += 2) {
        AT_QKSM(t, t & 3, pw); __builtin_amdgcn_sched_barrier(0); AT_PV(t & 3, pw);
        if (t + 2 < NT) { AT_STORE((t + 2) & 3, A); if (t + 4 < NT) AT_LOAD(t + 4, A); }
        AT_QKSM(t + 1, (t + 1) & 3, pw); __builtin_amdgcn_sched_barrier(0); AT_PV((t + 1) & 3, pw);
        if (t + 3 < NT) { AT_STORE((t + 3) & 3, B); if (t + 5 < NT) AT_LOAD(t + 5, B); }
        __syncthreads();
    }
    __syncthreads();
#undef AT_QKSM
#undef AT_PV
    lrun = pair_sum(lrun);
    const float linv = 1.0f / lrun;
    LAS float* xch = (LAS float*)C.lds;
    if (mp == 1) {
#pragma unroll
        for (int e = 0; e < 4; ++e)
#pragma unroll
            for (int r = 0; r < 16; ++r) xch[(wq * 32 + r32) * AT_XP + 32 * e + crow(r, hi)] = o[e][r] * linv;
    }
    __syncthreads();
    if (mp == 0 && ABL != 0) { asm volatile("" :: "v"(o[0]), "v"(o[1]), "v"(o[2]), "v"(o[3]), "v"(lrun)); }
    if (mp == 0 && ABL == 0) {
        const float* sg = ((const float*)A.in[13]);
        float ss = 0.f;
#pragma unroll
        for (int e = 0; e < 4; ++e)
#pragma unroll
            for (int r = 0; r < 16; ++r) { const float v = o[e][r] * linv - lam * xch[(wq * 32 + r32) * AT_XP + 32 * e + crow(r, hi)]; o[e][r] = v; ss += v * v; }
        ss = pair_sum(ss);
        const float rinv = (1.0f - LAMBDA_INIT) / sqrtf(ss * (1.f / 128.f) + RMS_EPS);
        LAS unsigned char* yst = C.lds + AT_YST + (wq * 32 + r32) * AT_YP;
#pragma unroll
        for (int e = 0; e < 4; ++e)
#pragma unroll
            for (int g = 0; g < 4; ++g) { const int ec = 32 * e + 8 * g + 4 * hi; const f32x4 g4 = *(const f32x4*)(sg + ec);
                u32x2 ov; ov.x = cvtpk(o[e][4 * g] * rinv * g4.x, o[e][4 * g + 1] * rinv * g4.y); ov.y = cvtpk(o[e][4 * g + 2] * rinv * g4.z, o[e][4 * g + 3] * rinv * g4.w);
                *(LAS u32x2*)(yst + ec * 2) = ov; }
    }
    __syncthreads();
    if (ABL == 0) {
        bf16* Y = (bf16*)(C.ws + WS_Y) + (size_t)(b * SEQ + qb * 128) * DM + h * 128;
#pragma unroll
        for (int i = 0; i < 4; ++i) { const int idx = tid + i * NTHR, row = idx >> 4, ch = idx & 15;
            *(GAS v4u*)(Y + (size_t)row * DM + 8 * ch) = *(const LAS v4u*)(C.lds + AT_YST + row * AT_YP + ch * 16); }
    }
    __syncthreads();
#undef AT_LOAD
#undef AT_STORE
}

constexpr int GL_BC = 0;
constexpr int GL_QE = 17408, GL_KE = GL_QE + 9216, GL_QS = GL_KE + 9216, GL_AM = GL_QS + 9216;
constexpr int GL_KD = GL_AM + 9216;
constexpr int GL_V = GL_KD + 12288;
constexpr int GL_SB = GL_V + 20480;
constexpr int GL_O = GL_SB + 20480;
constexpr int GL_SM = GL_O + 33792;
constexpr int GL_END = GL_SM + 768 + 2048;
static_assert(GL_END <= MISC_OFF, "GLA LDS map");

__device__ __forceinline__ void gla_unit(Ctx& C, const Args& A, int bh) {
    const int b = bh >> 2, h = bh & 3;
    int tid_ = C.tid; asm volatile("" : "+v"(tid_));
    const int tid = tid_, lane = tid & 63, w = C.wave, r32 = lane & 31, hi = lane >> 5;
    const bf16* P = (const bf16*)(C.ws + WS_PROJ) + (size_t)(b * SEQ) * NPROJ;
    bf16* Y = (bf16*)(C.ws + WS_Y) + (size_t)(b * SEQ) * DM + 512 + h * 128;
    LAS unsigned char* L = C.lds;
    LAS float* BC = (LAS float*)(L + GL_BC); LAS float* BMID = (LAS float*)(L + GL_SM); LAS float* BLAST = BMID + 64; LAS float* DEC = BMID + 128; LAS float* SEG = BMID + 192;
    LAS float* OI = (LAS float*)(L + GL_O);
    const float bg = ((const float*)A.in[15])[h * 64 + (tid & 63)];
    const int db = w & 1, eb = w >> 1;
    f32x16 S;
#pragma unroll
    for (int r = 0; r < 16; ++r) S[r] = 0.f;
    const int trq = (lane & 15) >> 2, trc = 16 * ((lane >> 4) & 1) + 4 * (lane & 3);
    unsigned short pre_n[8]; v4u q_n, k_n, v_n[2], r_n[2];
#define GL_FETCH(n_) do { const bf16* Pf_ = P + (size_t)((n_) * 64) * NPROJ; \
        _Pragma("unroll") for (int i = 0; i < 8; ++i) pre_n[i] = *(const GAS unsigned short*)(Pf_ + (size_t)(8 * (tid >> 6) + i) * NPROJ + C_GG + h * 64 + (tid & 63)); \
        q_n = *(const GAS v4u*)(Pf_ + (size_t)(tid >> 3) * NPROJ + C_GQ + h * 64 + 8 * (tid & 7)); k_n = *(const GAS v4u*)(Pf_ + (size_t)(tid >> 3) * NPROJ + C_GK + h * 64 + 8 * (tid & 7)); \
        _Pragma("unroll") for (int i = 0; i < 2; ++i) { const int idx_ = tid + i * NTHR; v_n[i] = *(const GAS v4u*)(Pf_ + (size_t)(idx_ >> 4) * NPROJ + C_GV + h * 128 + 8 * (idx_ & 15)); } \
        { const GAS v4u* rp_ = (const GAS v4u*)(Pf_ + (size_t)(tid >> 3) * NPROJ + C_GR + h * 128 + 16 * (tid & 7)); r_n[0] = rp_[0]; r_n[1] = rp_[1]; } } while (0)
    GL_FETCH(0);
    for (int n = 0; n < 32; ++n) {
        unsigned short pre_c[8]; v4u q_c = q_n, k_c = k_n, v_c[2] = {v_n[0], v_n[1]}, r_c[2] = {r_n[0], r_n[1]};
#pragma unroll
        for (int i = 0; i < 8; ++i) pre_c[i] = pre_n[i];
        GL_FETCH(n < 31 ? n + 1 : 31);
        {   const int d = tid & 63, seg = tid >> 6; float pre[8];
#pragma unroll
            for (int i = 0; i < 8; ++i) pre[i] = __uint_as_float((unsigned)pre_c[i] << 16);
            float run = 0.f;
#pragma unroll
            for (int i = 0; i < 8; ++i) { const float z = pre[i] + bg; const float ls = fminf(z, 0.f) - __logf(1.0f + __expf(-fabsf(z))); run += ls * (1.f / 16.f); pre[i] = run; }
            SEG[seg * 64 + d] = run;
            __syncthreads();
            float off = 0.f;
#pragma unroll
            for (int s = 0; s < 8; ++s) off += (s < seg) ? SEG[s * 64 + d] : 0.f;
#pragma unroll
            for (int i = 0; i < 8; ++i) { const float v = pre[i] + off; BC[(8 * seg + i) * 68 + d] = v;
                if (8 * seg + i == 32) BMID[d] = v;
                if (8 * seg + i == 63) { BLAST[d] = v; DEC[d] = __expf(v); } }
            __syncthreads();
        }
        {   const int c = tid >> 3, d8 = tid & 7;
            const v4u qw = q_c, kw = k_c;
            const unsigned qa[4] = {qw.x, qw.y, qw.z, qw.w}, ka[4] = {kw.x, kw.y, kw.z, kw.w};
            const f32x4 bc0 = *(const LAS f32x4*)(BC + c * 68 + 8 * d8), bc1 = *(const LAS f32x4*)(BC + c * 68 + 8 * d8 + 4);
            const f32x4 bm0 = *(const LAS f32x4*)(BMID + 8 * d8), bm1 = *(const LAS f32x4*)(BMID + 8 * d8 + 4);
            const f32x4 bl0 = *(const LAS f32x4*)(BLAST + 8 * d8), bl1 = *(const LAS f32x4*)(BLAST + 8 * d8 + 4);
            const float bcv[8] = {bc0.x, bc0.y, bc0.z, bc0.w, bc1.x, bc1.y, bc1.z, bc1.w}, bmv[8] = {bm0.x, bm0.y, bm0.z, bm0.w, bm1.x, bm1.y, bm1.z, bm1.w}, blv[8] = {bl0.x, bl0.y, bl0.z, bl0.w, bl1.x, bl1.y, bl1.z, bl1.w};
            float qe[8], ke[8], qs[8], kd[8];
#pragma unroll
            for (int i = 0; i < 8; ++i) { const float q = ((i & 1) ? bf_hi(qa[i >> 1]) : bf_lo(qa[i >> 1])) * 0.125f, k = (i & 1) ? bf_hi(ka[i >> 1]) : bf_lo(ka[i >> 1]);
                qe[i] = q * __expf(bcv[i] - bmv[i]); ke[i] = k * __expf(bmv[i] - bcv[i]); qs[i] = q * __expf(bcv[i]); kd[i] = k * __expf(blv[i] - bcv[i]); }
            v4u o_;
            o_.x = cvtpk(qe[0], qe[1]); o_.y = cvtpk(qe[2], qe[3]); o_.z = cvtpk(qe[4], qe[5]); o_.w = cvtpk(qe[6], qe[7]); *(LAS v4u*)(L + GL_QE + c * 144 + d8 * 16) = o_;
            o_.x = cvtpk(ke[0], ke[1]); o_.y = cvtpk(ke[2], ke[3]); o_.z = cvtpk(ke[4], ke[5]); o_.w = cvtpk(ke[6], ke[7]); *(LAS v4u*)(L + GL_KE + c * 144 + d8 * 16) = o_;
            o_.x = cvtpk(qs[0], qs[1]); o_.y = cvtpk(qs[2], qs[3]); o_.z = cvtpk(qs[4], qs[5]); o_.w = cvtpk(qs[6], qs[7]); *(LAS v4u*)(L + GL_QS + c * 144 + d8 * 16) = o_;
            o_.x = cvtpk(kd[0], kd[1]); o_.y = cvtpk(kd[2], kd[3]); o_.z = cvtpk(kd[4], kd[5]); o_.w = cvtpk(kd[6], kd[7]); *(LAS v4u*)(L + GL_KD + c * 192 + d8 * 16) = o_;
#pragma unroll
            for (int i = 0; i < 2; ++i) { const int idx = tid + i * NTHR, row = idx >> 4, ch = idx & 15;
                *(LAS v4u*)(L + GL_V + row * 320 + ch * 16) = v_c[i]; }
#pragma unroll
            for (int r = 0; r < 16; ++r) *(LAS unsigned short*)(L + GL_SB + (32 * db + crow(r, hi)) * 320 + (32 * eb + r32) * 2) = (unsigned short)(cvtpk(S[r], 0.f) & 0xffffu);
            __syncthreads();
        }
        if (w < 4) {
            const int cb = w & 1, jb = w >> 1; f32x16 a;
#pragma unroll
            for (int r = 0; r < 16; ++r) a[r] = 0.f;
#pragma unroll
            for (int kk = 0; kk < 4; ++kk) { const bf16x8 fa = *(const LAS bf16x8*)(L + GL_QE + (32 * cb + r32) * 144 + (16 * kk + 8 * hi) * 2), fb = *(const LAS bf16x8*)(L + GL_KE + (32 * jb + r32) * 144 + (16 * kk + 8 * hi) * 2);
                a = MFMA32(fa, fb, a); }
#pragma unroll
            for (int r = 0; r < 16; ++r) { const int cc = 32 * cb + crow(r, hi), jj = 32 * jb + r32; const float v = (jj <= cc) ? a[r] : 0.f;
                *(LAS unsigned short*)(L + GL_AM + cc * 144 + jj * 2) = (unsigned short)(cvtpk(v, 0.f) & 0xffffu); }
        }
        {
#pragma unroll
            for (int r = 0; r < 16; ++r) S[r] *= DEC[32 * db + crow(r, hi)];
#pragma unroll
            for (int kk = 0; kk < 4; ++kk) { const LAS unsigned char* pa = L + GL_KD + (16 * kk + 8 * hi + trq) * 192 + (32 * db + trc) * 2; const LAS unsigned char* pb = L + GL_V + (16 * kk + 8 * hi + trq) * 320 + (32 * eb + trc) * 2;
                const bf16x8 fa = mk8(tr16(pa), tr16(pa + 4 * 192)), fb = mk8(tr16(pb), tr16(pb + 4 * 320));
                S = MFMA32(fa, fb, S); }
        }
        __syncthreads();
        {   const int cb = w & 1; f32x16 a;
#pragma unroll
            for (int r = 0; r < 16; ++r) a[r] = 0.f;
#pragma unroll
            for (int kk = 0; kk < 4; ++kk) { const bf16x8 fa = *(const LAS bf16x8*)(L + GL_AM + (32 * cb + r32) * 144 + (16 * kk + 8 * hi) * 2);
                const LAS unsigned char* pb = L + GL_V + (16 * kk + 8 * hi + trq) * 320 + (32 * eb + trc) * 2;
                a = MFMA32(fa, mk8(tr16(pb), tr16(pb + 4 * 320)), a); }
#pragma unroll
            for (int kk = 0; kk < 4; ++kk) { const bf16x8 fa = *(const LAS bf16x8*)(L + GL_QS + (32 * cb + r32) * 144 + (16 * kk + 8 * hi) * 2);
                const LAS unsigned char* pb = L + GL_SB + (16 * kk + 8 * hi + trq) * 320 + (32 * eb + trc) * 2;
                a = MFMA32(fa, mk8(tr16(pb), tr16(pb + 4 * 320)), a); }
#pragma unroll
            for (int r = 0; r < 16; ++r) OI[(32 * cb + crow(r, hi)) * 132 + 32 * eb + r32] = a[r];
        }
        __syncthreads();
        {   const int c = tid >> 3, e8 = tid & 7; float ov[16];
#pragma unroll
            for (int i = 0; i < 4; ++i) { const f32x4 t4 = *(const LAS f32x4*)(OI + c * 132 + 16 * e8 + 4 * i); ov[4 * i] = t4.x; ov[4 * i + 1] = t4.y; ov[4 * i + 2] = t4.z; ov[4 * i + 3] = t4.w; }
            float ss = 0.f;
#pragma unroll
            for (int i = 0; i < 16; ++i) ss += ov[i] * ov[i];
            ss += __shfl_xor(ss, 1); ss += __shfl_xor(ss, 2); ss += __shfl_xor(ss, 4);
            const float rinv = 1.0f / sqrtf(ss * (1.f / 128.f) + RMS_EPS);
            const v4u r0 = r_c[0], r1 = r_c[1]; const unsigned ra[8] = {r0.x, r0.y, r0.z, r0.w, r1.x, r1.y, r1.z, r1.w};
            const float* gg = ((const float*)A.in[16]) + 16 * e8; float y[16];
#pragma unroll
            for (int i = 0; i < 16; ++i) { const float rv = (i & 1) ? bf_hi(ra[i >> 1]) : bf_lo(ra[i >> 1]); y[i] = ov[i] * rinv * gg[i] * (rv / (1.f + __expf(-rv))); }
            v4u o0, o1;
            o0.x = cvtpk(y[0], y[1]); o0.y = cvtpk(y[2], y[3]); o0.z = cvtpk(y[4], y[5]); o0.w = cvtpk(y[6], y[7]);
            o1.x = cvtpk(y[8], y[9]); o1.y = cvtpk(y[10], y[11]); o1.z = cvtpk(y[12], y[13]); o1.w = cvtpk(y[14], y[15]);
            GAS v4u* yp = (GAS v4u*)(Y + (size_t)(n * 64 + c) * DM + 16 * e8); yp[0] = o0; yp[1] = o1;
        }
    }
#undef GL_FETCH
    __syncthreads();
}

template <int ABL> __device__ __forceinline__ void phase3(Ctx& C, const Args& A, int rep) {
    float lam;
    {   const float a = ((const float*)A.in[9])[C.lane] * ((const float*)A.in[10])[C.lane], b2 = ((const float*)A.in[11])[C.lane] * ((const float*)A.in[12])[C.lane];
        lam = __expf(wave_sum(a)) - __expf(wave_sum(b2)) + LAMBDA_INIT; }
    constexpr int NITEM = 128 + 2048;
    for (;;) {
        if (C.tid == 0) C.MISC[0] = __hip_atomic_fetch_add(C.ctl + CW_Q + 64 * rep, 1u, __ATOMIC_RELAXED, __HIP_MEMORY_SCOPE_AGENT);
        __syncthreads();
        const int item = (int)C.MISC[0];
        __syncthreads();
        if (item >= NITEM) break;
        if (item < 128) { if (ABL == 0) gla_unit(C, A, item); }
        else { const int idx = item - 128; attn_unit<ABL>(C, A, idx & 127, 15 - (idx >> 7), lam); }
    }
}

constexpr int PK_P = 272;
constexpr int PK_BYTES = 128 * PK_P;
constexpr int PS_PITCH = 132, PS_EIDX = 2 * PK_BYTES, PS_EG = PS_EIDX + 64 * PS_PITCH * 4;
static_assert(PS_EG + 64 * PS_PITCH * 4 <= MISC_OFF, "PEER score LDS map");
#define CE_DESC(a, b) do { const float mx_ = fmaxf(a, b), mn_ = fminf(a, b); a = mx_; b = mn_; } while (0)
__device__ __forceinline__ void sort16_desc(float* v) {
#pragma unroll
    for (int k = 2; k <= 16; k *= 2)
#pragma unroll
        for (int j = k / 2; j > 0; j /= 2)
#pragma unroll
            for (int i = 0; i < 16; ++i) { const int l = i ^ j; if (l > i) { if ((i & k) == 0) CE_DESC(v[i], v[l]); else CE_DESC(v[l], v[i]); } }
}
__device__ __forceinline__ void bitonic_merge16_desc(float* v) {
#pragma unroll
    for (int j = 8; j > 0; j /= 2)
#pragma unroll
        for (int i = 0; i < 16; ++i) { const int l = i ^ j; if (l > i) CE_DESC(v[i], v[l]); }
}
__device__ __forceinline__ void merge_top16(float* a, const float* b) {
#pragma unroll
    for (int i = 0; i < 16; ++i) a[i] = fmaxf(a[i], b[15 - i]);
    bitonic_merge16_desc(a);
}
__device__ __forceinline__ void top16_pair64(float (&v)[64], float (&out)[16], int hi) {
    sort16_desc(v); sort16_desc(v + 16); sort16_desc(v + 32); sort16_desc(v + 48);
    merge_top16(v, v + 16); merge_top16(v + 32, v + 48); merge_top16(v, v + 32);
#pragma unroll
    for (int i = 0; i < 8; ++i) { const float p = v[i], q = v[15 - i]; v[i] = hi ? q : p; v[15 - i] = hi ? p : q; }
#pragma unroll
    for (int i = 0; i < 16; ++i) out[i] = pair_max(v[i]);
    bitonic_merge16_desc(out);
}

template <int SABL> __device__ __forceinline__ void peer_scores(Ctx& C, const Args& A, int t0) {
    const int lane = C.lane, w = C.wave, r32 = lane & 31, hi = lane >> 5;
    const bf16* QP = (const bf16*)(C.ws + WS_PROJ);
    int* EIDX = (int*)(C.ws + WS_EIDX); float* EG = (float*)(C.ws + WS_EG);
#pragma unroll 1
    for (int tb = 0; tb < 2; ++tb) {
        const int t = t0 + 32 * tb + r32;
        float tv[2][16];
#pragma unroll 1
        for (int half = 0; half < 2; ++half) {
            bf16x8 qf[8];
#pragma unroll
            for (int kk = 0; kk < 8; ++kk) qf[kk] = *(const GAS bf16x8*)(QP + (size_t)(SABL ? t0 : t) * NQP + w * 256 + half * 128 + 16 * kk + 8 * hi);
            float sv[64];
#pragma unroll
            for (int kb = 0; kb < 4; ++kb) { f32x16 s;
#pragma unroll
                for (int r = 0; r < 16; ++r) s[r] = 0.f;
#pragma unroll
                for (int kk = 0; kk < 8; ++kk) { const bf16x8 a = *(const LAS bf16x8*)(C.lds + half * PK_BYTES + (32 * kb + r32) * PK_P + (16 * kk + 8 * hi) * 2); s = MFMA32(a, qf[kk], s); }
#pragma unroll
                for (int r = 0; r < 16; ++r) sv[16 * kb + r] = __uint_as_float((__float_as_uint(s[r]) & ~127u) | (unsigned)(32 * kb + crow(r, hi))); }
            float to[16];
            if (SABL == 2) {
#pragma unroll
                for (int i = 0; i < 16; ++i) to[i] = sv[i] + sv[16 + i] + sv[32 + i] + sv[48 + i]; }
            else top16_pair64(sv, to, hi);
            if (half == 0) {
#pragma unroll
                for (int i = 0; i < 16; ++i) tv[0][i] = to[i];
            } else {
#pragma unroll
                for (int i = 0; i < 16; ++i) tv[1][i] = to[i];
            }
        }
        float cv[32];
#define PEER_CAND(k, a0, b0, a1, b1) do { const float s0_ = tv[0][a0] + tv[1][b0], s1_ = tv[0][a1] + tv[1][b1]; \
            const unsigned e0_ = ((__float_as_uint(tv[0][a0]) & 127u) << 7) | (__float_as_uint(tv[1][b0]) & 127u), e1_ = ((__float_as_uint(tv[0][a1]) & 127u) << 7) | (__float_as_uint(tv[1][b1]) & 127u); \
            const float s_ = hi ? s1_ : s0_; const unsigned e_ = hi ? e1_ : e0_; cv[k] = __uint_as_float((__float_as_uint(s_) & ~0x3FFFu) | e_); } while (0)
        PEER_CAND(0, 0, 0, 2, 1);
        PEER_CAND(1, 0, 1, 2, 2);
        PEER_CAND(2, 0, 2, 2, 3);
        PEER_CAND(3, 0, 3, 2, 4);
        PEER_CAND(4, 0, 4, 3, 0);
        PEER_CAND(5, 0, 5, 3, 1);
        PEER_CAND(6, 0, 6, 3, 2);
        PEER_CAND(7, 0, 7, 3, 3);
        PEER_CAND(8, 0, 8, 4, 0);
        PEER_CAND(9, 0, 9, 4, 1);
        PEER_CAND(10, 0, 10, 4, 2);
        PEER_CAND(11, 0, 11, 5, 0);
        PEER_CAND(12, 0, 12, 5, 1);
        PEER_CAND(13, 0, 13, 6, 0);
        PEER_CAND(14, 0, 14, 6, 1);
        PEER_CAND(15, 0, 15, 7, 0);
        PEER_CAND(16, 1, 0, 7, 1);
        PEER_CAND(17, 1, 1, 8, 0);
        PEER_CAND(18, 1, 2, 9, 0);
        PEER_CAND(19, 1, 3, 10, 0);
        PEER_CAND(20, 1, 4, 11, 0);
        PEER_CAND(21, 1, 5, 12, 0);
        PEER_CAND(22, 1, 6, 13, 0);
        PEER_CAND(23, 1, 7, 14, 0);
        PEER_CAND(24, 2, 0, 15, 0);
#undef PEER_CAND
#pragma unroll
        for (int k = 25; k < 32; ++k) cv[k] = -INFINITY;
        sort16_desc(cv); sort16_desc(cv + 16); merge_top16(cv, cv + 16);
#pragma unroll
        for (int i = 0; i < 8; ++i) { const float p = cv[i], q = cv[15 - i]; cv[i] = hi ? q : p; cv[15 - i] = hi ? p : q; }
        float selv[16]; int sele[16];
#pragma unroll
        for (int i = 0; i < 16; ++i) selv[i] = pair_max(cv[i]);
        bitonic_merge16_desc(selv);
#pragma unroll
        for (int k = 0; k < 16; ++k) { const unsigned b_ = __float_as_uint(selv[k]); sele[k] = (int)(b_ & 0x3FFFu); selv[k] = __uint_as_float(b_ & ~0x3FFFu); }
        float ex[16], sum = 0.f;
#pragma unroll
        for (int k = 0; k < 16; ++k) { ex[k] = __expf(selv[k] - selv[0]); sum += ex[k]; }
        const float inv = 1.0f / sum;
        if (hi == 0) { LAS int* p = (LAS int*)(C.lds + PS_EIDX) + (32 * tb + r32) * PS_PITCH + 2 * w;
#pragma unroll
            for (int kk = 0; kk < 16; ++kk) p[16 * (kk & 7) + (kk >> 3)] = sele[kk]; }
        else { LAS float* p = (LAS float*)(C.lds + PS_EG) + (32 * tb + r32) * PS_PITCH + 2 * w;
#pragma unroll
            for (int kk = 0; kk < 16; ++kk) p[16 * (kk & 7) + (kk >> 3)] = ex[kk] * inv; }
    }
}

__device__ __forceinline__ float gelu_erf(float v) {
    const float av = fabsf(v), t = __builtin_amdgcn_rcpf(av * 0.2316418882f + 1.0f);
    float q = t * 0.5307027145f + (-0.7265760135f); q = q * t + 0.7107068705f; q = q * t + (-0.142248368f); q = q * t + 0.127414796f; q = q * t;
    const float e = __builtin_amdgcn_exp2f((v * v) * (-0.72134752044f));
    const float m = v * (q * e);
    return v < 0.f ? m : v - m;
}
__device__ __forceinline__ float dpp_sum8(float x) {
    x += __int_as_float(__builtin_amdgcn_update_dpp(0, __float_as_int(x), 0xb1, 0xf, 0xf, false));
    x += __int_as_float(__builtin_amdgcn_update_dpp(0, __float_as_int(x), 0x4e, 0xf, 0xf, false));
    x += __int_as_float(__builtin_amdgcn_update_dpp(0, __float_as_int(x), 0x141, 0xf, 0xf, false));
    return x;
}
#define PG_PIN16(a) asm volatile("" : "+v"(a[0]), "+v"(a[1]), "+v"(a[2]), "+v"(a[3]), "+v"(a[4]), "+v"(a[5]), "+v"(a[6]), "+v"(a[7]), "+v"(a[8]), "+v"(a[9]), "+v"(a[10]), "+v"(a[11]), "+v"(a[12]), "+v"(a[13]), "+v"(a[14]), "+v"(a[15]))
#define PG_CVT(w, f) do { _Pragma("unroll") for (int d_ = 0; d_ < 4; ++d_) { const f32x2_t lo_ = __builtin_amdgcn_cvt_pk_f32_fp8((int)(w)[d_], false), hi_ = __builtin_amdgcn_cvt_pk_f32_fp8((int)(w)[d_], true); \
        f[4 * d_] = lo_.x; f[4 * d_ + 1] = lo_.y; f[4 * d_ + 2] = hi_.x; f[4 * d_ + 3] = hi_.y; } } while (0)

template <int SABL> __device__ __forceinline__ void phase_peer_scores(Ctx& C, const Args& A) {
    {
        const bf16* KB = (const bf16*)(C.ws + WS_KEYS);
        for (int idx = C.tid; idx < 2 * 128 * 16; idx += NTHR) { const int set = idx >> 11, row = (idx >> 4) & 127, ch = idx & 15;
            *(LAS v4u*)(C.lds + set * PK_BYTES + row * PK_P + ch * 16) = *(const GAS v4u*)(KB + (size_t)set * 16384 + row * 128 + ch * 8); }
        __syncthreads();
    }
    for (int tile = C.vcu; tile < NTOK / 64; tile += C.G) {
        peer_scores<SABL>(C, A, tile * 64);
        __syncthreads();
        unsigned short* EIDX = (unsigned short*)(C.ws + WS_EIDX) + (size_t)tile * 64 * 128; float* EG = (float*)(C.ws + WS_EG) + (size_t)tile * 64 * 128;
#pragma unroll
        for (int i = 0; i < 2; ++i) { const int idx = C.tid + i * NTHR, row = idx >> 4, ch = idx & 15;
            const v4u a = *(const LAS v4u*)(C.lds + PS_EIDX + (row * PS_PITCH + 8 * ch) * 4), b = *(const LAS v4u*)(C.lds + PS_EIDX + (row * PS_PITCH + 8 * ch + 4) * 4);
            *(GAS v4u*)(EIDX + row * 128 + 8 * ch) = (v4u){a.x | (a.y << 16), a.z | (a.w << 16), b.x | (b.y << 16), b.z | (b.w << 16)}; }
#pragma unroll
        for (int i = 0; i < 4; ++i) { const int idx = C.tid + i * NTHR, row = idx >> 5, ch = idx & 31;
            *(GAS v4u*)(EG + row * 128 + 4 * ch) = *(const LAS v4u*)(C.lds + PS_EG + (row * PS_PITCH + 4 * ch) * 4); }
        __syncthreads();
    }
}

template <int MODE> __device__ __forceinline__ void phase_peer_u(Ctx& C, const Args& A) {
    int lane_ = C.lane; asm volatile("" : "+v"(lane_)); const int lane = lane_;
    const int x = C.sx, j = C.sj, g = lane >> 3, c = lane & 7;
    const unsigned char* H = C.ws + WS_H + 128 * x + 16 * c;
    const float* RS = (const float*)(C.ws + WS_RS2);
    const unsigned short* EIDX = (const unsigned short*)(C.ws + WS_EIDX) + 16 * g;
    bf16* PD = (bf16*)(C.ws + WS_PD) + (size_t)x * NTOK * 128 + 16 * g;
    const __amdgpu_buffer_rsrc_t RU = __builtin_amdgcn_make_buffer_rsrc((void*)(C.ws + WS_EU + (size_t)x * (2u << 20)), 0, 2 << 20, 0x00020000);
    const int t0 = 2048 * j + 256 * C.wave, tlast = t0 + 255;
    const int kb_ = 8 * ((c >> 2) & 1) + 4 * ((c >> 1) & 1) + 2 * (c & 1);
    v4u en[2]; v4u h0n, hA0, hB0; float h1n, hA1, hB1;
    v4u rA[16], rB[16];
#define PU_LDE(t) do { en[0] = *(const GAS v4u*)(EIDX + (size_t)(t) * 128); en[1] = *(const GAS v4u*)(EIDX + (size_t)(t) * 128 + 8); \
        h0n = *(const GAS v4u*)(H + (size_t)(t) * DM); h1n = *(const GAS float*)(RS + (t)); } while (0)
#define PU_LDR(R) do { _Pragma("unroll") for (int k = 0; k < 16; ++k) { const unsigned w_ = en[k >> 3][(k >> 1) & 3]; const int ek_ = (int)((k & 1) ? (w_ >> 16) : (w_ & 0xffffu)); \
        R[k] = __builtin_bit_cast(v4u, __builtin_amdgcn_raw_buffer_load_b128(RU, ek_ * 128 + 16 * c, 0, 0)); } } while (0)
#define PU_COMP(R, h0, h1, t) do { const float hinv = h1; const int hq[4] = {(int)h0.x, (int)h0.y, (int)h0.z, (int)h0.w}; \
        __builtin_amdgcn_sched_barrier(0); \
        int ia_[16]; \
        _Pragma("unroll") for (int k = 0; k < 16; ++k) { asm volatile("" : "+v"(R[k])); \
            int a_ = __builtin_amdgcn_sdot4((int)R[k].x, hq[0], 0, false); a_ = __builtin_amdgcn_sdot4((int)R[k].y, hq[1], a_, false); \
            a_ = __builtin_amdgcn_sdot4((int)R[k].z, hq[2], a_, false); a_ = __builtin_amdgcn_sdot4((int)R[k].w, hq[3], a_, false); ia_[k] = a_; } \
          \
        int ib_[8], ic_[4], id0_, id1_; \
        { const bool b2 = (lane & 4) != 0, b1 = (lane & 2) != 0, b0 = (lane & 1) != 0; \
          _Pragma("unroll") for (int k = 0; k < 8; ++k) { const int keep = b2 ? ia_[k + 8] : ia_[k], send = b2 ? ia_[k] : ia_[k + 8]; ib_[k] = keep + __builtin_amdgcn_update_dpp(0, send, 0x141, 0xf, 0xf, false); } \
          _Pragma("unroll") for (int k = 0; k < 4; ++k) { const int keep = b1 ? ib_[k + 4] : ib_[k], send = b1 ? ib_[k] : ib_[k + 4]; ic_[k] = keep + __builtin_amdgcn_update_dpp(0, send, 0x1b, 0xf, 0xf, false); } \
          { const int keep = b0 ? ic_[2] : ic_[0], send = b0 ? ic_[0] : ic_[2]; id0_ = keep + __builtin_amdgcn_update_dpp(0, send, 0xb1, 0xf, 0xf, false); } \
          { const int keep = b0 ? ic_[3] : ic_[1], send = b0 ? ic_[1] : ic_[3]; id1_ = keep + __builtin_amdgcn_update_dpp(0, send, 0xb1, 0xf, 0xf, false); } } \
          \
        *(GAS unsigned*)(PD + (size_t)(t) * 128 + kb_) = cvtpk((float)id0_ * hinv, (float)id1_ * hinv); \
        __builtin_amdgcn_sched_barrier(0); } while (0)
    PU_LDE(t0);
    PU_LDR(rA); hA0 = h0n; hA1 = h1n;
    PU_LDE(t0 + 1);
#pragma unroll 1
    for (int ti = 0; ti < 256; ti += 2) {
        const int t = t0 + ti;
        PU_LDR(rB); hB0 = h0n; hB1 = h1n;
        PU_LDE(t + 2 < tlast ? t + 2 : tlast);
        __builtin_amdgcn_sched_barrier(0);
        PU_COMP(rA, hA0, hA1, t);
        PU_LDR(rA); hA0 = h0n; hA1 = h1n;
        PU_LDE(t + 3 < tlast ? t + 3 : tlast);
        __builtin_amdgcn_sched_barrier(0);
        PU_COMP(rB, hB0, hB1, t + 1);
    }
#undef PU_LDE
#undef PU_LDR
#undef PU_COMP
}

__device__ __forceinline__ void phase_peer_act(Ctx& C, const Args& A) {
    const bf16* PD = (const bf16*)(C.ws + WS_PD); const unsigned short* EIDX = (const unsigned short*)(C.ws + WS_EIDX); const float* EG = (const float*)(C.ws + WS_EG);
    unsigned* ACT8 = (unsigned*)(C.ws + WS_ACT); float* ACTS = (float*)(C.ws + WS_ACT + (size_t)NTOK * 128);
    LAS float* SU = (LAS float*)C.lds; LAS float* SV = SU + NEXP;
    { const GAS v4u* src = (const GAS v4u*)(C.ws + WS_ES); for (int i = C.tid; i < 2 * NEXP / 4; i += NTHR) ((LAS v4u*)C.lds)[i] = src[i]; }
    __syncthreads();
    const int gt = C.vcu * NTHR + C.tid, NGT = C.G * NTHR;
    for (int it = gt; it < NTOK * 128 / 4; it += NGT) {
        f32x4 z = {0.f, 0.f, 0.f, 0.f};
#pragma unroll
        for (int xs = 0; xs < 8; ++xs) { const u32x2 w_ = *(const GAS u32x2*)(PD + (size_t)xs * NTOK * 128 + (size_t)it * 4); z += (f32x4){bf_lo(w_.x), bf_hi(w_.x), bf_lo(w_.y), bf_hi(w_.y)}; }
        const u32x2 ew = *(const GAS u32x2*)(EIDX + (size_t)it * 4); const f32x4 gg = *(const GAS f32x4*)(EG + (size_t)it * 4);
        const int e0 = ew.x & 0xffffu, e1 = ew.x >> 16, e2 = ew.y & 0xffffu, e3 = ew.y >> 16;
        f32x4 a;
        a.x = gelu_erf(z.x * SU[e0]) * gg.x * SV[e0]; a.y = gelu_erf(z.y * SU[e1]) * gg.y * SV[e1];
        a.z = gelu_erf(z.z * SU[e2]) * gg.z * SV[e2]; a.w = gelu_erf(z.w * SU[e3]) * gg.w * SV[e3];
        float amax = fmaxf(fmaxf(fabsf(a.x), fabsf(a.y)), fmaxf(fabsf(a.z), fabsf(a.w)));
        amax = fmaxf(amax, __int_as_float(__builtin_amdgcn_update_dpp(0, __float_as_int(amax), 0xb1, 0xf, 0xf, false)));
        amax = fmaxf(amax, __int_as_float(__builtin_amdgcn_update_dpp(0, __float_as_int(amax), 0x4e, 0xf, 0xf, false)));
        amax = fmaxf(amax, __int_as_float(__builtin_amdgcn_update_dpp(0, __float_as_int(amax), 0x124, 0xf, 0xf, false)));
        amax = fmaxf(amax, __int_as_float(__builtin_amdgcn_update_dpp(0, __float_as_int(amax), 0x128, 0xf, 0xf, false)));
        { auto r = __builtin_amdgcn_permlane16_swap(__float_as_uint(amax), __float_as_uint(amax), false, false); amax = fmaxf(__uint_as_float(r[0]), __uint_as_float(r[1])); }
        const float as_ = amax > 0.f ? 127.f / amax : 1.f;
        const int b0 = (int)rintf(a.x * as_), b1 = (int)rintf(a.y * as_), b2 = (int)rintf(a.z * as_), b3 = (int)rintf(a.w * as_);
        ACT8[it] = (unsigned)(b0 & 0xff) | ((unsigned)(b1 & 0xff) << 8) | ((unsigned)(b2 & 0xff) << 16) | ((unsigned)(b3 & 0xff) << 24);
        if ((it & 31) == 0) ACTS[it >> 5] = amax > 0.f ? amax * (1.f / 127.f) : 1.f;
    }
}

template <int VABL> __device__ __forceinline__ void phase_peer_v(Ctx& C, const Args& A) {
    int lane_ = C.lane; asm volatile("" : "+v"(lane_)); const int lane = lane_;
    const int x = C.sx, j = C.sj, g = lane >> 3, c = lane & 7;
    const unsigned short* EIDX = (const unsigned short*)(C.ws + WS_EIDX) + 16 * g; const unsigned char* ACT8 = (const unsigned char*)(C.ws + WS_ACT) + 16 * g; const float* ACTS = (const float*)(C.ws + WS_ACT + (size_t)NTOK * 128);
    const __amdgpu_buffer_rsrc_t RV = __builtin_amdgcn_make_buffer_rsrc((void*)(C.ws + WS_EV + (size_t)x * (2u << 20)), 0, 2 << 20, 0x00020000);
    const int t0 = 2048 * j + 256 * C.wave, tlast = t0 + 255;
    const int col = 128 * x + 16 * c;
    v4u en[2]; v4u an, aA, aB; float sn, sA, sB; unsigned xn, xA, xB;
    const int cc_ = col + 2 * g;
    const bf16* X1 = (const bf16*)(C.ws + WS_X1) + cc_;
    const f32x2_t g2 = *(const f32x2_t*)((const float*)(C.ws + WS_MOD) + (size_t)(t0 >> 11) * NMOD + 5 * 1024 + cc_);
    v4u rA[16], rB[16];
#define PV_LDE(t) do { en[0] = *(const GAS v4u*)(EIDX + (size_t)(t) * 128); en[1] = *(const GAS v4u*)(EIDX + (size_t)(t) * 128 + 8); an = *(const GAS v4u*)(ACT8 + (size_t)(t) * 128); sn = *(const GAS float*)(ACTS + (t)); xn = *(const GAS unsigned*)(X1 + (size_t)(t) * DM); } while (0)
#define PV_LDR(R, AV, SV_, XV_) do { _Pragma("unroll") for (int k = 0; k < 16; ++k) { const unsigned w_ = en[k >> 3][(k >> 1) & 3]; const int ek_ = (int)((k & 1) ? (w_ >> 16) : (w_ & 0xffffu)); \
        R[k] = __builtin_bit_cast(v4u, __builtin_amdgcn_raw_buffer_load_b128(RV, ek_ * 128 + 16 * c, 0, 0)); } \
        AV = an; SV_ = sn; XV_ = xn; } while (0)
#define PV_COMP(R, AV, SV_, XV_, t) do { const float ainv = SV_; \
        const int aq[4] = {(int)AV.x, (int)AV.y, (int)AV.z, (int)AV.w}; \
        __builtin_amdgcn_sched_barrier(0); \
        int ia[16]; \
        _Pragma("unroll") for (int i = 0; i < 16; ++i) ia[i] = 0; \
        _Pragma("unroll") for (int kk = 0; kk < 4; ++kk) { asm volatile("" : "+v"(R[4 * kk]), "+v"(R[4 * kk + 1]), "+v"(R[4 * kk + 2]), "+v"(R[4 * kk + 3])); \
            _Pragma("unroll") for (int d = 0; d < 4; ++d) { const unsigned r0 = R[4 * kk][d], r1 = R[4 * kk + 1][d], r2 = R[4 * kk + 2][d], r3 = R[4 * kk + 3][d]; \
                const unsigned p01l = __builtin_amdgcn_perm(r1, r0, 0x05010400u), p01h = __builtin_amdgcn_perm(r1, r0, 0x07030602u); \
                const unsigned p23l = __builtin_amdgcn_perm(r3, r2, 0x05010400u), p23h = __builtin_amdgcn_perm(r3, r2, 0x07030602u); \
                const unsigned t0_ = VABL ? r0 : __builtin_amdgcn_perm(p23l, p01l, 0x05040100u), t1_ = VABL ? r1 : __builtin_amdgcn_perm(p23l, p01l, 0x07060302u); \
                const unsigned t2_ = VABL ? r2 : __builtin_amdgcn_perm(p23h, p01h, 0x05040100u), t3_ = VABL ? r3 : __builtin_amdgcn_perm(p23h, p01h, 0x07060302u); \
                ia[4 * d] = __builtin_amdgcn_sdot4((int)t0_, aq[kk], ia[4 * d], false); ia[4 * d + 1] = __builtin_amdgcn_sdot4((int)t1_, aq[kk], ia[4 * d + 1], false); \
                ia[4 * d + 2] = __builtin_amdgcn_sdot4((int)t2_, aq[kk], ia[4 * d + 2], false); ia[4 * d + 3] = __builtin_amdgcn_sdot4((int)t3_, aq[kk], ia[4 * d + 3], false); } } \
          \
        int ib[8], ic[4], id0, id1; \
        _Pragma("unroll") for (int i = 0; i < 8; ++i) { auto r = __builtin_amdgcn_permlane32_swap((unsigned)ia[i], (unsigned)ia[i + 8], false, false); ib[i] = (int)r[0] + (int)r[1]; } \
        _Pragma("unroll") for (int i = 0; i < 4; ++i) { auto r = __builtin_amdgcn_permlane16_swap((unsigned)ib[i], (unsigned)ib[i + 4], false, false); ic[i] = (int)r[0] + (int)r[1]; } \
        { const bool b3 = (lane & 8) != 0; \
          const int k0 = b3 ? ic[2] : ic[0], s0 = b3 ? ic[0] : ic[2], k1 = b3 ? ic[3] : ic[1], s1 = b3 ? ic[1] : ic[3]; \
          id0 = k0 + __builtin_amdgcn_update_dpp(0, s0, 0x128, 0xf, 0xf, false); id1 = k1 + __builtin_amdgcn_update_dpp(0, s1, 0x128, 0xf, 0xf, false); } \
        { const float x0 = bf_lo(XV_), x1 = bf_hi(XV_); \
          *(GAS f32x2_t*)(C.out + (size_t)(t) * DM + cc_) = (f32x2_t){x0 + g2.x * ((float)id0 * ainv), x1 + g2.y * ((float)id1 * ainv)}; } \
        __builtin_amdgcn_sched_barrier(0); } while (0)
    PV_LDE(t0);
    PV_LDR(rA, aA, sA, xA);
    PV_LDE(t0 + 1);
#pragma unroll 1
    for (int ti = 0; ti < 256; ti += 2) {
        const int t = t0 + ti;
        PV_LDR(rB, aB, sB, xB);
        PV_LDE(t + 2 < tlast ? t + 2 : tlast);
        __builtin_amdgcn_sched_barrier(0);
        PV_COMP(rA, aA, sA, xA, t);
        PV_LDR(rA, aA, sA, xA);
        PV_LDE(t + 3 < tlast ? t + 3 : tlast);
        __builtin_amdgcn_sched_barrier(0);
        PV_COMP(rB, aB, sB, xB, t + 1);
    }
#undef PV_LDE
#undef PV_LDR
#undef PV_COMP
}
#undef PG_PIN16
#undef PG_CVT

constexpr int NPHASE = 13;

__global__ void __launch_bounds__(NTHR, 2) fwd_kernel(Args args) {
    extern __shared__ __attribute__((aligned(16))) unsigned char lds[];
    Ctx C;
    C.lds = (LAS unsigned char*)lds; C.MISC = (volatile LAS unsigned*)(C.lds + MISC_OFF);
    C.tid = threadIdx.x; C.lane = C.tid & 63; C.wave = __builtin_amdgcn_readfirstlane(C.tid >> 6);
    C.G = gridDim.x; { const int bx = blockIdx.x; C.vcu = (C.G % 8 == 0) ? (bx % 8) * (C.G / 8) + bx / 8 : bx; }
    C.ws = args.ws; C.out = args.out; C.ctl = (gu32*)(args.ws + WS_CTL);
    if (C.tid < 64) ((LAS unsigned*)(C.lds + MISC_OFF))[C.tid] = 0u;
    __syncthreads();
    const int lo = args.ph_lo, hi = args.ph_hi;
    const bool multi = (hi - lo) > 1;
    XcdBarrier bar; bar.bar = (unsigned*)(C.ctl + CW_BAR); bar.x = 0; bar.st = nullptr;
    if (multi) bar = xcd_barrier_post((unsigned*)(C.ctl + CW_BAR), C.MISC + 8);
#ifndef PH_MASK
#define PH_MASK 0x1fff
#endif
#define IN(k) (((PH_MASK >> (k)) & 1) && lo <= (k) && (k) < hi)
#ifndef REP_MASK
#define REP_MASK 0
#endif
#ifndef ABL_MODE
#define ABL_MODE 0
#endif
#define SEAM(k) do { if (IN(k) && IN((k) + 1)) xcd_barrier(bar); } while (0)
#define NREP(k) (1 + ((REP_MASK >> (k)) & 1))
#define PFENCE() do { asm volatile("" : "+v"(C.tid) :: "memory"); C.lane = C.tid & 63; C.wave = __builtin_amdgcn_readfirstlane(C.tid >> 6); } while (0)
    for (int rp = 0; rp < NREP(0); ++rp) { if (rp) xcd_barrier(bar); PFENCE(); if (IN(0)) { phase0(C, args); } }
    if (IN(0) && (IN(12) || IN(1))) xcd_barrier(bar);
    if (IN(12)) { PFENCE(); phase0b(C, args); }
    for (int rp = 0; rp < NREP(1); ++rp) { if (rp) xcd_barrier(bar); PFENCE(); if (IN(1)) { phase1(C, args); } } SEAM(1);
    for (int rp = 0; rp < NREP(2); ++rp) { if (rp) xcd_barrier(bar); PFENCE();
    if (IN(2)) { pg8::Gemm g{(const pg8::bf16_t*)(C.ws + WS_H), (const pg8::bf16_t*)(C.ws + WS_WIN_T), NTOK, NPROJ, DM / 2}; pg8::StaticOrder S; S.init(NTOK, NPROJ, C.G, (int)blockIdx.x);
        pg8::EpiI8Bf16 E{(pg8::bf16_t*)(C.ws + WS_PROJ), NPROJ, (const float*)(C.ws + WS_RS1), (const float*)(C.ws + WS_CS), nullptr};
        pg8::gemm_phase_i8<pg8::EpiI8Bf16, pg8::StaticOrder, true, true>(C.lds, g, S, E); } } SEAM(2);
    if (IN(3)) { phase2b(C, args); } SEAM(3);
    for (int rp = 0; rp < NREP(4); ++rp) { if (rp) xcd_barrier(bar); PFENCE(); if (IN(4)) { if (rp + 1 < NREP(4)) phase3<ABL_MODE>(C, args, rp); else phase3<0>(C, args, rp); } } SEAM(4);
    for (int rp = 0; rp < NREP(5); ++rp) { if (rp) xcd_barrier(bar); PFENCE();
    if (IN(5)) { pg8::Gemm g{(const pg8::bf16_t*)(C.ws + WS_Y), (const pg8::bf16_t*)(C.ws + WS_WOUT_T), NTOK, DM, DM}; pg8::StaticOrder S; S.init(NTOK, DM, C.G, (int)blockIdx.x);
        pg8::EpiResidBf16 E{(const float*)args.in[0], (const float*)(C.ws + WS_MOD) + 2 * 1024, (pg8::bf16_t*)(C.ws + WS_X1)};
        pg8::gemm_phase<pg8::EpiResidBf16, pg8::StaticOrder, true, true>(C.lds, g, S, E); } } SEAM(5);
    for (int rp = 0; rp < NREP(6); ++rp) { if (rp) xcd_barrier(bar); PFENCE(); if (IN(6)) { phase5(C, args); } } SEAM(6);
    for (int rp = 0; rp < NREP(7); ++rp) { if (rp) xcd_barrier(bar); PFENCE();
    if (IN(7)) { pg8::Gemm g{(const pg8::bf16_t*)(C.ws + WS_H), (const pg8::bf16_t*)(C.ws + WS_WQ_T), NTOK, NQP, DM / 2}; pg8::StaticOrder S; S.init(NTOK, NQP, C.G, (int)blockIdx.x);
        pg8::EpiI8Bf16 E{(pg8::bf16_t*)(C.ws + WS_PROJ), NQP, (const float*)(C.ws + WS_RS2), (const float*)(C.ws + WS_CSQ), (const float*)args.in[20]};
        pg8::gemm_phase_i8<pg8::EpiI8Bf16, pg8::StaticOrder, true, true>(C.lds, g, S, E); } } SEAM(7);
    for (int rp = 0; rp < NREP(8); ++rp) { if (rp) xcd_barrier(bar); PFENCE(); if (IN(8)) { if (rp + 1 < NREP(8)) phase_peer_scores<ABL_MODE>(C, args); else phase_peer_scores<0>(C, args); } } SEAM(8);
    C.sx = C.vcu >> 5; C.sj = C.vcu & 31;
    if (multi && C.G == 256) {
        if (C.tid == 0) { unsigned* bw = (unsigned*)(C.ctl + CW_BAR); bool ok = true;
            for (int q = 0; q < 16; ++q) { const unsigned cnt = xb_ld(&bw[XB_XCNT(q)]); ok = ok && (q < 8 ? cnt == 32u : cnt == 0u); }
            unsigned code = 0xffffffffu;
            if (ok) { const unsigned xc = xb_xcc_id(); const unsigned r = __hip_atomic_fetch_add(C.ctl + CW_RANK + 64 * xc, 1u, __ATOMIC_RELAXED, __HIP_MEMORY_SCOPE_AGENT); code = (xc << 8) | (r & 31u); }
            C.MISC[1] = code; }
        __syncthreads();
        const unsigned code = C.MISC[1];
        if (code != 0xffffffffu) { C.sx = (int)(code >> 8); C.sj = (int)(code & 31u); }
    }
    for (int rp = 0; rp < NREP(9); ++rp) { if (rp) xcd_barrier(bar); PFENCE(); if (IN(9)) { if (rp + 1 < NREP(9)) phase_peer_u<ABL_MODE>(C, args); else phase_peer_u<0>(C, args); } } SEAM(9);
    for (int rp = 0; rp < NREP(10); ++rp) { if (rp) xcd_barrier(bar); PFENCE(); if (IN(10)) { phase_peer_act(C, args); } } SEAM(10);
    for (int rp = 0; rp < NREP(11); ++rp) { if (rp) xcd_barrier(bar); PFENCE(); if (IN(11)) { if (rp + 1 < NREP(11)) phase_peer_v<ABL_MODE>(C, args); else phase_peer_v<0>(C, args); } }
#undef IN
#undef SEAM
}

#ifndef MK_N_LAUNCHES
#define MK_N_LAUNCHES 1
#endif
extern "C" void kernel_launch(void* const* d_in, const int* in_sizes, int n_in, void* d_out, int out_size, void* d_ws, size_t ws_size, hipStream_t stream) {
    static int grid = 0;
    if (grid == 0) {
        if (n_in != 25 || in_sizes[0] != NTOK * DM || out_size != NTOK * DM || ws_size < WS_END) { fprintf(stderr, "kernel_launch: unexpected shapes (n_in %d, in0 %d, out %d, ws %zu)\n", n_in, n_in > 0 ? in_sizes[0] : -1, out_size, ws_size); grid = -1; return; }
        int dev = 0, cus = 0, per_cu = 0;
        if (hipGetDevice(&dev) != hipSuccess || hipDeviceGetAttribute(&cus, hipDeviceAttributeMultiprocessorCount, dev) != hipSuccess) { grid = -1; return; }
        if (hipFuncSetAttribute((const void*)fwd_kernel, hipFuncAttributeMaxDynamicSharedMemorySize, LDS_BYTES) != hipSuccess) { fprintf(stderr, "kernel_launch: hipFuncSetAttribute failed\n"); grid = -1; return; }
        if (hipOccupancyMaxActiveBlocksPerMultiprocessor(&per_cu, (const void*)fwd_kernel, NTHR, LDS_BYTES) != hipSuccess || per_cu < 1) fprintf(stderr, "kernel_launch: occupancy query says %d per CU\n", per_cu);
        (void)hipGetLastError();
        if (cus != 256) { fprintf(stderr, "kernel_launch: built for a 256-CU device (work maps assume 256 workgroups), found %d CUs; nothing launched\n", cus); grid = -1; return; }
        grid = cus;
    }
    if (grid < 0) return;
    if (hipMemsetAsync((char*)d_ws + WS_CTL, 0, CTL_ZERO_BYTES, stream) != hipSuccess) return;
    Args a{};
    for (int i = 0; i < 25; ++i) a.in[i] = d_in[i];
    a.out = (float*)d_out; a.ws = (unsigned char*)d_ws;
    if (MK_N_LAUNCHES == 1) { a.ph_lo = 0; a.ph_hi = NPHASE; a.li = 0; hipLaunchKernelGGL(fwd_kernel, dim3(grid), dim3(NTHR), LDS_BYTES, stream, a); }
    else { const int order[NPHASE] = {0, 12, 1, 2, 3, 4, 5, 6, 7, 8, 9, 10, 11}; for (int i = 0; i < NPHASE; ++i) { const int p = order[i]; a.ph_lo = p; a.ph_hi = p + 1; a.li = p; hipLaunchKernelGGL(fwd_kernel, dim3(grid), dim3(NTHR), LDS_BYTES, stream, a); } }
}
```

```cpp
#include <hip/hip_runtime.h>
#include <hip/hip_bf16.h>
#include <cstdio>
#include <cstdint>
#include <cmath>
namespace pg8 {
#define PG8_LAS __attribute__((address_space(3)))
typedef unsigned short bf16_t;
typedef short bf16x8 __attribute__((ext_vector_type(8)));
typedef float f32x4 __attribute__((ext_vector_type(4)));
typedef unsigned u32x4 __attribute__((ext_vector_type(4)));
constexpr int BM = 256, BK = 64, HALF = 128, HTB = HALF * BK * 2  , STAGE_BYTES = 8 * HTB, NXCD = 8, WGM = 8;

__host__ __device__ __forceinline__ int lds_byte(int r, int c) { const int st = (r >> 4) * 2 + (c >> 5), rr = r & 15, cc = c & 31, ob = rr * 64 + cc * 2; return st * 1024 + (ob ^ (((ob >> 9) & 1) << 5)); }
__host__ __device__ __forceinline__ void stage_rc(int b, int& R, int& C) { const int st = b / 1024, sb = b % 1024, swz = sb ^ (((sb >> 9) & 1) << 5); R = (st >> 1) * 16 + swz / 64; C = (st & 1) * 32 + (swz % 64) / 2; }
__host__ __device__ __forceinline__ int perm32(int rho) { const int n = rho >> 4, i = rho & 15; return 8 * (i >> 2) + 4 * n + (i & 3); }

struct Unit { int pm, pn; };
struct Gemm { const bf16_t* A; const bf16_t* Bt; int M, N, K; };

struct StaticOrder {
    int nM, nN, nwg, G, c;
    __host__ __device__ void init(int M, int N, int G_, int c_) { nM = M / BM; nN = N / BM; nwg = nM * nN; G = G_; c = c_; }
    __host__ __device__ bool next(int i, Unit& u) const {
        const long L = (long)i * G + c; if (L >= nwg) return false;
        int wgid = (int)L; { const int q = nwg / NXCD, r = nwg % NXCD, xcd = wgid % NXCD, off = wgid / NXCD; wgid = (xcd < r ? xcd * (q + 1) : r * (q + 1) + (xcd - r) * q) + off; }
        const int nig = WGM * nN, gid = wgid / nig, fm = gid * WGM, gsz = (nM - fm) < WGM ? (nM - fm) : WGM;
        u.pm = fm + ((wgid % nig) % gsz); u.pn = (wgid % nig) / gsz; return true;
    }
    __device__ __forceinline__ void a_ready(const Unit&) const {}
    __device__ __forceinline__ void done(const Unit&) const {}
};

__device__ __forceinline__ unsigned cvt_pk_bf16(float lo, float hi) { unsigned r; asm volatile("v_cvt_pk_bf16_f32 %0, %1, %2" : "=v"(r) : "v"(lo), "v"(hi)); return r; }
typedef float f32x2 __attribute__((ext_vector_type(2)));
__device__ __forceinline__ f32x2 gelu_pk(f32x2 v) {
    const f32x2 av = __builtin_elementwise_abs(v), d = av * 0.2316418882f + 1.0f;
    f32x2 t; t.x = __builtin_amdgcn_rcpf(d.x); t.y = __builtin_amdgcn_rcpf(d.y);
    f32x2 q = t * 0.5307027145f + (-0.7265760135f); q = q * t + 0.7107068705f; q = q * t + (-0.142248368f); q = q * t + 0.127414796f; q = q * t;
    const f32x2 s = (v * v) * (-0.72134752044f);
    f32x2 e; e.x = __builtin_amdgcn_exp2f(s.x); e.y = __builtin_amdgcn_exp2f(s.y);
    const f32x2 m = v * (q * e), r = v - m;
    f32x2 o; o.x = v.x < 0.f ? m.x : r.x; o.y = v.y < 0.f ? m.y : r.y; return o;
}

template <int ACT  > struct EpiBf16 {
    static constexpr bool PERM = true, AFTER_DRAIN = false; static_assert(ACT == 0 || ACT == 1, "EpiBf16: ACT is 0 (none) or 1 (gelu_pk)");
    bf16_t* O; int ldc; const float* bias; int split_cols; size_t split_stride; float scale0;
    __device__ __forceinline__ void operator()(const f32x4 (&acc)[2][2][4][2], const Unit& u, int wr, int wc, int fr, int fq) const {
        const int row0 = u.pm * BM + wr * 64 + fr; int colt = u.pn * BM; bf16_t* base = O;
        float sc = 1.f; if (split_cols) { const int t = colt / split_cols; base += (size_t)t * split_stride; colt -= t * split_cols; if (t == 0) sc = scale0; }
        const int col0 = colt + wc * 32 + 8 * fq, bcol0 = u.pn * BM + wc * 32 + 8 * fq;
        f32x4 bv[2][2];
#pragma unroll
        for (int bj = 0; bj < 2; ++bj)
#pragma unroll
            for (int n = 0; n < 2; ++n) bv[bj][n] = bias ? *(const f32x4*)(bias + bcol0 + bj * HALF + 4 * n) : (f32x4){0.f, 0.f, 0.f, 0.f};
#pragma unroll
        for (int ai = 0; ai < 2; ++ai)
#pragma unroll
            for (int m = 0; m < 4; ++m) { bf16_t* rowp = base + (size_t)(row0 + ai * HALF + m * 16) * ldc + col0;
#pragma unroll
                for (int bj = 0; bj < 2; ++bj) { f32x4 v0 = acc[ai][bj][m][0] + bv[bj][0], v1 = acc[ai][bj][m][1] + bv[bj][1];
                    if (ACT == 1) { f32x2 a = gelu_pk((f32x2){v0[0], v0[1]}), b = gelu_pk((f32x2){v0[2], v0[3]}), c = gelu_pk((f32x2){v1[0], v1[1]}), d = gelu_pk((f32x2){v1[2], v1[3]});
                        v0 = (f32x4){a.x, a.y, b.x, b.y}; v1 = (f32x4){c.x, c.y, d.x, d.y}; }
                    v0 = v0 * sc; v1 = v1 * sc; u32x4 w; w.x = cvt_pk_bf16(v0[0], v0[1]); w.y = cvt_pk_bf16(v0[2], v0[3]); w.z = cvt_pk_bf16(v1[0], v1[1]); w.w = cvt_pk_bf16(v1[2], v1[3]);
                    *(u32x4*)(rowp + bj * HALF) = w; } }
    }
};
struct EpiResid {
    static constexpr bool PERM = false, AFTER_DRAIN = false;
    const float* x; const float* gate; float* out;
    __device__ __forceinline__ void operator()(const f32x4 (&acc)[2][2][4][2], const Unit& u, int wr, int wc, int fr, int fq) const {
        const int b = (u.pm * BM) >> 11;
        const int col0 = u.pn * BM + wc * 32 + 4 * fq;
        f32x4 gv[2][2];
#pragma unroll
        for (int bj = 0; bj < 2; ++bj)
#pragma unroll
            for (int n = 0; n < 2; ++n) gv[bj][n] = *(const f32x4*)(gate + (size_t)b * 6144 + col0 + bj * HALF + n * 16);
#pragma unroll
        for (int ai = 0; ai < 2; ++ai)
#pragma unroll
            for (int m = 0; m < 4; ++m) { const size_t off = (size_t)(u.pm * BM + ai * HALF + wr * 64 + m * 16 + fr) * 1024 + col0;
#pragma unroll
                for (int bj = 0; bj < 2; ++bj)
#pragma unroll
                    for (int n = 0; n < 2; ++n) { const f32x4 xv = *(const f32x4*)(x + off + bj * HALF + n * 16);
                        *(f32x4*)(out + off + bj * HALF + n * 16) = xv + gv[bj][n] * acc[ai][bj][m][n]; } }
    }
};
struct EpiResidBf16 {
    static constexpr bool PERM = true, AFTER_DRAIN = false;
    const float* x; const float* gate; bf16_t* out;
    __device__ __forceinline__ void operator()(const f32x4 (&acc)[2][2][4][2], const Unit& u, int wr, int wc, int fr, int fq) const {
        const int b = (u.pm * BM) >> 11;
        const int col0 = u.pn * BM + wc * 32 + 8 * fq;
        f32x4 gv[2][2];
#pragma unroll
        for (int bj = 0; bj < 2; ++bj)
#pragma unroll
            for (int n = 0; n < 2; ++n) gv[bj][n] = *(const f32x4*)(gate + (size_t)b * 6144 + col0 + bj * HALF + 4 * n);
#pragma unroll
        for (int ai = 0; ai < 2; ++ai)
#pragma unroll
            for (int m = 0; m < 4; ++m) { const size_t off = (size_t)(u.pm * BM + ai * HALF + wr * 64 + m * 16 + fr) * 1024 + col0;
#pragma unroll
                for (int bj = 0; bj < 2; ++bj) { const f32x4 x0 = *(const f32x4*)(x + off + bj * HALF), x1 = *(const f32x4*)(x + off + bj * HALF + 4);
                    const f32x4 v0 = x0 + gv[bj][0] * acc[ai][bj][m][0], v1 = x1 + gv[bj][1] * acc[ai][bj][m][1];
                    u32x4 w; w.x = cvt_pk_bf16(v0[0], v0[1]); w.y = cvt_pk_bf16(v0[2], v0[3]); w.z = cvt_pk_bf16(v1[0], v1[1]); w.w = cvt_pk_bf16(v1[2], v1[3]);
                    *(u32x4*)(out + off + bj * HALF) = w; } }
    }
};
template <class Epi, class Sched, bool ALIGN_EPI = false, bool SP2 = false>
__device__ __forceinline__ void gemm_phase(PG8_LAS unsigned char* lds, const Gemm g, const Sched& S, const Epi& E) {
    const int tid = threadIdx.x, wid = __builtin_amdgcn_readfirstlane(tid >> 6), lane = tid & 63, wr = wid >> 2, wc = wid & 3, fr = lane & 15, fq = lane >> 4;
    const int K = g.K, nt = K / BK;
    unsigned voffA[2], voffB[2];
#pragma unroll
    for (int i = 0; i < 2; ++i) { int R, C; stage_rc(tid * 16 + i * 8192, R, C); const int Rb = Epi::PERM ? ((R & ~31) + perm32(R & 31)) : R;
        voffA[i] = (unsigned)(R * K + C) * 2u; voffB[i] = (unsigned)(Rb * K + C) * 2u; }
    const size_t kstep = (size_t)(BK * 2);
    const size_t hstep = (size_t)HALF * K * 2;
    const size_t tstep = 2 * hstep;
    const unsigned ldsw = (unsigned)wid * 1024u;
    const int aoff = lds_byte(wr * 64 + fr, fq * 8), boff = lds_byte(wc * 32 + fr, fq * 8);
#define PG8_SA(b, h) (((b) * 2 + (h)) * HTB)
#define PG8_SB(b, h) ((4 + (b) * 2 + (h)) * HTB)
#define PG8_STAGE(bufoff, gbase, voff) do { _Pragma("unroll") for (int _i = 0; _i < 2; ++_i) \
        __builtin_amdgcn_global_load_lds((const unsigned*)((const char*)(gbase) + (voff)[_i]), (PG8_LAS unsigned*)(lds + (bufoff) + ldsw + _i * 8192), 16, 0, 0); } while (0)
#define PG8_LDA(dst, b, h) do { _Pragma("unroll") for (int m = 0; m < 4; ++m) _Pragma("unroll") for (int k = 0; k < 2; ++k) dst[m][k] = *(const PG8_LAS bf16x8*)(lds + PG8_SA(b, h) + aoff + m * 2048 + k * 1024); } while (0)
#define PG8_LDB(dst, b, h) do { _Pragma("unroll") for (int n = 0; n < 2; ++n) _Pragma("unroll") for (int k = 0; k < 2; ++k) dst[n][k] = *(const PG8_LAS bf16x8*)(lds + PG8_SB(b, h) + boff + n * 2048 + k * 1024); } while (0)
#define PG8_MMA(ai, bj, At, Bt) do { __builtin_amdgcn_s_setprio(1); _Pragma("unroll") for (int m = 0; m < 4; ++m) _Pragma("unroll") for (int n = 0; n < 2; ++n) _Pragma("unroll") for (int k = 0; k < 2; ++k) \
        acc[ai][bj][m][n] = __builtin_amdgcn_mfma_f32_16x16x32_bf16(Bt[n][k], At[m][k], acc[ai][bj][m][n], 0, 0, 0); __builtin_amdgcn_s_setprio(0); } while (0)
#define PG8_WAIT_V(n) asm volatile("s_waitcnt vmcnt(" #n ")" ::: "memory")
#define PG8_WAIT_L(n) asm volatile("s_waitcnt lgkmcnt(" #n ")" ::: "memory")
#define PG8_BAR __builtin_amdgcn_s_barrier()
#define PG8_SCHED __builtin_amdgcn_sched_barrier(0)
    Unit cur, nxt; int ui = 0;
    if (!S.next(0, cur)) return;
    f32x4 acc[2][2][4][2];
#pragma unroll
    for (int a = 0; a < 2; ++a)
#pragma unroll
        for (int b = 0; b < 2; ++b)
#pragma unroll
            for (int m = 0; m < 4; ++m)
#pragma unroll
                for (int n = 0; n < 2; ++n) acc[a][b][m][n] = (f32x4){0.f, 0.f, 0.f, 0.f};
    bf16x8 At[4][2], B0[2][2], B1[2][2];
    const char* cA = (const char*)g.A + (size_t)cur.pm * tstep; const char* cB = (const char*)g.Bt + (size_t)cur.pn * tstep;
    S.a_ready(cur);
    if constexpr (SP2) {
        PG8_STAGE(PG8_SB(0, 0), cB, voffB); PG8_STAGE(PG8_SB(0, 1), cB + hstep, voffB); PG8_STAGE(PG8_SA(0, 0), cA, voffA); PG8_STAGE(PG8_SA(0, 1), cA + hstep, voffA);
        if (wr == 1) PG8_BAR;
        PG8_WAIT_V(2); PG8_BAR;
        PG8_STAGE(PG8_SB(1, 0), cB + kstep, voffB); PG8_STAGE(PG8_SA(1, 0), cA + kstep, voffA); PG8_STAGE(PG8_SB(1, 1), cB + hstep + kstep, voffB);
        PG8_WAIT_V(6); PG8_BAR;
    } else {
        PG8_STAGE(PG8_SB(0, 0), cB, voffB); PG8_STAGE(PG8_SA(0, 0), cA, voffA); PG8_STAGE(PG8_SB(0, 1), cB + hstep, voffB); PG8_STAGE(PG8_SA(0, 1), cA + hstep, voffA);
        if (wr == 1) PG8_BAR;
        PG8_WAIT_V(4); PG8_BAR;
        PG8_STAGE(PG8_SB(1, 0), cB + kstep, voffB); PG8_STAGE(PG8_SA(1, 0), cA + kstep, voffA); PG8_STAGE(PG8_SB(1, 1), cB + hstep + kstep, voffB);
        PG8_WAIT_V(6); PG8_BAR;
    }
    for (;;) {
        const bool has_next = S.next(ui + 1, nxt);
        const char* nA = has_next ? (const char*)g.A + (size_t)nxt.pm * tstep : cA; const char* nB = has_next ? (const char*)g.Bt + (size_t)nxt.pn * tstep : cB;
        for (int t = 0; t < nt; t += 2) {
            const bool last = (t == nt - 2);
            const char* a1 = cA + (size_t)(t + 1) * kstep;
            const char* a2 = last ? nA : cA + (size_t)(t + 2) * kstep; const char* b2 = last ? nB : cB + (size_t)(t + 2) * kstep;
            const char* a3 = a2 + kstep; const char* b3 = b2 + kstep;
            if (last && has_next) S.a_ready(nxt);
            if constexpr (SP2) {
            PG8_LDB(B0, 0, 0); PG8_LDB(B1, 0, 1); PG8_SCHED; PG8_LDA(At, 0, 0); PG8_STAGE(PG8_SA(1, 1), a1 + hstep, voffA);
            PG8_WAIT_V(8); PG8_WAIT_L(0); PG8_BAR; PG8_MMA(0, 0, At, B0); PG8_MMA(0, 1, At, B1); PG8_BAR; PG8_SCHED;
            PG8_LDA(At, 0, 1); PG8_STAGE(PG8_SB(0, 0), b2, voffB); PG8_STAGE(PG8_SB(0, 1), b2 + hstep, voffB); PG8_STAGE(PG8_SA(0, 0), a2, voffA);
            PG8_WAIT_V(8); PG8_WAIT_L(0); PG8_BAR; PG8_MMA(1, 0, At, B0); PG8_MMA(1, 1, At, B1); PG8_BAR; PG8_SCHED;
            PG8_LDB(B0, 1, 0); PG8_LDB(B1, 1, 1); PG8_SCHED; PG8_LDA(At, 1, 0); PG8_STAGE(PG8_SA(0, 1), a2 + hstep, voffA);
            PG8_WAIT_V(8); PG8_WAIT_L(0); PG8_BAR; PG8_MMA(0, 0, At, B0); PG8_MMA(0, 1, At, B1); PG8_BAR; PG8_SCHED;
            PG8_LDA(At, 1, 1); PG8_STAGE(PG8_SB(1, 0), b3, voffB); PG8_STAGE(PG8_SB(1, 1), b3 + hstep, voffB); PG8_STAGE(PG8_SA(1, 0), a3, voffA);
            PG8_WAIT_V(8); PG8_WAIT_L(0); PG8_BAR; PG8_MMA(1, 0, At, B0); PG8_MMA(1, 1, At, B1); PG8_BAR; PG8_SCHED;
            } else {
            PG8_LDB(B0, 0, 0); PG8_SCHED; PG8_LDA(At, 0, 0); PG8_STAGE(PG8_SA(1, 1), a1 + hstep, voffA);
            PG8_WAIT_L(8); PG8_BAR; PG8_WAIT_L(0); PG8_MMA(0, 0, At, B0); PG8_BAR; PG8_SCHED;
            PG8_LDB(B1, 0, 1); PG8_STAGE(PG8_SB(0, 0), b2, voffB);
            PG8_BAR; PG8_WAIT_L(0); PG8_MMA(0, 1, At, B1); PG8_BAR;
            PG8_LDA(At, 0, 1); PG8_STAGE(PG8_SA(0, 0), a2, voffA);
            PG8_BAR; PG8_WAIT_L(0); PG8_MMA(1, 0, At, B0); PG8_BAR; PG8_SCHED;
            PG8_STAGE(PG8_SB(0, 1), b2 + hstep, voffB);
            PG8_WAIT_V(6); PG8_BAR; PG8_MMA(1, 1, At, B1); PG8_BAR;
            PG8_LDB(B0, 1, 0); PG8_SCHED; PG8_LDA(At, 1, 0); PG8_STAGE(PG8_SA(0, 1), a2 + hstep, voffA);
            PG8_WAIT_L(8); PG8_BAR; PG8_WAIT_L(0); PG8_MMA(0, 0, At, B0); PG8_BAR; PG8_SCHED;
            PG8_LDB(B1, 1, 1); PG8_STAGE(PG8_SB(1, 0), b3, voffB);
            PG8_BAR; PG8_WAIT_L(0); PG8_MMA(0, 1, At, B1); PG8_BAR;
            PG8_LDA(At, 1, 1); PG8_STAGE(PG8_SA(1, 0), a3, voffA);
            PG8_BAR; PG8_WAIT_L(0); PG8_MMA(1, 0, At, B0); PG8_BAR; PG8_SCHED;
            PG8_STAGE(PG8_SB(1, 1), b3 + hstep, voffB);
            PG8_WAIT_V(6); PG8_BAR; PG8_MMA(1, 1, At, B1); PG8_BAR;
            }
        }
        if constexpr (ALIGN_EPI) { if (wr == 0) PG8_BAR; }
        if constexpr (!Epi::AFTER_DRAIN) { E(acc, cur, wr, wc, fr, fq); S.done(cur); }
        if (!has_next) break;
#pragma unroll
        for (int a = 0; a < 2; ++a)
#pragma unroll
            for (int b = 0; b < 2; ++b)
#pragma unroll
                for (int m = 0; m < 4; ++m)
#pragma unroll
                    for (int n = 0; n < 2; ++n) acc[a][b][m][n] = (f32x4){0.f, 0.f, 0.f, 0.f};
        cur = nxt; cA = nA; cB = nB; ++ui;
        if constexpr (ALIGN_EPI) { if (wr == 1) PG8_BAR; }
    }
    PG8_WAIT_V(0);
    if constexpr (!ALIGN_EPI) { if (wr == 0) PG8_BAR; }
    PG8_BAR;
    if constexpr (Epi::AFTER_DRAIN) { E.fused(acc, cur, wr, wc, fr, fq, lds, wid, lane); S.done(cur); }
#undef PG8_SA
#undef PG8_SB
#undef PG8_STAGE
#undef PG8_LDA
#undef PG8_LDB
#undef PG8_MMA
#undef PG8_WAIT_V
#undef PG8_WAIT_L
#undef PG8_BAR
#undef PG8_SCHED
}

typedef int i32x4 __attribute__((ext_vector_type(4)));
struct EpiI8Bf16 {
    static constexpr bool PERM = true, AFTER_DRAIN = false;
    bf16_t* O; int ldc; const float* rs; const float* cs; const float* bias;
    __device__ __forceinline__ void operator()(const i32x4 (&acc)[2][2][4][2], const Unit& u, int wr, int wc, int fr, int fq) const {
        const int row0 = u.pm * BM + wr * 64 + fr, col0 = u.pn * BM + wc * 32 + 8 * fq;
        f32x4 cv[2][2], bv[2][2];
#pragma unroll
        for (int bj = 0; bj < 2; ++bj)
#pragma unroll
            for (int n = 0; n < 2; ++n) { cv[bj][n] = *(const f32x4*)(cs + col0 + bj * HALF + 4 * n); bv[bj][n] = bias ? *(const f32x4*)(bias + col0 + bj * HALF + 4 * n) : (f32x4){0.f, 0.f, 0.f, 0.f}; }
#pragma unroll
        for (int ai = 0; ai < 2; ++ai)
#pragma unroll
            for (int m = 0; m < 4; ++m) { const int row = row0 + ai * HALF + m * 16; const float r = rs[row]; bf16_t* rowp = O + (size_t)row * ldc + col0;
#pragma unroll
                for (int bj = 0; bj < 2; ++bj) { const i32x4 a0 = acc[ai][bj][m][0], a1 = acc[ai][bj][m][1];
                    const f32x4 v0 = (f32x4){(float)a0[0], (float)a0[1], (float)a0[2], (float)a0[3]} * cv[bj][0] * r + bv[bj][0], v1 = (f32x4){(float)a1[0], (float)a1[1], (float)a1[2], (float)a1[3]} * cv[bj][1] * r + bv[bj][1];
                    u32x4 w; w.x = cvt_pk_bf16(v0[0], v0[1]); w.y = cvt_pk_bf16(v0[2], v0[3]); w.z = cvt_pk_bf16(v1[0], v1[1]); w.w = cvt_pk_bf16(v1[2], v1[3]);
                    *(u32x4*)(rowp + bj * HALF) = w; } }
    }
};
template <class Epi, class Sched, bool ALIGN_EPI = false, bool SP2 = false>
__device__ __forceinline__ void gemm_phase_i8(PG8_LAS unsigned char* lds, const Gemm g, const Sched& S, const Epi& E) {
    const int tid = threadIdx.x, wid = __builtin_amdgcn_readfirstlane(tid >> 6), lane = tid & 63, wr = wid >> 2, wc = wid & 3, fr = lane & 15, fq = lane >> 4;
    const int K = g.K, nt = K / BK;
    unsigned voffA[2], voffB[2];
#pragma unroll
    for (int i = 0; i < 2; ++i) { int R, C; stage_rc(tid * 16 + i * 8192, R, C); const int Rb = Epi::PERM ? ((R & ~31) + perm32(R & 31)) : R;
        voffA[i] = (unsigned)(R * K + C) * 2u; voffB[i] = (unsigned)(Rb * K + C) * 2u; }
    const size_t kstep = (size_t)(BK * 2);
    const size_t hstep = (size_t)HALF * K * 2;
    const size_t tstep = 2 * hstep;
    const unsigned ldsw = (unsigned)wid * 1024u;
    const int aoff = lds_byte(wr * 64 + fr, fq * 8), boff = lds_byte(wc * 32 + fr, fq * 8);
#define PG8_SA(b, h) (((b) * 2 + (h)) * HTB)
#define PG8_SB(b, h) ((4 + (b) * 2 + (h)) * HTB)
#define PG8_STAGE(bufoff, gbase, voff) do { _Pragma("unroll") for (int _i = 0; _i < 2; ++_i) \
        __builtin_amdgcn_global_load_lds((const unsigned*)((const char*)(gbase) + (voff)[_i]), (PG8_LAS unsigned*)(lds + (bufoff) + ldsw + _i * 8192), 16, 0, 0); } while (0)
#define PG8_LDA(dst, b, h) do { _Pragma("unroll") for (int m = 0; m < 4; ++m) _Pragma("unroll") for (int k = 0; k < 2; ++k) dst[m][k] = *(const PG8_LAS bf16x8*)(lds + PG8_SA(b, h) + aoff + m * 2048 + k * 1024); } while (0)
#define PG8_LDB(dst, b, h) do { _Pragma("unroll") for (int n = 0; n < 2; ++n) _Pragma("unroll") for (int k = 0; k < 2; ++k) dst[n][k] = *(const PG8_LAS bf16x8*)(lds + PG8_SB(b, h) + boff + n * 2048 + k * 1024); } while (0)
#define PG8_MMA(ai, bj, At, Bt) do { __builtin_amdgcn_s_setprio(1); _Pragma("unroll") for (int m = 0; m < 4; ++m) _Pragma("unroll") for (int n = 0; n < 2; ++n) _Pragma("unroll") for (int k = 0; k < 2; ++k) \
        acc[ai][bj][m][n] = __builtin_amdgcn_mfma_i32_16x16x64_i8(__builtin_bit_cast(i32x4, Bt[n][k]), __builtin_bit_cast(i32x4, At[m][k]), acc[ai][bj][m][n], 0, 0, 0); __builtin_amdgcn_s_setprio(0); } while (0)
#define PG8_WAIT_V(n) asm volatile("s_waitcnt vmcnt(" #n ")" ::: "memory")
#define PG8_WAIT_L(n) asm volatile("s_waitcnt lgkmcnt(" #n ")" ::: "memory")
#define PG8_BAR __builtin_amdgcn_s_barrier()
#define PG8_SCHED __builtin_amdgcn_sched_barrier(0)
    Unit cur, nxt; int ui = 0;
    if (!S.next(0, cur)) return;
    i32x4 acc[2][2][4][2];
#pragma unroll
    for (int a = 0; a < 2; ++a)
#pragma unroll
        for (int b = 0; b < 2; ++b)
#pragma unroll
            for (int m = 0; m < 4; ++m)
#pragma unroll
                for (int n = 0; n < 2; ++n) acc[a][b][m][n] = (i32x4){0, 0, 0, 0};
    bf16x8 At[4][2], B0[2][2], B1[2][2];
    const char* cA = (const char*)g.A + (size_t)cur.pm * tstep; const char* cB = (const char*)g.Bt + (size_t)cur.pn * tstep;
    S.a_ready(cur);
    if constexpr (SP2) {
        PG8_STAGE(PG8_SB(0, 0), cB, voffB); PG8_STAGE(PG8_SB(0, 1), cB + hstep, voffB); PG8_STAGE(PG8_SA(0, 0), cA, voffA); PG8_STAGE(PG8_SA(0, 1), cA + hstep, voffA);
        if (wr == 1) PG8_BAR;
        PG8_WAIT_V(2); PG8_BAR;
        PG8_STAGE(PG8_SB(1, 0), cB + kstep, voffB); PG8_STAGE(PG8_SA(1, 0), cA + kstep, voffA); PG8_STAGE(PG8_SB(1, 1), cB + hstep + kstep, voffB);
        PG8_WAIT_V(6); PG8_BAR;
    } else {
        PG8_STAGE(PG8_SB(0, 0), cB, voffB); PG8_STAGE(PG8_SA(0, 0), cA, voffA); PG8_STAGE(PG8_SB(0, 1), cB + hstep, voffB); PG8_STAGE(PG8_SA(0, 1), cA + hstep, voffA);
        if (wr == 1) PG8_BAR;
        PG8_WAIT_V(4); PG8_BAR;
        PG8_STAGE(PG8_SB(1, 0), cB + kstep, voffB); PG8_STAGE(PG8_SA(1, 0), cA + kstep, voffA); PG8_STAGE(PG8_SB(1, 1), cB + hstep + kstep, voffB);
        PG8_WAIT_V(6); PG8_BAR;
    }
    for (;;) {
        const bool has_next = S.next(ui + 1, nxt);
        const char* nA = has_next ? (const char*)g.A + (size_t)nxt.pm * tstep : cA; const char* nB = has_next ? (const char*)g.Bt + (size_t)nxt.pn * tstep : cB;
        for (int t = 0; t < nt; t += 2) {
            const bool last = (t == nt - 2);
            const char* a1 = cA + (size_t)(t + 1) * kstep;
            const char* a2 = last ? nA : cA + (size_t)(t + 2) * kstep; const char* b2 = last ? nB : cB + (size_t)(t + 2) * kstep;
            const char* a3 = a2 + kstep; const char* b3 = b2 + kstep;
            if (last && has_next) S.a_ready(nxt);
            if constexpr (SP2) {
            PG8_LDB(B0, 0, 0); PG8_LDB(B1, 0, 1); PG8_SCHED; PG8_LDA(At, 0, 0); PG8_STAGE(PG8_SA(1, 1), a1 + hstep, voffA);
            PG8_WAIT_V(8); PG8_WAIT_L(0); PG8_BAR; PG8_MMA(0, 0, At, B0); PG8_MMA(0, 1, At, B1); PG8_BAR; PG8_SCHED;
            PG8_LDA(At, 0, 1); PG8_STAGE(PG8_SB(0, 0), b2, voffB); PG8_STAGE(PG8_SB(0, 1), b2 + hstep, voffB); PG8_STAGE(PG8_SA(0, 0), a2, voffA);
            PG8_WAIT_V(8); PG8_WAIT_L(0); PG8_BAR; PG8_MMA(1, 0, At, B0); PG8_MMA(1, 1, At, B1); PG8_BAR; PG8_SCHED;
            PG8_LDB(B0, 1, 0); PG8_LDB(B1, 1, 1); PG8_SCHED; PG8_LDA(At, 1, 0); PG8_STAGE(PG8_SA(0, 1), a2 + hstep, voffA);
            PG8_WAIT_V(8); PG8_WAIT_L(0); PG8_BAR; PG8_MMA(0, 0, At, B0); PG8_MMA(0, 1, At, B1); PG8_BAR; PG8_SCHED;
            PG8_LDA(At, 1, 1); PG8_STAGE(PG8_SB(1, 0), b3, voffB); PG8_STAGE(PG8_SB(1, 1), b3 + hstep, voffB); PG8_STAGE(PG8_SA(1, 0), a3, voffA);
            PG8_WAIT_V(8); PG8_WAIT_L(0); PG8_BAR; PG8_MMA(1, 0, At, B0); PG8_MMA(1, 1, At, B1); PG8_BAR; PG8_SCHED;
            } else {
            PG8_LDB(B0, 0, 0); PG8_SCHED; PG8_LDA(At, 0, 0); PG8_STAGE(PG8_SA(1, 1), a1 + hstep, voffA);
            PG8_WAIT_L(8); PG8_BAR; PG8_WAIT_L(0); PG8_MMA(0, 0, At, B0); PG8_BAR; PG8_SCHED;
            PG8_LDB(B1, 0, 1); PG8_STAGE(PG8_SB(0, 0), b2, voffB);
            PG8_BAR; PG8_WAIT_L(0); PG8_MMA(0, 1, At, B1); PG8_BAR;
            PG8_LDA(At, 0, 1); PG8_STAGE(PG8_SA(0, 0), a2, voffA);
            PG8_BAR; PG8_WAIT_L(0); PG8_MMA(1, 0, At, B0); PG8_BAR; PG8_SCHED;
            PG8_STAGE(PG8_SB(0, 1), b2 + hstep, voffB);
            PG8_WAIT_V(6); PG8_BAR; PG8_MMA(1, 1, At, B1); PG8_BAR;
            PG8_LDB(B0, 1, 0); PG8_SCHED; PG8_LDA(At, 1, 0); PG8_STAGE(PG8_SA(0, 1), a2 + hstep, voffA);
            PG8_WAIT_L(8); PG8_BAR; PG8_WAIT_L(0); PG8_MMA(0, 0, At, B0); PG8_BAR; PG8_SCHED;
            PG8_LDB(B1, 1, 1); PG8_STAGE(PG8_SB(1, 0), b3, voffB);
            PG8_BAR; PG8_WAIT_L(0); PG8_MMA(0, 1, At, B1); PG8_BAR;
            PG8_LDA(At, 1, 1); PG8_STAGE(PG8_SA(1, 0), a3, voffA);
            PG8_BAR; PG8_WAIT_L(0); PG8_MMA(1, 0, At, B0); PG8_BAR; PG8_SCHED;
            PG8_STAGE(PG8_SB(1, 1), b3 + hstep, voffB);
            PG8_WAIT_V(6); PG8_BAR; PG8_MMA(1, 1, At, B1); PG8_BAR;
            }
        }
        if constexpr (ALIGN_EPI) { if (wr == 0) PG8_BAR; }
        if constexpr (!Epi::AFTER_DRAIN) { E(acc, cur, wr, wc, fr, fq); S.done(cur); }
        if (!has_next) break;
#pragma unroll
        for (int a = 0; a < 2; ++a)
#pragma unroll
            for (int b = 0; b < 2; ++b)
#pragma unroll
                for (int m = 0; m < 4; ++m)
#pragma unroll
                    for (int n = 0; n < 2; ++n) acc[a][b][m][n] = (i32x4){0, 0, 0, 0};
        cur = nxt; cA = nA; cB = nB; ++ui;
        if constexpr (ALIGN_EPI) { if (wr == 1) PG8_BAR; }
    }
    PG8_WAIT_V(0);
    if constexpr (!ALIGN_EPI) { if (wr == 0) PG8_BAR; }
    PG8_BAR;
    if constexpr (Epi::AFTER_DRAIN) { E.fused(acc, cur, wr, wc, fr, fq, lds, wid, lane); S.done(cur); }
#undef PG8_SA
#undef PG8_SB
#undef PG8_STAGE
#undef PG8_LDA
#undef PG8_LDB
#undef PG8_MMA
#undef PG8_WAIT_V
#undef PG8_WAIT_L
#undef PG8_BAR
#undef PG8_SCHED
}

}
#define GAS __attribute__((address_space(1)))
#define LAS __attribute__((address_space(3)))
typedef unsigned short bf16;
typedef unsigned v4u __attribute__((ext_vector_type(4)));
typedef float f32x4 __attribute__((ext_vector_type(4)));
typedef short bf16x8 __attribute__((ext_vector_type(8)));
typedef GAS unsigned gu32;
typedef GAS unsigned long long gu64;
#define RLX_AGENT __ATOMIC_RELAXED, __HIP_MEMORY_SCOPE_AGENT
#define LDS_WAIT() asm volatile("s_waitcnt lgkmcnt(0)" ::: "memory")
#define VM_WAIT() asm volatile("s_waitcnt vmcnt(0)" ::: "memory")
__device__ __forceinline__ unsigned long long rt() { return __builtin_amdgcn_s_memrealtime(); }
__device__ __forceinline__ unsigned f2bf(float f) { unsigned u = __builtin_bit_cast(unsigned, f); return (u + 0x7fffu + ((u >> 16) & 1u)) >> 16; }
__device__ __forceinline__ unsigned pk2(float lo, float hi) { return f2bf(lo) | (f2bf(hi) << 16); }

#define XB_TMO      128
#define XB_XCNT(j)  (256  + 64 * (j))
#define XB_XSUB(j)  (1280 + 64 * (j))
#define XB_XGEN(j)  (2304 + 64 * (j))
#define XB_TOP      3328
#define XB_TOPGEN   3392
#define XCD_BAR_WORDS 3456
#define XB_SPIN_CAP (1u << 18)

__device__ __forceinline__ unsigned xb_ld(unsigned* p)              { return __hip_atomic_load(p, __ATOMIC_RELAXED, __HIP_MEMORY_SCOPE_AGENT); }
__device__ __forceinline__ unsigned xb_add(unsigned* p, unsigned v) { return __hip_atomic_fetch_add(p, v, __ATOMIC_RELAXED, __HIP_MEMORY_SCOPE_AGENT); }
__device__ __forceinline__ unsigned xb_xcc_id() { return (unsigned)__builtin_amdgcn_s_getreg((3 << 11) | 20) & 0xFu; }
#define XB_SPIN(cond, bar) do { unsigned _sp = 0; while (cond) { __builtin_amdgcn_s_sleep(1); \
    if ((++_sp & 255u) == 0u) { if (xb_ld(&(bar)[XB_TMO])) break; if (_sp > XB_SPIN_CAP) { atomicAdd(&(bar)[XB_TMO], 1u); break; } } } } while (0)

struct XcdBarrier {
    unsigned* bar; unsigned x;
    volatile LAS unsigned* st;
};

__device__ __forceinline__ XcdBarrier xcd_barrier_post(unsigned* bar, volatile LAS unsigned* st) {
    XcdBarrier b; b.bar = bar; b.x = xb_xcc_id(); b.st = st;
    if (threadIdx.x == 0) (void)xb_add(&bar[XB_XCNT(b.x)], 1u);
    return b;
}
__device__ __forceinline__ void xcd_barrier_complete(unsigned* bar, unsigned x, unsigned& nloc, unsigned& nx) {
    const unsigned G = gridDim.x * gridDim.y * gridDim.z;
    unsigned sum, cnt, mine, sp = 0u;
    for (;;) {
        sum = 0u; cnt = 0u; mine = 0u;
#pragma unroll
        for (unsigned j = 0; j < 16; ++j) { const unsigned c = xb_ld(&bar[XB_XCNT(j)]); sum += c; cnt += (c > 0u) ? 1u : 0u; mine = (j == x) ? c : mine; }
        if (sum == G) break;
        __builtin_amdgcn_s_sleep(1);
        if ((++sp & 255u) == 0u) { if (xb_ld(&bar[XB_TMO])) break; if (sp > XB_SPIN_CAP) { atomicAdd(&bar[XB_TMO], 1u); break; } }
    }
    nloc = mine > 0u ? mine : 1u; nx = cnt > 0u ? cnt : 1u;
}

__device__ __forceinline__ void xcd_barrier(const XcdBarrier& b) {
    asm volatile("s_waitcnt vmcnt(0)" ::: "memory");
    __syncthreads();
    if (threadIdx.x == 0) {
        unsigned* bar = b.bar;
        __builtin_amdgcn_s_waitcnt(0);
        unsigned nloc = b.st[0], nx = b.st[1];
        if (nloc == 0u) { xcd_barrier_complete(bar, b.x, nloc, nx); b.st[0] = nloc; b.st[1] = nx; }
        const unsigned old = xb_add(&bar[XB_XSUB(b.x)], 1u);
        const unsigned gen = old / nloc;
        if (old + 1u == (gen + 1u) * nloc) {
            __builtin_amdgcn_fence(__ATOMIC_RELEASE, "agent");
            asm volatile("s_waitcnt vmcnt(0)" ::: "memory");
            const unsigned og = xb_add(&bar[XB_TOP], 1u);
            const unsigned tg = og / nx;
            if (og + 1u == (tg + 1u) * nx) xb_add(&bar[XB_TOPGEN], 1u);
            else XB_SPIN(xb_ld(&bar[XB_TOPGEN]) == tg, bar);
            __builtin_amdgcn_fence(__ATOMIC_ACQUIRE, "agent");
            xb_add(&bar[XB_XGEN(b.x)], 1u);
            asm volatile("s_waitcnt vmcnt(0)" ::: "memory");
        } else {
            XB_SPIN(xb_ld(&bar[XB_XGEN(b.x)]) == gen, bar);
            __builtin_amdgcn_fence(__ATOMIC_ACQUIRE, "agent");
            asm volatile("s_waitcnt vmcnt(0)" ::: "memory");
        }
    }
    __syncthreads();
}

typedef float f32x16 __attribute__((ext_vector_type(16)));
typedef short v4i16_t __attribute__((ext_vector_type(4)));
typedef float f32x2_t __attribute__((ext_vector_type(2)));
typedef __bf16 bf16x2_t __attribute__((ext_vector_type(2)));
typedef int i32x4 __attribute__((ext_vector_type(4)));
typedef unsigned u32x2 __attribute__((ext_vector_type(2)));

constexpr int NWAVES = 8, NTHR = 512;
constexpr int BATCH = 32, SEQ = 2048, DM = 1024, NTOK = BATCH * SEQ;
constexpr int NIN = 3088, NPROJ = 3328, NQP = 2048, NMOD = 6144;
constexpr int C_DQ = 0, C_DK = 512, C_DV = 1024, C_GQ = 1536, C_GK = 1792, C_GV = 2048, C_GR = 2560, C_GG = 3072;
constexpr int NEXP = 16384;
constexpr float RMS_EPS = 1e-6f;
constexpr float LAMBDA_INIT = 0.2f;
constexpr float QSCALE = 0.125f * 1.4426950408889634f;

constexpr size_t MiB = 1u << 20;
constexpr size_t WS_CTL = 0, CTL_ZERO_BYTES = 1 * MiB;
constexpr size_t WS_WIN_T = 2 * MiB;
constexpr size_t WS_WOUT_T = 10 * MiB;
constexpr size_t WS_WQ_T = 12 * MiB;
constexpr size_t WS_KEYS = 16 * MiB;
constexpr size_t WS_MOD = 17 * MiB;
constexpr size_t WS_WEFF = 18 * MiB;
constexpr size_t WS_CS = 19 * MiB;
constexpr size_t WS_RS1 = 20 * MiB;
constexpr size_t WS_RS2 = 21 * MiB;
constexpr size_t WS_CSQ = 19 * MiB + 16384;
constexpr size_t WS_COS = 32 * MiB;
constexpr size_t WS_SIN = 40 * MiB;
constexpr size_t WS_EU = 64 * MiB;
constexpr size_t WS_EV = 80 * MiB;
constexpr size_t WS_ES = 96 * MiB;
constexpr size_t WS_H = 128 * MiB;
constexpr size_t WS_HN = 192 * MiB;
constexpr size_t WS_PROJ = 256 * MiB;
constexpr size_t WS_PD = 256 * MiB;
constexpr size_t WS_X1 = 512 * MiB;
constexpr size_t WS_Y = 864 * MiB;
constexpr size_t WS_ACT = 768 * MiB;
constexpr size_t WS_EIDX = 800 * MiB;
constexpr size_t WS_EG = 832 * MiB;
constexpr size_t WS_END = 992 * MiB;
constexpr int CW_TMO = 0, CW_Q = 64, CW_RANK = 1024, CW_BAR = 4096, CW_WMAX = 32768;

constexpr int LDS_BYTES = 163840;
constexpr int MISC_OFF = LDS_BYTES - 256;

struct Args { const void* in[25]; float* out; unsigned char* ws; int ph_lo, ph_hi, li, pad; };
struct Ctx {
    LAS unsigned char* lds;
    volatile LAS unsigned* MISC;
    gu32* ctl;
    int tid, lane, wave, vcu, G;
    int sx, sj;
    float* out; unsigned char* ws;
};

__device__ __forceinline__ float wave_sum(float v) {
#pragma unroll
    for (int o = 1; o < 64; o <<= 1) v += __shfl_xor(v, o);
    return v;
}
__device__ __forceinline__ float wave_sum_fast(float x) {
    x += __int_as_float(__builtin_amdgcn_update_dpp(0, __float_as_int(x), 0xb1, 0xf, 0xf, false));
    x += __int_as_float(__builtin_amdgcn_update_dpp(0, __float_as_int(x), 0x4e, 0xf, 0xf, false));
    x += __int_as_float(__builtin_amdgcn_update_dpp(0, __float_as_int(x), 0x124, 0xf, 0xf, false));
    x += __int_as_float(__builtin_amdgcn_update_dpp(0, __float_as_int(x), 0x128, 0xf, 0xf, false));
    { auto r = __builtin_amdgcn_permlane16_swap(__float_as_uint(x), __float_as_uint(x), false, false); x = __uint_as_float(r[0]) + __uint_as_float(r[1]); }
    { auto r = __builtin_amdgcn_permlane32_swap(__float_as_uint(x), __float_as_uint(x), false, false); x = __uint_as_float(r[0]) + __uint_as_float(r[1]); }
    return x;
}
__device__ __forceinline__ unsigned cvtpk(float lo, float hi) { f32x2_t v = {lo, hi}; bf16x2_t b = __builtin_convertvector(v, bf16x2_t); return __builtin_bit_cast(unsigned, b); }
__device__ __forceinline__ float bf_lo(unsigned w) { return __uint_as_float(w << 16); }
__device__ __forceinline__ float bf_hi(unsigned w) { return __uint_as_float(w & 0xffff0000u); }
__device__ __forceinline__ int crow(int r, int hi) { return (r & 3) + 8 * (r >> 2) + 4 * hi; }
__device__ __forceinline__ float pair_max(float m) { auto rr = __builtin_amdgcn_permlane32_swap(__float_as_uint(m), __float_as_uint(m), false, false); return fmaxf(__uint_as_float(rr[0]), __uint_as_float(rr[1])); }
__device__ __forceinline__ float pair_sum(float m) { auto rr = __builtin_amdgcn_permlane32_swap(__float_as_uint(m), __float_as_uint(m), false, false); return __uint_as_float(rr[0]) + __uint_as_float(rr[1]); }
__device__ __forceinline__ int pair_maxi(int m) { auto rr = __builtin_amdgcn_permlane32_swap((unsigned)m, (unsigned)m, false, false); const int a = (int)rr[0], b = (int)rr[1]; return a > b ? a : b; }
__device__ __forceinline__ v4i16_t tr16(LAS const unsigned char* p) { return __builtin_amdgcn_ds_read_tr16_b64_v4i16((LAS v4i16_t*)p); }
__device__ __forceinline__ bf16x8 mk8(v4i16_t a, v4i16_t b) { return (bf16x8){a[0], a[1], a[2], a[3], b[0], b[1], b[2], b[3]}; }
#define MFMA32(a, b, c) __builtin_amdgcn_mfma_f32_32x32x16_bf16((a), (b), (c), 0, 0, 0)

__device__ __forceinline__ void p0_transpose_item(const float* W, int K, int ldw, int nblk, bf16* WT, LAS float* scr, int item, int lane) {
    const int kb = item / nblk, nb = item % nblk, k0 = 64 * kb, n0 = 32 * nb;
#pragma unroll 8
    for (int i = 0; i < 32; ++i) { const int kk = 2 * i + (lane >> 5); scr[kk * 33 + (lane & 31)] = W[(size_t)(k0 + kk) * ldw + n0 + (lane & 31)]; }
    LDS_WAIT(); asm volatile("" ::: "memory");
    const int c = lane & 7;
#pragma unroll
    for (int j = 0; j < 4; ++j) { const int n = (lane >> 3) + 8 * j; const LAS float* s = scr + (8 * c) * 33 + n;
        v4u o; o.x = pk2(s[0 * 33], s[1 * 33]); o.y = pk2(s[2 * 33], s[3 * 33]); o.z = pk2(s[4 * 33], s[5 * 33]); o.w = pk2(s[6 * 33], s[7 * 33]);
        *(GAS v4u*)(WT + (size_t)(n0 + n) * K + k0 + 8 * c) = o; }
    LDS_WAIT(); asm volatile("" ::: "memory");
}

__device__ __forceinline__ void mod_gemv(Ctx& C, const Args& A) {
    const float* cc = ((const float*)A.in[1]); const float* w_ada = ((const float*)A.in[3]); const float* b_ada = ((const float*)A.in[4]); float* mod = (float*)(C.ws + WS_MOD);
    LAS float* sc = (LAS float*)C.lds;
    LAS float* red = (LAS float*)(C.lds + 32768);
    const int col0 = C.vcu * 32, col = C.tid & 31, ks = C.tid >> 5;
    float acc[32];
#pragma unroll
    for (int i = 0; i < 32; ++i) acc[i] = 0.f;
    for (int kt = 0; kt < 4; ++kt) {
        for (int idx = C.tid; idx < 8192; idx += NTHR) { const int kk = idx >> 5, b = idx & 31; const float v = cc[b * 1024 + kt * 256 + kk]; sc[idx] = v / (1.f + __expf(-v)); }
        __syncthreads();
#pragma unroll 4
        for (int k2 = 0; k2 < 16; ++k2) { const int k = ks * 16 + k2; const float w = w_ada[(size_t)(kt * 256 + k) * NMOD + col0 + col];
#pragma unroll
            for (int b4 = 0; b4 < 8; ++b4) { const f32x4 f = *(const LAS f32x4*)(sc + k * 32 + 4 * b4);
                acc[4 * b4 + 0] += w * f.x; acc[4 * b4 + 1] += w * f.y; acc[4 * b4 + 2] += w * f.z; acc[4 * b4 + 3] += w * f.w; } }
        __syncthreads();
    }
#pragma unroll
    for (int b = 0; b < 32; ++b) red[(ks * 32 + b) * 32 + col] = acc[b];
    __syncthreads();
#pragma unroll
    for (int oo = 0; oo < 2; ++oo) { const int o = C.tid + oo * NTHR, c_ = o & 31, b = o >> 5; float s = 0.f;
#pragma unroll
        for (int k = 0; k < 16; ++k) s += red[(k * 32 + b) * 32 + c_];
        mod[b * NMOD + col0 + c_] = s + b_ada[col0 + c_]; }
    __syncthreads();
}

__device__ __forceinline__ void phase0(Ctx& C, const Args& A) {
    if (C.vcu < 192) mod_gemv(C, A);
    bf16* WoutT = (bf16*)(C.ws + WS_WOUT_T);
    const float* w_in = ((const float*)A.in[6]);
    unsigned* wmax = (unsigned*)(C.ctl + CW_WMAX);
    {
        LAS float* scr = (LAS float*)(C.lds + C.wave * 16384);
        const int gw = C.vcu * NWAVES + C.wave, NGW = C.G * NWAVES;
        constexpr int I_OUT = 16 * 32;
        for (int it = gw; it < I_OUT; it += NGW) p0_transpose_item(((const float*)A.in[17]), 1024, 1024, 32, WoutT, scr, it, C.lane);
    }
    const int gt = C.vcu * NTHR + C.tid, NGT = C.G * NTHR;
    {
        for (int it = gt; it < 16 * 3072; it += NGT) { const int kb = it / 3072, n = it - kb * 3072; float mx = 0.f;
#pragma unroll 8
            for (int k = 0; k < 64; ++k) mx = fmaxf(mx, fabsf(w_in[(size_t)(64 * kb + k) * NIN + n]));
            atomicMax(wmax + n, __float_as_uint(mx)); }
        const float* w_q = ((const float*)A.in[19]);
        for (int it = gt; it < 16 * 2048; it += NGT) { const int kb = it >> 11, n = it & 2047; float mx = 0.f;
#pragma unroll 8
            for (int k = 0; k < 64; ++k) mx = fmaxf(mx, fabsf(w_q[(size_t)(64 * kb + k) * NQP + n]));
            atomicMax(wmax + NPROJ + n, __float_as_uint(mx)); }
    }
    {
        const float* wg2 = ((const float*)A.in[14]); float* WE = (float*)(C.ws + WS_WEFF);
        for (int it = gt; it < 256 * 128; it += NGT) { const int j = it >> 7, kc = it & 127; float g[16];
#pragma unroll
            for (int r = 0; r < 16; ++r) g[r] = wg2[r * 256 + j];
            float o[8], mx = 0.f;
#pragma unroll
            for (int i = 0; i < 8; ++i) { const float* wr = w_in + (size_t)(8 * kc + i) * NIN + 3072; float s_ = 0.f;
#pragma unroll
                for (int r4 = 0; r4 < 4; ++r4) { const f32x4 w4 = *(const f32x4*)(wr + 4 * r4); s_ += w4.x * g[4 * r4] + w4.y * g[4 * r4 + 1] + w4.z * g[4 * r4 + 2] + w4.w * g[4 * r4 + 3]; }
                o[i] = s_; mx = fmaxf(mx, fabsf(s_)); }
            *(f32x4*)(WE + (size_t)j * 1024 + 8 * kc) = (f32x4){o[0], o[1], o[2], o[3]}; *(f32x4*)(WE + (size_t)j * 1024 + 8 * kc + 4) = (f32x4){o[4], o[5], o[6], o[7]};
            atomicMax(wmax + 3072 + j, __float_as_uint(mx)); }
    }
    {
        bf16* KB = (bf16*)(C.ws + WS_KEYS);
        for (int it = gt; it < 4096; it += NGT) { const float* src = (it < 2048 ? ((const float*)A.in[21]) : ((const float*)A.in[22])) + (size_t)(it & 2047) * 8;
            const f32x4 a = *(const f32x4*)src, b = *(const f32x4*)(src + 4);
            v4u ov; ov.x = pk2(a.x, a.y); ov.y = pk2(a.z, a.w); ov.z = pk2(b.x, b.y); ov.w = pk2(b.z, b.w);
            *(GAS v4u*)(KB + (size_t)it * 8) = ov; }
    }
    {
        const float* eu = ((const float*)A.in[23]); const float* ev = ((const float*)A.in[24]);
        unsigned char* E8 = C.ws + WS_EU; float* ES = (float*)(C.ws + WS_ES);
        const int gw = C.vcu * NWAVES + C.wave, NGW = C.G * NWAVES;
        f32x4 nv[4];
        { const int row = gw < 2 * NEXP ? gw : 0; const float* src = (row < NEXP ? eu + (size_t)row * 1024 : ev + (size_t)(row - NEXP) * 1024) + 16 * C.lane;
#pragma unroll
          for (int i = 0; i < 4; ++i) nv[i] = *(const f32x4*)(src + 4 * i); }
        for (int row = gw; row < 2 * NEXP; row += NGW) {
            f32x4 v[4]; float mx = 0.f;
#pragma unroll
            for (int i = 0; i < 4; ++i) v[i] = nv[i];
            { const int rn = row + NGW < 2 * NEXP ? row + NGW : row; const float* src = (rn < NEXP ? eu + (size_t)rn * 1024 : ev + (size_t)(rn - NEXP) * 1024) + 16 * C.lane;
#pragma unroll
              for (int i = 0; i < 4; ++i) nv[i] = *(const f32x4*)(src + 4 * i); }
#pragma unroll
            for (int i = 0; i < 4; ++i) mx = fmaxf(mx, fmaxf(fmaxf(fabsf(v[i].x), fabsf(v[i].y)), fmaxf(fabsf(v[i].z), fabsf(v[i].w))));
            mx = fmaxf(mx, __int_as_float(__builtin_amdgcn_update_dpp(0, __float_as_int(mx), 0xb1, 0xf, 0xf, false)));
            mx = fmaxf(mx, __int_as_float(__builtin_amdgcn_update_dpp(0, __float_as_int(mx), 0x4e, 0xf, 0xf, false)));
            mx = fmaxf(mx, __int_as_float(__builtin_amdgcn_update_dpp(0, __float_as_int(mx), 0x124, 0xf, 0xf, false)));
            mx = fmaxf(mx, __int_as_float(__builtin_amdgcn_update_dpp(0, __float_as_int(mx), 0x128, 0xf, 0xf, false)));
            { auto r = __builtin_amdgcn_permlane16_swap(__float_as_uint(mx), __float_as_uint(mx), false, false); mx = fmaxf(__uint_as_float(r[0]), __uint_as_float(r[1])); }
            { auto r = __builtin_amdgcn_permlane32_swap(__float_as_uint(mx), __float_as_uint(mx), false, false); mx = fmaxf(__uint_as_float(r[0]), __uint_as_float(r[1])); }
            if (row < NEXP) {
                float ss = 0.f;
#pragma unroll
                for (int i = 0; i < 4; ++i) ss += (v[i].x * v[i].x + v[i].y * v[i].y) + (v[i].z * v[i].z + v[i].w * v[i].w);
                const float rms = sqrtf(wave_sum_fast(ss) * (1.f / 1024.f));
                const float step = rms > 0.f ? 0.335f * rms : 1.f, istep = 1.f / step;
                u32x2 ow;
#pragma unroll
                for (int q = 0; q < 2; ++q) { unsigned w = 0u;
#pragma unroll
                    for (int jj = 0; jj < 4; ++jj) { const int nl = (int)fminf(fmaxf(floorf(v[2 * q][jj] * istep), -8.f), 7.f), nh = (int)fminf(fmaxf(floorf(v[2 * q + 1][jj] * istep), -8.f), 7.f);
                        w |= ((unsigned)(nl & 15) | ((unsigned)(nh & 15) << 4)) << (8 * jj); }
                    ow[q] = w; }
                *(GAS u32x2*)(E8 + (size_t)(C.lane >> 4) * (2u << 20) + (size_t)row * 128 + 8 * (C.lane & 15)) = ow;
                if (C.lane == 0) ES[row] = step;
            } else {
            const float top = 127.f;
            const float sc = mx > 0.f ? top / mx : 1.f, inv = mx > 0.f ? mx / top : 1.f;
            v4u ov;
#pragma unroll
            for (int i = 0; i < 4; ++i) {
                const int b0 = (int)rintf(v[i].x * sc), b1 = (int)rintf(v[i].y * sc), b2 = (int)rintf(v[i].z * sc), b3 = (int)rintf(v[i].w * sc);
                    ov[i] = (unsigned)(b0 & 0xff) | ((unsigned)(b1 & 0xff) << 8) | ((unsigned)(b2 & 0xff) << 16) | ((unsigned)(b3 & 0xff) << 24); }
            *(GAS v4u*)(E8 + (size_t)(16u << 20) + (size_t)(C.lane >> 3) * (2u << 20) + (size_t)(row & (NEXP - 1)) * 128 + 16 * (C.lane & 7)) = ov;
            if (C.lane == 0) ES[row] = inv;
            }
        }
    }
}

__device__ __forceinline__ void phase0b(Ctx& C, const Args& A) {
    const float* w_in = ((const float*)A.in[6]); const float* WE = (const float*)(C.ws + WS_WEFF); const unsigned* wmax = (const unsigned*)(C.ctl + CW_WMAX);
    unsigned char* W8 = C.ws + WS_WIN_T; float* CS = (float*)(C.ws + WS_CS);
    const int gt = C.vcu * NTHR + C.tid, NGT = C.G * NTHR;
    for (int n = gt; n < NPROJ; n += NGT) { const float mx = __uint_as_float(__hip_atomic_load(wmax + n, __ATOMIC_RELAXED, __HIP_MEMORY_SCOPE_AGENT)); CS[n] = mx > 0.f ? mx * (1.f / 127.f) : 1.f; }
    for (int it = gt; it < 64 * 3072; it += NGT) { const int kb = it / 3072, n = it - kb * 3072;
        const float mx = __uint_as_float(__hip_atomic_load(wmax + n, __ATOMIC_RELAXED, __HIP_MEMORY_SCOPE_AGENT)); const float sc = mx > 0.f ? 127.f / mx : 1.f;
        v4u ov;
#pragma unroll
        for (int q = 0; q < 4; ++q) { int b_[4];
#pragma unroll
            for (int i = 0; i < 4; ++i) b_[i] = (int)rintf(w_in[(size_t)(16 * kb + 4 * q + i) * NIN + n] * sc);
            ov[q] = (unsigned)(b_[0] & 0xff) | ((unsigned)(b_[1] & 0xff) << 8) | ((unsigned)(b_[2] & 0xff) << 16) | ((unsigned)(b_[3] & 0xff) << 24); }
        *(GAS v4u*)(W8 + (size_t)n * 1024 + 16 * kb) = ov; }
    {   const float* w_q = ((const float*)A.in[19]); unsigned char* Q8 = C.ws + WS_WQ_T; float* CSQ = (float*)(C.ws + WS_CSQ);
        for (int n = gt; n < NQP; n += NGT) { const float mx = __uint_as_float(__hip_atomic_load(wmax + NPROJ + n, __ATOMIC_RELAXED, __HIP_MEMORY_SCOPE_AGENT)); CSQ[n] = mx > 0.f ? mx * (1.f / 127.f) : 1.f; }
        for (int it = gt; it < 64 * 2048; it += NGT) { const int kb = it >> 11, n = it & 2047;
            const float mx = __uint_as_float(__hip_atomic_load(wmax + NPROJ + n, __ATOMIC_RELAXED, __HIP_MEMORY_SCOPE_AGENT)); const float sc = mx > 0.f ? 127.f / mx : 1.f;
            v4u ov;
#pragma unroll
            for (int q = 0; q < 4; ++q) { int b_[4];
#pragma unroll
                for (int i = 0; i < 4; ++i) b_[i] = (int)rintf(w_q[(size_t)(16 * kb + 4 * q + i) * NQP + n] * sc);
                ov[q] = (unsigned)(b_[0] & 0xff) | ((unsigned)(b_[1] & 0xff) << 8) | ((unsigned)(b_[2] & 0xff) << 16) | ((unsigned)(b_[3] & 0xff) << 24); }
            *(GAS v4u*)(Q8 + (size_t)n * 1024 + 16 * kb) = ov; }
    }
    for (int it = gt; it < 256 * 64; it += NGT) { const int j = it >> 6, kb = it & 63;
        const float mx = __uint_as_float(__hip_atomic_load(wmax + 3072 + j, __ATOMIC_RELAXED, __HIP_MEMORY_SCOPE_AGENT)); const float sc = mx > 0.f ? 127.f / mx : 1.f;
        v4u ov;
#pragma unroll
        for (int q = 0; q < 4; ++q) { const f32x4 w4 = *(const f32x4*)(WE + (size_t)j * 1024 + 16 * kb + 4 * q);
            const int b0 = (int)rintf(w4.x * sc), b1 = (int)rintf(w4.y * sc), b2 = (int)rintf(w4.z * sc), b3 = (int)rintf(w4.w * sc);
            ov[q] = (unsigned)(b0 & 0xff) | ((unsigned)(b1 & 0xff) << 8) | ((unsigned)(b2 & 0xff) << 16) | ((unsigned)(b3 & 0xff) << 24); }
        *(GAS v4u*)(W8 + (size_t)(3072 + j) * 1024 + 16 * kb) = ov; }
}

template <bool XBF, bool OUT8, bool PLANES = false> __device__ __forceinline__ void norm_mod_rows32(const float* X, const float* g, const float* sc, const float* sh, bf16* O, float* RS, int row0, int rstride, int lane,
                                                                   const int* pos, float* COS, float* SIN, float invf) {
    f32x4 gs[4], hs[4];
#pragma unroll
    for (int j = 0; j < 4; ++j) { const int cidx = 128 * (j >> 1) + 2 * lane + (j & 1); const f32x4 g4 = ((const f32x4*)g)[cidx], s4 = ((const f32x4*)sc)[cidx]; gs[j] = g4 * (s4 + 1.0f); hs[j] = ((const f32x4*)sh)[cidx]; }
    f32x4 nx[4], ny[4], nz[4];
#define NM_LOAD(dst, r) do { if (!XBF) { _Pragma("unroll") for (int j = 0; j < 4; ++j) dst[j] = ((const GAS f32x4*)(X + (size_t)(r) * DM))[128 * (j >> 1) + 2 * lane + (j & 1)]; } \
        else { _Pragma("unroll") for (int hf_ = 0; hf_ < 2; ++hf_) { const v4u w_ = ((const GAS v4u*)((const bf16*)X + (size_t)(r) * DM))[64 * hf_ + lane]; \
            dst[2 * hf_] = (f32x4){bf_lo(w_.x), bf_hi(w_.x), bf_lo(w_.y), bf_hi(w_.y)}; dst[2 * hf_ + 1] = (f32x4){bf_lo(w_.z), bf_hi(w_.z), bf_lo(w_.w), bf_hi(w_.w)}; } } } while (0)
    NM_LOAD(nx, row0); NM_LOAD(ny, row0 + rstride); NM_LOAD(nz, row0 + 2 * rstride);
#pragma unroll 1
    for (int i = 0; i < 32; ++i) {
        const int m = row0 + i * rstride, mn = row0 + (i < 29 ? i + 3 : 31) * rstride;
        f32x4 v[4];
#pragma unroll
        for (int j = 0; j < 4; ++j) { v[j] = nx[j]; nx[j] = ny[j]; ny[j] = nz[j]; }
        NM_LOAD(nz, mn);
        float s = 0.f;
#pragma unroll
        for (int j = 0; j < 4; ++j) s += (v[j].x * v[j].x + v[j].y * v[j].y) + (v[j].z * v[j].z + v[j].w * v[j].w);
        const float rinv = 1.0f / sqrtf(wave_sum_fast(s) * (1.f / 1024.f) + RMS_EPS);
        if (!OUT8) {
            GAS v4u* o16 = (GAS v4u*)(O + (size_t)m * DM) + lane;
#pragma unroll
            for (int hf = 0; hf < 2; ++hf) { const f32x4 y0 = v[2 * hf] * rinv * gs[2 * hf] + hs[2 * hf], y1 = v[2 * hf + 1] * rinv * gs[2 * hf + 1] + hs[2 * hf + 1];
                o16[64 * hf] = (v4u){cvtpk(y0.x, y0.y), cvtpk(y0.z, y0.w), cvtpk(y1.x, y1.y), cvtpk(y1.z, y1.w)}; }
        } else {
            f32x4 y[4]; float mx = 0.f;
#pragma unroll
            for (int j = 0; j < 4; ++j) { y[j] = v[j] * rinv * gs[j] + hs[j]; mx = fmaxf(mx, fmaxf(fmaxf(fabsf(y[j].x), fabsf(y[j].y)), fmaxf(fabsf(y[j].z), fabsf(y[j].w)))); }
            mx = fmaxf(mx, __int_as_float(__builtin_amdgcn_update_dpp(0, __float_as_int(mx), 0xb1, 0xf, 0xf, false)));
            mx = fmaxf(mx, __int_as_float(__builtin_amdgcn_update_dpp(0, __float_as_int(mx), 0x4e, 0xf, 0xf, false)));
            mx = fmaxf(mx, __int_as_float(__builtin_amdgcn_update_dpp(0, __float_as_int(mx), 0x124, 0xf, 0xf, false)));
            mx = fmaxf(mx, __int_as_float(__builtin_amdgcn_update_dpp(0, __float_as_int(mx), 0x128, 0xf, 0xf, false)));
            { auto r = __builtin_amdgcn_permlane16_swap(__float_as_uint(mx), __float_as_uint(mx), false, false); mx = fmaxf(__uint_as_float(r[0]), __uint_as_float(r[1])); }
            { auto r = __builtin_amdgcn_permlane32_swap(__float_as_uint(mx), __float_as_uint(mx), false, false); mx = fmaxf(__uint_as_float(r[0]), __uint_as_float(r[1])); }
            constexpr float QTOP = PLANES ? 119.f : 127.f;
            const float qs = mx > 0.f ? QTOP / mx : 1.f;
            GAS u32x2* o8 = (GAS u32x2*)((unsigned char*)O + (size_t)m * DM) + lane;
#pragma unroll
            for (int hf = 0; hf < 2; ++hf) { u32x2 w; unsigned pa = 0u, pb = 0u;
#pragma unroll
                for (int q = 0; q < 2; ++q) { const f32x4 yy = y[2 * hf + q]; const int b0 = (int)rintf(yy.x * qs), b1 = (int)rintf(yy.y * qs), b2 = (int)rintf(yy.z * qs), b3 = (int)rintf(yy.w * qs);
                    w[q] = (unsigned)(b0 & 0xff) | ((unsigned)(b1 & 0xff) << 8) | ((unsigned)(b2 & 0xff) << 16) | ((unsigned)(b3 & 0xff) << 24);
                    if (PLANES) { const int bb[4] = {b0, b1, b2, b3};
#pragma unroll
                        for (int jj = 0; jj < 4; ++jj) { pa |= (unsigned)(((bb[jj] + 8) >> 4) & 15) << (8 * jj + 4 * q); pb |= (unsigned)(bb[jj] & 15) << (8 * jj + 4 * q); } } }
                o8[64 * hf] = w;
                if (PLANES) {
                    GAS unsigned* hn = (GAS unsigned*)((unsigned char*)O + (WS_HN - WS_H) + (size_t)m * DM + 256 * (2 * hf + (lane >> 5)) + 32 * ((lane >> 2) & 7) + 4 * (lane & 3));
                    hn[0] = pa; hn[4] = pb; } }
            if (lane == 0) RS[m] = mx > 0.f ? mx * (1.f / QTOP) : 1.f;
        }
    }
#undef NM_LOAD
}
__device__ __forceinline__ void phase1(Ctx& C, const Args& A) {
    const float* x = ((const float*)A.in[0]); const int* pos = (const int*)((const float*)A.in[2]); const float* g = ((const float*)A.in[5]); const float* mod = (const float*)(C.ws + WS_MOD);
    bf16* H = (bf16*)(C.ws + WS_H); float* COS = (float*)(C.ws + WS_COS); float* SIN = (float*)(C.ws + WS_SIN);
    const int gw = C.vcu * NWAVES + C.wave, NGW = C.G * NWAVES;
    const float invf = __builtin_amdgcn_exp2f(-(float)(C.lane & 31) * 0.41524101186092029f);
    for (int ch = gw; ch < NTOK / 32; ch += NGW) { const int b = ch >> 6;
        norm_mod_rows32<false, true>(x, g, mod + b * NMOD + 1024, mod + b * NMOD, H, (float*)(C.ws + WS_RS1), 2048 * b + (ch & 63), 64, C.lane, pos, COS, SIN, invf); }
}
__device__ __forceinline__ void phase5(Ctx& C, const Args& A) {
    const float* x1 = (const float*)(C.ws + WS_X1); const float* g = ((const float*)A.in[18]); const float* mod = (const float*)(C.ws + WS_MOD); bf16* H = (bf16*)(C.ws + WS_H);
    const int gw = C.vcu * NWAVES + C.wave, NGW = C.G * NWAVES;
    for (int ch = gw; ch < NTOK / 32; ch += NGW) { const int b = ch >> 6;
        norm_mod_rows32<true, true, true>(x1, g, mod + b * NMOD + 4 * 1024, mod + b * NMOD + 3 * 1024, H, (float*)(C.ws + WS_RS2), 2048 * b + (ch & 63), 64, C.lane, nullptr, nullptr, nullptr, 0.f); }
}

__device__ __forceinline__ void phase2b(Ctx& C, const Args& A) {
    bf16* PROJ = (bf16*)(C.ws + WS_PROJ); const int* pos = (const int*)A.in[2];
    const float* qn = ((const float*)A.in[7]); const float* kn = ((const float*)A.in[8]);
    const int gw = C.vcu * NWAVES + C.wave, NGW = C.G * NWAVES, lane = C.lane;
    const int grp = lane >> 2, qd = lane & 3;
    float gain[16];
#pragma unroll
    for (int i = 0; i < 16; ++i) gain[i] = (grp < 8 ? qn : kn)[16 * qd + i] * (grp < 8 ? QSCALE : 1.0f);
    const float sgn = (qd < 2) ? -1.f : 1.f;
    float invf[16];
#pragma unroll
    for (int i = 0; i < 16; ++i) invf[i] = __builtin_amdgcn_exp2f(-(float)(16 * (qd & 1) + i) * 0.41524101186092029f);
    v4u n0, n1; int npos;
    { const int m0 = gw < NTOK ? gw : 0; const GAS v4u* p = (const GAS v4u*)(PROJ + (size_t)m0 * NPROJ + 16 * lane); n0 = p[0]; n1 = p[1]; npos = pos[m0]; }
    for (int m = gw; m < NTOK; m += NGW) {
        GAS v4u* p = (GAS v4u*)(PROJ + (size_t)m * NPROJ + 16 * lane);
        const v4u w0 = n0, w1 = n1; const int ipos = npos;
        { const int mn = m + NGW < NTOK ? m + NGW : m; const GAS v4u* pn = (const GAS v4u*)(PROJ + (size_t)mn * NPROJ + 16 * lane); n0 = pn[0]; n1 = pn[1]; npos = pos[mn]; }
        float xv[16];
        xv[0] = bf_lo(w0.x); xv[1] = bf_hi(w0.x); xv[2] = bf_lo(w0.y); xv[3] = bf_hi(w0.y); xv[4] = bf_lo(w0.z); xv[5] = bf_hi(w0.z); xv[6] = bf_lo(w0.w); xv[7] = bf_hi(w0.w);
        xv[8] = bf_lo(w1.x); xv[9] = bf_hi(w1.x); xv[10] = bf_lo(w1.y); xv[11] = bf_hi(w1.y); xv[12] = bf_lo(w1.z); xv[13] = bf_hi(w1.z); xv[14] = bf_lo(w1.w); xv[15] = bf_hi(w1.w);
        float ss = 0.f;
#pragma unroll
        for (int i = 0; i < 16; ++i) ss += xv[i] * xv[i];
        ss += __int_as_float(__builtin_amdgcn_update_dpp(0, __float_as_int(ss), 0xb1, 0xf, 0xf, false)); ss += __int_as_float(__builtin_amdgcn_update_dpp(0, __float_as_int(ss), 0x4e, 0xf, 0xf, false));
        const float rinv = 1.0f / sqrtf(ss * (1.f / 64.f) + RMS_EPS);
        const float fpos = (float)ipos;
        float cs[16], sn[16];
#pragma unroll
        for (int i = 0; i < 16; ++i) { const float ang = fpos * invf[i]; const float fr = __builtin_amdgcn_fractf(ang * 0.15915494309189535f);
            cs[i] = __builtin_amdgcn_cosf(fr); sn[i] = __builtin_amdgcn_sinf(fr); }
        float y[16];
#pragma unroll
        for (int i = 0; i < 16; ++i) { const float v = xv[i] * rinv * gain[i]; const float pv = __int_as_float(__builtin_amdgcn_update_dpp(0, __float_as_int(v), 0x4e, 0xf, 0xf, false)); y[i] = v * cs[i] + sgn * pv * sn[i]; }
        v4u o0, o1;
        o0.x = cvtpk(y[0], y[1]); o0.y = cvtpk(y[2], y[3]); o0.z = cvtpk(y[4], y[5]); o0.w = cvtpk(y[6], y[7]);
        o1.x = cvtpk(y[8], y[9]); o1.y = cvtpk(y[10], y[11]); o1.z = cvtpk(y[12], y[13]); o1.w = cvtpk(y[14], y[15]);
        p[0] = o0; p[1] = o1;
    }
}

constexpr int AT_KP = 144, AT_VP = 320;
constexpr int AT_K1 = 64 * AT_KP, AT_V = 2 * 64 * AT_KP, AT_STG = AT_V + 64 * AT_VP;
constexpr int AT_XP = 129;
constexpr int AT_YST = 66048, AT_YP = 272;
static_assert(4 * AT_STG <= MISC_OFF && 128 * AT_XP * 4 <= AT_YST && AT_YST + 128 * AT_YP <= 4 * AT_STG, "attention LDS map");

template <int ABL> __device__ __forceinline__ void attn_unit(Ctx& C, const Args& A, int bh, int qb, float lam) {
    const int b = bh >> 2, h = bh & 3;
    int tid_ = C.tid; asm volatile("" : "+v"(tid_));
    const int tid = tid_, lane = tid & 63, w = C.wave, r32 = lane & 31, hi = lane >> 5, mp = w >> 2, wq = w & 3;
    const bf16* P = (const bf16*)(C.ws + WS_PROJ) + (size_t)(b * SEQ) * NPROJ;
    const int NT = 2 * qb + 2;
    const int krow = tid >> 3, kch = tid & 7, vrow = tid >> 4, vch = tid & 15;
    const bf16* gk = P + (size_t)krow * NPROJ + C_DK + h * 128 + 8 * kch;
    const bf16* gv = P + (size_t)vrow * NPROJ + C_DV + h * 128 + 8 * vch;
    v4u skA0, skA1, svA0, svA1, skB0, skB1, svB0, svB1;
#define AT_LOAD(t, S) do { const size_t o_ = (size_t)(t) * 64 * NPROJ; sk##S##0 = *(const GAS v4u*)(gk + o_); sk##S##1 = *(const GAS v4u*)(gk + o_ + 64); \
        sv##S##0 = *(const GAS v4u*)(gv + o_); sv##S##1 = *(const GAS v4u*)(gv + o_ + (size_t)32 * NPROJ); } while (0)
#define AT_STORE(s, S) do { LAS unsigned char* bs_ = C.lds + (s) * AT_STG; *(LAS v4u*)(bs_ + krow * AT_KP + kch * 16) = sk##S##0; *(LAS v4u*)(bs_ + AT_K1 + krow * AT_KP + kch * 16) = sk##S##1; \
        *(LAS v4u*)(bs_ + AT_V + vrow * AT_VP + vch * 16) = sv##S##0; *(LAS v4u*)(bs_ + AT_V + (vrow + 32) * AT_VP + vch * 16) = sv##S##1; } while (0)
    AT_LOAD(0, A);
    AT_LOAD(1, B);
    const int qrow = qb * 128 + wq * 32 + r32;
    bf16x8 qf[4];
#pragma unroll
    for (int kk = 0; kk < 4; ++kk) qf[kk] = *(const GAS bf16x8*)(P + (size_t)qrow * NPROJ + C_DQ + h * 128 + mp * 64 + 16 * kk + 8 * hi);
    f32x16 o[4];
#pragma unroll
    for (int e = 0; e < 4; ++e)
#pragma unroll
        for (int r = 0; r < 16; ++r) o[e][r] = 0.f;
    float mrun = -1e30f, lrun = 0.f;
    AT_STORE(0, A); AT_STORE(1, B);
    if (2 < NT) { AT_LOAD(2, A); AT_LOAD(3, B); }
    __syncthreads();
    const int trbase = ((lane & 15) >> 2) * AT_VP + (16 * ((lane >> 4) & 1) + 4 * (lane & 3)) * 2;
#define AT_QKSM(t, stg, PW) do { \
        const LAS unsigned char* base = C.lds + (stg) * AT_STG; \
        f32x16 p0, p1; \
        _Pragma("unroll") for (int r = 0; r < 16; ++r) { p0[r] = 0.f; p1[r] = 0.f; } \
        const LAS unsigned char* kb_ = base + mp * AT_K1 + r32 * AT_KP + hi * 16; \
        bf16x8 ka_[4], kb2_[4]; \
        _Pragma("unroll") for (int kk = 0; kk < 4; ++kk) { ka_[kk] = *(const LAS bf16x8*)(kb_ + kk * 32); kb2_[kk] = *(const LAS bf16x8*)(kb_ + 32 * AT_KP + kk * 32); } \
        __builtin_amdgcn_s_setprio(1); \
        _Pragma("unroll") for (int kk = 0; kk < 4; ++kk) { p0 = MFMA32(ka_[kk], qf[kk], p0); p1 = MFMA32(kb2_[kk], qf[kk], p1); } \
        __builtin_amdgcn_s_setprio(0); \
        if ((t) >= 2 * qb) { \
            _Pragma("unroll") for (int r = 0; r < 16; ++r) { const int key = 64 * (t) + crow(r, hi); if (key > qrow) p0[r] = -1e30f; if (key + 32 > qrow) p1[r] = -1e30f; } } \
        float mx = fmaxf(p0[0], p1[0]); \
        _Pragma("unroll") for (int r = 1; r < 16; ++r) mx = fmaxf(mx, fmaxf(p0[r], p1[r])); \
        mx = pair_max(mx); \
        const float mnew = fmaxf(mrun, mx); \
        if (__any(mnew > mrun)) { const float alpha = __builtin_amdgcn_exp2f(mrun - mnew); mrun = mnew; lrun *= alpha; \
            _Pragma("unroll") for (int e = 0; e < 4; ++e) _Pragma("unroll") for (int r = 0; r < 16; ++r) o[e][r] *= alpha; } \
        float rs = 0.f; \
        _Pragma("unroll") for (int r = 0; r < 16; ++r) { p0[r] = __builtin_amdgcn_exp2f(p0[r] - mrun); p1[r] = __builtin_amdgcn_exp2f(p1[r] - mrun); rs += p0[r] + p1[r]; } \
        lrun += rs; \
        { v4u t0, t1, t2, t3; \
          t0.x = cvtpk(p0[0], p0[1]); t0.y = cvtpk(p0[2], p0[3]); t0.z = cvtpk(p0[4], p0[5]); t0.w = cvtpk(p0[6], p0[7]); \
          t1.x = cvtpk(p0[8], p0[9]); t1.y = cvtpk(p0[10], p0[11]); t1.z = cvtpk(p0[12], p0[13]); t1.w = cvtpk(p0[14], p0[15]); \
          t2.x = cvtpk(p1[0], p1[1]); t2.y = cvtpk(p1[2], p1[3]); t2.z = cvtpk(p1[4], p1[5]); t2.w = cvtpk(p1[6], p1[7]); \
          t3.x = cvtpk(p1[8], p1[9]); t3.y = cvtpk(p1[10], p1[11]); t3.z = cvtpk(p1[12], p1[13]); t3.w = cvtpk(p1[14], p1[15]); \
          PW[0] = __builtin_bit_cast(bf16x8, t0); PW[1] = __builtin_bit_cast(bf16x8, t1); PW[2] = __builtin_bit_cast(bf16x8, t2); PW[3] = __builtin_bit_cast(bf16x8, t3); } \
    } while (0)
#define AT_PV(stage, PW) do { const LAS unsigned char* vb_ = C.lds + (stage) * AT_STG + AT_V + trbase + (4 * hi) * AT_VP; \
        _Pragma("unroll") for (int e = 0; e < 4; ++e) { \
            v4i16_t lo[4], hi4[4]; \
            _Pragma("unroll") for (int s = 0; s < 4; ++s) { const LAS unsigned char* a_ = vb_ + (16 * s) * AT_VP + e * 64; lo[s] = tr16(a_); hi4[s] = tr16(a_ + 8 * AT_VP); } \
            __builtin_amdgcn_s_setprio(1); \
            _Pragma("unroll") for (int s = 0; s < 4; ++s) o[e] = MFMA32(mk8(lo[s], hi4[s]), PW[s], o[e]); \
            __builtin_amdgcn_s_setprio(0); \
            __builtin_amdgcn_sched_barrier(0); \
        } } while (0)
    bf16x8 pw[4];
    for (int t = 0; t < NT; t += 2) {
        AT_QKSM(t, t & 3, pw); __builtin_amdgcn_sched_barrier(0); AT_PV(t & 3, pw);
        if (t + 2 < NT) { AT_STORE((t + 2) & 3, A); if (t + 4 < NT) AT_LOAD(t + 4, A); }
        AT_QKSM(t + 1, (t + 1) & 3, pw); __builtin_amdgcn_sched_barrier(0); AT_PV((t + 1) & 3, pw);
        if (t + 3 < NT) { AT_STORE((t + 3) & 3, B); if (t + 5 < NT) AT_LOAD(t + 5, B); }
        __syncthreads();
    }
    __syncthreads();
#undef AT_QKSM
#undef AT_PV
    lrun = pair_sum(lrun);
    const float linv = 1.0f / lrun;
    LAS float* xch = (LAS float*)C.lds;
    if (mp == 1) {
#pragma unroll
        for (int e = 0; e < 4; ++e)
#pragma unroll
            for (int r = 0; r < 16; ++r) xch[(wq * 32 + r32) * AT_XP + 32 * e + crow(r, hi)] = o[e][r] * linv;
    }
    __syncthreads();
    if (mp == 0 && ABL != 0) { asm volatile("" :: "v"(o[0]), "v"(o[1]), "v"(o[2]), "v"(o[3]), "v"(lrun)); }
    if (mp == 0 && ABL == 0) {
        const float* sg = ((const float*)A.in[13]);
        float ss = 0.f;
#pragma unroll
        for (int e = 0; e < 4; ++e)
#pragma unroll
            for (int r = 0; r < 16; ++r) { const float v = o[e][r] * linv - lam * xch[(wq * 32 + r32) * AT_XP + 32 * e + crow(r, hi)]; o[e][r] = v; ss += v * v; }
        ss = pair_sum(ss);
        const float rinv = (1.0f - LAMBDA_INIT) / sqrtf(ss * (1.f / 128.f) + RMS_EPS);
        LAS unsigned char* yst = C.lds + AT_YST + (wq * 32 + r32) * AT_YP;
#pragma unroll
        for (int e = 0; e < 4; ++e)
#pragma unroll
            for (int g = 0; g < 4; ++g) { const int ec = 32 * e + 8 * g + 4 * hi; const f32x4 g4 = *(const f32x4*)(sg + ec);
                u32x2 ov; ov.x = cvtpk(o[e][4 * g] * rinv * g4.x, o[e][4 * g + 1] * rinv * g4.y); ov.y = cvtpk(o[e][4 * g + 2] * rinv * g4.z, o[e][4 * g + 3] * rinv * g4.w);
                *(LAS u32x2*)(yst + ec * 2) = ov; }
    }
    __syncthreads();
    if (ABL == 0) {
        bf16* Y = (bf16*)(C.ws + WS_Y) + (size_t)(b * SEQ + qb * 128) * DM + h * 128;
#pragma unroll
        for (int i = 0; i < 4; ++i) { const int idx = tid + i * NTHR, row = idx >> 4, ch = idx & 15;
            *(GAS v4u*)(Y + (size_t)row * DM + 8 * ch) = *(const LAS v4u*)(C.lds + AT_YST + row * AT_YP + ch * 16); }
    }
    __syncthreads();
#undef AT_LOAD
#undef AT_STORE
}

constexpr int GL_BC = 0;
constexpr int GL_QE = 17408, GL_KE = GL_QE + 9216, GL_QS = GL_KE + 9216, GL_AM = GL_QS + 9216;
constexpr int GL_KD = GL_AM + 9216;
constexpr int GL_V = GL_KD + 12288;
constexpr int GL_SB = GL_V + 20480;
constexpr int GL_O = GL_SB + 20480;
constexpr int GL_SM = GL_O + 33792;
constexpr int GL_END = GL_SM + 768 + 2048;
static_assert(GL_END <= MISC_OFF, "GLA LDS map");

__device__ __forceinline__ void gla_unit(Ctx& C, const Args& A, int bh) {
    const int b = bh >> 2, h = bh & 3;
    int tid_ = C.tid; asm volatile("" : "+v"(tid_));
    const int tid = tid_, lane = tid & 63, w = C.wave, r32 = lane & 31, hi = lane >> 5;
    const bf16* P = (const bf16*)(C.ws + WS_PROJ) + (size_t)(b * SEQ) * NPROJ;
    bf16* Y = (bf16*)(C.ws + WS_Y) + (size_t)(b * SEQ) * DM + 512 + h * 128;
    LAS unsigned char* L = C.lds;
    LAS float* BC = (LAS float*)(L + GL_BC); LAS float* BMID = (LAS float*)(L + GL_SM); LAS float* BLAST = BMID + 64; LAS float* DEC = BMID + 128; LAS float* SEG = BMID + 192;
    LAS float* OI = (LAS float*)(L + GL_O);
    const float bg = ((const float*)A.in[15])[h * 64 + (tid & 63)];
    const int db = w & 1, eb = w >> 1;
    f32x16 S;
#pragma unroll
    for (int r = 0; r < 16; ++r) S[r] = 0.f;
    const int trq = (lane & 15) >> 2, trc = 16 * ((lane >> 4) & 1) + 4 * (lane & 3);
    unsigned short pre_n[8]; v4u q_n, k_n, v_n[2], r_n[2];
#define GL_FETCH(n_) do { const bf16* Pf_ = P + (size_t)((n_) * 64) * NPROJ; \
        _Pragma("unroll") for (int i = 0; i < 8; ++i) pre_n[i] = *(const GAS unsigned short*)(Pf_ + (size_t)(8 * (tid >> 6) + i) * NPROJ + C_GG + h * 64 + (tid & 63)); \
        q_n = *(const GAS v4u*)(Pf_ + (size_t)(tid >> 3) * NPROJ + C_GQ + h * 64 + 8 * (tid & 7)); k_n = *(const GAS v4u*)(Pf_ + (size_t)(tid >> 3) * NPROJ + C_GK + h * 64 + 8 * (tid & 7)); \
        _Pragma("unroll") for (int i = 0; i < 2; ++i) { const int idx_ = tid + i * NTHR; v_n[i] = *(const GAS v4u*)(Pf_ + (size_t)(idx_ >> 4) * NPROJ + C_GV + h * 128 + 8 * (idx_ & 15)); } \
        { const GAS v4u* rp_ = (const GAS v4u*)(Pf_ + (size_t)(tid >> 3) * NPROJ + C_GR + h * 128 + 16 * (tid & 7)); r_n[0] = rp_[0]; r_n[1] = rp_[1]; } } while (0)
    GL_FETCH(0);
    for (int n = 0; n < 32; ++n) {
        unsigned short pre_c[8]; v4u q_c = q_n, k_c = k_n, v_c[2] = {v_n[0], v_n[1]}, r_c[2] = {r_n[0], r_n[1]};
#pragma unroll
        for (int i = 0; i < 8; ++i) pre_c[i] = pre_n[i];
        GL_FETCH(n < 31 ? n + 1 : 31);
        {   const int d = tid & 63, seg = tid >> 6; float pre[8];
#pragma unroll
            for (int i = 0; i < 8; ++i) pre[i] = __uint_as_float((unsigned)pre_c[i] << 16);
            float run = 0.f;
#pragma unroll
            for (int i = 0; i < 8; ++i) { const float z = pre[i] + bg; const float ls = fminf(z, 0.f) - __logf(1.0f + __expf(-fabsf(z))); run += ls * (1.f / 16.f); pre[i] = run; }
            SEG[seg * 64 + d] = run;
            __syncthreads();
            float off = 0.f;
#pragma unroll
            for (int s = 0; s < 8; ++s) off += (s < seg) ? SEG[s * 64 + d] : 0.f;
#pragma unroll
            for (int i = 0; i < 8; ++i) { const float v = pre[i] + off; BC[(8 * seg + i) * 68 + d] = v;
                if (8 * seg + i == 32) BMID[d] = v;
                if (8 * seg + i == 63) { BLAST[d] = v; DEC[d] = __expf(v); } }
            __syncthreads();
        }
        {   const int c = tid >> 3, d8 = tid & 7;
            const v4u qw = q_c, kw = k_c;
            const unsigned qa[4] = {qw.x, qw.y, qw.z, qw.w}, ka[4] = {kw.x, kw.y, kw.z, kw.w};
            const f32x4 bc0 = *(const LAS f32x4*)(BC + c * 68 + 8 * d8), bc1 = *(const LAS f32x4*)(BC + c * 68 + 8 * d8 + 4);
            const f32x4 bm0 = *(const LAS f32x4*)(BMID + 8 * d8), bm1 = *(const LAS f32x4*)(BMID + 8 * d8 + 4);
            const f32x4 bl0 = *(const LAS f32x4*)(BLAST + 8 * d8), bl1 = *(const LAS f32x4*)(BLAST + 8 * d8 + 4);
            const float bcv[8] = {bc0.x, bc0.y, bc0.z, bc0.w, bc1.x, bc1.y, bc1.z, bc1.w}, bmv[8] = {bm0.x, bm0.y, bm0.z, bm0.w, bm1.x, bm1.y, bm1.z, bm1.w}, blv[8] = {bl0.x, bl0.y, bl0.z, bl0.w, bl1.x, bl1.y, bl1.z, bl1.w};
            float qe[8], ke[8], qs[8], kd[8];
#pragma unroll
            for (int i = 0; i < 8; ++i) { const float q = ((i & 1) ? bf_hi(qa[i >> 1]) : bf_lo(qa[i >> 1])) * 0.125f, k = (i & 1) ? bf_hi(ka[i >> 1]) : bf_lo(ka[i >> 1]);
                qe[i] = q * __expf(bcv[i] - bmv[i]); ke[i] = k * __expf(bmv[i] - bcv[i]); qs[i] = q * __expf(bcv[i]); kd[i] = k * __expf(blv[i] - bcv[i]); }
            v4u o_;
            o_.x = cvtpk(qe[0], qe[1]); o_.y = cvtpk(qe[2], qe[3]); o_.z = cvtpk(qe[4], qe[5]); o_.w = cvtpk(qe[6], qe[7]); *(LAS v4u*)(L + GL_QE + c * 144 + d8 * 16) = o_;
            o_.x = cvtpk(ke[0], ke[1]); o_.y = cvtpk(ke[2], ke[3]); o_.z = cvtpk(ke[4], ke[5]); o_.w = cvtpk(ke[6], ke[7]); *(LAS v4u*)(L + GL_KE + c * 144 + d8 * 16) = o_;
            o_.x = cvtpk(qs[0], qs[1]); o_.y = cvtpk(qs[2], qs[3]); o_.z = cvtpk(qs[4], qs[5]); o_.w = cvtpk(qs[6], qs[7]); *(LAS v4u*)(L + GL_QS + c * 144 + d8 * 16) = o_;
            o_.x = cvtpk(kd[0], kd[1]); o_.y = cvtpk(kd[2], kd[3]); o_.z = cvtpk(kd[4], kd[5]); o_.w = cvtpk(kd[6], kd[7]); *(LAS v4u*)(L + GL_KD + c * 192 + d8 * 16) = o_;
#pragma unroll
            for (int i = 0; i < 2; ++i) { const int idx = tid + i * NTHR, row = idx >> 4, ch = idx & 15;
                *(LAS v4u*)(L + GL_V + row * 320 + ch * 16) = v_c[i]; }
#pragma unroll
            for (int r = 0; r < 16; ++r) *(LAS unsigned short*)(L + GL_SB + (32 * db + crow(r, hi)) * 320 + (32 * eb + r32) * 2) = (unsigned short)(cvtpk(S[r], 0.f) & 0xffffu);
            __syncthreads();
        }
        if (w < 4) {
            const int cb = w & 1, jb = w >> 1; f32x16 a;
#pragma unroll
            for (int r = 0; r < 16; ++r) a[r] = 0.f;
#pragma unroll
            for (int kk = 0; kk < 4; ++kk) { const bf16x8 fa = *(const LAS bf16x8*)(L + GL_QE + (32 * cb + r32) * 144 + (16 * kk + 8 * hi) * 2), fb = *(const LAS bf16x8*)(L + GL_KE + (32 * jb + r32) * 144 + (16 * kk + 8 * hi) * 2);
                a = MFMA32(fa, fb, a); }
#pragma unroll
            for (int r = 0; r < 16; ++r) { const int cc = 32 * cb + crow(r, hi), jj = 32 * jb + r32; const float v = (jj <= cc) ? a[r] : 0.f;
                *(LAS unsigned short*)(L + GL_AM + cc * 144 + jj * 2) = (unsigned short)(cvtpk(v, 0.f) & 0xffffu); }
        }
        {
#pragma unroll
            for (int r = 0; r < 16; ++r) S[r] *= DEC[32 * db + crow(r, hi)];
#pragma unroll
            for (int kk = 0; kk < 4; ++kk) { const LAS unsigned char* pa = L + GL_KD + (16 * kk + 8 * hi + trq) * 192 + (32 * db + trc) * 2; const LAS unsigned char* pb = L + GL_V + (16 * kk + 8 * hi + trq) * 320 + (32 * eb + trc) * 2;
                const bf16x8 fa = mk8(tr16(pa), tr16(pa + 4 * 192)), fb = mk8(tr16(pb), tr16(pb + 4 * 320));
                S = MFMA32(fa, fb, S); }
        }
        __syncthreads();
        {   const int cb = w & 1; f32x16 a;
#pragma unroll
            for (int r = 0; r < 16; ++r) a[r] = 0.f;
#pragma unroll
            for (int kk = 0; kk < 4; ++kk) { const bf16x8 fa = *(const LAS bf16x8*)(L + GL_AM + (32 * cb + r32) * 144 + (16 * kk + 8 * hi) * 2);
                const LAS unsigned char* pb = L + GL_V + (16 * kk + 8 * hi + trq) * 320 + (32 * eb + trc) * 2;
                a = MFMA32(fa, mk8(tr16(pb), tr16(pb + 4 * 320)), a); }
#pragma unroll
            for (int kk = 0; kk < 4; ++kk) { const bf16x8 fa = *(const LAS bf16x8*)(L + GL_QS + (32 * cb + r32) * 144 + (16 * kk + 8 * hi) * 2);
                const LAS unsigned char* pb = L + GL_SB + (16 * kk + 8 * hi + trq) * 320 + (32 * eb + trc) * 2;
                a = MFMA32(fa, mk8(tr16(pb), tr16(pb + 4 * 320)), a); }
#pragma unroll
            for (int r = 0; r < 16; ++r) OI[(32 * cb + crow(r, hi)) * 132 + 32 * eb + r32] = a[r];
        }
        __syncthreads();
        {   const int c = tid >> 3, e8 = tid & 7; float ov[16];
#pragma unroll
            for (int i = 0; i < 4; ++i) { const f32x4 t4 = *(const LAS f32x4*)(OI + c * 132 + 16 * e8 + 4 * i); ov[4 * i] = t4.x; ov[4 * i + 1] = t4.y; ov[4 * i + 2] = t4.z; ov[4 * i + 3] = t4.w; }
            float ss = 0.f;
#pragma unroll
            for (int i = 0; i < 16; ++i) ss += ov[i] * ov[i];
            ss += __shfl_xor(ss, 1); ss += __shfl_xor(ss, 2); ss += __shfl_xor(ss, 4);
            const float rinv = 1.0f / sqrtf(ss * (1.f / 128.f) + RMS_EPS);
            const v4u r0 = r_c[0], r1 = r_c[1]; const unsigned ra[8] = {r0.x, r0.y, r0.z, r0.w, r1.x, r1.y, r1.z, r1.w};
            const float* gg = ((const float*)A.in[16]) + 16 * e8; float y[16];
#pragma unroll
            for (int i = 0; i < 16; ++i) { const float rv = (i & 1) ? bf_hi(ra[i >> 1]) : bf_lo(ra[i >> 1]); y[i] = ov[i] * rinv * gg[i] * (rv / (1.f + __expf(-rv))); }
            v4u o0, o1;
            o0.x = cvtpk(y[0], y[1]); o0.y = cvtpk(y[2], y[3]); o0.z = cvtpk(y[4], y[5]); o0.w = cvtpk(y[6], y[7]);
            o1.x = cvtpk(y[8], y[9]); o1.y = cvtpk(y[10], y[11]); o1.z = cvtpk(y[12], y[13]); o1.w = cvtpk(y[14], y[15]);
            GAS v4u* yp = (GAS v4u*)(Y + (size_t)(n * 64 + c) * DM + 16 * e8); yp[0] = o0; yp[1] = o1;
        }
    }
#undef GL_FETCH
    __syncthreads();
}

template <int ABL> __device__ __forceinline__ void phase3(Ctx& C, const Args& A, int rep) {
    float lam;
    {   const float a = ((const float*)A.in[9])[C.lane] * ((const float*)A.in[10])[C.lane], b2 = ((const float*)A.in[11])[C.lane] * ((const float*)A.in[12])[C.lane];
        lam = __expf(wave_sum(a)) - __expf(wave_sum(b2)) + LAMBDA_INIT; }
    constexpr int NITEM = 128 + 2048;
    for (;;) {
        if (C.tid == 0) C.MISC[0] = __hip_atomic_fetch_add(C.ctl + CW_Q + 64 * rep, 1u, __ATOMIC_RELAXED, __HIP_MEMORY_SCOPE_AGENT);
        __syncthreads();
        const int item = (int)C.MISC[0];
        __syncthreads();
        if (item >= NITEM) break;
        if (item < 128) { if (ABL == 0) gla_unit(C, A, item); }
        else { const int idx = item - 128; attn_unit<ABL>(C, A, idx & 127, 15 - (idx >> 7), lam); }
    }
}

constexpr int PK_P = 272;
constexpr int PK_BYTES = 128 * PK_P;
constexpr int PS_PITCH = 132, PS_EIDX = 2 * PK_BYTES, PS_EG = PS_EIDX + 64 * PS_PITCH * 4;
static_assert(PS_EG + 64 * PS_PITCH * 4 <= MISC_OFF, "PEER score LDS map");
#define CE_DESC(a, b) do { const float mx_ = fmaxf(a, b), mn_ = fminf(a, b); a = mx_; b = mn_; } while (0)
__device__ __forceinline__ void sort16_desc(float* v) {
#pragma unroll
    for (int k = 2; k <= 16; k *= 2)
#pragma unroll
        for (int j = k / 2; j > 0; j /= 2)
#pragma unroll
            for (int i = 0; i < 16; ++i) { const int l = i ^ j; if (l > i) { if ((i & k) == 0) CE_DESC(v[i], v[l]); else CE_DESC(v[l], v[i]); } }
}
__device__ __forceinline__ void bitonic_merge16_desc(float* v) {
#pragma unroll
    for (int j = 8; j > 0; j /= 2)
#pragma unroll
        for (int i = 0; i < 16; ++i) { const int l = i ^ j; if (l > i) CE_DESC(v[i], v[l]); }
}
__device__ __forceinline__ void merge_top16(float* a, const float* b) {
#pragma unroll
    for (int i = 0; i < 16; ++i) a[i] = fmaxf(a[i], b[15 - i]);
    bitonic_merge16_desc(a);
}
__device__ __forceinline__ void top16_pair64(float (&v)[64], float (&out)[16], int hi) {
    sort16_desc(v); sort16_desc(v + 16); sort16_desc(v + 32); sort16_desc(v + 48);
    merge_top16(v, v + 16); merge_top16(v + 32, v + 48); merge_top16(v, v + 32);
#pragma unroll
    for (int i = 0; i < 8; ++i) { const float p = v[i], q = v[15 - i]; v[i] = hi ? q : p; v[15 - i] = hi ? p : q; }
#pragma unroll
    for (int i = 0; i < 16; ++i) out[i] = pair_max(v[i]);
    bitonic_merge16_desc(out);
}

template <int SABL> __device__ __forceinline__ void peer_scores(Ctx& C, const Args& A, int t0) {
    const int lane = C.lane, w = C.wave, r32 = lane & 31, hi = lane >> 5;
    const bf16* QP = (const bf16*)(C.ws + WS_PROJ);
    int* EIDX = (int*)(C.ws + WS_EIDX); float* EG = (float*)(C.ws + WS_EG);
#pragma unroll 1
    for (int tb = 0; tb < 2; ++tb) {
        const int t = t0 + 32 * tb + r32;
        float tv[2][16];
#pragma unroll 1
        for (int half = 0; half < 2; ++half) {
            bf16x8 qf[8];
#pragma unroll
            for (int kk = 0; kk < 8; ++kk) qf[kk] = *(const GAS bf16x8*)(QP + (size_t)(SABL ? t0 : t) * NQP + w * 256 + half * 128 + 16 * kk + 8 * hi);
            float sv[64];
#pragma unroll
            for (int kb = 0; kb < 4; ++kb) { f32x16 s;
#pragma unroll
                for (int r = 0; r < 16; ++r) s[r] = 0.f;
#pragma unroll
                for (int kk = 0; kk < 8; ++kk) { const bf16x8 a = *(const LAS bf16x8*)(C.lds + half * PK_BYTES + (32 * kb + r32) * PK_P + (16 * kk + 8 * hi) * 2); s = MFMA32(a, qf[kk], s); }
#pragma unroll
                for (int r = 0; r < 16; ++r) sv[16 * kb + r] = __uint_as_float((__float_as_uint(s[r]) & ~127u) | (unsigned)(32 * kb + crow(r, hi))); }
            float to[16];
            if (SABL == 2) {
#pragma unroll
                for (int i = 0; i < 16; ++i) to[i] = sv[i] + sv[16 + i] + sv[32 + i] + sv[48 + i]; }
            else top16_pair64(sv, to, hi);
            if (half == 0) {
#pragma unroll
                for (int i = 0; i < 16; ++i) tv[0][i] = to[i];
            } else {
#pragma unroll
                for (int i = 0; i < 16; ++i) tv[1][i] = to[i];
            }
        }
        float cv[32];
#define PEER_CAND(k, a0, b0, a1, b1) do { const float s0_ = tv[0][a0] + tv[1][b0], s1_ = tv[0][a1] + tv[1][b1]; \
            const unsigned e0_ = ((__float_as_uint(tv[0][a0]) & 127u) << 7) | (__float_as_uint(tv[1][b0]) & 127u), e1_ = ((__float_as_uint(tv[0][a1]) & 127u) << 7) | (__float_as_uint(tv[1][b1]) & 127u); \
            const float s_ = hi ? s1_ : s0_; const unsigned e_ = hi ? e1_ : e0_; cv[k] = __uint_as_float((__float_as_uint(s_) & ~0x3FFFu) | e_); } while (0)
        PEER_CAND(0, 0, 0, 2, 1);
        PEER_CAND(1, 0, 1, 2, 2);
        PEER_CAND(2, 0, 2, 2, 3);
        PEER_CAND(3, 0, 3, 2, 4);
        PEER_CAND(4, 0, 4, 3, 0);
        PEER_CAND(5, 0, 5, 3, 1);
        PEER_CAND(6, 0, 6, 3, 2);
        PEER_CAND(7, 0, 7, 3, 3);
        PEER_CAND(8, 0, 8, 4, 0);
        PEER_CAND(9, 0, 9, 4, 1);
        PEER_CAND(10, 0, 10, 4, 2);
        PEER_CAND(11, 0, 11, 5, 0);
        PEER_CAND(12, 0, 12, 5, 1);
        PEER_CAND(13, 0, 13, 6, 0);
        PEER_CAND(14, 0, 14, 6, 1);
        PEER_CAND(15, 0, 15, 7, 0);
        PEER_CAND(16, 1, 0, 7, 1);
        PEER_CAND(17, 1, 1, 8, 0);
        PEER_CAND(18, 1, 2, 9, 0);
        PEER_CAND(19, 1, 3, 10, 0);
        PEER_CAND(20, 1, 4, 11, 0);
        PEER_CAND(21, 1, 5, 12, 0);
        PEER_CAND(22, 1, 6, 13, 0);
        PEER_CAND(23, 1, 7, 14, 0);
        PEER_CAND(24, 2, 0, 15, 0);
#undef PEER_CAND
#pragma unroll
        for (int k = 25; k < 32; ++k) cv[k] = -INFINITY;
        sort16_desc(cv); sort16_desc(cv + 16); merge_top16(cv, cv + 16);
#pragma unroll
        for (int i = 0; i < 8; ++i) { const float p = cv[i], q = cv[15 - i]; cv[i] = hi ? q : p; cv[15 - i] = hi ? p : q; }
        float selv[16]; int sele[16];
#pragma unroll
        for (int i = 0; i < 16; ++i) selv[i] = pair_max(cv[i]);
        bitonic_merge16_desc(selv);
#pragma unroll
        for (int k = 0; k < 16; ++k) { const unsigned b_ = __float_as_uint(selv[k]); sele[k] = (int)(b_ & 0x3FFFu); selv[k] = __uint_as_float(b_ & ~0x3FFFu); }
        float ex[16], sum = 0.f;
#pragma unroll
        for (int k = 0; k < 16; ++k) { ex[k] = __expf(selv[k] - selv[0]); sum += ex[k]; }
        const float inv = 1.0f / sum;
        if (hi == 0) { LAS int* p = (LAS int*)(C.lds + PS_EIDX) + (32 * tb + r32) * PS_PITCH + 2 * w;
#pragma unroll
            for (int kk = 0; kk < 16; ++kk) p[16 * (kk & 7) + (kk >> 3)] = sele[kk]; }
        else { LAS float* p = (LAS float*)(C.lds + PS_EG) + (32 * tb + r32) * PS_PITCH + 2 * w;
#pragma unroll
            for (int kk = 0; kk < 16; ++kk) p[16 * (kk & 7) + (kk >> 3)] = ex[kk] * inv; }
    }
}

__device__ __forceinline__ float gelu_erf(float v) {
    const float av = fabsf(v), t = __builtin_amdgcn_rcpf(av * 0.2316418882f + 1.0f);
    float q = t * 0.5307027145f + (-0.7265760135f); q = q * t + 0.7107068705f; q = q * t + (-0.142248368f); q = q * t + 0.127414796f; q = q * t;
    const float e = __builtin_amdgcn_exp2f((v * v) * (-0.72134752044f));
    const float m = v * (q * e);
    return v < 0.f ? m : v - m;
}
__device__ __forceinline__ float dpp_sum8(float x) {
    x += __int_as_float(__builtin_amdgcn_update_dpp(0, __float_as_int(x), 0xb1, 0xf, 0xf, false));
    x += __int_as_float(__builtin_amdgcn_update_dpp(0, __float_as_int(x), 0x4e, 0xf, 0xf, false));
    x += __int_as_float(__builtin_amdgcn_update_dpp(0, __float_as_int(x), 0x141, 0xf, 0xf, false));
    return x;
}
#define PG_PIN16(a) asm volatile("" : "+v"(a[0]), "+v"(a[1]), "+v"(a[2]), "+v"(a[3]), "+v"(a[4]), "+v"(a[5]), "+v"(a[6]), "+v"(a[7]), "+v"(a[8]), "+v"(a[9]), "+v"(a[10]), "+v"(a[11]), "+v"(a[12]), "+v"(a[13]), "+v"(a[14]), "+v"(a[15]))
#define PG_CVT(w, f) do { _Pragma("unroll") for (int d_ = 0; d_ < 4; ++d_) { const f32x2_t lo_ = __builtin_amdgcn_cvt_pk_f32_fp8((int)(w)[d_], false), hi_ = __builtin_amdgcn_cvt_pk_f32_fp8((int)(w)[d_], true); \
        f[4 * d_] = lo_.x; f[4 * d_ + 1] = lo_.y; f[4 * d_ + 2] = hi_.x; f[4 * d_ + 3] = hi_.y; } } while (0)

template <int SABL> __device__ __forceinline__ void phase_peer_scores(Ctx& C, const Args& A) {
    {
        const bf16* KB = (const bf16*)(C.ws + WS_KEYS);
        for (int idx = C.tid; idx < 2 * 128 * 16; idx += NTHR) { const int set = idx >> 11, row = (idx >> 4) & 127, ch = idx & 15;
            *(LAS v4u*)(C.lds + set * PK_BYTES + row * PK_P + ch * 16) = *(const GAS v4u*)(KB + (size_t)set * 16384 + row * 128 + ch * 8); }
        __syncthreads();
    }
    for (int tile = C.vcu; tile < NTOK / 64; tile += C.G) {
        peer_scores<SABL>(C, A, tile * 64);
        __syncthreads();
        unsigned short* EIDX = (unsigned short*)(C.ws + WS_EIDX) + (size_t)tile * 64 * 128; float* EG = (float*)(C.ws + WS_EG) + (size_t)tile * 64 * 128;
#pragma unroll
        for (int i = 0; i < 2; ++i) { const int idx = C.tid + i * NTHR, row = idx >> 4, ch = idx & 15;
            const v4u a = *(const LAS v4u*)(C.lds + PS_EIDX + (row * PS_PITCH + 8 * ch) * 4), b = *(const LAS v4u*)(C.lds + PS_EIDX + (row * PS_PITCH + 8 * ch + 4) * 4);
            *(GAS v4u*)(EIDX + row * 128 + 8 * ch) = (v4u){a.x | (a.y << 16), a.z | (a.w << 16), b.x | (b.y << 16), b.z | (b.w << 16)}; }
#pragma unroll
        for (int i = 0; i < 4; ++i) { const int idx = C.tid + i * NTHR, row = idx >> 5, ch = idx & 31;
            *(GAS v4u*)(EG + row * 128 + 4 * ch) = *(const LAS v4u*)(C.lds + PS_EG + (row * PS_PITCH + 4 * ch) * 4); }
        __syncthreads();
    }
}

template <int MODE> __device__ __forceinline__ void phase_peer_u(Ctx& C, const Args& A) {
    int lane_ = C.lane; asm volatile("" : "+v"(lane_)); const int lane = lane_;
    const int x = C.sx >> 1, j = ((C.sx & 1) << 5) | C.sj, g = lane >> 3, c = lane & 7;
    const unsigned char* HN = C.ws + WS_HN + 256 * x + 32 * c;
    const float* RS = (const float*)(C.ws + WS_RS2);
    const unsigned short* EIDX = (const unsigned short*)(C.ws + WS_EIDX) + 16 * g;
    bf16* PD = (bf16*)(C.ws + WS_PD) + (size_t)x * NTOK * 128 + 16 * g;
    const __amdgpu_buffer_rsrc_t RU = __builtin_amdgcn_make_buffer_rsrc((void*)(C.ws + WS_EU + (size_t)x * (2u << 20)), 0, 2 << 20, 0x00020000);
    const int t0 = 1024 * j + 128 * C.wave, tlast = t0 + 127;
    const int kb_ = 8 * ((c >> 2) & 1) + 4 * ((c >> 1) & 1) + 2 * (c & 1);
    v4u en[2]; v4u han, hbn, haA, hbA, haB, hbB; float h1n, hA1, hB1;
    v4u rA[16], rB[16];
#define PU_LDE(t) do { en[0] = *(const GAS v4u*)(EIDX + (size_t)(t) * 128); en[1] = *(const GAS v4u*)(EIDX + (size_t)(t) * 128 + 8); \
        han = *(const GAS v4u*)(HN + (size_t)(t) * DM); hbn = *(const GAS v4u*)(HN + (size_t)(t) * DM + 16); h1n = *(const GAS float*)(RS + (t)); } while (0)
#define PU_LDR(R) do { _Pragma("unroll") for (int k = 0; k < 16; ++k) { const unsigned w_ = en[k >> 3][(k >> 1) & 3]; const int ek_ = (int)((k & 1) ? (w_ >> 16) : (w_ & 0xffffu)); \
        R[k] = __builtin_bit_cast(v4u, __builtin_amdgcn_raw_buffer_load_b128(RU, ek_ * 128 + 16 * c, 0, 0)); } } while (0)
#define PU_COMP(R, ha, hb, h1, t) do { const float hinv = h1; const int pa_[4] = {(int)ha.x, (int)ha.y, (int)ha.z, (int)ha.w}, pb_[4] = {(int)hb.x, (int)hb.y, (int)hb.z, (int)hb.w}; \
        __builtin_amdgcn_sched_barrier(0); \
          \
        int sa_ = 0, sb_ = 0; \
        _Pragma("unroll") for (int d = 0; d < 4; ++d) { sa_ = __builtin_amdgcn_sdot8(pa_[d], 0x11111111, sa_, false); sb_ = __builtin_amdgcn_sdot8(pb_[d], 0x11111111, sb_, false); } \
        const float corr_ = dpp_sum8((float)((sa_ << 4) + sb_)) * (0.5f * hinv); \
        int ia_[16]; \
        _Pragma("unroll") for (int k = 0; k < 16; ++k) { asm volatile("" : "+v"(R[k])); int a_ = 0, b_ = 0; \
            _Pragma("unroll") for (int d = 0; d < 4; ++d) { a_ = __builtin_amdgcn_sdot8((int)R[k][d], pa_[d], a_, false); b_ = __builtin_amdgcn_sdot8((int)R[k][d], pb_[d], b_, false); } \
            ia_[k] = (a_ << 4) + b_; } \
          \
        int ib_[8], ic_[4], id0_, id1_; \
        { const bool b2 = (lane & 4) != 0, b1 = (lane & 2) != 0, b0 = (lane & 1) != 0; \
          _Pragma("unroll") for (int k = 0; k < 8; ++k) { const int keep = b2 ? ia_[k + 8] : ia_[k], send = b2 ? ia_[k] : ia_[k + 8]; ib_[k] = keep + __builtin_amdgcn_update_dpp(0, send, 0x141, 0xf, 0xf, false); } \
          _Pragma("unroll") for (int k = 0; k < 4; ++k) { const int keep = b1 ? ib_[k + 4] : ib_[k], send = b1 ? ib_[k] : ib_[k + 4]; ic_[k] = keep + __builtin_amdgcn_update_dpp(0, send, 0x1b, 0xf, 0xf, false); } \
          { const int keep = b0 ? ic_[2] : ic_[0], send = b0 ? ic_[0] : ic_[2]; id0_ = keep + __builtin_amdgcn_update_dpp(0, send, 0xb1, 0xf, 0xf, false); } \
          { const int keep = b0 ? ic_[3] : ic_[1], send = b0 ? ic_[1] : ic_[3]; id1_ = keep + __builtin_amdgcn_update_dpp(0, send, 0xb1, 0xf, 0xf, false); } } \
          \
        *(GAS unsigned*)(PD + (size_t)(t) * 128 + kb_) = cvtpk((float)id0_ * hinv + corr_, (float)id1_ * hinv + corr_); \
        __builtin_amdgcn_sched_barrier(0); } while (0)
    PU_LDE(t0);
    PU_LDR(rA); haA = han; hbA = hbn; hA1 = h1n;
    PU_LDE(t0 + 1);
#pragma unroll 1
    for (int ti = 0; ti < 128; ti += 2) {
        const int t = t0 + ti;
        PU_LDR(rB); haB = han; hbB = hbn; hB1 = h1n;
        PU_LDE(t + 2 < tlast ? t + 2 : tlast);
        __builtin_amdgcn_sched_barrier(0);
        PU_COMP(rA, haA, hbA, hA1, t);
        PU_LDR(rA); haA = han; hbA = hbn; hA1 = h1n;
        PU_LDE(t + 3 < tlast ? t + 3 : tlast);
        __builtin_amdgcn_sched_barrier(0);
        PU_COMP(rB, haB, hbB, hB1, t + 1);
    }
#undef PU_LDE
#undef PU_LDR
#undef PU_COMP
}

__device__ __forceinline__ void phase_peer_act(Ctx& C, const Args& A) {
    const bf16* PD = (const bf16*)(C.ws + WS_PD); const unsigned short* EIDX = (const unsigned short*)(C.ws + WS_EIDX); const float* EG = (const float*)(C.ws + WS_EG);
    unsigned* ACT8 = (unsigned*)(C.ws + WS_ACT); float* ACTS = (float*)(C.ws + WS_ACT + (size_t)NTOK * 128);
    LAS float* SU = (LAS float*)C.lds; LAS float* SV = SU + NEXP;
    { const GAS v4u* src = (const GAS v4u*)(C.ws + WS_ES); for (int i = C.tid; i < 2 * NEXP / 4; i += NTHR) ((LAS v4u*)C.lds)[i] = src[i]; }
    __syncthreads();
    const int gt = C.vcu * NTHR + C.tid, NGT = C.G * NTHR;
    for (int it = gt; it < NTOK * 128 / 4; it += NGT) {
        f32x4 z = {0.f, 0.f, 0.f, 0.f};
#pragma unroll
        for (int xs = 0; xs < 4; ++xs) { const u32x2 w_ = *(const GAS u32x2*)(PD + (size_t)xs * NTOK * 128 + (size_t)it * 4); z += (f32x4){bf_lo(w_.x), bf_hi(w_.x), bf_lo(w_.y), bf_hi(w_.y)}; }
        const u32x2 ew = *(const GAS u32x2*)(EIDX + (size_t)it * 4); const f32x4 gg = *(const GAS f32x4*)(EG + (size_t)it * 4);
        const int e0 = ew.x & 0xffffu, e1 = ew.x >> 16, e2 = ew.y & 0xffffu, e3 = ew.y >> 16;
        f32x4 a;
        a.x = gelu_erf(z.x * SU[e0]) * gg.x * SV[e0]; a.y = gelu_erf(z.y * SU[e1]) * gg.y * SV[e1];
        a.z = gelu_erf(z.z * SU[e2]) * gg.z * SV[e2]; a.w = gelu_erf(z.w * SU[e3]) * gg.w * SV[e3];
        float amax = fmaxf(fmaxf(fabsf(a.x), fabsf(a.y)), fmaxf(fabsf(a.z), fabsf(a.w)));
        amax = fmaxf(amax, __int_as_float(__builtin_amdgcn_update_dpp(0, __float_as_int(amax), 0xb1, 0xf, 0xf, false)));
        amax = fmaxf(amax, __int_as_float(__builtin_amdgcn_update_dpp(0, __float_as_int(amax), 0x4e, 0xf, 0xf, false)));
        amax = fmaxf(amax, __int_as_float(__builtin_amdgcn_update_dpp(0, __float_as_int(amax), 0x124, 0xf, 0xf, false)));
        amax = fmaxf(amax, __int_as_float(__builtin_amdgcn_update_dpp(0, __float_as_int(amax), 0x128, 0xf, 0xf, false)));
        { auto r = __builtin_amdgcn_permlane16_swap(__float_as_uint(amax), __float_as_uint(amax), false, false); amax = fmaxf(__uint_as_float(r[0]), __uint_as_float(r[1])); }
        const float as_ = amax > 0.f ? 127.f / amax : 1.f;
        const int b0 = (int)rintf(a.x * as_), b1 = (int)rintf(a.y * as_), b2 = (int)rintf(a.z * as_), b3 = (int)rintf(a.w * as_);
        ACT8[it] = (unsigned)(b0 & 0xff) | ((unsigned)(b1 & 0xff) << 8) | ((unsigned)(b2 & 0xff) << 16) | ((unsigned)(b3 & 0xff) << 24);
        if ((it & 31) == 0) ACTS[it >> 5] = amax > 0.f ? amax * (1.f / 127.f) : 1.f;
    }
}

template <int VABL> __device__ __forceinline__ void phase_peer_v(Ctx& C, const Args& A) {
    int lane_ = C.lane; asm volatile("" : "+v"(lane_)); const int lane = lane_;
    const int x = C.sx, j = C.sj, g = lane >> 3, c = lane & 7;
    const unsigned short* EIDX = (const unsigned short*)(C.ws + WS_EIDX) + 16 * g; const unsigned char* ACT8 = (const unsigned char*)(C.ws + WS_ACT) + 16 * g; const float* ACTS = (const float*)(C.ws + WS_ACT + (size_t)NTOK * 128);
    const __amdgpu_buffer_rsrc_t RV = __builtin_amdgcn_make_buffer_rsrc((void*)(C.ws + WS_EV + (size_t)x * (2u << 20)), 0, 2 << 20, 0x00020000);
    const int t0 = 2048 * j + 256 * C.wave, tlast = t0 + 255;
    const int col = 128 * x + 16 * c;
    v4u en[2]; v4u an, aA, aB; float sn, sA, sB; unsigned xn, xA, xB;
    const int cc_ = col + 2 * g;
    const bf16* X1 = (const bf16*)(C.ws + WS_X1) + cc_;
    const f32x2_t g2 = *(const f32x2_t*)((const float*)(C.ws + WS_MOD) + (size_t)(t0 >> 11) * NMOD + 5 * 1024 + cc_);
    v4u rA[16], rB[16];
#define PV_LDE(t) do { en[0] = *(const GAS v4u*)(EIDX + (size_t)(t) * 128); en[1] = *(const GAS v4u*)(EIDX + (size_t)(t) * 128 + 8); an = *(const GAS v4u*)(ACT8 + (size_t)(t) * 128); sn = *(const GAS float*)(ACTS + (t)); xn = *(const GAS unsigned*)(X1 + (size_t)(t) * DM); } while (0)
#define PV_LDR(R, AV, SV_, XV_) do { _Pragma("unroll") for (int k = 0; k < 16; ++k) { const unsigned w_ = en[k >> 3][(k >> 1) & 3]; const int ek_ = (int)((k & 1) ? (w_ >> 16) : (w_ & 0xffffu)); \
        R[k] = __builtin_bit_cast(v4u, __builtin_amdgcn_raw_buffer_load_b128(RV, ek_ * 128 + 16 * c, 0, 0)); } \
        AV = an; SV_ = sn; XV_ = xn; } while (0)
#define PV_COMP(R, AV, SV_, XV_, t) do { const float ainv = SV_; \
        const int aq[4] = {(int)AV.x, (int)AV.y, (int)AV.z, (int)AV.w}; \
        __builtin_amdgcn_sched_barrier(0); \
        int ia[16]; \
        _Pragma("unroll") for (int i = 0; i < 16; ++i) ia[i] = 0; \
        _Pragma("unroll") for (int kk = 0; kk < 4; ++kk) { asm volatile("" : "+v"(R[4 * kk]), "+v"(R[4 * kk + 1]), "+v"(R[4 * kk + 2]), "+v"(R[4 * kk + 3])); \
            _Pragma("unroll") for (int d = 0; d < 4; ++d) { const unsigned r0 = R[4 * kk][d], r1 = R[4 * kk + 1][d], r2 = R[4 * kk + 2][d], r3 = R[4 * kk + 3][d]; \
                const unsigned p01l = __builtin_amdgcn_perm(r1, r0, 0x05010400u), p01h = __builtin_amdgcn_perm(r1, r0, 0x07030602u); \
                const unsigned p23l = __builtin_amdgcn_perm(r3, r2, 0x05010400u), p23h = __builtin_amdgcn_perm(r3, r2, 0x07030602u); \
                const unsigned t0_ = VABL == 1 ? r0 : __builtin_amdgcn_perm(p23l, p01l, 0x05040100u), t1_ = VABL == 1 ? r1 : __builtin_amdgcn_perm(p23l, p01l, 0x07060302u); \
                const unsigned t2_ = VABL == 1 ? r2 : __builtin_amdgcn_perm(p23h, p01h, 0x05040100u), t3_ = VABL == 1 ? r3 : __builtin_amdgcn_perm(p23h, p01h, 0x07060302u); \
                ia[4 * d] = __builtin_amdgcn_sdot4((int)t0_, aq[kk], ia[4 * d], false); ia[4 * d + 1] = __builtin_amdgcn_sdot4((int)t1_, aq[kk], ia[4 * d + 1], false); \
                ia[4 * d + 2] = __builtin_amdgcn_sdot4((int)t2_, aq[kk], ia[4 * d + 2], false); ia[4 * d + 3] = __builtin_amdgcn_sdot4((int)t3_, aq[kk], ia[4 * d + 3], false); } } \
          \
        int ib[8], ic[4], id0, id1; \
        _Pragma("unroll") for (int i = 0; i < 8; ++i) { auto r = __builtin_amdgcn_permlane32_swap((unsigned)ia[i], (unsigned)ia[i + 8], false, false); ib[i] = (int)r[0] + (int)r[1]; } \
        _Pragma("unroll") for (int i = 0; i < 4; ++i) { auto r = __builtin_amdgcn_permlane16_swap((unsigned)ib[i], (unsigned)ib[i + 4], false, false); ic[i] = (int)r[0] + (int)r[1]; } \
        { const bool b3 = (lane & 8) != 0; \
          const int k0 = b3 ? ic[2] : ic[0], s0 = b3 ? ic[0] : ic[2], k1 = b3 ? ic[3] : ic[1], s1 = b3 ? ic[1] : ic[3]; \
          id0 = k0 + __builtin_amdgcn_update_dpp(0, s0, 0x128, 0xf, 0xf, false); id1 = k1 + __builtin_amdgcn_update_dpp(0, s1, 0x128, 0xf, 0xf, false); } \
        { const float x0 = bf_lo(XV_), x1 = bf_hi(XV_); \
          *(GAS f32x2_t*)(C.out + (size_t)(t) * DM + cc_) = (f32x2_t){x0 + g2.x * ((float)id0 * ainv), x1 + g2.y * ((float)id1 * ainv)}; } \
        __builtin_amdgcn_sched_barrier(0); } while (0)
    PV_LDE(t0);
    PV_LDR(rA, aA, sA, xA);
    PV_LDE(t0 + 1);
#pragma unroll 1
    for (int ti = 0; ti < (VABL == 2 ? 128 : 256); ti += 2) {
        const int t = t0 + ti;
        PV_LDR(rB, aB, sB, xB);
        PV_LDE(t + 2 < tlast ? t + 2 : tlast);
        __builtin_amdgcn_sched_barrier(0);
        PV_COMP(rA, aA, sA, xA, t);
        if (VABL == 2) PV_COMP(rA, aA, sA, xA, t);
        PV_LDR(rA, aA, sA, xA);
        PV_LDE(t + 3 < tlast ? t + 3 : tlast);
        __builtin_amdgcn_sched_barrier(0);
        PV_COMP(rB, aB, sB, xB, t + 1);
        if (VABL == 2) PV_COMP(rB, aB, sB, xB, t + 1);
    }
#undef PV_LDE
#undef PV_LDR
#undef PV_COMP
}
#undef PG_PIN16
#undef PG_CVT

constexpr int NPHASE = 13;

__global__ void __launch_bounds__(NTHR, 2) fwd_kernel(Args args) {
    extern __shared__ __attribute__((aligned(16))) unsigned char lds[];
    Ctx C;
    C.lds = (LAS unsigned char*)lds; C.MISC = (volatile LAS unsigned*)(C.lds + MISC_OFF);
    C.tid = threadIdx.x; C.lane = C.tid & 63; C.wave = __builtin_amdgcn_readfirstlane(C.tid >> 6);
    C.G = gridDim.x; { const int bx = blockIdx.x; C.vcu = (C.G % 8 == 0) ? (bx % 8) * (C.G / 8) + bx / 8 : bx; }
    C.ws = args.ws; C.out = args.out; C.ctl = (gu32*)(args.ws + WS_CTL);
    if (C.tid < 64) ((LAS unsigned*)(C.lds + MISC_OFF))[C.tid] = 0u;
    __syncthreads();
    const int lo = args.ph_lo, hi = args.ph_hi;
    const bool multi = (hi - lo) > 1;
    XcdBarrier bar; bar.bar = (unsigned*)(C.ctl + CW_BAR); bar.x = 0; bar.st = nullptr;
    if (multi) bar = xcd_barrier_post((unsigned*)(C.ctl + CW_BAR), C.MISC + 8);
#ifndef PH_MASK
#define PH_MASK 0x1fff
#endif
#define IN(k) (((PH_MASK >> (k)) & 1) && lo <= (k) && (k) < hi)
#ifndef REP_MASK
#define REP_MASK 0
#endif
#ifndef ABL_MODE
#define ABL_MODE 0
#endif
#define SEAM(k) do { if (IN(k) && IN((k) + 1)) xcd_barrier(bar); } while (0)
#define NREP(k) (1 + ((REP_MASK >> (k)) & 1))
#define PFENCE() do { asm volatile("" : "+v"(C.tid) :: "memory"); C.lane = C.tid & 63; C.wave = __builtin_amdgcn_readfirstlane(C.tid >> 6); } while (0)
    for (int rp = 0; rp < NREP(0); ++rp) { if (rp) xcd_barrier(bar); PFENCE(); if (IN(0)) { phase0(C, args); } }
    if (IN(0) && (IN(12) || IN(1))) xcd_barrier(bar);
    if (IN(12)) { PFENCE(); phase0b(C, args); }
    for (int rp = 0; rp < NREP(1); ++rp) { if (rp) xcd_barrier(bar); PFENCE(); if (IN(1)) { phase1(C, args); } } SEAM(1);
    for (int rp = 0; rp < NREP(2); ++rp) { if (rp) xcd_barrier(bar); PFENCE();
    if (IN(2)) { pg8::Gemm g{(const pg8::bf16_t*)(C.ws + WS_H), (const pg8::bf16_t*)(C.ws + WS_WIN_T), NTOK, NPROJ, DM / 2}; pg8::StaticOrder S; S.init(NTOK, NPROJ, C.G, (int)blockIdx.x);
        pg8::EpiI8Bf16 E{(pg8::bf16_t*)(C.ws + WS_PROJ), NPROJ, (const float*)(C.ws + WS_RS1), (const float*)(C.ws + WS_CS), nullptr};
        pg8::gemm_phase_i8<pg8::EpiI8Bf16, pg8::StaticOrder, true, true>(C.lds, g, S, E); } } SEAM(2);
    if (IN(3)) { phase2b(C, args); } SEAM(3);
    for (int rp = 0; rp < NREP(4); ++rp) { if (rp) xcd_barrier(bar); PFENCE(); if (IN(4)) { if (rp + 1 < NREP(4)) phase3<ABL_MODE>(C, args, rp); else phase3<0>(C, args, rp); } } SEAM(4);
    for (int rp = 0; rp < NREP(5); ++rp) { if (rp) xcd_barrier(bar); PFENCE();
    if (IN(5)) { pg8::Gemm g{(const pg8::bf16_t*)(C.ws + WS_Y), (const pg8::bf16_t*)(C.ws + WS_WOUT_T), NTOK, DM, DM}; pg8::StaticOrder S; S.init(NTOK, DM, C.G, (int)blockIdx.x);
        pg8::EpiResidBf16 E{(const float*)args.in[0], (const float*)(C.ws + WS_MOD) + 2 * 1024, (pg8::bf16_t*)(C.ws + WS_X1)};
        pg8::gemm_phase<pg8::EpiResidBf16, pg8::StaticOrder, true, true>(C.lds, g, S, E); } } SEAM(5);
    for (int rp = 0; rp < NREP(6); ++rp) { if (rp) xcd_barrier(bar); PFENCE(); if (IN(6)) { phase5(C, args); } } SEAM(6);
    for (int rp = 0; rp < NREP(7); ++rp) { if (rp) xcd_barrier(bar); PFENCE();
    if (IN(7)) { pg8::Gemm g{(const pg8::bf16_t*)(C.ws + WS_H), (const pg8::bf16_t*)(C.ws + WS_WQ_T), NTOK, NQP, DM / 2}; pg8::StaticOrder S; S.init(NTOK, NQP, C.G, (int)blockIdx.x);
        pg8::EpiI8Bf16 E{(pg8::bf16_t*)(C.ws + WS_PROJ), NQP, (const float*)(C.ws + WS_RS2), (const float*)(C.ws + WS_CSQ), (const float*)args.in[20]};
        pg8::gemm_phase_i8<pg8::EpiI8Bf16, pg8::StaticOrder, true, true>(C.lds, g, S, E); } } SEAM(7);
    for (int rp = 0; rp < NREP(8); ++rp) { if (rp) xcd_barrier(bar); PFENCE(); if (IN(8)) { if (rp + 1 < NREP(8)) phase_peer_scores<ABL_MODE>(C, args); else phase_peer_scores<0>(C, args); } } SEAM(8);
    C.sx = C.vcu >> 5; C.sj = C.vcu & 31;
    if (multi && C.G == 256) {
        if (C.tid == 0) { unsigned* bw = (unsigned*)(C.ctl + CW_BAR); bool ok = true;
            for (int q = 0; q < 16; ++q) { const unsigned cnt = xb_ld(&bw[XB_XCNT(q)]); ok = ok && (q < 8 ? cnt == 32u : cnt == 0u); }
            unsigned code = 0xffffffffu;
            if (ok) { const unsigned xc = xb_xcc_id(); const unsigned r = __hip_atomic_fetch_add(C.ctl + CW_RANK + 64 * xc, 1u, __ATOMIC_RELAXED, __HIP_MEMORY_SCOPE_AGENT); code = (xc << 8) | (r & 31u); }
            C.MISC[1] = code; }
        __syncthreads();
        const unsigned code = C.MISC[1];
        if (code != 0xffffffffu) { C.sx = (int)(code >> 8); C.sj = (int)(code & 31u); }
    }
    for (int rp = 0; rp < NREP(9); ++rp) { if (rp) xcd_barrier(bar); PFENCE(); if (IN(9)) { if (rp + 1 < NREP(9)) phase_peer_u<ABL_MODE>(C, args); else phase_peer_u<0>(C, args); } } SEAM(9);
    for (int rp = 0; rp < NREP(10); ++rp) { if (rp) xcd_barrier(bar); PFENCE(); if (IN(10)) { phase_peer_act(C, args); } } SEAM(10);
    for (int rp = 0; rp < NREP(11); ++rp) { if (rp) xcd_barrier(bar); PFENCE(); if (IN(11)) { if (rp + 1 < NREP(11)) phase_peer_v<ABL_MODE>(C, args); else phase_peer_v<0>(C, args); } }
#undef IN
#undef SEAM
}

#ifndef MK_N_LAUNCHES
#define MK_N_LAUNCHES 1
#endif
extern "C" void kernel_launch(void* const* d_in, const int* in_sizes, int n_in, void* d_out, int out_size, void* d_ws, size_t ws_size, hipStream_t stream) {
    static int grid = 0;
    if (grid == 0) {
        if (n_in != 25 || in_sizes[0] != NTOK * DM || out_size != NTOK * DM || ws_size < WS_END) { fprintf(stderr, "kernel_launch: unexpected shapes (n_in %d, in0 %d, out %d, ws %zu)\n", n_in, n_in > 0 ? in_sizes[0] : -1, out_size, ws_size); grid = -1; return; }
        int dev = 0, cus = 0, per_cu = 0;
        if (hipGetDevice(&dev) != hipSuccess || hipDeviceGetAttribute(&cus, hipDeviceAttributeMultiprocessorCount, dev) != hipSuccess) { grid = -1; return; }
        if (hipFuncSetAttribute((const void*)fwd_kernel, hipFuncAttributeMaxDynamicSharedMemorySize, LDS_BYTES) != hipSuccess) { fprintf(stderr, "kernel_launch: hipFuncSetAttribute failed\n"); grid = -1; return; }
        if (hipOccupancyMaxActiveBlocksPerMultiprocessor(&per_cu, (const void*)fwd_kernel, NTHR, LDS_BYTES) != hipSuccess || per_cu < 1) fprintf(stderr, "kernel_launch: occupancy query says %d per CU\n", per_cu);
        (void)hipGetLastError();
        if (cus != 256) { fprintf(stderr, "kernel_launch: built for a 256-CU device (work maps assume 256 workgroups), found %d CUs; nothing launched\n", cus); grid = -1; return; }
        grid = cus;
    }
    if (grid < 0) return;
    if (hipMemsetAsync((char*)d_ws + WS_CTL, 0, CTL_ZERO_BYTES, stream) != hipSuccess) return;
    Args a{};
    for (int i = 0; i < 25; ++i) a.in[i] = d_in[i];
    a.out = (float*)d_out; a.ws = (unsigned char*)d_ws;
    if (MK_N_LAUNCHES == 1) { a.ph_lo = 0; a.ph_hi = NPHASE; a.li = 0; hipLaunchKernelGGL(fwd_kernel, dim3(grid), dim3(NTHR), LDS_BYTES, stream, a); }
    else { const int order[NPHASE] = {0, 12, 1, 2, 3, 4, 5, 6, 7, 8, 9, 10, 11}; for (int i = 0; i < NPHASE; ++i) { const int p = order[i]; a.ph_lo = p; a.ph_hi = p + 1; a.li = p; hipLaunchKernelGGL(fwd_kernel, dim3(grid), dim3(NTHR), LDS_BYTES, stream, a); } }
}
```

```cpp
#include <hip/hip_runtime.h>
#include <hip/hip_bf16.h>
#include <cstdio>
#include <cstdint>
#include <cmath>
namespace pg8 {
#define PG8_LAS __attribute__((address_space(3)))
typedef unsigned short bf16_t;
typedef short bf16x8 __attribute__((ext_vector_type(8)));
typedef float f32x4 __attribute__((ext_vector_type(4)));
typedef unsigned u32x4 __attribute__((ext_vector_type(4)));
constexpr int BM = 256, BK = 64, HALF = 128, HTB = HALF * BK * 2  , STAGE_BYTES = 8 * HTB, NXCD = 8, WGM = 8;

__host__ __device__ __forceinline__ int lds_byte(int r, int c) { const int st = (r >> 4) * 2 + (c >> 5), rr = r & 15, cc = c & 31, ob = rr * 64 + cc * 2; return st * 1024 + (ob ^ (((ob >> 9) & 1) << 5)); }
__host__ __device__ __forceinline__ void stage_rc(int b, int& R, int& C) { const int st = b / 1024, sb = b % 1024, swz = sb ^ (((sb >> 9) & 1) << 5); R = (st >> 1) * 16 + swz / 64; C = (st & 1) * 32 + (swz % 64) / 2; }
__host__ __device__ __forceinline__ int perm32(int rho) { const int n = rho >> 4, i = rho & 15; return 8 * (i >> 2) + 4 * n + (i & 3); }

struct Unit { int pm, pn; };
struct Gemm { const bf16_t* A; const bf16_t* Bt; int M, N, K; };

struct StaticOrder {
    int nM, nN, nwg, G, c;
    __host__ __device__ void init(int M, int N, int G_, int c_) { nM = M / BM; nN = N / BM; nwg = nM * nN; G = G_; c = c_; }
    __host__ __device__ bool next(int i, Unit& u) const {
        const long L = (long)i * G + c; if (L >= nwg) return false;
        int wgid = (int)L; { const int q = nwg / NXCD, r = nwg % NXCD, xcd = wgid % NXCD, off = wgid / NXCD; wgid = (xcd < r ? xcd * (q + 1) : r * (q + 1) + (xcd - r) * q) + off; }
        const int nig = WGM * nN, gid = wgid / nig, fm = gid * WGM, gsz = (nM - fm) < WGM ? (nM - fm) : WGM;
        u.pm = fm + ((wgid % nig) % gsz); u.pn = (wgid % nig) / gsz; return true;
    }
    __device__ __forceinline__ void a_ready(const Unit&) const {}
    __device__ __forceinline__ void done(const Unit&) const {}
};

__device__ __forceinline__ unsigned cvt_pk_bf16(float lo, float hi) { unsigned r; asm volatile("v_cvt_pk_bf16_f32 %0, %1, %2" : "=v"(r) : "v"(lo), "v"(hi)); return r; }
typedef float f32x2 __attribute__((ext_vector_type(2)));
__device__ __forceinline__ f32x2 gelu_pk(f32x2 v) {
    const f32x2 av = __builtin_elementwise_abs(v), d = av * 0.2316418882f + 1.0f;
    f32x2 t; t.x = __builtin_amdgcn_rcpf(d.x); t.y = __builtin_amdgcn_rcpf(d.y);
    f32x2 q = t * 0.5307027145f + (-0.7265760135f); q = q * t + 0.7107068705f; q = q * t + (-0.142248368f); q = q * t + 0.127414796f; q = q * t;
    const f32x2 s = (v * v) * (-0.72134752044f);
    f32x2 e; e.x = __builtin_amdgcn_exp2f(s.x); e.y = __builtin_amdgcn_exp2f(s.y);
    const f32x2 m = v * (q * e), r = v - m;
    f32x2 o; o.x = v.x < 0.f ? m.x : r.x; o.y = v.y < 0.f ? m.y : r.y; return o;
}

template <int ACT  > struct EpiBf16 {
    static constexpr bool PERM = true, AFTER_DRAIN = false; static_assert(ACT == 0 || ACT == 1, "EpiBf16: ACT is 0 (none) or 1 (gelu_pk)");
    bf16_t* O; int ldc; const float* bias; int split_cols; size_t split_stride; float scale0;
    __device__ __forceinline__ void operator()(const f32x4 (&acc)[2][2][4][2], const Unit& u, int wr, int wc, int fr, int fq) const {
        const int row0 = u.pm * BM + wr * 64 + fr; int colt = u.pn * BM; bf16_t* base = O;
        float sc = 1.f; if (split_cols) { const int t = colt / split_cols; base += (size_t)t * split_stride; colt -= t * split_cols; if (t == 0) sc = scale0; }
        const int col0 = colt + wc * 32 + 8 * fq, bcol0 = u.pn * BM + wc * 32 + 8 * fq;
        f32x4 bv[2][2];
#pragma unroll
        for (int bj = 0; bj < 2; ++bj)
#pragma unroll
            for (int n = 0; n < 2; ++n) bv[bj][n] = bias ? *(const f32x4*)(bias + bcol0 + bj * HALF + 4 * n) : (f32x4){0.f, 0.f, 0.f, 0.f};
#pragma unroll
        for (int ai = 0; ai < 2; ++ai)
#pragma unroll
            for (int m = 0; m < 4; ++m) { bf16_t* rowp = base + (size_t)(row0 + ai * HALF + m * 16) * ldc + col0;
#pragma unroll
                for (int bj = 0; bj < 2; ++bj) { f32x4 v0 = acc[ai][bj][m][0] + bv[bj][0], v1 = acc[ai][bj][m][1] + bv[bj][1];
                    if (ACT == 1) { f32x2 a = gelu_pk((f32x2){v0[0], v0[1]}), b = gelu_pk((f32x2){v0[2], v0[3]}), c = gelu_pk((f32x2){v1[0], v1[1]}), d = gelu_pk((f32x2){v1[2], v1[3]});
                        v0 = (f32x4){a.x, a.y, b.x, b.y}; v1 = (f32x4){c.x, c.y, d.x, d.y}; }
                    v0 = v0 * sc; v1 = v1 * sc; u32x4 w; w.x = cvt_pk_bf16(v0[0], v0[1]); w.y = cvt_pk_bf16(v0[2], v0[3]); w.z = cvt_pk_bf16(v1[0], v1[1]); w.w = cvt_pk_bf16(v1[2], v1[3]);
                    *(u32x4*)(rowp + bj * HALF) = w; } }
    }
};
struct EpiResid {
    static constexpr bool PERM = false, AFTER_DRAIN = false;
    const float* x; const float* gate; float* out;
    __device__ __forceinline__ void operator()(const f32x4 (&acc)[2][2][4][2], const Unit& u, int wr, int wc, int fr, int fq) const {
        const int b = (u.pm * BM) >> 11;
        const int col0 = u.pn * BM + wc * 32 + 4 * fq;
        f32x4 gv[2][2];
#pragma unroll
        for (int bj = 0; bj < 2; ++bj)
#pragma unroll
            for (int n = 0; n < 2; ++n) gv[bj][n] = *(const f32x4*)(gate + (size_t)b * 6144 + col0 + bj * HALF + n * 16);
#pragma unroll
        for (int ai = 0; ai < 2; ++ai)
#pragma unroll
            for (int m = 0; m < 4; ++m) { const size_t off = (size_t)(u.pm * BM + ai * HALF + wr * 64 + m * 16 + fr) * 1024 + col0;
#pragma unroll
                for (int bj = 0; bj < 2; ++bj)
#pragma unroll
                    for (int n = 0; n < 2; ++n) { const f32x4 xv = *(const f32x4*)(x + off + bj * HALF + n * 16);
                        *(f32x4*)(out + off + bj * HALF + n * 16) = xv + gv[bj][n] * acc[ai][bj][m][n]; } }
    }
};
struct EpiResidBf16 {
    static constexpr bool PERM = true, AFTER_DRAIN = false;
    const float* x; const float* gate; bf16_t* out;
    __device__ __forceinline__ void operator()(const f32x4 (&acc)[2][2][4][2], const Unit& u, int wr, int wc, int fr, int fq) const {
        const int b = (u.pm * BM) >> 11;
        const int col0 = u.pn * BM + wc * 32 + 8 * fq;
        f32x4 gv[2][2];
#pragma unroll
        for (int bj = 0; bj < 2; ++bj)
#pragma unroll
            for (int n = 0; n < 2; ++n) gv[bj][n] = *(const f32x4*)(gate + (size_t)b * 6144 + col0 + bj * HALF + 4 * n);
#pragma unroll
        for (int ai = 0; ai < 2; ++ai)
#pragma unroll
            for (int m = 0; m < 4; ++m) { const size_t off = (size_t)(u.pm * BM + ai * HALF + wr * 64 + m * 16 + fr) * 1024 + col0;
#pragma unroll
                for (int bj = 0; bj < 2; ++bj) { const f32x4 x0 = *(const f32x4*)(x + off + bj * HALF), x1 = *(const f32x4*)(x + off + bj * HALF + 4);
                    const f32x4 v0 = x0 + gv[bj][0] * acc[ai][bj][m][0], v1 = x1 + gv[bj][1] * acc[ai][bj][m][1];
                    u32x4 w; w.x = cvt_pk_bf16(v0[0], v0[1]); w.y = cvt_pk_bf16(v0[2], v0[3]); w.z = cvt_pk_bf16(v1[0], v1[1]); w.w = cvt_pk_bf16(v1[2], v1[3]);
                    *(u32x4*)(out + off + bj * HALF) = w; } }
    }
};
template <class Epi, class Sched, bool ALIGN_EPI = false, bool SP2 = false>
__device__ __forceinline__ void gemm_phase(PG8_LAS unsigned char* lds, const Gemm g, const Sched& S, const Epi& E) {
    const int tid = threadIdx.x, wid = __builtin_amdgcn_readfirstlane(tid >> 6), lane = tid & 63, wr = wid >> 2, wc = wid & 3, fr = lane & 15, fq = lane >> 4;
    const int K = g.K, nt = K / BK;
    unsigned voffA[2], voffB[2];
#pragma unroll
    for (int i = 0; i < 2; ++i) { int R, C; stage_rc(tid * 16 + i * 8192, R, C); const int Rb = Epi::PERM ? ((R & ~31) + perm32(R & 31)) : R;
        voffA[i] = (unsigned)(R * K + C) * 2u; voffB[i] = (unsigned)(Rb * K + C) * 2u; }
    const size_t kstep = (size_t)(BK * 2);
    const size_t hstep = (size_t)HALF * K * 2;
    const size_t tstep = 2 * hstep;
    const unsigned ldsw = (unsigned)wid * 1024u;
    const int aoff = lds_byte(wr * 64 + fr, fq * 8), boff = lds_byte(wc * 32 + fr, fq * 8);
#define PG8_SA(b, h) (((b) * 2 + (h)) * HTB)
#define PG8_SB(b, h) ((4 + (b) * 2 + (h)) * HTB)
#define PG8_STAGE(bufoff, gbase, voff) do { _Pragma("unroll") for (int _i = 0; _i < 2; ++_i) \
        __builtin_amdgcn_global_load_lds((const unsigned*)((const char*)(gbase) + (voff)[_i]), (PG8_LAS unsigned*)(lds + (bufoff) + ldsw + _i * 8192), 16, 0, 0); } while (0)
#define PG8_LDA(dst, b, h) do { _Pragma("unroll") for (int m = 0; m < 4; ++m) _Pragma("unroll") for (int k = 0; k < 2; ++k) dst[m][k] = *(const PG8_LAS bf16x8*)(lds + PG8_SA(b, h) + aoff + m * 2048 + k * 1024); } while (0)
#define PG8_LDB(dst, b, h) do { _Pragma("unroll") for (int n = 0; n < 2; ++n) _Pragma("unroll") for (int k = 0; k < 2; ++k) dst[n][k] = *(const PG8_LAS bf16x8*)(lds + PG8_SB(b, h) + boff + n * 2048 + k * 1024); } while (0)
#define PG8_MMA(ai, bj, At, Bt) do { __builtin_amdgcn_s_setprio(1); _Pragma("unroll") for (int m = 0; m < 4; ++m) _Pragma("unroll") for (int n = 0; n < 2; ++n) _Pragma("unroll") for (int k = 0; k < 2; ++k) \
        acc[ai][bj][m][n] = __builtin_amdgcn_mfma_f32_16x16x32_bf16(Bt[n][k], At[m][k], acc[ai][bj][m][n], 0, 0, 0); __builtin_amdgcn_s_setprio(0); } while (0)
#define PG8_WAIT_V(n) asm volatile("s_waitcnt vmcnt(" #n ")" ::: "memory")
#define PG8_WAIT_L(n) asm volatile("s_waitcnt lgkmcnt(" #n ")" ::: "memory")
#define PG8_BAR __builtin_amdgcn_s_barrier()
#define PG8_SCHED __builtin_amdgcn_sched_barrier(0)
    Unit cur, nxt; int ui = 0;
    if (!S.next(0, cur)) return;
    f32x4 acc[2][2][4][2];
#pragma unroll
    for (int a = 0; a < 2; ++a)
#pragma unroll
        for (int b = 0; b < 2; ++b)
#pragma unroll
            for (int m = 0; m < 4; ++m)
#pragma unroll
                for (int n = 0; n < 2; ++n) acc[a][b][m][n] = (f32x4){0.f, 0.f, 0.f, 0.f};
    bf16x8 At[4][2], B0[2][2], B1[2][2];
    const char* cA = (const char*)g.A + (size_t)cur.pm * tstep; const char* cB = (const char*)g.Bt + (size_t)cur.pn * tstep;
    S.a_ready(cur);
    if constexpr (SP2) {
        PG8_STAGE(PG8_SB(0, 0), cB, voffB); PG8_STAGE(PG8_SB(0, 1), cB + hstep, voffB); PG8_STAGE(PG8_SA(0, 0), cA, voffA); PG8_STAGE(PG8_SA(0, 1), cA + hstep, voffA);
        if (wr == 1) PG8_BAR;
        PG8_WAIT_V(2); PG8_BAR;
        PG8_STAGE(PG8_SB(1, 0), cB + kstep, voffB); PG8_STAGE(PG8_SA(1, 0), cA + kstep, voffA); PG8_STAGE(PG8_SB(1, 1), cB + hstep + kstep, voffB);
        PG8_WAIT_V(6); PG8_BAR;
    } else {
        PG8_STAGE(PG8_SB(0, 0), cB, voffB); PG8_STAGE(PG8_SA(0, 0), cA, voffA); PG8_STAGE(PG8_SB(0, 1), cB + hstep, voffB); PG8_STAGE(PG8_SA(0, 1), cA + hstep, voffA);
        if (wr == 1) PG8_BAR;
        PG8_WAIT_V(4); PG8_BAR;
        PG8_STAGE(PG8_SB(1, 0), cB + kstep, voffB); PG8_STAGE(PG8_SA(1, 0), cA + kstep, voffA); PG8_STAGE(PG8_SB(1, 1), cB + hstep + kstep, voffB);
        PG8_WAIT_V(6); PG8_BAR;
    }
    for (;;) {
        const bool has_next = S.next(ui + 1, nxt);
        const char* nA = has_next ? (const char*)g.A + (size_t)nxt.pm * tstep : cA; const char* nB = has_next ? (const char*)g.Bt + (size_t)nxt.pn * tstep : cB;
        for (int t = 0; t < nt; t += 2) {
            const bool last = (t == nt - 2);
            const char* a1 = cA + (size_t)(t + 1) * kstep;
            const char* a2 = last ? nA : cA + (size_t)(t + 2) * kstep; const char* b2 = last ? nB : cB + (size_t)(t + 2) * kstep;
            const char* a3 = a2 + kstep; const char* b3 = b2 + kstep;
            if (last && has_next) S.a_ready(nxt);
            if constexpr (SP2) {
            PG8_LDB(B0, 0, 0); PG8_LDB(B1, 0, 1); PG8_SCHED; PG8_LDA(At, 0, 0); PG8_STAGE(PG8_SA(1, 1), a1 + hstep, voffA);
            PG8_WAIT_V(8); PG8_WAIT_L(0); PG8_BAR; PG8_MMA(0, 0, At, B0); PG8_MMA(0, 1, At, B1); PG8_BAR; PG8_SCHED;
            PG8_LDA(At, 0, 1); PG8_STAGE(PG8_SB(0, 0), b2, voffB); PG8_STAGE(PG8_SB(0, 1), b2 + hstep, voffB); PG8_STAGE(PG8_SA(0, 0), a2, voffA);
            PG8_WAIT_V(8); PG8_WAIT_L(0); PG8_BAR; PG8_MMA(1, 0, At, B0); PG8_MMA(1, 1, At, B1); PG8_BAR; PG8_SCHED;
            PG8_LDB(B0, 1, 0); PG8_LDB(B1, 1, 1); PG8_SCHED; PG8_LDA(At, 1, 0); PG8_STAGE(PG8_SA(0, 1), a2 + hstep, voffA);
            PG8_WAIT_V(8); PG8_WAIT_L(0); PG8_BAR; PG8_MMA(0, 0, At, B0); PG8_MMA(0, 1, At, B1); PG8_BAR; PG8_SCHED;
            PG8_LDA(At, 1, 1); PG8_STAGE(PG8_SB(1, 0), b3, voffB); PG8_STAGE(PG8_SB(1, 1), b3 + hstep, voffB); PG8_STAGE(PG8_SA(1, 0), a3, voffA);
            PG8_WAIT_V(8); PG8_WAIT_L(0); PG8_BAR; PG8_MMA(1, 0, At, B0); PG8_MMA(1, 1, At, B1); PG8_BAR; PG8_SCHED;
            } else {
            PG8_LDB(B0, 0, 0); PG8_SCHED; PG8_LDA(At, 0, 0); PG8_STAGE(PG8_SA(1, 1), a1 + hstep, voffA);
            PG8_WAIT_L(8); PG8_BAR; PG8_WAIT_L(0); PG8_MMA(0, 0, At, B0); PG8_BAR; PG8_SCHED;
            PG8_LDB(B1, 0, 1); PG8_STAGE(PG8_SB(0, 0), b2, voffB);
            PG8_BAR; PG8_WAIT_L(0); PG8_MMA(0, 1, At, B1); PG8_BAR;
            PG8_LDA(At, 0, 1); PG8_STAGE(PG8_SA(0, 0), a2, voffA);
            PG8_BAR; PG8_WAIT_L(0); PG8_MMA(1, 0, At, B0); PG8_BAR; PG8_SCHED;
            PG8_STAGE(PG8_SB(0, 1), b2 + hstep, voffB);
            PG8_WAIT_V(6); PG8_BAR; PG8_MMA(1, 1, At, B1); PG8_BAR;
            PG8_LDB(B0, 1, 0); PG8_SCHED; PG8_LDA(At, 1, 0); PG8_STAGE(PG8_SA(0, 1), a2 + hstep, voffA);
            PG8_WAIT_L(8); PG8_BAR; PG8_WAIT_L(0); PG8_MMA(0, 0, At, B0); PG8_BAR; PG8_SCHED;
            PG8_LDB(B1, 1, 1); PG8_STAGE(PG8_SB(1, 0), b3, voffB);
            PG8_BAR; PG8_WAIT_L(0); PG8_MMA(0, 1, At, B1); PG8_BAR;
            PG8_LDA(At, 1, 1); PG8_STAGE(PG8_SA(1, 0), a3, voffA);
            PG8_BAR; PG8_WAIT_L(0); PG8_MMA(1, 0, At, B0); PG8_BAR; PG8_SCHED;
            PG8_STAGE(PG8_SB(1, 1), b3 + hstep, voffB);
            PG8_WAIT_V(6); PG8_BAR; PG8_MMA(1, 1, At, B1); PG8_BAR;
            }
        }
        if constexpr (ALIGN_EPI) { if (wr == 0) PG8_BAR; }
        if constexpr (!Epi::AFTER_DRAIN) { E(acc, cur, wr, wc, fr, fq); S.done(cur); }
        if (!has_next) break;
#pragma unroll
        for (int a = 0; a < 2; ++a)
#pragma unroll
            for (int b = 0; b < 2; ++b)
#pragma unroll
                for (int m = 0; m < 4; ++m)
#pragma unroll
                    for (int n = 0; n < 2; ++n) acc[a][b][m][n] = (f32x4){0.f, 0.f, 0.f, 0.f};
        cur = nxt; cA = nA; cB = nB; ++ui;
        if constexpr (ALIGN_EPI) { if (wr == 1) PG8_BAR; }
    }
    PG8_WAIT_V(0);
    if constexpr (!ALIGN_EPI) { if (wr == 0) PG8_BAR; }
    PG8_BAR;
    if constexpr (Epi::AFTER_DRAIN) { E.fused(acc, cur, wr, wc, fr, fq, lds, wid, lane); S.done(cur); }
#undef PG8_SA
#undef PG8_SB
#undef PG8_STAGE
#undef PG8_LDA
#undef PG8_LDB
#undef PG8_MMA
#undef PG8_WAIT_V
#undef PG8_WAIT_L
#undef PG8_BAR
#undef PG8_SCHED
}

typedef int i32x4 __attribute__((ext_vector_type(4)));
struct EpiI8Bf16 {
    static constexpr bool PERM = true, AFTER_DRAIN = false;
    bf16_t* O; int ldc; const float* rs; const float* cs; const float* bias;
    __device__ __forceinline__ void operator()(const i32x4 (&acc)[2][2][4][2], const Unit& u, int wr, int wc, int fr, int fq) const {
        const int row0 = u.pm * BM + wr * 64 + fr, col0 = u.pn * BM + wc * 32 + 8 * fq;
        f32x4 cv[2][2], bv[2][2];
#pragma unroll
        for (int bj = 0; bj < 2; ++bj)
#pragma unroll
            for (int n = 0; n < 2; ++n) { cv[bj][n] = *(const f32x4*)(cs + col0 + bj * HALF + 4 * n); bv[bj][n] = bias ? *(const f32x4*)(bias + col0 + bj * HALF + 4 * n) : (f32x4){0.f, 0.f, 0.f, 0.f}; }
#pragma unroll
        for (int ai = 0; ai < 2; ++ai)
#pragma unroll
            for (int m = 0; m < 4; ++m) { const int row = row0 + ai * HALF + m * 16; const float r = rs[row]; bf16_t* rowp = O + (size_t)row * ldc + col0;
#pragma unroll
                for (int bj = 0; bj < 2; ++bj) { const i32x4 a0 = acc[ai][bj][m][0], a1 = acc[ai][bj][m][1];
                    const f32x4 v0 = (f32x4){(float)a0[0], (float)a0[1], (float)a0[2], (float)a0[3]} * cv[bj][0] * r + bv[bj][0], v1 = (f32x4){(float)a1[0], (float)a1[1], (float)a1[2], (float)a1[3]} * cv[bj][1] * r + bv[bj][1];
                    u32x4 w; w.x = cvt_pk_bf16(v0[0], v0[1]); w.y = cvt_pk_bf16(v0[2], v0[3]); w.z = cvt_pk_bf16(v1[0], v1[1]); w.w = cvt_pk_bf16(v1[2], v1[3]);
                    *(u32x4*)(rowp + bj * HALF) = w; } }
    }
};
template <class Epi, class Sched, bool ALIGN_EPI = false, bool SP2 = false>
__device__ __forceinline__ void gemm_phase_i8(PG8_LAS unsigned char* lds, const Gemm g, const Sched& S, const Epi& E) {
    const int tid = threadIdx.x, wid = __builtin_amdgcn_readfirstlane(tid >> 6), lane = tid & 63, wr = wid >> 2, wc = wid & 3, fr = lane & 15, fq = lane >> 4;
    const int K = g.K, nt = K / BK;
    unsigned voffA[2], voffB[2];
#pragma unroll
    for (int i = 0; i < 2; ++i) { int R, C; stage_rc(tid * 16 + i * 8192, R, C); const int Rb = Epi::PERM ? ((R & ~31) + perm32(R & 31)) : R;
        voffA[i] = (unsigned)(R * K + C) * 2u; voffB[i] = (unsigned)(Rb * K + C) * 2u; }
    const size_t kstep = (size_t)(BK * 2);
    const size_t hstep = (size_t)HALF * K * 2;
    const size_t tstep = 2 * hstep;
    const unsigned ldsw = (unsigned)wid * 1024u;
    const int aoff = lds_byte(wr * 64 + fr, fq * 8), boff = lds_byte(wc * 32 + fr, fq * 8);
#define PG8_SA(b, h) (((b) * 2 + (h)) * HTB)
#define PG8_SB(b, h) ((4 + (b) * 2 + (h)) * HTB)
#define PG8_STAGE(bufoff, gbase, voff) do { _Pragma("unroll") for (int _i = 0; _i < 2; ++_i) \
        __builtin_amdgcn_global_load_lds((const unsigned*)((const char*)(gbase) + (voff)[_i]), (PG8_LAS unsigned*)(lds + (bufoff) + ldsw + _i * 8192), 16, 0, 0); } while (0)
#define PG8_LDA(dst, b, h) do { _Pragma("unroll") for (int m = 0; m < 4; ++m) _Pragma("unroll") for (int k = 0; k < 2; ++k) dst[m][k] = *(const PG8_LAS bf16x8*)(lds + PG8_SA(b, h) + aoff + m * 2048 + k * 1024); } while (0)
#define PG8_LDB(dst, b, h) do { _Pragma("unroll") for (int n = 0; n < 2; ++n) _Pragma("unroll") for (int k = 0; k < 2; ++k) dst[n][k] = *(const PG8_LAS bf16x8*)(lds + PG8_SB(b, h) + boff + n * 2048 + k * 1024); } while (0)
#define PG8_MMA(ai, bj, At, Bt) do { __builtin_amdgcn_s_setprio(1); _Pragma("unroll") for (int m = 0; m < 4; ++m) _Pragma("unroll") for (int n = 0; n < 2; ++n) _Pragma("unroll") for (int k = 0; k < 2; ++k) \
        acc[ai][bj][m][n] = __builtin_amdgcn_mfma_i32_16x16x64_i8(__builtin_bit_cast(i32x4, Bt[n][k]), __builtin_bit_cast(i32x4, At[m][k]), acc[ai][bj][m][n], 0, 0, 0); __builtin_amdgcn_s_setprio(0); } while (0)
#define PG8_WAIT_V(n) asm volatile("s_waitcnt vmcnt(" #n ")" ::: "memory")
#define PG8_WAIT_L(n) asm volatile("s_waitcnt lgkmcnt(" #n ")" ::: "memory")
#define PG8_BAR __builtin_amdgcn_s_barrier()
#define PG8_SCHED __builtin_amdgcn_sched_barrier(0)
    Unit cur, nxt; int ui = 0;
    if (!S.next(0, cur)) return;
    i32x4 acc[2][2][4][2];
#pragma unroll
    for (int a = 0; a < 2; ++a)
#pragma unroll
        for (int b = 0; b < 2; ++b)
#pragma unroll
            for (int m = 0; m < 4; ++m)
#pragma unroll
                for (int n = 0; n < 2; ++n) acc[a][b][m][n] = (i32x4){0, 0, 0, 0};
    bf16x8 At[4][2], B0[2][2], B1[2][2];
    const char* cA = (const char*)g.A + (size_t)cur.pm * tstep; const char* cB = (const char*)g.Bt + (size_t)cur.pn * tstep;
    S.a_ready(cur);
    if constexpr (SP2) {
        PG8_STAGE(PG8_SB(0, 0), cB, voffB); PG8_STAGE(PG8_SB(0, 1), cB + hstep, voffB); PG8_STAGE(PG8_SA(0, 0), cA, voffA); PG8_STAGE(PG8_SA(0, 1), cA + hstep, voffA);
        if (wr == 1) PG8_BAR;
        PG8_WAIT_V(2); PG8_BAR;
        PG8_STAGE(PG8_SB(1, 0), cB + kstep, voffB); PG8_STAGE(PG8_SA(1, 0), cA + kstep, voffA); PG8_STAGE(PG8_SB(1, 1), cB + hstep + kstep, voffB);
        PG8_WAIT_V(6); PG8_BAR;
    } else {
        PG8_STAGE(PG8_SB(0, 0), cB, voffB); PG8_STAGE(PG8_SA(0, 0), cA, voffA); PG8_STAGE(PG8_SB(0, 1), cB + hstep, voffB); PG8_STAGE(PG8_SA(0, 1), cA + hstep, voffA);
        if (wr == 1) PG8_BAR;
        PG8_WAIT_V(4); PG8_BAR;
        PG8_STAGE(PG8_SB(1, 0), cB + kstep, voffB); PG8_STAGE(PG8_SA(1, 0), cA + kstep, voffA); PG8_STAGE(PG8_SB(1, 1), cB + hstep + kstep, voffB);
        PG8_WAIT_V(6); PG8_BAR;
    }
    for (;;) {
        const bool has_next = S.next(ui + 1, nxt);
        const char* nA = has_next ? (const char*)g.A + (size_t)nxt.pm * tstep : cA; const char* nB = has_next ? (const char*)g.Bt + (size_t)nxt.pn * tstep : cB;
        for (int t = 0; t < nt; t += 2) {
            const bool last = (t == nt - 2);
            const char* a1 = cA + (size_t)(t + 1) * kstep;
            const char* a2 = last ? nA : cA + (size_t)(t + 2) * kstep; const char* b2 = last ? nB : cB + (size_t)(t + 2) * kstep;
            const char* a3 = a2 + kstep; const char* b3 = b2 + kstep;
            if (last && has_next) S.a_ready(nxt);
            if constexpr (SP2) {
            PG8_LDB(B0, 0, 0); PG8_LDB(B1, 0, 1); PG8_SCHED; PG8_LDA(At, 0, 0); PG8_STAGE(PG8_SA(1, 1), a1 + hstep, voffA);
            PG8_WAIT_V(8); PG8_WAIT_L(0); PG8_BAR; PG8_MMA(0, 0, At, B0); PG8_MMA(0, 1, At, B1); PG8_BAR; PG8_SCHED;
            PG8_LDA(At, 0, 1); PG8_STAGE(PG8_SB(0, 0), b2, voffB); PG8_STAGE(PG8_SB(0, 1), b2 + hstep, voffB); PG8_STAGE(PG8_SA(0, 0), a2, voffA);
            PG8_WAIT_V(8); PG8_WAIT_L(0); PG8_BAR; PG8_MMA(1, 0, At, B0); PG8_MMA(1, 1, At, B1); PG8_BAR; PG8_SCHED;
            PG8_LDB(B0, 1, 0); PG8_LDB(B1, 1, 1); PG8_SCHED; PG8_LDA(At, 1, 0); PG8_STAGE(PG8_SA(0, 1), a2 + hstep, voffA);
            PG8_WAIT_V(8); PG8_WAIT_L(0); PG8_BAR; PG8_MMA(0, 0, At, B0); PG8_MMA(0, 1, At, B1); PG8_BAR; PG8_SCHED;
            PG8_LDA(At, 1, 1); PG8_STAGE(PG8_SB(1, 0), b3, voffB); PG8_STAGE(PG8_SB(1, 1), b3 + hstep, voffB); PG8_STAGE(PG8_SA(1, 0), a3, voffA);
            PG8_WAIT_V(8); PG8_WAIT_L(0); PG8_BAR; PG8_MMA(1, 0, At, B0); PG8_MMA(1, 1, At, B1); PG8_BAR; PG8_SCHED;
            } else {
            PG8_LDB(B0, 0, 0); PG8_SCHED; PG8_LDA(At, 0, 0); PG8_STAGE(PG8_SA(1, 1), a1 + hstep, voffA);
            PG8_WAIT_L(8); PG8_BAR; PG8_WAIT_L(0); PG8_MMA(0, 0, At, B0); PG8_BAR; PG8_SCHED;
            PG8_LDB(B1, 0, 1); PG8_STAGE(PG8_SB(0, 0), b2, voffB);
            PG8_BAR; PG8_WAIT_L(0); PG8_MMA(0, 1, At, B1); PG8_BAR;
            PG8_LDA(At, 0, 1); PG8_STAGE(PG8_SA(0, 0), a2, voffA);
            PG8_BAR; PG8_WAIT_L(0); PG8_MMA(1, 0, At, B0); PG8_BAR; PG8_SCHED;
            PG8_STAGE(PG8_SB(0, 1), b2 + hstep, voffB);
            PG8_WAIT_V(6); PG8_BAR; PG8_MMA(1, 1, At, B1); PG8_BAR;
            PG8_LDB(B0, 1, 0); PG8_SCHED; PG8_LDA(At, 1, 0); PG8_STAGE(PG8_SA(0, 1), a2 + hstep, voffA);
            PG8_WAIT_L(8); PG8_BAR; PG8_WAIT_L(0); PG8_MMA(0, 0, At, B0); PG8_BAR; PG8_SCHED;
            PG8_LDB(B1, 1, 1); PG8_STAGE(PG8_SB(1, 0), b3, voffB);
            PG8_BAR; PG8_WAIT_L(0); PG8_MMA(0, 1, At, B1); PG8_BAR;
            PG8_LDA(At, 1, 1); PG8_STAGE(PG8_SA(1, 0), a3, voffA);
            PG8_BAR; PG8_WAIT_L(0); PG8_MMA(1, 0, At, B0); PG8_BAR; PG8_SCHED;
            PG8_STAGE(PG8_SB(1, 1), b3 + hstep, voffB);
            PG8_WAIT_V(6); PG8_BAR; PG8_MMA(1, 1, At, B1); PG8_BAR;
            }
        }
        if constexpr (ALIGN_EPI) { if (wr == 0) PG8_BAR; }
        if constexpr (!Epi::AFTER_DRAIN) { E(acc, cur, wr, wc, fr, fq); S.done(cur); }
        if (!has_next) break;
#pragma unroll
        for (int a = 0; a < 2; ++a)
#pragma unroll
            for (int b = 0; b < 2; ++b)
#pragma unroll
                for (int m = 0; m < 4; ++m)
#pragma unroll
                    for (int n = 0; n < 2; ++n) acc[a][b][m][n] = (i32x4){0, 0, 0, 0};
        cur = nxt; cA = nA; cB = nB; ++ui;
        if constexpr (ALIGN_EPI) { if (wr == 1) PG8_BAR; }
    }
    PG8_WAIT_V(0);
    if constexpr (!ALIGN_EPI) { if (wr == 0) PG8_BAR; }
    PG8_BAR;
    if constexpr (Epi::AFTER_DRAIN) { E.fused(acc, cur, wr, wc, fr, fq, lds, wid, lane); S.done(cur); }
#undef PG8_SA
#undef PG8_SB
#undef PG8_STAGE
#undef PG8_LDA
#undef PG8_LDB
#undef PG8_MMA
#undef PG8_WAIT_V
#undef PG8_WAIT_L
#undef PG8_BAR
#undef PG8_SCHED
}

}
#define GAS __attribute__((address_space(1)))
#define LAS __attribute__((address_space(3)))
typedef unsigned short bf16;
typedef unsigned v4u __attribute__((ext_vector_type(4)));
typedef float f32x4 __attribute__((ext_vector_type(4)));
typedef short bf16x8 __attribute__((ext_vector_type(8)));
typedef GAS unsigned gu32;
typedef GAS unsigned long long gu64;
#define RLX_AGENT __ATOMIC_RELAXED, __HIP_MEMORY_SCOPE_AGENT
#define LDS_WAIT() asm volatile("s_waitcnt lgkmcnt(0)" ::: "memory")
#define VM_WAIT() asm volatile("s_waitcnt vmcnt(0)" ::: "memory")
__device__ __forceinline__ unsigned long long rt() { return __builtin_amdgcn_s_memrealtime(); }
__device__ __forceinline__ unsigned f2bf(float f) { unsigned u = __builtin_bit_cast(unsigned, f); return (u + 0x7fffu + ((u >> 16) & 1u)) >> 16; }
__device__ __forceinline__ unsigned pk2(float lo, float hi) { return f2bf(lo) | (f2bf(hi) << 16); }

#define XB_TMO      128
#define XB_XCNT(j)  (256  + 64 * (j))
#define XB_XSUB(j)  (1280 + 64 * (j))
#define XB_XGEN(j)  (2304 + 64 * (j))
#define XB_TOP      3328
#define XB_TOPGEN   3392
#define XCD_BAR_WORDS 3456
#define XB_SPIN_CAP (1u << 18)

__device__ __forceinline__ unsigned xb_ld(unsigned* p)              { return __hip_atomic_load(p, __ATOMIC_RELAXED, __HIP_MEMORY_SCOPE_AGENT); }
__device__ __forceinline__ unsigned xb_add(unsigned* p, unsigned v) { return __hip_atomic_fetch_add(p, v, __ATOMIC_RELAXED, __HIP_MEMORY_SCOPE_AGENT); }
__device__ __forceinline__ unsigned xb_xcc_id() { return (unsigned)__builtin_amdgcn_s_getreg((3 << 11) | 20) & 0xFu; }
#define XB_SPIN(cond, bar) do { unsigned _sp = 0; while (cond) { __builtin_amdgcn_s_sleep(1); \
    if ((++_sp & 255u) == 0u) { if (xb_ld(&(bar)[XB_TMO])) break; if (_sp > XB_SPIN_CAP) { atomicAdd(&(bar)[XB_TMO], 1u); break; } } } } while (0)

struct XcdBarrier {
    unsigned* bar; unsigned x;
    volatile LAS unsigned* st;
};

__device__ __forceinline__ XcdBarrier xcd_barrier_post(unsigned* bar, volatile LAS unsigned* st) {
    XcdBarrier b; b.bar = bar; b.x = xb_xcc_id(); b.st = st;
    if (threadIdx.x == 0) (void)xb_add(&bar[XB_XCNT(b.x)], 1u);
    return b;
}
__device__ __forceinline__ void xcd_barrier_complete(unsigned* bar, unsigned x, unsigned& nloc, unsigned& nx) {
    const unsigned G = gridDim.x * gridDim.y * gridDim.z;
    unsigned sum, cnt, mine, sp = 0u;
    for (;;) {
        sum = 0u; cnt = 0u; mine = 0u;
#pragma unroll
        for (unsigned j = 0; j < 16; ++j) { const unsigned c = xb_ld(&bar[XB_XCNT(j)]); sum += c; cnt += (c > 0u) ? 1u : 0u; mine = (j == x) ? c : mine; }
        if (sum == G) break;
        __builtin_amdgcn_s_sleep(1);
        if ((++sp & 255u) == 0u) { if (xb_ld(&bar[XB_TMO])) break; if (sp > XB_SPIN_CAP) { atomicAdd(&bar[XB_TMO], 1u); break; } }
    }
    nloc = mine > 0u ? mine : 1u; nx = cnt > 0u ? cnt : 1u;
}

__device__ __forceinline__ void xcd_barrier(const XcdBarrier& b) {
    asm volatile("s_waitcnt vmcnt(0)" ::: "memory");
    __syncthreads();
    if (threadIdx.x == 0) {
        unsigned* bar = b.bar;
        __builtin_amdgcn_s_waitcnt(0);
        unsigned nloc = b.st[0], nx = b.st[1];
        if (nloc == 0u) { xcd_barrier_complete(bar, b.x, nloc, nx); b.st[0] = nloc; b.st[1] = nx; }
        const unsigned old = xb_add(&bar[XB_XSUB(b.x)], 1u);
        const unsigned gen = old / nloc;
        if (old + 1u == (gen + 1u) * nloc) {
            __builtin_amdgcn_fence(__ATOMIC_RELEASE, "agent");
            asm volatile("s_waitcnt vmcnt(0)" ::: "memory");
            const unsigned og = xb_add(&bar[XB_TOP], 1u);
            const unsigned tg = og / nx;
            if (og + 1u == (tg + 1u) * nx) xb_add(&bar[XB_TOPGEN], 1u);
            else XB_SPIN(xb_ld(&bar[XB_TOPGEN]) == tg, bar);
            __builtin_amdgcn_fence(__ATOMIC_ACQUIRE, "agent");
            xb_add(&bar[XB_XGEN(b.x)], 1u);
            asm volatile("s_waitcnt vmcnt(0)" ::: "memory");
        } else {
            XB_SPIN(xb_ld(&bar[XB_XGEN(b.x)]) == gen, bar);
            __builtin_amdgcn_fence(__ATOMIC_ACQUIRE, "agent");
            asm volatile("s_waitcnt vmcnt(0)" ::: "memory");
        }
    }
    __syncthreads();
}

typedef float f32x16 __attribute__((ext_vector_type(16)));
typedef short v4i16_t __attribute__((ext_vector_type(4)));
typedef float f32x2_t __attribute__((ext_vector_type(2)));
typedef __bf16 bf16x2_t __attribute__((ext_vector_type(2)));
typedef int i32x4 __attribute__((ext_vector_type(4)));
typedef unsigned u32x2 __attribute__((ext_vector_type(2)));

constexpr int NWAVES = 8, NTHR = 512;
constexpr int BATCH = 32, SEQ = 2048, DM = 1024, NTOK = BATCH * SEQ;
constexpr int NIN = 3088, NPROJ = 3328, NQP = 2048, NMOD = 6144;
constexpr int C_DQ = 0, C_DK = 512, C_DV = 1024, C_GQ = 1536, C_GK = 1792, C_GV = 2048, C_GR = 2560, C_GG = 3072;
constexpr int NEXP = 16384;
constexpr float RMS_EPS = 1e-6f;
constexpr float LAMBDA_INIT = 0.2f;
constexpr float QSCALE = 0.125f * 1.4426950408889634f;

constexpr size_t MiB = 1u << 20;
constexpr size_t WS_CTL = 0, CTL_ZERO_BYTES = 1 * MiB;
constexpr size_t WS_WIN_T = 2 * MiB;
constexpr size_t WS_WOUT_T = 10 * MiB;
constexpr size_t WS_WQ_T = 12 * MiB;
constexpr size_t WS_KEYS = 16 * MiB;
constexpr size_t WS_MOD = 17 * MiB;
constexpr size_t WS_WEFF = 18 * MiB;
constexpr size_t WS_CS = 19 * MiB;
constexpr size_t WS_RS1 = 20 * MiB;
constexpr size_t WS_RS2 = 21 * MiB;
constexpr size_t WS_CSQ = 19 * MiB + 16384;
constexpr size_t WS_COS = 32 * MiB;
constexpr size_t WS_SIN = 40 * MiB;
constexpr size_t WS_EU = 64 * MiB;
constexpr size_t WS_EV = 80 * MiB;
constexpr size_t WS_ES = 96 * MiB;
constexpr size_t WS_H = 128 * MiB;
constexpr size_t WS_HN = 192 * MiB;
constexpr size_t WS_PROJ = 256 * MiB;
constexpr size_t WS_PD = 256 * MiB;
constexpr size_t WS_X1 = 512 * MiB;
constexpr size_t WS_Y = 864 * MiB;
constexpr size_t WS_ACT = 768 * MiB;
constexpr size_t WS_EIDX = 800 * MiB;
constexpr size_t WS_EG = 832 * MiB;
constexpr size_t WS_END = 992 * MiB;
constexpr int CW_TMO = 0, CW_Q = 64, CW_RANK = 1024, CW_BAR = 4096, CW_WMAX = 32768;

constexpr int LDS_BYTES = 163840;
constexpr int MISC_OFF = LDS_BYTES - 256;

struct Args { const void* in[25]; float* out; unsigned char* ws; int ph_lo, ph_hi, li, pad; };
struct Ctx {
    LAS unsigned char* lds;
    volatile LAS unsigned* MISC;
    gu32* ctl;
    int tid, lane, wave, vcu, G;
    int sx, sj;
    float* out; unsigned char* ws;
};

__device__ __forceinline__ float wave_sum(float v) {
#pragma unroll
    for (int o = 1; o < 64; o <<= 1) v += __shfl_xor(v, o);
    return v;
}
__device__ __forceinline__ float wave_sum_fast(float x) {
    x += __int_as_float(__builtin_amdgcn_update_dpp(0, __float_as_int(x), 0xb1, 0xf, 0xf, false));
    x += __int_as_float(__builtin_amdgcn_update_dpp(0, __float_as_int(x), 0x4e, 0xf, 0xf, false));
    x += __int_as_float(__builtin_amdgcn_update_dpp(0, __float_as_int(x), 0x124, 0xf, 0xf, false));
    x += __int_as_float(__builtin_amdgcn_update_dpp(0, __float_as_int(x), 0x128, 0xf, 0xf, false));
    { auto r = __builtin_amdgcn_permlane16_swap(__float_as_uint(x), __float_as_uint(x), false, false); x = __uint_as_float(r[0]) + __uint_as_float(r[1]); }
    { auto r = __builtin_amdgcn_permlane32_swap(__float_as_uint(x), __float_as_uint(x), false, false); x = __uint_as_float(r[0]) + __uint_as_float(r[1]); }
    return x;
}
__device__ __forceinline__ unsigned cvtpk(float lo, float hi) { f32x2_t v = {lo, hi}; bf16x2_t b = __builtin_convertvector(v, bf16x2_t); return __builtin_bit_cast(unsigned, b); }
__device__ __forceinline__ float bf_lo(unsigned w) { return __uint_as_float(w << 16); }
__device__ __forceinline__ float bf_hi(unsigned w) { return __uint_as_float(w & 0xffff0000u); }
__device__ __forceinline__ int crow(int r, int hi) { return (r & 3) + 8 * (r >> 2) + 4 * hi; }
__device__ __forceinline__ float pair_max(float m) { auto rr = __builtin_amdgcn_permlane32_swap(__float_as_uint(m), __float_as_uint(m), false, false); return fmaxf(__uint_as_float(rr[0]), __uint_as_float(rr[1])); }
__device__ __forceinline__ float pair_sum(float m) { auto rr = __builtin_amdgcn_permlane32_swap(__float_as_uint(m), __float_as_uint(m), false, false); return __uint_as_float(rr[0]) + __uint_as_float(rr[1]); }
__device__ __forceinline__ int pair_maxi(int m) { auto rr = __builtin_amdgcn_permlane32_swap((unsigned)m, (unsigned)m, false, false); const int a = (int)rr[0], b = (int)rr[1]; return a > b ? a : b; }
__device__ __forceinline__ v4i16_t tr16(LAS const unsigned char* p) { return __builtin_amdgcn_ds_read_tr16_b64_v4i16((LAS v4i16_t*)p); }
__device__ __forceinline__ bf16x8 mk8(v4i16_t a, v4i16_t b) { return (bf16x8){a[0], a[1], a[2], a[3], b[0], b[1], b[2], b[3]}; }
#define MFMA32(a, b, c) __builtin_amdgcn_mfma_f32_32x32x16_bf16((a), (b), (c), 0, 0, 0)

__device__ __forceinline__ void p0_transpose_item(const float* W, int K, int ldw, int nblk, bf16* WT, LAS float* scr, int item, int lane) {
    const int kb = item / nblk, nb = item % nblk, k0 = 64 * kb, n0 = 32 * nb;
#pragma unroll 8
    for (int i = 0; i < 32; ++i) { const int kk = 2 * i + (lane >> 5); scr[kk * 33 + (lane & 31)] = W[(size_t)(k0 + kk) * ldw + n0 + (lane & 31)]; }
    LDS_WAIT(); asm volatile("" ::: "memory");
    const int c = lane & 7;
#pragma unroll
    for (int j = 0; j < 4; ++j) { const int n = (lane >> 3) + 8 * j; const LAS float* s = scr + (8 * c) * 33 + n;
        v4u o; o.x = pk2(s[0 * 33], s[1 * 33]); o.y = pk2(s[2 * 33], s[3 * 33]); o.z = pk2(s[4 * 33], s[5 * 33]); o.w = pk2(s[6 * 33], s[7 * 33]);
        *(GAS v4u*)(WT + (size_t)(n0 + n) * K + k0 + 8 * c) = o; }
    LDS_WAIT(); asm volatile("" ::: "memory");
}

__device__ __forceinline__ void mod_gemv(Ctx& C, const Args& A) {
    const float* cc = ((const float*)A.in[1]); const float* w_ada = ((const float*)A.in[3]); const float* b_ada = ((const float*)A.in[4]); float* mod = (float*)(C.ws + WS_MOD);
    LAS float* sc = (LAS float*)C.lds;
    LAS float* red = (LAS float*)(C.lds + 32768);
    const int col0 = C.vcu * 32, col = C.tid & 31, ks = C.tid >> 5;
    float acc[32];
#pragma unroll
    for (int i = 0; i < 32; ++i) acc[i] = 0.f;
    for (int kt = 0; kt < 4; ++kt) {
        for (int idx = C.tid; idx < 8192; idx += NTHR) { const int kk = idx >> 5, b = idx & 31; const float v = cc[b * 1024 + kt * 256 + kk]; sc[idx] = v / (1.f + __expf(-v)); }
        __syncthreads();
#pragma unroll 4
        for (int k2 = 0; k2 < 16; ++k2) { const int k = ks * 16 + k2; const float w = w_ada[(size_t)(kt * 256 + k) * NMOD + col0 + col];
#pragma unroll
            for (int b4 = 0; b4 < 8; ++b4) { const f32x4 f = *(const LAS f32x4*)(sc + k * 32 + 4 * b4);
                acc[4 * b4 + 0] += w * f.x; acc[4 * b4 + 1] += w * f.y; acc[4 * b4 + 2] += w * f.z; acc[4 * b4 + 3] += w * f.w; } }
        __syncthreads();
    }
#pragma unroll
    for (int b = 0; b < 32; ++b) red[(ks * 32 + b) * 32 + col] = acc[b];
    __syncthreads();
#pragma unroll
    for (int oo = 0; oo < 2; ++oo) { const int o = C.tid + oo * NTHR, c_ = o & 31, b = o >> 5; float s = 0.f;
#pragma unroll
        for (int k = 0; k < 16; ++k) s += red[(k * 32 + b) * 32 + c_];
        mod[b * NMOD + col0 + c_] = s + b_ada[col0 + c_]; }
    __syncthreads();
}

__device__ __forceinline__ void phase0(Ctx& C, const Args& A) {
    if (C.vcu < 192) mod_gemv(C, A);
    bf16* WoutT = (bf16*)(C.ws + WS_WOUT_T);
    const float* w_in = ((const float*)A.in[6]);
    unsigned* wmax = (unsigned*)(C.ctl + CW_WMAX);
    {
        LAS float* scr = (LAS float*)(C.lds + C.wave * 16384);
        const int gw = C.vcu * NWAVES + C.wave, NGW = C.G * NWAVES;
        constexpr int I_OUT = 16 * 32;
        for (int it = gw; it < I_OUT; it += NGW) p0_transpose_item(((const float*)A.in[17]), 1024, 1024, 32, WoutT, scr, it, C.lane);
    }
    const int gt = C.vcu * NTHR + C.tid, NGT = C.G * NTHR;
    {
        for (int it = gt; it < 16 * 3072; it += NGT) { const int kb = it / 3072, n = it - kb * 3072; float mx = 0.f;
#pragma unroll 8
            for (int k = 0; k < 64; ++k) mx = fmaxf(mx, fabsf(w_in[(size_t)(64 * kb + k) * NIN + n]));
            atomicMax(wmax + n, __float_as_uint(mx)); }
        const float* w_q = ((const float*)A.in[19]);
        for (int it = gt; it < 16 * 2048; it += NGT) { const int kb = it >> 11, n = it & 2047; float mx = 0.f;
#pragma unroll 8
            for (int k = 0; k < 64; ++k) mx = fmaxf(mx, fabsf(w_q[(size_t)(64 * kb + k) * NQP + n]));
            atomicMax(wmax + NPROJ + n, __float_as_uint(mx)); }
    }
    {
        const float* wg2 = ((const float*)A.in[14]); float* WE = (float*)(C.ws + WS_WEFF);
        for (int it = gt; it < 256 * 128; it += NGT) { const int j = it >> 7, kc = it & 127; float g[16];
#pragma unroll
            for (int r = 0; r < 16; ++r) g[r] = wg2[r * 256 + j];
            float o[8], mx = 0.f;
#pragma unroll
            for (int i = 0; i < 8; ++i) { const float* wr = w_in + (size_t)(8 * kc + i) * NIN + 3072; float s_ = 0.f;
#pragma unroll
                for (int r4 = 0; r4 < 4; ++r4) { const f32x4 w4 = *(const f32x4*)(wr + 4 * r4); s_ += w4.x * g[4 * r4] + w4.y * g[4 * r4 + 1] + w4.z * g[4 * r4 + 2] + w4.w * g[4 * r4 + 3]; }
                o[i] = s_; mx = fmaxf(mx, fabsf(s_)); }
            *(f32x4*)(WE + (size_t)j * 1024 + 8 * kc) = (f32x4){o[0], o[1], o[2], o[3]}; *(f32x4*)(WE + (size_t)j * 1024 + 8 * kc + 4) = (f32x4){o[4], o[5], o[6], o[7]};
            atomicMax(wmax + 3072 + j, __float_as_uint(mx)); }
    }
    {
        bf16* KB = (bf16*)(C.ws + WS_KEYS);
        for (int it = gt; it < 4096; it += NGT) { const float* src = (it < 2048 ? ((const float*)A.in[21]) : ((const float*)A.in[22])) + (size_t)(it & 2047) * 8;
            const f32x4 a = *(const f32x4*)src, b = *(const f32x4*)(src + 4);
            v4u ov; ov.x = pk2(a.x, a.y); ov.y = pk2(a.z, a.w); ov.z = pk2(b.x, b.y); ov.w = pk2(b.z, b.w);
            *(GAS v4u*)(KB + (size_t)it * 8) = ov; }
    }
    {
        const float* eu = ((const float*)A.in[23]); const float* ev = ((const float*)A.in[24]);
        unsigned char* E8 = C.ws + WS_EU; float* ES = (float*)(C.ws + WS_ES);
        const int gw = C.vcu * NWAVES + C.wave, NGW = C.G * NWAVES;
        f32x4 nv[4];
        { const int row = gw < 2 * NEXP ? gw : 0; const float* src = (row < NEXP ? eu + (size_t)row * 1024 : ev + (size_t)(row - NEXP) * 1024) + 16 * C.lane;
#pragma unroll
          for (int i = 0; i < 4; ++i) nv[i] = *(const f32x4*)(src + 4 * i); }
        for (int row = gw; row < 2 * NEXP; row += NGW) {
            f32x4 v[4];
#pragma unroll
            for (int i = 0; i < 4; ++i) v[i] = nv[i];
            { const int rn = row + NGW < 2 * NEXP ? row + NGW : row; const float* src = (rn < NEXP ? eu + (size_t)rn * 1024 : ev + (size_t)(rn - NEXP) * 1024) + 16 * C.lane;
#pragma unroll
              for (int i = 0; i < 4; ++i) nv[i] = *(const f32x4*)(src + 4 * i); }
            {
                float ss = 0.f;
#pragma unroll
                for (int i = 0; i < 4; ++i) ss += (v[i].x * v[i].x + v[i].y * v[i].y) + (v[i].z * v[i].z + v[i].w * v[i].w);
                const float rms = sqrtf(wave_sum_fast(ss) * (1.f / 1024.f));
                const float step = rms > 0.f ? 0.335f * rms : 1.f, istep = 1.f / step;
                const int lofs = row < NEXP ? 0 : 8;
                u32x2 ow;
#pragma unroll
                for (int q = 0; q < 2; ++q) { unsigned w = 0u;
#pragma unroll
                    for (int jj = 0; jj < 4; ++jj) { const int nl = (int)fminf(fmaxf(floorf(v[2 * q][jj] * istep), -8.f), 7.f), nh = (int)fminf(fmaxf(floorf(v[2 * q + 1][jj] * istep), -8.f), 7.f);
                        w |= ((unsigned)((nl + lofs) & 15) | ((unsigned)(nh & 15) << 4)) << (8 * jj); }
                    ow[q] = w; }
                *(GAS u32x2*)(E8 + (size_t)(row >= NEXP ? 1 : 0) * (16u << 20) + (size_t)(C.lane >> 4) * (2u << 20) + (size_t)(row & (NEXP - 1)) * 128 + 8 * (C.lane & 15)) = ow;
                if (C.lane == 0) ES[row] = step;
            }
        }
    }
}

__device__ __forceinline__ void phase0b(Ctx& C, const Args& A) {
    const float* w_in = ((const float*)A.in[6]); const float* WE = (const float*)(C.ws + WS_WEFF); const unsigned* wmax = (const unsigned*)(C.ctl + CW_WMAX);
    unsigned char* W8 = C.ws + WS_WIN_T; float* CS = (float*)(C.ws + WS_CS);
    const int gt = C.vcu * NTHR + C.tid, NGT = C.G * NTHR;
    for (int n = gt; n < NPROJ; n += NGT) { const float mx = __uint_as_float(__hip_atomic_load(wmax + n, __ATOMIC_RELAXED, __HIP_MEMORY_SCOPE_AGENT)); CS[n] = mx > 0.f ? mx * (1.f / 127.f) : 1.f; }
    for (int it = gt; it < 64 * 3072; it += NGT) { const int kb = it / 3072, n = it - kb * 3072;
        const float mx = __uint_as_float(__hip_atomic_load(wmax + n, __ATOMIC_RELAXED, __HIP_MEMORY_SCOPE_AGENT)); const float sc = mx > 0.f ? 127.f / mx : 1.f;
        v4u ov;
#pragma unroll
        for (int q = 0; q < 4; ++q) { int b_[4];
#pragma unroll
            for (int i = 0; i < 4; ++i) b_[i] = (int)rintf(w_in[(size_t)(16 * kb + 4 * q + i) * NIN + n] * sc);
            ov[q] = (unsigned)(b_[0] & 0xff) | ((unsigned)(b_[1] & 0xff) << 8) | ((unsigned)(b_[2] & 0xff) << 16) | ((unsigned)(b_[3] & 0xff) << 24); }
        *(GAS v4u*)(W8 + (size_t)n * 1024 + 16 * kb) = ov; }
    {   const float* w_q = ((const float*)A.in[19]); unsigned char* Q8 = C.ws + WS_WQ_T; float* CSQ = (float*)(C.ws + WS_CSQ);
        for (int n = gt; n < NQP; n += NGT) { const float mx = __uint_as_float(__hip_atomic_load(wmax + NPROJ + n, __ATOMIC_RELAXED, __HIP_MEMORY_SCOPE_AGENT)); CSQ[n] = mx > 0.f ? mx * (1.f / 127.f) : 1.f; }
        for (int it = gt; it < 64 * 2048; it += NGT) { const int kb = it >> 11, n = it & 2047;
            const float mx = __uint_as_float(__hip_atomic_load(wmax + NPROJ + n, __ATOMIC_RELAXED, __HIP_MEMORY_SCOPE_AGENT)); const float sc = mx > 0.f ? 127.f / mx : 1.f;
            v4u ov;
#pragma unroll
            for (int q = 0; q < 4; ++q) { int b_[4];
#pragma unroll
                for (int i = 0; i < 4; ++i) b_[i] = (int)rintf(w_q[(size_t)(16 * kb + 4 * q + i) * NQP + n] * sc);
                ov[q] = (unsigned)(b_[0] & 0xff) | ((unsigned)(b_[1] & 0xff) << 8) | ((unsigned)(b_[2] & 0xff) << 16) | ((unsigned)(b_[3] & 0xff) << 24); }
            *(GAS v4u*)(Q8 + (size_t)n * 1024 + 16 * kb) = ov; }
    }
    for (int it = gt; it < 256 * 64; it += NGT) { const int j = it >> 6, kb = it & 63;
        const float mx = __uint_as_float(__hip_atomic_load(wmax + 3072 + j, __ATOMIC_RELAXED, __HIP_MEMORY_SCOPE_AGENT)); const float sc = mx > 0.f ? 127.f / mx : 1.f;
        v4u ov;
#pragma unroll
        for (int q = 0; q < 4; ++q) { const f32x4 w4 = *(const f32x4*)(WE + (size_t)j * 1024 + 16 * kb + 4 * q);
            const int b0 = (int)rintf(w4.x * sc), b1 = (int)rintf(w4.y * sc), b2 = (int)rintf(w4.z * sc), b3 = (int)rintf(w4.w * sc);
            ov[q] = (unsigned)(b0 & 0xff) | ((unsigned)(b1 & 0xff) << 8) | ((unsigned)(b2 & 0xff) << 16) | ((unsigned)(b3 & 0xff) << 24); }
        *(GAS v4u*)(W8 + (size_t)(3072 + j) * 1024 + 16 * kb) = ov; }
}

template <bool XBF, bool OUT8, bool PLANES = false> __device__ __forceinline__ void norm_mod_rows32(const float* X, const float* g, const float* sc, const float* sh, bf16* O, float* RS, int row0, int rstride, int lane,
                                                                   const int* pos, float* COS, float* SIN, float invf) {
    f32x4 gs[4], hs[4];
#pragma unroll
    for (int j = 0; j < 4; ++j) { const int cidx = 128 * (j >> 1) + 2 * lane + (j & 1); const f32x4 g4 = ((const f32x4*)g)[cidx], s4 = ((const f32x4*)sc)[cidx]; gs[j] = g4 * (s4 + 1.0f); hs[j] = ((const f32x4*)sh)[cidx]; }
    f32x4 nx[4], ny[4], nz[4];
#define NM_LOAD(dst, r) do { if (!XBF) { _Pragma("unroll") for (int j = 0; j < 4; ++j) dst[j] = ((const GAS f32x4*)(X + (size_t)(r) * DM))[128 * (j >> 1) + 2 * lane + (j & 1)]; } \
        else { _Pragma("unroll") for (int hf_ = 0; hf_ < 2; ++hf_) { const v4u w_ = ((const GAS v4u*)((const bf16*)X + (size_t)(r) * DM))[64 * hf_ + lane]; \
            dst[2 * hf_] = (f32x4){bf_lo(w_.x), bf_hi(w_.x), bf_lo(w_.y), bf_hi(w_.y)}; dst[2 * hf_ + 1] = (f32x4){bf_lo(w_.z), bf_hi(w_.z), bf_lo(w_.w), bf_hi(w_.w)}; } } } while (0)
    NM_LOAD(nx, row0); NM_LOAD(ny, row0 + rstride); NM_LOAD(nz, row0 + 2 * rstride);
#pragma unroll 1
    for (int i = 0; i < 32; ++i) {
        const int m = row0 + i * rstride, mn = row0 + (i < 29 ? i + 3 : 31) * rstride;
        f32x4 v[4];
#pragma unroll
        for (int j = 0; j < 4; ++j) { v[j] = nx[j]; nx[j] = ny[j]; ny[j] = nz[j]; }
        NM_LOAD(nz, mn);
        float s = 0.f;
#pragma unroll
        for (int j = 0; j < 4; ++j) s += (v[j].x * v[j].x + v[j].y * v[j].y) + (v[j].z * v[j].z + v[j].w * v[j].w);
        const float rinv = 1.0f / sqrtf(wave_sum_fast(s) * (1.f / 1024.f) + RMS_EPS);
        if (!OUT8) {
            GAS v4u* o16 = (GAS v4u*)(O + (size_t)m * DM) + lane;
#pragma unroll
            for (int hf = 0; hf < 2; ++hf) { const f32x4 y0 = v[2 * hf] * rinv * gs[2 * hf] + hs[2 * hf], y1 = v[2 * hf + 1] * rinv * gs[2 * hf + 1] + hs[2 * hf + 1];
                o16[64 * hf] = (v4u){cvtpk(y0.x, y0.y), cvtpk(y0.z, y0.w), cvtpk(y1.x, y1.y), cvtpk(y1.z, y1.w)}; }
        } else {
            f32x4 y[4]; float mx = 0.f;
#pragma unroll
            for (int j = 0; j < 4; ++j) { y[j] = v[j] * rinv * gs[j] + hs[j]; mx = fmaxf(mx, fmaxf(fmaxf(fabsf(y[j].x), fabsf(y[j].y)), fmaxf(fabsf(y[j].z), fabsf(y[j].w)))); }
            mx = fmaxf(mx, __int_as_float(__builtin_amdgcn_update_dpp(0, __float_as_int(mx), 0xb1, 0xf, 0xf, false)));
            mx = fmaxf(mx, __int_as_float(__builtin_amdgcn_update_dpp(0, __float_as_int(mx), 0x4e, 0xf, 0xf, false)));
            mx = fmaxf(mx, __int_as_float(__builtin_amdgcn_update_dpp(0, __float_as_int(mx), 0x124, 0xf, 0xf, false)));
            mx = fmaxf(mx, __int_as_float(__builtin_amdgcn_update_dpp(0, __float_as_int(mx), 0x128, 0xf, 0xf, false)));
            { auto r = __builtin_amdgcn_permlane16_swap(__float_as_uint(mx), __float_as_uint(mx), false, false); mx = fmaxf(__uint_as_float(r[0]), __uint_as_float(r[1])); }
            { auto r = __builtin_amdgcn_permlane32_swap(__float_as_uint(mx), __float_as_uint(mx), false, false); mx = fmaxf(__uint_as_float(r[0]), __uint_as_float(r[1])); }
            constexpr float QTOP = PLANES ? 119.f : 127.f;
            const float qs = mx > 0.f ? QTOP / mx : 1.f;
            GAS u32x2* o8 = (GAS u32x2*)((unsigned char*)O + (size_t)m * DM) + lane;
#pragma unroll
            for (int hf = 0; hf < 2; ++hf) { u32x2 w; unsigned pa = 0u, pb = 0u;
#pragma unroll
                for (int q = 0; q < 2; ++q) { const f32x4 yy = y[2 * hf + q]; const int b0 = (int)rintf(yy.x * qs), b1 = (int)rintf(yy.y * qs), b2 = (int)rintf(yy.z * qs), b3 = (int)rintf(yy.w * qs);
                    w[q] = (unsigned)(b0 & 0xff) | ((unsigned)(b1 & 0xff) << 8) | ((unsigned)(b2 & 0xff) << 16) | ((unsigned)(b3 & 0xff) << 24);
                    if (PLANES) { const int bb[4] = {b0, b1, b2, b3};
#pragma unroll
                        for (int jj = 0; jj < 4; ++jj) { pa |= (unsigned)(((bb[jj] + 8) >> 4) & 15) << (8 * jj + 4 * q); pb |= (unsigned)(bb[jj] & 15) << (8 * jj + 4 * q); } } }
                o8[64 * hf] = w;
                if (PLANES) {
                    GAS unsigned* hn = (GAS unsigned*)((unsigned char*)O + (WS_HN - WS_H) + (size_t)m * DM + 256 * (2 * hf + (lane >> 5)) + 32 * ((lane >> 2) & 7) + 4 * (lane & 3));
                    hn[0] = pa; hn[4] = pb; } }
            if (lane == 0) RS[m] = mx > 0.f ? mx * (1.f / QTOP) : 1.f;
        }
    }
#undef NM_LOAD
}
__device__ __forceinline__ void phase1(Ctx& C, const Args& A) {
    const float* x = ((const float*)A.in[0]); const int* pos = (const int*)((const float*)A.in[2]); const float* g = ((const float*)A.in[5]); const float* mod = (const float*)(C.ws + WS_MOD);
    bf16* H = (bf16*)(C.ws + WS_H); float* COS = (float*)(C.ws + WS_COS); float* SIN = (float*)(C.ws + WS_SIN);
    const int gw = C.vcu * NWAVES + C.wave, NGW = C.G * NWAVES;
    const float invf = __builtin_amdgcn_exp2f(-(float)(C.lane & 31) * 0.41524101186092029f);
    for (int ch = gw; ch < NTOK / 32; ch += NGW) { const int b = ch >> 6;
        norm_mod_rows32<false, true>(x, g, mod + b * NMOD + 1024, mod + b * NMOD, H, (float*)(C.ws + WS_RS1), 2048 * b + (ch & 63), 64, C.lane, pos, COS, SIN, invf); }
}
__device__ __forceinline__ void phase5(Ctx& C, const Args& A) {
    const float* x1 = (const float*)(C.ws + WS_X1); const float* g = ((const float*)A.in[18]); const float* mod = (const float*)(C.ws + WS_MOD); bf16* H = (bf16*)(C.ws + WS_H);
    const int gw = C.vcu * NWAVES + C.wave, NGW = C.G * NWAVES;
    for (int ch = gw; ch < NTOK / 32; ch += NGW) { const int b = ch >> 6;
        norm_mod_rows32<true, true, true>(x1, g, mod + b * NMOD + 4 * 1024, mod + b * NMOD + 3 * 1024, H, (float*)(C.ws + WS_RS2), 2048 * b + (ch & 63), 64, C.lane, nullptr, nullptr, nullptr, 0.f); }
}

__device__ __forceinline__ void phase2b(Ctx& C, const Args& A) {
    bf16* PROJ = (bf16*)(C.ws + WS_PROJ); const int* pos = (const int*)A.in[2];
    const float* qn = ((const float*)A.in[7]); const float* kn = ((const float*)A.in[8]);
    const int gw = C.vcu * NWAVES + C.wave, NGW = C.G * NWAVES, lane = C.lane;
    const int grp = lane >> 2, qd = lane & 3;
    float gain[16];
#pragma unroll
    for (int i = 0; i < 16; ++i) gain[i] = (grp < 8 ? qn : kn)[16 * qd + i] * (grp < 8 ? QSCALE : 1.0f);
    const float sgn = (qd < 2) ? -1.f : 1.f;
    float invf[16];
#pragma unroll
    for (int i = 0; i < 16; ++i) invf[i] = __builtin_amdgcn_exp2f(-(float)(16 * (qd & 1) + i) * 0.41524101186092029f);
    v4u n0, n1; int npos;
    { const int m0 = gw < NTOK ? gw : 0; const GAS v4u* p = (const GAS v4u*)(PROJ + (size_t)m0 * NPROJ + 16 * lane); n0 = p[0]; n1 = p[1]; npos = pos[m0]; }
    for (int m = gw; m < NTOK; m += NGW) {
        GAS v4u* p = (GAS v4u*)(PROJ + (size_t)m * NPROJ + 16 * lane);
        const v4u w0 = n0, w1 = n1; const int ipos = npos;
        { const int mn = m + NGW < NTOK ? m + NGW : m; const GAS v4u* pn = (const GAS v4u*)(PROJ + (size_t)mn * NPROJ + 16 * lane); n0 = pn[0]; n1 = pn[1]; npos = pos[mn]; }
        float xv[16];
        xv[0] = bf_lo(w0.x); xv[1] = bf_hi(w0.x); xv[2] = bf_lo(w0.y); xv[3] = bf_hi(w0.y); xv[4] = bf_lo(w0.z); xv[5] = bf_hi(w0.z); xv[6] = bf_lo(w0.w); xv[7] = bf_hi(w0.w);
        xv[8] = bf_lo(w1.x); xv[9] = bf_hi(w1.x); xv[10] = bf_lo(w1.y); xv[11] = bf_hi(w1.y); xv[12] = bf_lo(w1.z); xv[13] = bf_hi(w1.z); xv[14] = bf_lo(w1.w); xv[15] = bf_hi(w1.w);
        float ss = 0.f;
#pragma unroll
        for (int i = 0; i < 16; ++i) ss += xv[i] * xv[i];
        ss += __int_as_float(__builtin_amdgcn_update_dpp(0, __float_as_int(ss), 0xb1, 0xf, 0xf, false)); ss += __int_as_float(__builtin_amdgcn_update_dpp(0, __float_as_int(ss), 0x4e, 0xf, 0xf, false));
        const float rinv = 1.0f / sqrtf(ss * (1.f / 64.f) + RMS_EPS);
        const float fpos = (float)ipos;
        float cs[16], sn[16];
#pragma unroll
        for (int i = 0; i < 16; ++i) { const float ang = fpos * invf[i]; const float fr = __builtin_amdgcn_fractf(ang * 0.15915494309189535f);
            cs[i] = __builtin_amdgcn_cosf(fr); sn[i] = __builtin_amdgcn_sinf(fr); }
        float y[16];
#pragma unroll
        for (int i = 0; i < 16; ++i) { const float v = xv[i] * rinv * gain[i]; const float pv = __int_as_float(__builtin_amdgcn_update_dpp(0, __float_as_int(v), 0x4e, 0xf, 0xf, false)); y[i] = v * cs[i] + sgn * pv * sn[i]; }
        v4u o0, o1;
        o0.x = cvtpk(y[0], y[1]); o0.y = cvtpk(y[2], y[3]); o0.z = cvtpk(y[4], y[5]); o0.w = cvtpk(y[6], y[7]);
        o1.x = cvtpk(y[8], y[9]); o1.y = cvtpk(y[10], y[11]); o1.z = cvtpk(y[12], y[13]); o1.w = cvtpk(y[14], y[15]);
        p[0] = o0; p[1] = o1;
    }
}

constexpr int AT_KP = 144, AT_VP = 320;
constexpr int AT_K1 = 64 * AT_KP, AT_V = 2 * 64 * AT_KP, AT_STG = AT_V + 64 * AT_VP;
constexpr int AT_XP = 129;
constexpr int AT_YST = 66048, AT_YP = 272;
static_assert(4 * AT_STG <= MISC_OFF && 128 * AT_XP * 4 <= AT_YST && AT_YST + 128 * AT_YP <= 4 * AT_STG, "attention LDS map");

template <int ABL> __device__ __forceinline__ void attn_unit(Ctx& C, const Args& A, int bh, int qb, float lam) {
    const int b = bh >> 2, h = bh & 3;
    int tid_ = C.tid; asm volatile("" : "+v"(tid_));
    const int tid = tid_, lane = tid & 63, w = C.wave, r32 = lane & 31, hi = lane >> 5, mp = w >> 2, wq = w & 3;
    const bf16* P = (const bf16*)(C.ws + WS_PROJ) + (size_t)(b * SEQ) * NPROJ;
    const int NT = 2 * qb + 2;
    const int krow = tid >> 3, kch = tid & 7, vrow = tid >> 4, vch = tid & 15;
    const bf16* gk = P + (size_t)krow * NPROJ + C_DK + h * 128 + 8 * kch;
    const bf16* gv = P + (size_t)vrow * NPROJ + C_DV + h * 128 + 8 * vch;
    v4u skA0, skA1, svA0, svA1, skB0, skB1, svB0, svB1;
#define AT_LOAD(t, S) do { const size_t o_ = (size_t)(t) * 64 * NPROJ; sk##S##0 = *(const GAS v4u*)(gk + o_); sk##S##1 = *(const GAS v4u*)(gk + o_ + 64); \
        sv##S##0 = *(const GAS v4u*)(gv + o_); sv##S##1 = *(const GAS v4u*)(gv + o_ + (size_t)32 * NPROJ); } while (0)
#define AT_STORE(s, S) do { LAS unsigned char* bs_ = C.lds + (s) * AT_STG; *(LAS v4u*)(bs_ + krow * AT_KP + kch * 16) = sk##S##0; *(LAS v4u*)(bs_ + AT_K1 + krow * AT_KP + kch * 16) = sk##S##1; \
        *(LAS v4u*)(bs_ + AT_V + vrow * AT_VP + vch * 16) = sv##S##0; *(LAS v4u*)(bs_ + AT_V + (vrow + 32) * AT_VP + vch * 16) = sv##S##1; } while (0)
    AT_LOAD(0, A);
    AT_LOAD(1, B);
    const int qrow = qb * 128 + wq * 32 + r32;
    bf16x8 qf[4];
#pragma unroll
    for (int kk = 0; kk < 4; ++kk) qf[kk] = *(const GAS bf16x8*)(P + (size_t)qrow * NPROJ + C_DQ + h * 128 + mp * 64 + 16 * kk + 8 * hi);
    f32x16 o[4];
#pragma unroll
    for (int e = 0; e < 4; ++e)
#pragma unroll
        for (int r = 0; r < 16; ++r) o[e][r] = 0.f;
    float mrun = -1e30f, lrun = 0.f;
    AT_STORE(0, A); AT_STORE(1, B);
    if (2 < NT) { AT_LOAD(2, A); AT_LOAD(3, B); }
    __syncthreads();
    const int trbase = ((lane & 15) >> 2) * AT_VP + (16 * ((lane >> 4) & 1) + 4 * (lane & 3)) * 2;
#define AT_QKSM(t, stg, PW) do { \
        const LAS unsigned char* base = C.lds + (stg) * AT_STG; \
        f32x16 p0, p1; \
        _Pragma("unroll") for (int r = 0; r < 16; ++r) { p0[r] = 0.f; p1[r] = 0.f; } \
        const LAS unsigned char* kb_ = base + mp * AT_K1 + r32 * AT_KP + hi * 16; \
        bf16x8 ka_[4], kb2_[4]; \
        _Pragma("unroll") for (int kk = 0; kk < 4; ++kk) { ka_[kk] = *(const LAS bf16x8*)(kb_ + kk * 32); kb2_[kk] = *(const LAS bf16x8*)(kb_ + 32 * AT_KP + kk * 32); } \
        __builtin_amdgcn_s_setprio(1); \
        _Pragma("unroll") for (int kk = 0; kk < 4; ++kk) { p0 = MFMA32(ka_[kk], qf[kk], p0); p1 = MFMA32(kb2_[kk], qf[kk], p1); } \
        __builtin_amdgcn_s_setprio(0); \
        if ((t) >= 2 * qb) { \
            _Pragma("unroll") for (int r = 0; r < 16; ++r) { const int key = 64 * (t) + crow(r, hi); if (key > qrow) p0[r] = -1e30f; if (key + 32 > qrow) p1[r] = -1e30f; } } \
        float mx = fmaxf(p0[0], p1[0]); \
        _Pragma("unroll") for (int r = 1; r < 16; ++r) mx = fmaxf(mx, fmaxf(p0[r], p1[r])); \
        mx = pair_max(mx); \
        const float mnew = fmaxf(mrun, mx); \
        if (__any(mnew > mrun)) { const float alpha = __builtin_amdgcn_exp2f(mrun - mnew); mrun = mnew; lrun *= alpha; \
            _Pragma("unroll") for (int e = 0; e < 4; ++e) _Pragma("unroll") for (int r = 0; r < 16; ++r) o[e][r] *= alpha; } \
        float rs = 0.f; \
        _Pragma("unroll") for (int r = 0; r < 16; ++r) { p0[r] = __builtin_amdgcn_exp2f(p0[r] - mrun); p1[r] = __builtin_amdgcn_exp2f(p1[r] - mrun); rs += p0[r] + p1[r]; } \
        lrun += rs; \
        { v4u t0, t1, t2, t3; \
          t0.x = cvtpk(p0[0], p0[1]); t0.y = cvtpk(p0[2], p0[3]); t0.z = cvtpk(p0[4], p0[5]); t0.w = cvtpk(p0[6], p0[7]); \
          t1.x = cvtpk(p0[8], p0[9]); t1.y = cvtpk(p0[10], p0[11]); t1.z = cvtpk(p0[12], p0[13]); t1.w = cvtpk(p0[14], p0[15]); \
          t2.x = cvtpk(p1[0], p1[1]); t2.y = cvtpk(p1[2], p1[3]); t2.z = cvtpk(p1[4], p1[5]); t2.w = cvtpk(p1[6], p1[7]); \
          t3.x = cvtpk(p1[8], p1[9]); t3.y = cvtpk(p1[10], p1[11]); t3.z = cvtpk(p1[12], p1[13]); t3.w = cvtpk(p1[14], p1[15]); \
          PW[0] = __builtin_bit_cast(bf16x8, t0); PW[1] = __builtin_bit_cast(bf16x8, t1); PW[2] = __builtin_bit_cast(bf16x8, t2); PW[3] = __builtin_bit_cast(bf16x8, t3); } \
    } while (0)
#define AT_PV(stage, PW) do { const LAS unsigned char* vb_ = C.lds + (stage) * AT_STG + AT_V + trbase + (4 * hi) * AT_VP; \
        _Pragma("unroll") for (int e = 0; e < 4; ++e) { \
            v4i16_t lo[4], hi4[4]; \
            _Pragma("unroll") for (int s = 0; s < 4; ++s) { const LAS unsigned char* a_ = vb_ + (16 * s) * AT_VP + e * 64; lo[s] = tr16(a_); hi4[s] = tr16(a_ + 8 * AT_VP); } \
            __builtin_amdgcn_s_setprio(1); \
            _Pragma("unroll") for (int s = 0; s < 4; ++s) o[e] = MFMA32(mk8(lo[s], hi4[s]), PW[s], o[e]); \
            __builtin_amdgcn_s_setprio(0); \
            __builtin_amdgcn_sched_barrier(0); \
        } } while (0)
    bf16x8 pw[4];
    for (int t = 0; t < NT; t += 2) {
        AT_QKSM(t, t & 3, pw); __builtin_amdgcn_sched_barrier(0); AT_PV(t & 3, pw);
        if (t + 2 < NT) { AT_STORE((t + 2) & 3, A); if (t + 4 < NT) AT_LOAD(t + 4, A); }
        AT_QKSM(t + 1, (t + 1) & 3, pw); __builtin_amdgcn_sched_barrier(0); AT_PV((t + 1) & 3, pw);
        if (t + 3 < NT) { AT_STORE((t + 3) & 3, B); if (t + 5 < NT) AT_LOAD(t + 5, B); }
        __syncthreads();
    }
    __syncthreads();
#undef AT_QKSM
#undef AT_PV
    lrun = pair_sum(lrun);
    const float linv = 1.0f / lrun;
    LAS float* xch = (LAS float*)C.lds;
    if (mp == 1) {
#pragma unroll
        for (int e = 0; e < 4; ++e)
#pragma unroll
            for (int r = 0; r < 16; ++r) xch[(wq * 32 + r32) * AT_XP + 32 * e + crow(r, hi)] = o[e][r] * linv;
    }
    __syncthreads();
    if (mp == 0 && ABL != 0) { asm volatile("" :: "v"(o[0]), "v"(o[1]), "v"(o[2]), "v"(o[3]), "v"(lrun)); }
    if (mp == 0 && ABL == 0) {
        const float* sg = ((const float*)A.in[13]);
        float ss = 0.f;
#pragma unroll
        for (int e = 0; e < 4; ++e)
#pragma unroll
            for (int r = 0; r < 16; ++r) { const float v = o[e][r] * linv - lam * xch[(wq * 32 + r32) * AT_XP + 32 * e + crow(r, hi)]; o[e][r] = v; ss += v * v; }
        ss = pair_sum(ss);
        const float rinv = (1.0f - LAMBDA_INIT) / sqrtf(ss * (1.f / 128.f) + RMS_EPS);
        LAS unsigned char* yst = C.lds + AT_YST + (wq * 32 + r32) * AT_YP;
#pragma unroll
        for (int e = 0; e < 4; ++e)
#pragma unroll
            for (int g = 0; g < 4; ++g) { const int ec = 32 * e + 8 * g + 4 * hi; const f32x4 g4 = *(const f32x4*)(sg + ec);
                u32x2 ov; ov.x = cvtpk(o[e][4 * g] * rinv * g4.x, o[e][4 * g + 1] * rinv * g4.y); ov.y = cvtpk(o[e][4 * g + 2] * rinv * g4.z, o[e][4 * g + 3] * rinv * g4.w);
                *(LAS u32x2*)(yst + ec * 2) = ov; }
    }
    __syncthreads();
    if (ABL == 0) {
        bf16* Y = (bf16*)(C.ws + WS_Y) + (size_t)(b * SEQ + qb * 128) * DM + h * 128;
#pragma unroll
        for (int i = 0; i < 4; ++i) { const int idx = tid + i * NTHR, row = idx >> 4, ch = idx & 15;
            *(GAS v4u*)(Y + (size_t)row * DM + 8 * ch) = *(const LAS v4u*)(C.lds + AT_YST + row * AT_YP + ch * 16); }
    }
    __syncthreads();
#undef AT_LOAD
#undef AT_STORE
}

constexpr int GL_BC = 0;
constexpr int GL_QE = 17408, GL_KE = GL_QE + 9216, GL_QS = GL_KE + 9216, GL_AM = GL_QS + 9216;
constexpr int GL_KD = GL_AM + 9216;
constexpr int GL_V = GL_KD + 12288;
constexpr int GL_SB = GL_V + 20480;
constexpr int GL_O = GL_SB + 20480;
constexpr int GL_SM = GL_O + 33792;
constexpr int GL_END = GL_SM + 768 + 2048;
static_assert(GL_END <= MISC_OFF, "GLA LDS map");

__device__ __forceinline__ void gla_unit(Ctx& C, const Args& A, int bh) {
    const int b = bh >> 2, h = bh & 3;
    int tid_ = C.tid; asm volatile("" : "+v"(tid_));
    const int tid = tid_, lane = tid & 63, w = C.wave, r32 = lane & 31, hi = lane >> 5;
    const bf16* P = (const bf16*)(C.ws + WS_PROJ) + (size_t)(b * SEQ) * NPROJ;
    bf16* Y = (bf16*)(C.ws + WS_Y) + (size_t)(b * SEQ) * DM + 512 + h * 128;
    LAS unsigned char* L = C.lds;
    LAS float* BC = (LAS float*)(L + GL_BC); LAS float* BMID = (LAS float*)(L + GL_SM); LAS float* BLAST = BMID + 64; LAS float* DEC = BMID + 128; LAS float* SEG = BMID + 192;
    LAS float* OI = (LAS float*)(L + GL_O);
    const float bg = ((const float*)A.in[15])[h * 64 + (tid & 63)];
    const int db = w & 1, eb = w >> 1;
    f32x16 S;
#pragma unroll
    for (int r = 0; r < 16; ++r) S[r] = 0.f;
    const int trq = (lane & 15) >> 2, trc = 16 * ((lane >> 4) & 1) + 4 * (lane & 3);
    unsigned short pre_n[8]; v4u q_n, k_n, v_n[2], r_n[2];
#define GL_FETCH(n_) do { const bf16* Pf_ = P + (size_t)((n_) * 64) * NPROJ; \
        _Pragma("unroll") for (int i = 0; i < 8; ++i) pre_n[i] = *(const GAS unsigned short*)(Pf_ + (size_t)(8 * (tid >> 6) + i) * NPROJ + C_GG + h * 64 + (tid & 63)); \
        q_n = *(const GAS v4u*)(Pf_ + (size_t)(tid >> 3) * NPROJ + C_GQ + h * 64 + 8 * (tid & 7)); k_n = *(const GAS v4u*)(Pf_ + (size_t)(tid >> 3) * NPROJ + C_GK + h * 64 + 8 * (tid & 7)); \
        _Pragma("unroll") for (int i = 0; i < 2; ++i) { const int idx_ = tid + i * NTHR; v_n[i] = *(const GAS v4u*)(Pf_ + (size_t)(idx_ >> 4) * NPROJ + C_GV + h * 128 + 8 * (idx_ & 15)); } \
        { const GAS v4u* rp_ = (const GAS v4u*)(Pf_ + (size_t)(tid >> 3) * NPROJ + C_GR + h * 128 + 16 * (tid & 7)); r_n[0] = rp_[0]; r_n[1] = rp_[1]; } } while (0)
    GL_FETCH(0);
    for (int n = 0; n < 32; ++n) {
        unsigned short pre_c[8]; v4u q_c = q_n, k_c = k_n, v_c[2] = {v_n[0], v_n[1]}, r_c[2] = {r_n[0], r_n[1]};
#pragma unroll
        for (int i = 0; i < 8; ++i) pre_c[i] = pre_n[i];
        GL_FETCH(n < 31 ? n + 1 : 31);
        {   const int d = tid & 63, seg = tid >> 6; float pre[8];
#pragma unroll
            for (int i = 0; i < 8; ++i) pre[i] = __uint_as_float((unsigned)pre_c[i] << 16);
            float run = 0.f;
#pragma unroll
            for (int i = 0; i < 8; ++i) { const float z = pre[i] + bg; const float ls = fminf(z, 0.f) - __logf(1.0f + __expf(-fabsf(z))); run += ls * (1.f / 16.f); pre[i] = run; }
            SEG[seg * 64 + d] = run;
            __syncthreads();
            float off = 0.f;
#pragma unroll
            for (int s = 0; s < 8; ++s) off += (s < seg) ? SEG[s * 64 + d] : 0.f;
#pragma unroll
            for (int i = 0; i < 8; ++i) { const float v = pre[i] + off; BC[(8 * seg + i) * 68 + d] = v;
                if (8 * seg + i == 32) BMID[d] = v;
                if (8 * seg + i == 63) { BLAST[d] = v; DEC[d] = __expf(v); } }
            __syncthreads();
        }
        {   const int c = tid >> 3, d8 = tid & 7;
            const v4u qw = q_c, kw = k_c;
            const unsigned qa[4] = {qw.x, qw.y, qw.z, qw.w}, ka[4] = {kw.x, kw.y, kw.z, kw.w};
            const f32x4 bc0 = *(const LAS f32x4*)(BC + c * 68 + 8 * d8), bc1 = *(const LAS f32x4*)(BC + c * 68 + 8 * d8 + 4);
            const f32x4 bm0 = *(const LAS f32x4*)(BMID + 8 * d8), bm1 = *(const LAS f32x4*)(BMID + 8 * d8 + 4);
            const f32x4 bl0 = *(const LAS f32x4*)(BLAST + 8 * d8), bl1 = *(const LAS f32x4*)(BLAST + 8 * d8 + 4);
            const float bcv[8] = {bc0.x, bc0.y, bc0.z, bc0.w, bc1.x, bc1.y, bc1.z, bc1.w}, bmv[8] = {bm0.x, bm0.y, bm0.z, bm0.w, bm1.x, bm1.y, bm1.z, bm1.w}, blv[8] = {bl0.x, bl0.y, bl0.z, bl0.w, bl1.x, bl1.y, bl1.z, bl1.w};
            float qe[8], ke[8], qs[8], kd[8];
#pragma unroll
            for (int i = 0; i < 8; ++i) { const float q = ((i & 1) ? bf_hi(qa[i >> 1]) : bf_lo(qa[i >> 1])) * 0.125f, k = (i & 1) ? bf_hi(ka[i >> 1]) : bf_lo(ka[i >> 1]);
                qe[i] = q * __expf(bcv[i] - bmv[i]); ke[i] = k * __expf(bmv[i] - bcv[i]); qs[i] = q * __expf(bcv[i]); kd[i] = k * __expf(blv[i] - bcv[i]); }
            v4u o_;
            o_.x = cvtpk(qe[0], qe[1]); o_.y = cvtpk(qe[2], qe[3]); o_.z = cvtpk(qe[4], qe[5]); o_.w = cvtpk(qe[6], qe[7]); *(LAS v4u*)(L + GL_QE + c * 144 + d8 * 16) = o_;
            o_.x = cvtpk(ke[0], ke[1]); o_.y = cvtpk(ke[2], ke[3]); o_.z = cvtpk(ke[4], ke[5]); o_.w = cvtpk(ke[6], ke[7]); *(LAS v4u*)(L + GL_KE + c * 144 + d8 * 16) = o_;
            o_.x = cvtpk(qs[0], qs[1]); o_.y = cvtpk(qs[2], qs[3]); o_.z = cvtpk(qs[4], qs[5]); o_.w = cvtpk(qs[6], qs[7]); *(LAS v4u*)(L + GL_QS + c * 144 + d8 * 16) = o_;
            o_.x = cvtpk(kd[0], kd[1]); o_.y = cvtpk(kd[2], kd[3]); o_.z = cvtpk(kd[4], kd[5]); o_.w = cvtpk(kd[6], kd[7]); *(LAS v4u*)(L + GL_KD + c * 192 + d8 * 16) = o_;
#pragma unroll
            for (int i = 0; i < 2; ++i) { const int idx = tid + i * NTHR, row = idx >> 4, ch = idx & 15;
                *(LAS v4u*)(L + GL_V + row * 320 + ch * 16) = v_c[i]; }
#pragma unroll
            for (int r = 0; r < 16; ++r) *(LAS unsigned short*)(L + GL_SB + (32 * db + crow(r, hi)) * 320 + (32 * eb + r32) * 2) = (unsigned short)(cvtpk(S[r], 0.f) & 0xffffu);
            __syncthreads();
        }
        if (w < 4) {
            const int cb = w & 1, jb = w >> 1; f32x16 a;
#pragma unroll
            for (int r = 0; r < 16; ++r) a[r] = 0.f;
#pragma unroll
            for (int kk = 0; kk < 4; ++kk) { const bf16x8 fa = *(const LAS bf16x8*)(L + GL_QE + (32 * cb + r32) * 144 + (16 * kk + 8 * hi) * 2), fb = *(const LAS bf16x8*)(L + GL_KE + (32 * jb + r32) * 144 + (16 * kk + 8 * hi) * 2);
                a = MFMA32(fa, fb, a); }
#pragma unroll
            for (int r = 0; r < 16; ++r) { const int cc = 32 * cb + crow(r, hi), jj = 32 * jb + r32; const float v = (jj <= cc) ? a[r] : 0.f;
                *(LAS unsigned short*)(L + GL_AM + cc * 144 + jj * 2) = (unsigned short)(cvtpk(v, 0.f) & 0xffffu); }
        }
        {
#pragma unroll
            for (int r = 0; r < 16; ++r) S[r] *= DEC[32 * db + crow(r, hi)];
#pragma unroll
            for (int kk = 0; kk < 4; ++kk) { const LAS unsigned char* pa = L + GL_KD + (16 * kk + 8 * hi + trq) * 192 + (32 * db + trc) * 2; const LAS unsigned char* pb = L + GL_V + (16 * kk + 8 * hi + trq) * 320 + (32 * eb + trc) * 2;
                const bf16x8 fa = mk8(tr16(pa), tr16(pa + 4 * 192)), fb = mk8(tr16(pb), tr16(pb + 4 * 320));
                S = MFMA32(fa, fb, S); }
        }
        __syncthreads();
        {   const int cb = w & 1; f32x16 a;
#pragma unroll
            for (int r = 0; r < 16; ++r) a[r] = 0.f;
#pragma unroll
            for (int kk = 0; kk < 4; ++kk) { const bf16x8 fa = *(const LAS bf16x8*)(L + GL_AM + (32 * cb + r32) * 144 + (16 * kk + 8 * hi) * 2);
                const LAS unsigned char* pb = L + GL_V + (16 * kk + 8 * hi + trq) * 320 + (32 * eb + trc) * 2;
                a = MFMA32(fa, mk8(tr16(pb), tr16(pb + 4 * 320)), a); }
#pragma unroll
            for (int kk = 0; kk < 4; ++kk) { const bf16x8 fa = *(const LAS bf16x8*)(L + GL_QS + (32 * cb + r32) * 144 + (16 * kk + 8 * hi) * 2);
                const LAS unsigned char* pb = L + GL_SB + (16 * kk + 8 * hi + trq) * 320 + (32 * eb + trc) * 2;
                a = MFMA32(fa, mk8(tr16(pb), tr16(pb + 4 * 320)), a); }
#pragma unroll
            for (int r = 0; r < 16; ++r) OI[(32 * cb + crow(r, hi)) * 132 + 32 * eb + r32] = a[r];
        }
        __syncthreads();
        {   const int c = tid >> 3, e8 = tid & 7; float ov[16];
#pragma unroll
            for (int i = 0; i < 4; ++i) { const f32x4 t4 = *(const LAS f32x4*)(OI + c * 132 + 16 * e8 + 4 * i); ov[4 * i] = t4.x; ov[4 * i + 1] = t4.y; ov[4 * i + 2] = t4.z; ov[4 * i + 3] = t4.w; }
            float ss = 0.f;
#pragma unroll
            for (int i = 0; i < 16; ++i) ss += ov[i] * ov[i];
            ss += __shfl_xor(ss, 1); ss += __shfl_xor(ss, 2); ss += __shfl_xor(ss, 4);
            const float rinv = 1.0f / sqrtf(ss * (1.f / 128.f) + RMS_EPS);
            const v4u r0 = r_c[0], r1 = r_c[1]; const unsigned ra[8] = {r0.x, r0.y, r0.z, r0.w, r1.x, r1.y, r1.z, r1.w};
            const float* gg = ((const float*)A.in[16]) + 16 * e8; float y[16];
#pragma unroll
            for (int i = 0; i < 16; ++i) { const float rv = (i & 1) ? bf_hi(ra[i >> 1]) : bf_lo(ra[i >> 1]); y[i] = ov[i] * rinv * gg[i] * (rv / (1.f + __expf(-rv))); }
            v4u o0, o1;
            o0.x = cvtpk(y[0], y[1]); o0.y = cvtpk(y[2], y[3]); o0.z = cvtpk(y[4], y[5]); o0.w = cvtpk(y[6], y[7]);
            o1.x = cvtpk(y[8], y[9]); o1.y = cvtpk(y[10], y[11]); o1.z = cvtpk(y[12], y[13]); o1.w = cvtpk(y[14], y[15]);
            GAS v4u* yp = (GAS v4u*)(Y + (size_t)(n * 64 + c) * DM + 16 * e8); yp[0] = o0; yp[1] = o1;
        }
    }
#undef GL_FETCH
    __syncthreads();
}

template <int ABL> __device__ __forceinline__ void phase3(Ctx& C, const Args& A, int rep) {
    float lam;
    {   const float a = ((const float*)A.in[9])[C.lane] * ((const float*)A.in[10])[C.lane], b2 = ((const float*)A.in[11])[C.lane] * ((const float*)A.in[12])[C.lane];
        lam = __expf(wave_sum(a)) - __expf(wave_sum(b2)) + LAMBDA_INIT; }
    constexpr int NITEM = 128 + 2048;
    for (;;) {
        if (C.tid == 0) C.MISC[0] = __hip_atomic_fetch_add(C.ctl + CW_Q + 64 * rep, 1u, __ATOMIC_RELAXED, __HIP_MEMORY_SCOPE_AGENT);
        __syncthreads();
        const int item = (int)C.MISC[0];
        __syncthreads();
        if (item >= NITEM) break;
        if (item < 128) { if (ABL == 0) gla_unit(C, A, item); }
        else { const int idx = item - 128; attn_unit<ABL>(C, A, idx & 127, 15 - (idx >> 7), lam); }
    }
}

constexpr int PK_P = 272;
constexpr int PK_BYTES = 128 * PK_P;
constexpr int PS_PITCH = 132, PS_EIDX = 2 * PK_BYTES, PS_EG = PS_EIDX + 64 * PS_PITCH * 4;
static_assert(PS_EG + 64 * PS_PITCH * 4 <= MISC_OFF, "PEER score LDS map");
#define CE_DESC(a, b) do { const float mx_ = fmaxf(a, b), mn_ = fminf(a, b); a = mx_; b = mn_; } while (0)
__device__ __forceinline__ void sort16_desc(float* v) {
#pragma unroll
    for (int k = 2; k <= 16; k *= 2)
#pragma unroll
        for (int j = k / 2; j > 0; j /= 2)
#pragma unroll
            for (int i = 0; i < 16; ++i) { const int l = i ^ j; if (l > i) { if ((i & k) == 0) CE_DESC(v[i], v[l]); else CE_DESC(v[l], v[i]); } }
}
__device__ __forceinline__ void bitonic_merge16_desc(float* v) {
#pragma unroll
    for (int j = 8; j > 0; j /= 2)
#pragma unroll
        for (int i = 0; i < 16; ++i) { const int l = i ^ j; if (l > i) CE_DESC(v[i], v[l]); }
}
__device__ __forceinline__ void merge_top16(float* a, const float* b) {
#pragma unroll
    for (int i = 0; i < 16; ++i) a[i] = fmaxf(a[i], b[15 - i]);
    bitonic_merge16_desc(a);
}
__device__ __forceinline__ void top16_pair64(float (&v)[64], float (&out)[16], int hi) {
    sort16_desc(v); sort16_desc(v + 16); sort16_desc(v + 32); sort16_desc(v + 48);
    merge_top16(v, v + 16); merge_top16(v + 32, v + 48); merge_top16(v, v + 32);
#pragma unroll
    for (int i = 0; i < 8; ++i) { const float p = v[i], q = v[15 - i]; v[i] = hi ? q : p; v[15 - i] = hi ? p : q; }
#pragma unroll
    for (int i = 0; i < 16; ++i) out[i] = pair_max(v[i]);
    bitonic_merge16_desc(out);
}

template <int SABL> __device__ __forceinline__ void peer_scores(Ctx& C, const Args& A, int t0) {
    const int lane = C.lane, w = C.wave, r32 = lane & 31, hi = lane >> 5;
    const bf16* QP = (const bf16*)(C.ws + WS_PROJ);
    int* EIDX = (int*)(C.ws + WS_EIDX); float* EG = (float*)(C.ws + WS_EG);
#pragma unroll 1
    for (int tb = 0; tb < 2; ++tb) {
        const int t = t0 + 32 * tb + r32;
        float tv[2][16];
#pragma unroll 1
        for (int half = 0; half < 2; ++half) {
            bf16x8 qf[8];
#pragma unroll
            for (int kk = 0; kk < 8; ++kk) qf[kk] = *(const GAS bf16x8*)(QP + (size_t)(SABL ? t0 : t) * NQP + w * 256 + half * 128 + 16 * kk + 8 * hi);
            float sv[64];
#pragma unroll
            for (int kb = 0; kb < 4; ++kb) { f32x16 s;
#pragma unroll
                for (int r = 0; r < 16; ++r) s[r] = 0.f;
#pragma unroll
                for (int kk = 0; kk < 8; ++kk) { const bf16x8 a = *(const LAS bf16x8*)(C.lds + half * PK_BYTES + (32 * kb + r32) * PK_P + (16 * kk + 8 * hi) * 2); s = MFMA32(a, qf[kk], s); }
#pragma unroll
                for (int r = 0; r < 16; ++r) sv[16 * kb + r] = __uint_as_float((__float_as_uint(s[r]) & ~127u) | (unsigned)(32 * kb + crow(r, hi))); }
            float to[16];
            if (SABL == 2) {
#pragma unroll
                for (int i = 0; i < 16; ++i) to[i] = sv[i] + sv[16 + i] + sv[32 + i] + sv[48 + i]; }
            else top16_pair64(sv, to, hi);
            if (half == 0) {
#pragma unroll
                for (int i = 0; i < 16; ++i) tv[0][i] = to[i];
            } else {
#pragma unroll
                for (int i = 0; i < 16; ++i) tv[1][i] = to[i];
            }
        }
        float cv[32];
#define PEER_CAND(k, a0, b0, a1, b1) do { const float s0_ = tv[0][a0] + tv[1][b0], s1_ = tv[0][a1] + tv[1][b1]; \
            const unsigned e0_ = ((__float_as_uint(tv[0][a0]) & 127u) << 7) | (__float_as_uint(tv[1][b0]) & 127u), e1_ = ((__float_as_uint(tv[0][a1]) & 127u) << 7) | (__float_as_uint(tv[1][b1]) & 127u); \
            const float s_ = hi ? s1_ : s0_; const unsigned e_ = hi ? e1_ : e0_; cv[k] = __uint_as_float((__float_as_uint(s_) & ~0x3FFFu) | e_); } while (0)
        PEER_CAND(0, 0, 0, 2, 1);
        PEER_CAND(1, 0, 1, 2, 2);
        PEER_CAND(2, 0, 2, 2, 3);
        PEER_CAND(3, 0, 3, 2, 4);
        PEER_CAND(4, 0, 4, 3, 0);
        PEER_CAND(5, 0, 5, 3, 1);
        PEER_CAND(6, 0, 6, 3, 2);
        PEER_CAND(7, 0, 7, 3, 3);
        PEER_CAND(8, 0, 8, 4, 0);
        PEER_CAND(9, 0, 9, 4, 1);
        PEER_CAND(10, 0, 10, 4, 2);
        PEER_CAND(11, 0, 11, 5, 0);
        PEER_CAND(12, 0, 12, 5, 1);
        PEER_CAND(13, 0, 13, 6, 0);
        PEER_CAND(14, 0, 14, 6, 1);
        PEER_CAND(15, 0, 15, 7, 0);
        PEER_CAND(16, 1, 0, 7, 1);
        PEER_CAND(17, 1, 1, 8, 0);
        PEER_CAND(18, 1, 2, 9, 0);
        PEER_CAND(19, 1, 3, 10, 0);
        PEER_CAND(20, 1, 4, 11, 0);
        PEER_CAND(21, 1, 5, 12, 0);
        PEER_CAND(22, 1, 6, 13, 0);
        PEER_CAND(23, 1, 7, 14, 0);
        PEER_CAND(24, 2, 0, 15, 0);
#undef PEER_CAND
#pragma unroll
        for (int k = 25; k < 32; ++k) cv[k] = -INFINITY;
        sort16_desc(cv); sort16_desc(cv + 16); merge_top16(cv, cv + 16);
#pragma unroll
        for (int i = 0; i < 8; ++i) { const float p = cv[i], q = cv[15 - i]; cv[i] = hi ? q : p; cv[15 - i] = hi ? p : q; }
        float selv[16]; int sele[16];
#pragma unroll
        for (int i = 0; i < 16; ++i) selv[i] = pair_max(cv[i]);
        bitonic_merge16_desc(selv);
#pragma unroll
        for (int k = 0; k < 16; ++k) { const unsigned b_ = __float_as_uint(selv[k]); sele[k] = (int)(b_ & 0x3FFFu); selv[k] = __uint_as_float(b_ & ~0x3FFFu); }
        float ex[16], sum = 0.f;
#pragma unroll
        for (int k = 0; k < 16; ++k) { ex[k] = __expf(selv[k] - selv[0]); sum += ex[k]; }
        const float inv = 1.0f / sum;
        if (hi == 0) { LAS int* p = (LAS int*)(C.lds + PS_EIDX) + (32 * tb + r32) * PS_PITCH + 2 * w;
#pragma unroll
            for (int kk = 0; kk < 16; ++kk) p[16 * (kk & 7) + (kk >> 3)] = sele[kk]; }
        else { LAS float* p = (LAS float*)(C.lds + PS_EG) + (32 * tb + r32) * PS_PITCH + 2 * w;
#pragma unroll
            for (int kk = 0; kk < 16; ++kk) p[16 * (kk & 7) + (kk >> 3)] = ex[kk] * inv; }
    }
}

__device__ __forceinline__ float gelu_erf(float v) {
    const float av = fabsf(v), t = __builtin_amdgcn_rcpf(av * 0.2316418882f + 1.0f);
    float q = t * 0.5307027145f + (-0.7265760135f); q = q * t + 0.7107068705f; q = q * t + (-0.142248368f); q = q * t + 0.127414796f; q = q * t;
    const float e = __builtin_amdgcn_exp2f((v * v) * (-0.72134752044f));
    const float m = v * (q * e);
    return v < 0.f ? m : v - m;
}
__device__ __forceinline__ float dpp_sum8(float x) {
    x += __int_as_float(__builtin_amdgcn_update_dpp(0, __float_as_int(x), 0xb1, 0xf, 0xf, false));
    x += __int_as_float(__builtin_amdgcn_update_dpp(0, __float_as_int(x), 0x4e, 0xf, 0xf, false));
    x += __int_as_float(__builtin_amdgcn_update_dpp(0, __float_as_int(x), 0x141, 0xf, 0xf, false));
    return x;
}
#define PG_PIN16(a) asm volatile("" : "+v"(a[0]), "+v"(a[1]), "+v"(a[2]), "+v"(a[3]), "+v"(a[4]), "+v"(a[5]), "+v"(a[6]), "+v"(a[7]), "+v"(a[8]), "+v"(a[9]), "+v"(a[10]), "+v"(a[11]), "+v"(a[12]), "+v"(a[13]), "+v"(a[14]), "+v"(a[15]))
#define PG_CVT(w, f) do { _Pragma("unroll") for (int d_ = 0; d_ < 4; ++d_) { const f32x2_t lo_ = __builtin_amdgcn_cvt_pk_f32_fp8((int)(w)[d_], false), hi_ = __builtin_amdgcn_cvt_pk_f32_fp8((int)(w)[d_], true); \
        f[4 * d_] = lo_.x; f[4 * d_ + 1] = lo_.y; f[4 * d_ + 2] = hi_.x; f[4 * d_ + 3] = hi_.y; } } while (0)

template <int SABL> __device__ __forceinline__ void phase_peer_scores(Ctx& C, const Args& A) {
    {
        const bf16* KB = (const bf16*)(C.ws + WS_KEYS);
        for (int idx = C.tid; idx < 2 * 128 * 16; idx += NTHR) { const int set = idx >> 11, row = (idx >> 4) & 127, ch = idx & 15;
            *(LAS v4u*)(C.lds + set * PK_BYTES + row * PK_P + ch * 16) = *(const GAS v4u*)(KB + (size_t)set * 16384 + row * 128 + ch * 8); }
        __syncthreads();
    }
    for (int tile = C.vcu; tile < NTOK / 64; tile += C.G) {
        peer_scores<SABL>(C, A, tile * 64);
        __syncthreads();
        unsigned short* EIDX = (unsigned short*)(C.ws + WS_EIDX) + (size_t)tile * 64 * 128; float* EG = (float*)(C.ws + WS_EG) + (size_t)tile * 64 * 128;
#pragma unroll
        for (int i = 0; i < 2; ++i) { const int idx = C.tid + i * NTHR, row = idx >> 4, ch = idx & 15;
            const v4u a = *(const LAS v4u*)(C.lds + PS_EIDX + (row * PS_PITCH + 8 * ch) * 4), b = *(const LAS v4u*)(C.lds + PS_EIDX + (row * PS_PITCH + 8 * ch + 4) * 4);
            *(GAS v4u*)(EIDX + row * 128 + 8 * ch) = (v4u){a.x | (a.y << 16), a.z | (a.w << 16), b.x | (b.y << 16), b.z | (b.w << 16)}; }
#pragma unroll
        for (int i = 0; i < 4; ++i) { const int idx = C.tid + i * NTHR, row = idx >> 5, ch = idx & 31;
            *(GAS v4u*)(EG + row * 128 + 4 * ch) = *(const LAS v4u*)(C.lds + PS_EG + (row * PS_PITCH + 4 * ch) * 4); }
        __syncthreads();
    }
}

template <int MODE> __device__ __forceinline__ void phase_peer_u(Ctx& C, const Args& A) {
    int lane_ = C.lane; asm volatile("" : "+v"(lane_)); const int lane = lane_;
    const int x = C.sx >> 1, j = ((C.sx & 1) << 5) | C.sj, g = lane >> 3, c = lane & 7;
    const unsigned char* HN = C.ws + WS_HN + 256 * x + 32 * c;
    const float* RS = (const float*)(C.ws + WS_RS2);
    const unsigned short* EIDX = (const unsigned short*)(C.ws + WS_EIDX) + 16 * g;
    bf16* PD = (bf16*)(C.ws + WS_PD) + (size_t)x * NTOK * 128 + 16 * g;
    const __amdgpu_buffer_rsrc_t RU = __builtin_amdgcn_make_buffer_rsrc((void*)(C.ws + WS_EU + (size_t)x * (2u << 20)), 0, 2 << 20, 0x00020000);
    const int t0 = 1024 * j + 128 * C.wave, tlast = t0 + 127;
    const int kb_ = 8 * ((c >> 2) & 1) + 4 * ((c >> 1) & 1) + 2 * (c & 1);
    v4u en[2]; v4u han, hbn, haA, hbA, haB, hbB; float h1n, hA1, hB1;
    v4u rA[16], rB[16];
#define PU_LDE(t) do { en[0] = *(const GAS v4u*)(EIDX + (size_t)(t) * 128); en[1] = *(const GAS v4u*)(EIDX + (size_t)(t) * 128 + 8); \
        han = *(const GAS v4u*)(HN + (size_t)(t) * DM); hbn = *(const GAS v4u*)(HN + (size_t)(t) * DM + 16); h1n = *(const GAS float*)(RS + (t)); } while (0)
#define PU_LDR(R) do { _Pragma("unroll") for (int k = 0; k < 16; ++k) { const unsigned w_ = en[k >> 3][(k >> 1) & 3]; const int ek_ = (int)((k & 1) ? (w_ >> 16) : (w_ & 0xffffu)); \
        R[k] = __builtin_bit_cast(v4u, __builtin_amdgcn_raw_buffer_load_b128(RU, ek_ * 128 + 16 * c, 0, 0)); } } while (0)
#define PU_COMP(R, ha, hb, h1, t) do { const float hinv = h1; const int pa_[4] = {(int)ha.x, (int)ha.y, (int)ha.z, (int)ha.w}, pb_[4] = {(int)hb.x, (int)hb.y, (int)hb.z, (int)hb.w}; \
        __builtin_amdgcn_sched_barrier(0); \
          \
        int sa_ = 0, sb_ = 0; \
        _Pragma("unroll") for (int d = 0; d < 4; ++d) { sa_ = __builtin_amdgcn_sdot8(pa_[d], 0x11111111, sa_, false); sb_ = __builtin_amdgcn_sdot8(pb_[d], 0x11111111, sb_, false); } \
        const float corr_ = dpp_sum8((float)((sa_ << 4) + sb_)) * (0.5f * hinv); \
        int ia_[16]; \
        _Pragma("unroll") for (int k = 0; k < 16; ++k) { asm volatile("" : "+v"(R[k])); int a_ = 0, b_ = 0; \
            _Pragma("unroll") for (int d = 0; d < 4; ++d) { a_ = __builtin_amdgcn_sdot8((int)R[k][d], pa_[d], a_, false); b_ = __builtin_amdgcn_sdot8((int)R[k][d], pb_[d], b_, false); } \
            ia_[k] = (a_ << 4) + b_; } \
          \
        int ib_[8], ic_[4], id0_, id1_; \
        { const bool b2 = (lane & 4) != 0, b1 = (lane & 2) != 0, b0 = (lane & 1) != 0; \
          _Pragma("unroll") for (int k = 0; k < 8; ++k) { const int keep = b2 ? ia_[k + 8] : ia_[k], send = b2 ? ia_[k] : ia_[k + 8]; ib_[k] = keep + __builtin_amdgcn_update_dpp(0, send, 0x141, 0xf, 0xf, false); } \
          _Pragma("unroll") for (int k = 0; k < 4; ++k) { const int keep = b1 ? ib_[k + 4] : ib_[k], send = b1 ? ib_[k] : ib_[k + 4]; ic_[k] = keep + __builtin_amdgcn_update_dpp(0, send, 0x1b, 0xf, 0xf, false); } \
          { const int keep = b0 ? ic_[2] : ic_[0], send = b0 ? ic_[0] : ic_[2]; id0_ = keep + __builtin_amdgcn_update_dpp(0, send, 0xb1, 0xf, 0xf, false); } \
          { const int keep = b0 ? ic_[3] : ic_[1], send = b0 ? ic_[1] : ic_[3]; id1_ = keep + __builtin_amdgcn_update_dpp(0, send, 0xb1, 0xf, 0xf, false); } } \
          \
        *(GAS unsigned*)(PD + (size_t)(t) * 128 + kb_) = cvtpk((float)id0_ * hinv + corr_, (float)id1_ * hinv + corr_); \
        __builtin_amdgcn_sched_barrier(0); } while (0)
    PU_LDE(t0);
    PU_LDR(rA); haA = han; hbA = hbn; hA1 = h1n;
    PU_LDE(t0 + 1);
#pragma unroll 1
    for (int ti = 0; ti < 128; ti += 2) {
        const int t = t0 + ti;
        PU_LDR(rB); haB = han; hbB = hbn; hB1 = h1n;
        PU_LDE(t + 2 < tlast ? t + 2 : tlast);
        __builtin_amdgcn_sched_barrier(0);
        PU_COMP(rA, haA, hbA, hA1, t);
        PU_LDR(rA); haA = han; hbA = hbn; hA1 = h1n;
        PU_LDE(t + 3 < tlast ? t + 3 : tlast);
        __builtin_amdgcn_sched_barrier(0);
        PU_COMP(rB, haB, hbB, hB1, t + 1);
    }
#undef PU_LDE
#undef PU_LDR
#undef PU_COMP
}

__device__ __forceinline__ void phase_peer_act(Ctx& C, const Args& A) {
    const bf16* PD = (const bf16*)(C.ws + WS_PD); const unsigned short* EIDX = (const unsigned short*)(C.ws + WS_EIDX); const float* EG = (const float*)(C.ws + WS_EG);
    unsigned* ACT8 = (unsigned*)(C.ws + WS_ACT); float* ACTS = (float*)(C.ws + WS_ACT + (size_t)NTOK * 128);
    LAS float* SU = (LAS float*)C.lds; LAS float* SV = SU + NEXP;
    { const GAS v4u* src = (const GAS v4u*)(C.ws + WS_ES); for (int i = C.tid; i < 2 * NEXP / 4; i += NTHR) ((LAS v4u*)C.lds)[i] = src[i]; }
    __syncthreads();
    const int gt = C.vcu * NTHR + C.tid, NGT = C.G * NTHR;
    for (int it = gt; it < NTOK * 128 / 4; it += NGT) {
        f32x4 z = {0.f, 0.f, 0.f, 0.f};
#pragma unroll
        for (int xs = 0; xs < 4; ++xs) { const u32x2 w_ = *(const GAS u32x2*)(PD + (size_t)xs * NTOK * 128 + (size_t)it * 4); z += (f32x4){bf_lo(w_.x), bf_hi(w_.x), bf_lo(w_.y), bf_hi(w_.y)}; }
        const u32x2 ew = *(const GAS u32x2*)(EIDX + (size_t)it * 4); const f32x4 gg = *(const GAS f32x4*)(EG + (size_t)it * 4);
        const int e0 = ew.x & 0xffffu, e1 = ew.x >> 16, e2 = ew.y & 0xffffu, e3 = ew.y >> 16;
        f32x4 a;
        a.x = gelu_erf(z.x * SU[e0]) * gg.x * SV[e0]; a.y = gelu_erf(z.y * SU[e1]) * gg.y * SV[e1];
        a.z = gelu_erf(z.z * SU[e2]) * gg.z * SV[e2]; a.w = gelu_erf(z.w * SU[e3]) * gg.w * SV[e3];
        float amax = fmaxf(fmaxf(fabsf(a.x), fabsf(a.y)), fmaxf(fabsf(a.z), fabsf(a.w)));
        amax = fmaxf(amax, __int_as_float(__builtin_amdgcn_update_dpp(0, __float_as_int(amax), 0xb1, 0xf, 0xf, false)));
        amax = fmaxf(amax, __int_as_float(__builtin_amdgcn_update_dpp(0, __float_as_int(amax), 0x4e, 0xf, 0xf, false)));
        amax = fmaxf(amax, __int_as_float(__builtin_amdgcn_update_dpp(0, __float_as_int(amax), 0x124, 0xf, 0xf, false)));
        amax = fmaxf(amax, __int_as_float(__builtin_amdgcn_update_dpp(0, __float_as_int(amax), 0x128, 0xf, 0xf, false)));
        { auto r = __builtin_amdgcn_permlane16_swap(__float_as_uint(amax), __float_as_uint(amax), false, false); amax = fmaxf(__uint_as_float(r[0]), __uint_as_float(r[1])); }
        const float as_ = amax > 0.f ? 127.f / amax : 1.f;
        const int b0 = (int)rintf(a.x * as_), b1 = (int)rintf(a.y * as_), b2 = (int)rintf(a.z * as_), b3 = (int)rintf(a.w * as_);
        ACT8[it] = (unsigned)(b0 & 0xff) | ((unsigned)(b1 & 0xff) << 8) | ((unsigned)(b2 & 0xff) << 16) | ((unsigned)(b3 & 0xff) << 24);
        int bs = (b0 + b1) + (b2 + b3);
        bs += __builtin_amdgcn_update_dpp(0, bs, 0xb1, 0xf, 0xf, false); bs += __builtin_amdgcn_update_dpp(0, bs, 0x4e, 0xf, 0xf, false);
        bs += __builtin_amdgcn_update_dpp(0, bs, 0x124, 0xf, 0xf, false); bs += __builtin_amdgcn_update_dpp(0, bs, 0x128, 0xf, 0xf, false);
        { auto r = __builtin_amdgcn_permlane16_swap((unsigned)bs, (unsigned)bs, false, false); bs = (int)r[0] + (int)r[1]; }
        if ((it & 31) == 0) { ACTS[it >> 5] = amax > 0.f ? amax * (1.f / 127.f) : 1.f; ACTS[NTOK + (it >> 5)] = (float)bs; }
    }
}

template <int VABL> __device__ __forceinline__ void phase_peer_v(Ctx& C, const Args& A) {
    int lane_ = C.lane; asm volatile("" : "+v"(lane_)); const int lane = lane_;
    const int x = C.sx >> 1, j = ((C.sx & 1) << 5) | C.sj, g = lane >> 3, c = lane & 7;
    const unsigned short* EIDX = (const unsigned short*)(C.ws + WS_EIDX) + 16 * g; const unsigned char* ACT8 = (const unsigned char*)(C.ws + WS_ACT) + 16 * g; const float* ACTS = (const float*)(C.ws + WS_ACT + (size_t)NTOK * 128);
    const __amdgpu_buffer_rsrc_t RV = __builtin_amdgcn_make_buffer_rsrc((void*)(C.ws + WS_EV + (size_t)x * (2u << 20)), 0, 2 << 20, 0x00020000);
    const int t0 = 1024 * j + 128 * C.wave, tlast = t0 + 127;
    const int cc_ = 256 * x + 32 * c + 4 * g;
    const bf16* X1 = (const bf16*)(C.ws + WS_X1) + cc_;
    const f32x4 g2 = *(const f32x4*)((const float*)(C.ws + WS_MOD) + (size_t)(t0 >> 11) * NMOD + 5 * 1024 + cc_);
    const float mulc = (g & 1) ? 0.0625f : 1.f, addc = (g & 1) ? 0.5f : -7.5f;
    v4u en[2]; v4u an, aA, aB; float sn, sA, sB, zn, zA, zB; u32x2 xn, xA, xB;
    v4u rA[16], rB[16];
#define PV_LDE(t) do { en[0] = *(const GAS v4u*)(EIDX + (size_t)(t) * 128); en[1] = *(const GAS v4u*)(EIDX + (size_t)(t) * 128 + 8); an = *(const GAS v4u*)(ACT8 + (size_t)(t) * 128); \
        sn = *(const GAS float*)(ACTS + (t)); zn = *(const GAS float*)(ACTS + NTOK + (t)); xn = *(const GAS u32x2*)(X1 + (size_t)(t) * DM); } while (0)
#define PV_LDR(R, AV, SV_, ZV_, XV_) do { _Pragma("unroll") for (int k = 0; k < 16; ++k) { const unsigned w_ = en[k >> 3][(k >> 1) & 3]; const int ek_ = (int)((k & 1) ? (w_ >> 16) : (w_ & 0xffffu)); \
        R[k] = __builtin_bit_cast(v4u, __builtin_amdgcn_raw_buffer_load_b128(RV, ek_ * 128 + 16 * c, 0, 0)); } \
        AV = an; SV_ = sn; ZV_ = zn; XV_ = xn; } while (0)
#define PV_COMP(R, AV, SV_, ZV_, XV_, t) do { const float ainv = SV_, asum = ZV_; \
        const int aq[4] = {(int)AV.x, (int)AV.y, (int)AV.z, (int)AV.w}; \
        __builtin_amdgcn_sched_barrier(0); \
        int ia[32]; \
        _Pragma("unroll") for (int i = 0; i < 32; ++i) ia[i] = 0; \
        _Pragma("unroll") for (int kk = 0; kk < 4; ++kk) { asm volatile("" : "+v"(R[4 * kk]), "+v"(R[4 * kk + 1]), "+v"(R[4 * kk + 2]), "+v"(R[4 * kk + 3])); \
            _Pragma("unroll") for (int d = 0; d < 4; ++d) { const unsigned r0 = R[4 * kk][d], r1 = R[4 * kk + 1][d], r2 = R[4 * kk + 2][d], r3 = R[4 * kk + 3][d]; \
                const unsigned p01l = __builtin_amdgcn_perm(r1, r0, 0x05010400u), p01h = __builtin_amdgcn_perm(r1, r0, 0x07030602u); \
                const unsigned p23l = __builtin_amdgcn_perm(r3, r2, 0x05010400u), p23h = __builtin_amdgcn_perm(r3, r2, 0x07030602u); \
                unsigned tt_[4]; \
                tt_[0] = __builtin_amdgcn_perm(p23l, p01l, 0x05040100u); tt_[1] = __builtin_amdgcn_perm(p23l, p01l, 0x07060302u); \
                tt_[2] = __builtin_amdgcn_perm(p23h, p01h, 0x05040100u); tt_[3] = __builtin_amdgcn_perm(p23h, p01h, 0x07060302u); \
                _Pragma("unroll") for (int b = 0; b < 4; ++b) { \
                    ia[8 * d + b] = __builtin_amdgcn_sdot4((int)(tt_[b] & 0x0f0f0f0fu), aq[kk], ia[8 * d + b], false); \
                    ia[8 * d + 4 + b] = __builtin_amdgcn_sdot4((int)(tt_[b] & 0xf0f0f0f0u), aq[kk], ia[8 * d + 4 + b], false); } } } \
          \
        int ib[16], ic[8], id[4]; \
        _Pragma("unroll") for (int i = 0; i < 16; ++i) { auto r = __builtin_amdgcn_permlane32_swap((unsigned)ia[i], (unsigned)ia[i + 16], false, false); ib[i] = (int)r[0] + (int)r[1]; } \
        _Pragma("unroll") for (int i = 0; i < 8; ++i) { auto r = __builtin_amdgcn_permlane16_swap((unsigned)ib[i], (unsigned)ib[i + 8], false, false); ic[i] = (int)r[0] + (int)r[1]; } \
        { const bool b3 = (lane & 8) != 0; \
          _Pragma("unroll") for (int i = 0; i < 4; ++i) { const int k0 = b3 ? ic[i + 4] : ic[i], s0 = b3 ? ic[i] : ic[i + 4]; id[i] = k0 + __builtin_amdgcn_update_dpp(0, s0, 0x128, 0xf, 0xf, false); } } \
        { const float az = addc * asum; \
          const f32x4 xv = {bf_lo(XV_.x), bf_hi(XV_.x), bf_lo(XV_.y), bf_hi(XV_.y)}; \
          const f32x4 fv = {((float)id[0] * mulc + az) * ainv, ((float)id[1] * mulc + az) * ainv, ((float)id[2] * mulc + az) * ainv, ((float)id[3] * mulc + az) * ainv}; \
          *(GAS f32x4*)(C.out + (size_t)(t) * DM + cc_) = xv + g2 * fv; } \
        __builtin_amdgcn_sched_barrier(0); } while (0)
    PV_LDE(t0);
    PV_LDR(rA, aA, sA, zA, xA);
    PV_LDE(t0 + 1);
#pragma unroll 1
    for (int ti = 0; ti < 128; ti += 2) {
        const int t = t0 + ti;
        PV_LDR(rB, aB, sB, zB, xB);
        PV_LDE(t + 2 < tlast ? t + 2 : tlast);
        __builtin_amdgcn_sched_barrier(0);
        PV_COMP(rA, aA, sA, zA, xA, t);
        PV_LDR(rA, aA, sA, zA, xA);
        PV_LDE(t + 3 < tlast ? t + 3 : tlast);
        __builtin_amdgcn_sched_barrier(0);
        PV_COMP(rB, aB, sB, zB, xB, t + 1);
    }
#undef PV_LDE
#undef PV_LDR
#undef PV_COMP
}
#undef PG_PIN16
#undef PG_CVT

constexpr int NPHASE = 13;

__global__ void __launch_bounds__(NTHR, 2) fwd_kernel(Args args) {
    extern __shared__ __attribute__((aligned(16))) unsigned char lds[];
    Ctx C;
    C.lds = (LAS unsigned char*)lds; C.MISC = (volatile LAS unsigned*)(C.lds + MISC_OFF);
    C.tid = threadIdx.x; C.lane = C.tid & 63; C.wave = __builtin_amdgcn_readfirstlane(C.tid >> 6);
    C.G = gridDim.x; { const int bx = blockIdx.x; C.vcu = (C.G % 8 == 0) ? (bx % 8) * (C.G / 8) + bx / 8 : bx; }
    C.ws = args.ws; C.out = args.out; C.ctl = (gu32*)(args.ws + WS_CTL);
    if (C.tid < 64) ((LAS unsigned*)(C.lds + MISC_OFF))[C.tid] = 0u;
    __syncthreads();
    const int lo = args.ph_lo, hi = args.ph_hi;
    const bool multi = (hi - lo) > 1;
    XcdBarrier bar; bar.bar = (unsigned*)(C.ctl + CW_BAR); bar.x = 0; bar.st = nullptr;
    if (multi) bar = xcd_barrier_post((unsigned*)(C.ctl + CW_BAR), C.MISC + 8);
#ifndef PH_MASK
#define PH_MASK 0x1fff
#endif
#define IN(k) (((PH_MASK >> (k)) & 1) && lo <= (k) && (k) < hi)
#ifndef REP_MASK
#define REP_MASK 0
#endif
#ifndef ABL_MODE
#define ABL_MODE 0
#endif
#define SEAM(k) do { if (IN(k) && IN((k) + 1)) xcd_barrier(bar); } while (0)
#define NREP(k) (1 + ((REP_MASK >> (k)) & 1))
#define PFENCE() do { asm volatile("" : "+v"(C.tid) :: "memory"); C.lane = C.tid & 63; C.wave = __builtin_amdgcn_readfirstlane(C.tid >> 6); } while (0)
    for (int rp = 0; rp < NREP(0); ++rp) { if (rp) xcd_barrier(bar); PFENCE(); if (IN(0)) { phase0(C, args); } }
    if (IN(0) && (IN(12) || IN(1))) xcd_barrier(bar);
    if (IN(12)) { PFENCE(); phase0b(C, args); }
    for (int rp = 0; rp < NREP(1); ++rp) { if (rp) xcd_barrier(bar); PFENCE(); if (IN(1)) { phase1(C, args); } } SEAM(1);
    for (int rp = 0; rp < NREP(2); ++rp) { if (rp) xcd_barrier(bar); PFENCE();
    if (IN(2)) { pg8::Gemm g{(const pg8::bf16_t*)(C.ws + WS_H), (const pg8::bf16_t*)(C.ws + WS_WIN_T), NTOK, NPROJ, DM / 2}; pg8::StaticOrder S; S.init(NTOK, NPROJ, C.G, (int)blockIdx.x);
        pg8::EpiI8Bf16 E{(pg8::bf16_t*)(C.ws + WS_PROJ), NPROJ, (const float*)(C.ws + WS_RS1), (const float*)(C.ws + WS_CS), nullptr};
        pg8::gemm_phase_i8<pg8::EpiI8Bf16, pg8::StaticOrder, true, true>(C.lds, g, S, E); } } SEAM(2);
    if (IN(3)) { phase2b(C, args); } SEAM(3);
    for (int rp = 0; rp < NREP(4); ++rp) { if (rp) xcd_barrier(bar); PFENCE(); if (IN(4)) { if (rp + 1 < NREP(4)) phase3<ABL_MODE>(C, args, rp); else phase3<0>(C, args, rp); } } SEAM(4);
    for (int rp = 0; rp < NREP(5); ++rp) { if (rp) xcd_barrier(bar); PFENCE();
    if (IN(5)) { pg8::Gemm g{(const pg8::bf16_t*)(C.ws + WS_Y), (const pg8::bf16_t*)(C.ws + WS_WOUT_T), NTOK, DM, DM}; pg8::StaticOrder S; S.init(NTOK, DM, C.G, (int)blockIdx.x);
        pg8::EpiResidBf16 E{(const float*)args.in[0], (const float*)(C.ws + WS_MOD) + 2 * 1024, (pg8::bf16_t*)(C.ws + WS_X1)};
        pg8::gemm_phase<pg8::EpiResidBf16, pg8::StaticOrder, true, true>(C.lds, g, S, E); } } SEAM(5);
    for (int rp = 0; rp < NREP(6); ++rp) { if (rp) xcd_barrier(bar); PFENCE(); if (IN(6)) { phase5(C, args); } } SEAM(6);
    for (int rp = 0; rp < NREP(7); ++rp) { if (rp) xcd_barrier(bar); PFENCE();
    if (IN(7)) { pg8::Gemm g{(const pg8::bf16_t*)(C.ws + WS_H), (const pg8::bf16_t*)(C.ws + WS_WQ_T), NTOK, NQP, DM / 2}; pg8::StaticOrder S; S.init(NTOK, NQP, C.G, (int)blockIdx.x);
        pg8::EpiI8Bf16 E{(pg8::bf16_t*)(C.ws + WS_PROJ), NQP, (const float*)(C.ws + WS_RS2), (const float*)(C.ws + WS_CSQ), (const float*)args.in[20]};
        pg8::gemm_phase_i8<pg8::EpiI8Bf16, pg8::StaticOrder, true, true>(C.lds, g, S, E); } } SEAM(7);
    for (int rp = 0; rp < NREP(8); ++rp) { if (rp) xcd_barrier(bar); PFENCE(); if (IN(8)) { if (rp + 1 < NREP(8)) phase_peer_scores<ABL_MODE>(C, args); else phase_peer_scores<0>(C, args); } } SEAM(8);
    C.sx = C.vcu >> 5; C.sj = C.vcu & 31;
    if (multi && C.G == 256) {
        if (C.tid == 0) { unsigned* bw = (unsigned*)(C.ctl + CW_BAR); bool ok = true;
            for (int q = 0; q < 16; ++q) { const unsigned cnt = xb_ld(&bw[XB_XCNT(q)]); ok = ok && (q < 8 ? cnt == 32u : cnt == 0u); }
            unsigned code = 0xffffffffu;
            if (ok) { const unsigned xc = xb_xcc_id(); const unsigned r = __hip_atomic_fetch_add(C.ctl + CW_RANK + 64 * xc, 1u, __ATOMIC_RELAXED, __HIP_MEMORY_SCOPE_AGENT); code = (xc << 8) | (r & 31u); }
            C.MISC[1] = code; }
        __syncthreads();
        const unsigned code = C.MISC[1];
        if (code != 0xffffffffu) { C.sx = (int)(code >> 8); C.sj = (int)(code & 31u); }
    }
    for (int rp = 0; rp < NREP(9); ++rp) { if (rp) xcd_barrier(bar); PFENCE(); if (IN(9)) { if (rp + 1 < NREP(9)) phase_peer_u<ABL_MODE>(C, args); else phase_peer_u<0>(C, args); } } SEAM(9);
    for (int rp = 0; rp < NREP(10); ++rp) { if (rp) xcd_barrier(bar); PFENCE(); if (IN(10)) { phase_peer_act(C, args); } } SEAM(10);
    for (int rp = 0; rp < NREP(11); ++rp) { if (rp) xcd_barrier(bar); PFENCE(); if (IN(11)) { if (rp + 1 < NREP(11)) phase_peer_v<ABL_MODE>(C, args); else phase_peer_v<0>(C, args); } }
#undef IN
#undef SEAM
}

#ifndef MK_N_LAUNCHES
#define MK_N_LAUNCHES 1
#endif
extern "C" void kernel_launch(void* const* d_in, const int* in_sizes, int n_in, void* d_out, int out_size, void* d_ws, size_t ws_size, hipStream_t stream) {
    static int grid = 0;
    if (grid == 0) {
        if (n_in != 25 || in_sizes[0] != NTOK * DM || out_size != NTOK * DM || ws_size < WS_END) { fprintf(stderr, "kernel_launch: unexpected shapes (n_in %d, in0 %d, out %d, ws %zu)\n", n_in, n_in > 0 ? in_sizes[0] : -1, out_size, ws_size); grid = -1; return; }
        int dev = 0, cus = 0, per_cu = 0;
        if (hipGetDevice(&dev) != hipSuccess || hipDeviceGetAttribute(&cus, hipDeviceAttributeMultiprocessorCount, dev) != hipSuccess) { grid = -1; return; }
        if (hipFuncSetAttribute((const void*)fwd_kernel, hipFuncAttributeMaxDynamicSharedMemorySize, LDS_BYTES) != hipSuccess) { fprintf(stderr, "kernel_launch: hipFuncSetAttribute failed\n"); grid = -1; return; }
        if (hipOccupancyMaxActiveBlocksPerMultiprocessor(&per_cu, (const void*)fwd_kernel, NTHR, LDS_BYTES) != hipSuccess || per_cu < 1) fprintf(stderr, "kernel_launch: occupancy query says %d per CU\n", per_cu);
        (void)hipGetLastError();
        if (cus != 256) { fprintf(stderr, "kernel_launch: built for a 256-CU device (work maps assume 256 workgroups), found %d CUs; nothing launched\n", cus); grid = -1; return; }
        grid = cus;
    }
    if (grid < 0) return;
    if (hipMemsetAsync((char*)d_ws + WS_CTL, 0, CTL_ZERO_BYTES, stream) != hipSuccess) return;
    Args a{};
    for (int i = 0; i < 25; ++i) a.in[i] = d_in[i];
    a.out = (float*)d_out; a.ws = (unsigned char*)d_ws;
    if (MK_N_LAUNCHES == 1) { a.ph_lo = 0; a.ph_hi = NPHASE; a.li = 0; hipLaunchKernelGGL(fwd_kernel, dim3(grid), dim3(NTHR), LDS_BYTES, stream, a); }
    else { const int order[NPHASE] = {0, 12, 1, 2, 3, 4, 5, 6, 7, 8, 9, 10, 11}; for (int i = 0; i < NPHASE; ++i) { const int p = order[i]; a.ph_lo = p; a.ph_hi = p + 1; a.li = p; hipLaunchKernelGGL(fwd_kernel, dim3(grid), dim3(NTHR), LDS_BYTES, stream, a); } }
}
```

```cpp
#include <hip/hip_runtime.h>
#include <hip/hip_bf16.h>
#include <cstdio>
#include <cstdint>
#include <cmath>
namespace pg8 {
#define PG8_LAS __attribute__((address_space(3)))
typedef unsigned short bf16_t;
typedef short bf16x8 __attribute__((ext_vector_type(8)));
typedef float f32x4 __attribute__((ext_vector_type(4)));
typedef unsigned u32x4 __attribute__((ext_vector_type(4)));
constexpr int BM = 256, BK = 64, HALF = 128, HTB = HALF * BK * 2  , STAGE_BYTES = 8 * HTB, NXCD = 8, WGM = 8;

__host__ __device__ __forceinline__ int lds_byte(int r, int c) { const int st = (r >> 4) * 2 + (c >> 5), rr = r & 15, cc = c & 31, ob = rr * 64 + cc * 2; return st * 1024 + (ob ^ (((ob >> 9) & 1) << 5)); }
__host__ __device__ __forceinline__ void stage_rc(int b, int& R, int& C) { const int st = b / 1024, sb = b % 1024, swz = sb ^ (((sb >> 9) & 1) << 5); R = (st >> 1) * 16 + swz / 64; C = (st & 1) * 32 + (swz % 64) / 2; }
__host__ __device__ __forceinline__ int perm32(int rho) { const int n = rho >> 4, i = rho & 15; return 8 * (i >> 2) + 4 * n + (i & 3); }

struct Unit { int pm, pn; };
struct Gemm { const bf16_t* A; const bf16_t* Bt; int M, N, K; };

struct StaticOrder {
    int nM, nN, nwg, G, c;
    __host__ __device__ void init(int M, int N, int G_, int c_) { nM = M / BM; nN = N / BM; nwg = nM * nN; G = G_; c = c_; }
    __host__ __device__ bool next(int i, Unit& u) const {
        const long L = (long)i * G + c; if (L >= nwg) return false;
        int wgid = (int)L; { const int q = nwg / NXCD, r = nwg % NXCD, xcd = wgid % NXCD, off = wgid / NXCD; wgid = (xcd < r ? xcd * (q + 1) : r * (q + 1) + (xcd - r) * q) + off; }
        const int nig = WGM * nN, gid = wgid / nig, fm = gid * WGM, gsz = (nM - fm) < WGM ? (nM - fm) : WGM;
        u.pm = fm + ((wgid % nig) % gsz); u.pn = (wgid % nig) / gsz; return true;
    }
    __device__ __forceinline__ void a_ready(const Unit&) const {}
    __device__ __forceinline__ void done(const Unit&) const {}
};

__device__ __forceinline__ unsigned cvt_pk_bf16(float lo, float hi) { unsigned r; asm volatile("v_cvt_pk_bf16_f32 %0, %1, %2" : "=v"(r) : "v"(lo), "v"(hi)); return r; }
typedef float f32x2 __attribute__((ext_vector_type(2)));
__device__ __forceinline__ f32x2 gelu_pk(f32x2 v) {
    const f32x2 av = __builtin_elementwise_abs(v), d = av * 0.2316418882f + 1.0f;
    f32x2 t; t.x = __builtin_amdgcn_rcpf(d.x); t.y = __builtin_amdgcn_rcpf(d.y);
    f32x2 q = t * 0.5307027145f + (-0.7265760135f); q = q * t + 0.7107068705f; q = q * t + (-0.142248368f); q = q * t + 0.127414796f; q = q * t;
    const f32x2 s = (v * v) * (-0.72134752044f);
    f32x2 e; e.x = __builtin_amdgcn_exp2f(s.x); e.y = __builtin_amdgcn_exp2f(s.y);
    const f32x2 m = v * (q * e), r = v - m;
    f32x2 o; o.x = v.x < 0.f ? m.x : r.x; o.y = v.y < 0.f ? m.y : r.y; return o;
}

template <int ACT  > struct EpiBf16 {
    static constexpr bool PERM = true, AFTER_DRAIN = false; static_assert(ACT == 0 || ACT == 1, "EpiBf16: ACT is 0 (none) or 1 (gelu_pk)");
    bf16_t* O; int ldc; const float* bias; int split_cols; size_t split_stride; float scale0;
    __device__ __forceinline__ void operator()(const f32x4 (&acc)[2][2][4][2], const Unit& u, int wr, int wc, int fr, int fq) const {
        const int row0 = u.pm * BM + wr * 64 + fr; int colt = u.pn * BM; bf16_t* base = O;
        float sc = 1.f; if (split_cols) { const int t = colt / split_cols; base += (size_t)t * split_stride; colt -= t * split_cols; if (t == 0) sc = scale0; }
        const int col0 = colt + wc * 32 + 8 * fq, bcol0 = u.pn * BM + wc * 32 + 8 * fq;
        f32x4 bv[2][2];
#pragma unroll
        for (int bj = 0; bj < 2; ++bj)
#pragma unroll
            for (int n = 0; n < 2; ++n) bv[bj][n] = bias ? *(const f32x4*)(bias + bcol0 + bj * HALF + 4 * n) : (f32x4){0.f, 0.f, 0.f, 0.f};
#pragma unroll
        for (int ai = 0; ai < 2; ++ai)
#pragma unroll
            for (int m = 0; m < 4; ++m) { bf16_t* rowp = base + (size_t)(row0 + ai * HALF + m * 16) * ldc + col0;
#pragma unroll
                for (int bj = 0; bj < 2; ++bj) { f32x4 v0 = acc[ai][bj][m][0] + bv[bj][0], v1 = acc[ai][bj][m][1] + bv[bj][1];
                    if (ACT == 1) { f32x2 a = gelu_pk((f32x2){v0[0], v0[1]}), b = gelu_pk((f32x2){v0[2], v0[3]}), c = gelu_pk((f32x2){v1[0], v1[1]}), d = gelu_pk((f32x2){v1[2], v1[3]});
                        v0 = (f32x4){a.x, a.y, b.x, b.y}; v1 = (f32x4){c.x, c.y, d.x, d.y}; }
                    v0 = v0 * sc; v1 = v1 * sc; u32x4 w; w.x = cvt_pk_bf16(v0[0], v0[1]); w.y = cvt_pk_bf16(v0[2], v0[3]); w.z = cvt_pk_bf16(v1[0], v1[1]); w.w = cvt_pk_bf16(v1[2], v1[3]);
                    *(u32x4*)(rowp + bj * HALF) = w; } }
    }
};
struct EpiResid {
    static constexpr bool PERM = false, AFTER_DRAIN = false;
    const float* x; const float* gate; float* out;
    __device__ __forceinline__ void operator()(const f32x4 (&acc)[2][2][4][2], const Unit& u, int wr, int wc, int fr, int fq) const {
        const int b = (u.pm * BM) >> 11;
        const int col0 = u.pn * BM + wc * 32 + 4 * fq;
        f32x4 gv[2][2];
#pragma unroll
        for (int bj = 0; bj < 2; ++bj)
#pragma unroll
            for (int n = 0; n < 2; ++n) gv[bj][n] = *(const f32x4*)(gate + (size_t)b * 6144 + col0 + bj * HALF + n * 16);
#pragma unroll
        for (int ai = 0; ai < 2; ++ai)
#pragma unroll
            for (int m = 0; m < 4; ++m) { const size_t off = (size_t)(u.pm * BM + ai * HALF + wr * 64 + m * 16 + fr) * 1024 + col0;
#pragma unroll
                for (int bj = 0; bj < 2; ++bj)
#pragma unroll
                    for (int n = 0; n < 2; ++n) { const f32x4 xv = *(const f32x4*)(x + off + bj * HALF + n * 16);
                        *(f32x4*)(out + off + bj * HALF + n * 16) = xv + gv[bj][n] * acc[ai][bj][m][n]; } }
    }
};
struct EpiResidBf16 {
    static constexpr bool PERM = true, AFTER_DRAIN = false;
    const float* x; const float* gate; bf16_t* out;
    __device__ __forceinline__ void operator()(const f32x4 (&acc)[2][2][4][2], const Unit& u, int wr, int wc, int fr, int fq) const {
        const int b = (u.pm * BM) >> 11;
        const int col0 = u.pn * BM + wc * 32 + 8 * fq;
        f32x4 gv[2][2];
#pragma unroll
        for (int bj = 0; bj < 2; ++bj)
#pragma unroll
            for (int n = 0; n < 2; ++n) gv[bj][n] = *(const f32x4*)(gate + (size_t)b * 6144 + col0 + bj * HALF + 4 * n);
#pragma unroll
        for (int ai = 0; ai < 2; ++ai)
#pragma unroll
            for (int m = 0; m < 4; ++m) { const size_t off = (size_t)(u.pm * BM + ai * HALF + wr * 64 + m * 16 + fr) * 1024 + col0;
#pragma unroll
                for (int bj = 0; bj < 2; ++bj) { const f32x4 x0 = *(const f32x4*)(x + off + bj * HALF), x1 = *(const f32x4*)(x + off + bj * HALF + 4);
                    const f32x4 v0 = x0 + gv[bj][0] * acc[ai][bj][m][0], v1 = x1 + gv[bj][1] * acc[ai][bj][m][1];
                    u32x4 w; w.x = cvt_pk_bf16(v0[0], v0[1]); w.y = cvt_pk_bf16(v0[2], v0[3]); w.z = cvt_pk_bf16(v1[0], v1[1]); w.w = cvt_pk_bf16(v1[2], v1[3]);
                    *(u32x4*)(out + off + bj * HALF) = w; } }
    }
};
template <class Epi, class Sched, bool ALIGN_EPI = false, bool SP2 = false>
__device__ __forceinline__ void gemm_phase(PG8_LAS unsigned char* lds, const Gemm g, const Sched& S, const Epi& E) {
    const int tid = threadIdx.x, wid = __builtin_amdgcn_readfirstlane(tid >> 6), lane = tid & 63, wr = wid >> 2, wc = wid & 3, fr = lane & 15, fq = lane >> 4;
    const int K = g.K, nt = K / BK;
    unsigned voffA[2], voffB[2];
#pragma unroll
    for (int i = 0; i < 2; ++i) { int R, C; stage_rc(tid * 16 + i * 8192, R, C); const int Rb = Epi::PERM ? ((R & ~31) + perm32(R & 31)) : R;
        voffA[i] = (unsigned)(R * K + C) * 2u; voffB[i] = (unsigned)(Rb * K + C) * 2u; }
    const size_t kstep = (size_t)(BK * 2);
    const size_t hstep = (size_t)HALF * K * 2;
    const size_t tstep = 2 * hstep;
    const unsigned ldsw = (unsigned)wid * 1024u;
    const int aoff = lds_byte(wr * 64 + fr, fq * 8), boff = lds_byte(wc * 32 + fr, fq * 8);
#define PG8_SA(b, h) (((b) * 2 + (h)) * HTB)
#define PG8_SB(b, h) ((4 + (b) * 2 + (h)) * HTB)
#define PG8_STAGE(bufoff, gbase, voff) do { _Pragma("unroll") for (int _i = 0; _i < 2; ++_i) \
        __builtin_amdgcn_global_load_lds((const unsigned*)((const char*)(gbase) + (voff)[_i]), (PG8_LAS unsigned*)(lds + (bufoff) + ldsw + _i * 8192), 16, 0, 0); } while (0)
#define PG8_LDA(dst, b, h) do { _Pragma("unroll") for (int m = 0; m < 4; ++m) _Pragma("unroll") for (int k = 0; k < 2; ++k) dst[m][k] = *(const PG8_LAS bf16x8*)(lds + PG8_SA(b, h) + aoff + m * 2048 + k * 1024); } while (0)
#define PG8_LDB(dst, b, h) do { _Pragma("unroll") for (int n = 0; n < 2; ++n) _Pragma("unroll") for (int k = 0; k < 2; ++k) dst[n][k] = *(const PG8_LAS bf16x8*)(lds + PG8_SB(b, h) + boff + n * 2048 + k * 1024); } while (0)
#define PG8_MMA(ai, bj, At, Bt) do { __builtin_amdgcn_s_setprio(1); _Pragma("unroll") for (int m = 0; m < 4; ++m) _Pragma("unroll") for (int n = 0; n < 2; ++n) _Pragma("unroll") for (int k = 0; k < 2; ++k) \
        acc[ai][bj][m][n] = __builtin_amdgcn_mfma_f32_16x16x32_bf16(Bt[n][k], At[m][k], acc[ai][bj][m][n], 0, 0, 0); __builtin_amdgcn_s_setprio(0); } while (0)
#define PG8_WAIT_V(n) asm volatile("s_waitcnt vmcnt(" #n ")" ::: "memory")
#define PG8_WAIT_L(n) asm volatile("s_waitcnt lgkmcnt(" #n ")" ::: "memory")
#define PG8_BAR __builtin_amdgcn_s_barrier()
#define PG8_SCHED __builtin_amdgcn_sched_barrier(0)
    Unit cur, nxt; int ui = 0;
    if (!S.next(0, cur)) return;
    f32x4 acc[2][2][4][2];
#pragma unroll
    for (int a = 0; a < 2; ++a)
#pragma unroll
        for (int b = 0; b < 2; ++b)
#pragma unroll
            for (int m = 0; m < 4; ++m)
#pragma unroll
                for (int n = 0; n < 2; ++n) acc[a][b][m][n] = (f32x4){0.f, 0.f, 0.f, 0.f};
    bf16x8 At[4][2], B0[2][2], B1[2][2];
    const char* cA = (const char*)g.A + (size_t)cur.pm * tstep; const char* cB = (const char*)g.Bt + (size_t)cur.pn * tstep;
    S.a_ready(cur);
    if constexpr (SP2) {
        PG8_STAGE(PG8_SB(0, 0), cB, voffB); PG8_STAGE(PG8_SB(0, 1), cB + hstep, voffB); PG8_STAGE(PG8_SA(0, 0), cA, voffA); PG8_STAGE(PG8_SA(0, 1), cA + hstep, voffA);
        if (wr == 1) PG8_BAR;
        PG8_WAIT_V(2); PG8_BAR;
        PG8_STAGE(PG8_SB(1, 0), cB + kstep, voffB); PG8_STAGE(PG8_SA(1, 0), cA + kstep, voffA); PG8_STAGE(PG8_SB(1, 1), cB + hstep + kstep, voffB);
        PG8_WAIT_V(6); PG8_BAR;
    } else {
        PG8_STAGE(PG8_SB(0, 0), cB, voffB); PG8_STAGE(PG8_SA(0, 0), cA, voffA); PG8_STAGE(PG8_SB(0, 1), cB + hstep, voffB); PG8_STAGE(PG8_SA(0, 1), cA + hstep, voffA);
        if (wr == 1) PG8_BAR;
        PG8_WAIT_V(4); PG8_BAR;
        PG8_STAGE(PG8_SB(1, 0), cB + kstep, voffB); PG8_STAGE(PG8_SA(1, 0), cA + kstep, voffA); PG8_STAGE(PG8_SB(1, 1), cB + hstep + kstep, voffB);
        PG8_WAIT_V(6); PG8_BAR;
    }
    for (;;) {
        const bool has_next = S.next(ui + 1, nxt);
        const char* nA = has_next ? (const char*)g.A + (size_t)nxt.pm * tstep : cA; const char* nB = has_next ? (const char*)g.Bt + (size_t)nxt.pn * tstep : cB;
        for (int t = 0; t < nt; t += 2) {
            const bool last = (t == nt - 2);
            const char* a1 = cA + (size_t)(t + 1) * kstep;
            const char* a2 = last ? nA : cA + (size_t)(t + 2) * kstep; const char* b2 = last ? nB : cB + (size_t)(t + 2) * kstep;
            const char* a3 = a2 + kstep; const char* b3 = b2 + kstep;
            if (last && has_next) S.a_ready(nxt);
            if constexpr (SP2) {
            PG8_LDB(B0, 0, 0); PG8_LDB(B1, 0, 1); PG8_SCHED; PG8_LDA(At, 0, 0); PG8_STAGE(PG8_SA(1, 1), a1 + hstep, voffA);
            PG8_WAIT_V(8); PG8_WAIT_L(0); PG8_BAR; PG8_MMA(0, 0, At, B0); PG8_MMA(0, 1, At, B1); PG8_BAR; PG8_SCHED;
            PG8_LDA(At, 0, 1); PG8_STAGE(PG8_SB(0, 0), b2, voffB); PG8_STAGE(PG8_SB(0, 1), b2 + hstep, voffB); PG8_STAGE(PG8_SA(0, 0), a2, voffA);
            PG8_WAIT_V(8); PG8_WAIT_L(0); PG8_BAR; PG8_MMA(1, 0, At, B0); PG8_MMA(1, 1, At, B1); PG8_BAR; PG8_SCHED;
            PG8_LDB(B0, 1, 0); PG8_LDB(B1, 1, 1); PG8_SCHED; PG8_LDA(At, 1, 0); PG8_STAGE(PG8_SA(0, 1), a2 + hstep, voffA);
            PG8_WAIT_V(8); PG8_WAIT_L(0); PG8_BAR; PG8_MMA(0, 0, At, B0); PG8_MMA(0, 1, At, B1); PG8_BAR; PG8_SCHED;
            PG8_LDA(At, 1, 1); PG8_STAGE(PG8_SB(1, 0), b3, voffB); PG8_STAGE(PG8_SB(1, 1), b3 + hstep, voffB); PG8_STAGE(PG8_SA(1, 0), a3, voffA);
            PG8_WAIT_V(8); PG8_WAIT_L(0); PG8_BAR; PG8_MMA(1, 0, At, B0); PG8_MMA(1, 1, At, B1); PG8_BAR; PG8_SCHED;
            } else {
            PG8_LDB(B0, 0, 0); PG8_SCHED; PG8_LDA(At, 0, 0); PG8_STAGE(PG8_SA(1, 1), a1 + hstep, voffA);
            PG8_WAIT_L(8); PG8_BAR; PG8_WAIT_L(0); PG8_MMA(0, 0, At, B0); PG8_BAR; PG8_SCHED;
            PG8_LDB(B1, 0, 1); PG8_STAGE(PG8_SB(0, 0), b2, voffB);
            PG8_BAR; PG8_WAIT_L(0); PG8_MMA(0, 1, At, B1); PG8_BAR;
            PG8_LDA(At, 0, 1); PG8_STAGE(PG8_SA(0, 0), a2, voffA);
            PG8_BAR; PG8_WAIT_L(0); PG8_MMA(1, 0, At, B0); PG8_BAR; PG8_SCHED;
            PG8_STAGE(PG8_SB(0, 1), b2 + hstep, voffB);
            PG8_WAIT_V(6); PG8_BAR; PG8_MMA(1, 1, At, B1); PG8_BAR;
            PG8_LDB(B0, 1, 0); PG8_SCHED; PG8_LDA(At, 1, 0); PG8_STAGE(PG8_SA(0, 1), a2 + hstep, voffA);
            PG8_WAIT_L(8); PG8_BAR; PG8_WAIT_L(0); PG8_MMA(0, 0, At, B0); PG8_BAR; PG8_SCHED;
            PG8_LDB(B1, 1, 1); PG8_STAGE(PG8_SB(1, 0), b3, voffB);
            PG8_BAR; PG8_WAIT_L(0); PG8_MMA(0, 1, At, B1); PG8_BAR;
            PG8_LDA(At, 1, 1); PG8_STAGE(PG8_SA(1, 0), a3, voffA);
            PG8_BAR; PG8_WAIT_L(0); PG8_MMA(1, 0, At, B0); PG8_BAR; PG8_SCHED;
            PG8_STAGE(PG8_SB(1, 1), b3 + hstep, voffB);
            PG8_WAIT_V(6); PG8_BAR; PG8_MMA(1, 1, At, B1); PG8_BAR;
            }
        }
        if constexpr (ALIGN_EPI) { if (wr == 0) PG8_BAR; }
        if constexpr (!Epi::AFTER_DRAIN) { E(acc, cur, wr, wc, fr, fq); S.done(cur); }
        if (!has_next) break;
#pragma unroll
        for (int a = 0; a < 2; ++a)
#pragma unroll
            for (int b = 0; b < 2; ++b)
#pragma unroll
                for (int m = 0; m < 4; ++m)
#pragma unroll
                    for (int n = 0; n < 2; ++n) acc[a][b][m][n] = (f32x4){0.f, 0.f, 0.f, 0.f};
        cur = nxt; cA = nA; cB = nB; ++ui;
        if constexpr (ALIGN_EPI) { if (wr == 1) PG8_BAR; }
    }
    PG8_WAIT_V(0);
    if constexpr (!ALIGN_EPI) { if (wr == 0) PG8_BAR; }
    PG8_BAR;
    if constexpr (Epi::AFTER_DRAIN) { E.fused(acc, cur, wr, wc, fr, fq, lds, wid, lane); S.done(cur); }
#undef PG8_SA
#undef PG8_SB
#undef PG8_STAGE
#undef PG8_LDA
#undef PG8_LDB
#undef PG8_MMA
#undef PG8_WAIT_V
#undef PG8_WAIT_L
#undef PG8_BAR
#undef PG8_SCHED
}

typedef int i32x4 __attribute__((ext_vector_type(4)));
struct EpiI8Bf16 {
    static constexpr bool PERM = true, AFTER_DRAIN = false;
    bf16_t* O; int ldc; const float* rs; const float* cs; const float* bias;
    __device__ __forceinline__ void operator()(const i32x4 (&acc)[2][2][4][2], const Unit& u, int wr, int wc, int fr, int fq) const {
        const int row0 = u.pm * BM + wr * 64 + fr, col0 = u.pn * BM + wc * 32 + 8 * fq;
        f32x4 cv[2][2], bv[2][2];
#pragma unroll
        for (int bj = 0; bj < 2; ++bj)
#pragma unroll
            for (int n = 0; n < 2; ++n) { cv[bj][n] = *(const f32x4*)(cs + col0 + bj * HALF + 4 * n); bv[bj][n] = bias ? *(const f32x4*)(bias + col0 + bj * HALF + 4 * n) : (f32x4){0.f, 0.f, 0.f, 0.f}; }
#pragma unroll
        for (int ai = 0; ai < 2; ++ai)
#pragma unroll
            for (int m = 0; m < 4; ++m) { const int row = row0 + ai * HALF + m * 16; const float r = rs[row]; bf16_t* rowp = O + (size_t)row * ldc + col0;
#pragma unroll
                for (int bj = 0; bj < 2; ++bj) { const i32x4 a0 = acc[ai][bj][m][0], a1 = acc[ai][bj][m][1];
                    const f32x4 v0 = (f32x4){(float)a0[0], (float)a0[1], (float)a0[2], (float)a0[3]} * cv[bj][0] * r + bv[bj][0], v1 = (f32x4){(float)a1[0], (float)a1[1], (float)a1[2], (float)a1[3]} * cv[bj][1] * r + bv[bj][1];
                    u32x4 w; w.x = cvt_pk_bf16(v0[0], v0[1]); w.y = cvt_pk_bf16(v0[2], v0[3]); w.z = cvt_pk_bf16(v1[0], v1[1]); w.w = cvt_pk_bf16(v1[2], v1[3]);
                    *(u32x4*)(rowp + bj * HALF) = w; } }
    }
};
template <class Epi, class Sched, bool ALIGN_EPI = false, bool SP2 = false>
__device__ __forceinline__ void gemm_phase_i8(PG8_LAS unsigned char* lds, const Gemm g, const Sched& S, const Epi& E) {
    const int tid = threadIdx.x, wid = __builtin_amdgcn_readfirstlane(tid >> 6), lane = tid & 63, wr = wid >> 2, wc = wid & 3, fr = lane & 15, fq = lane >> 4;
    const int K = g.K, nt = K / BK;
    unsigned voffA[2], voffB[2];
#pragma unroll
    for (int i = 0; i < 2; ++i) { int R, C; stage_rc(tid * 16 + i * 8192, R, C); const int Rb = Epi::PERM ? ((R & ~31) + perm32(R & 31)) : R;
        voffA[i] = (unsigned)(R * K + C) * 2u; voffB[i] = (unsigned)(Rb * K + C) * 2u; }
    const size_t kstep = (size_t)(BK * 2);
    const size_t hstep = (size_t)HALF * K * 2;
    const size_t tstep = 2 * hstep;
    const unsigned ldsw = (unsigned)wid * 1024u;
    const int aoff = lds_byte(wr * 64 + fr, fq * 8), boff = lds_byte(wc * 32 + fr, fq * 8);
#define PG8_SA(b, h) (((b) * 2 + (h)) * HTB)
#define PG8_SB(b, h) ((4 + (b) * 2 + (h)) * HTB)
#define PG8_STAGE(bufoff, gbase, voff) do { _Pragma("unroll") for (int _i = 0; _i < 2; ++_i) \
        __builtin_amdgcn_global_load_lds((const unsigned*)((const char*)(gbase) + (voff)[_i]), (PG8_LAS unsigned*)(lds + (bufoff) + ldsw + _i * 8192), 16, 0, 0); } while (0)
#define PG8_LDA(dst, b, h) do { _Pragma("unroll") for (int m = 0; m < 4; ++m) _Pragma("unroll") for (int k = 0; k < 2; ++k) dst[m][k] = *(const PG8_LAS bf16x8*)(lds + PG8_SA(b, h) + aoff + m * 2048 + k * 1024); } while (0)
#define PG8_LDB(dst, b, h) do { _Pragma("unroll") for (int n = 0; n < 2; ++n) _Pragma("unroll") for (int k = 0; k < 2; ++k) dst[n][k] = *(const PG8_LAS bf16x8*)(lds + PG8_SB(b, h) + boff + n * 2048 + k * 1024); } while (0)
#define PG8_MMA(ai, bj, At, Bt) do { __builtin_amdgcn_s_setprio(1); _Pragma("unroll") for (int m = 0; m < 4; ++m) _Pragma("unroll") for (int n = 0; n < 2; ++n) _Pragma("unroll") for (int k = 0; k < 2; ++k) \
        acc[ai][bj][m][n] = __builtin_amdgcn_mfma_i32_16x16x64_i8(__builtin_bit_cast(i32x4, Bt[n][k]), __builtin_bit_cast(i32x4, At[m][k]), acc[ai][bj][m][n], 0, 0, 0); __builtin_amdgcn_s_setprio(0); } while (0)
#define PG8_WAIT_V(n) asm volatile("s_waitcnt vmcnt(" #n ")" ::: "memory")
#define PG8_WAIT_L(n) asm volatile("s_waitcnt lgkmcnt(" #n ")" ::: "memory")
#define PG8_BAR __builtin_amdgcn_s_barrier()
#define PG8_SCHED __builtin_amdgcn_sched_barrier(0)
    Unit cur, nxt; int ui = 0;
    if (!S.next(0, cur)) return;
    i32x4 acc[2][2][4][2];
#pragma unroll
    for (int a = 0; a < 2; ++a)
#pragma unroll
        for (int b = 0; b < 2; ++b)
#pragma unroll
            for (int m = 0; m < 4; ++m)
#pragma unroll
                for (int n = 0; n < 2; ++n) acc[a][b][m][n] = (i32x4){0, 0, 0, 0};
    bf16x8 At[4][2], B0[2][2], B1[2][2];
    const char* cA = (const char*)g.A + (size_t)cur.pm * tstep; const char* cB = (const char*)g.Bt + (size_t)cur.pn * tstep;
    S.a_ready(cur);
    if constexpr (SP2) {
        PG8_STAGE(PG8_SB(0, 0), cB, voffB); PG8_STAGE(PG8_SB(0, 1), cB + hstep, voffB); PG8_STAGE(PG8_SA(0, 0), cA, voffA); PG8_STAGE(PG8_SA(0, 1), cA + hstep, voffA);
        if (wr == 1) PG8_BAR;
        PG8_WAIT_V(2); PG8_BAR;
        PG8_STAGE(PG8_SB(1, 0), cB + kstep, voffB); PG8_STAGE(PG8_SA(1, 0), cA + kstep, voffA); PG8_STAGE(PG8_SB(1, 1), cB + hstep + kstep, voffB);
        PG8_WAIT_V(6); PG8_BAR;
    } else {
        PG8_STAGE(PG8_SB(0, 0), cB, voffB); PG8_STAGE(PG8_SA(0, 0), cA, voffA); PG8_STAGE(PG8_SB(0, 1), cB + hstep, voffB); PG8_STAGE(PG8_SA(0, 1), cA + hstep, voffA);
        if (wr == 1) PG8_BAR;
        PG8_WAIT_V(4); PG8_BAR;
        PG8_STAGE(PG8_SB(1, 0), cB + kstep, voffB); PG8_STAGE(PG8_SA(1, 0), cA + kstep, voffA); PG8_STAGE(PG8_SB(1, 1), cB + hstep + kstep, voffB);
        PG8_WAIT_V(6); PG8_BAR;
    }
    for (;;) {
        const bool has_next = S.next(ui + 1, nxt);
        const char* nA = has_next ? (const char*)g.A + (size_t)nxt.pm * tstep : cA; const char* nB = has_next ? (const char*)g.Bt + (size_t)nxt.pn * tstep : cB;
        for (int t = 0; t < nt; t += 2) {
            const bool last = (t == nt - 2);
            const char* a1 = cA + (size_t)(t + 1) * kstep;
            const char* a2 = last ? nA : cA + (size_t)(t + 2) * kstep; const char* b2 = last ? nB : cB + (size_t)(t + 2) * kstep;
            const char* a3 = a2 + kstep; const char* b3 = b2 + kstep;
            if (last && has_next) S.a_ready(nxt);
            if constexpr (SP2) {
            PG8_LDB(B0, 0, 0); PG8_LDB(B1, 0, 1); PG8_SCHED; PG8_LDA(At, 0, 0); PG8_STAGE(PG8_SA(1, 1), a1 + hstep, voffA);
            PG8_WAIT_V(8); PG8_WAIT_L(0); PG8_BAR; PG8_MMA(0, 0, At, B0); PG8_MMA(0, 1, At, B1); PG8_BAR; PG8_SCHED;
            PG8_LDA(At, 0, 1); PG8_STAGE(PG8_SB(0, 0), b2, voffB); PG8_STAGE(PG8_SB(0, 1), b2 + hstep, voffB); PG8_STAGE(PG8_SA(0, 0), a2, voffA);
            PG8_WAIT_V(8); PG8_WAIT_L(0); PG8_BAR; PG8_MMA(1, 0, At, B0); PG8_MMA(1, 1, At, B1); PG8_BAR; PG8_SCHED;
            PG8_LDB(B0, 1, 0); PG8_LDB(B1, 1, 1); PG8_SCHED; PG8_LDA(At, 1, 0); PG8_STAGE(PG8_SA(0, 1), a2 + hstep, voffA);
            PG8_WAIT_V(8); PG8_WAIT_L(0); PG8_BAR; PG8_MMA(0, 0, At, B0); PG8_MMA(0, 1, At, B1); PG8_BAR; PG8_SCHED;
            PG8_LDA(At, 1, 1); PG8_STAGE(PG8_SB(1, 0), b3, voffB); PG8_STAGE(PG8_SB(1, 1), b3 + hstep, voffB); PG8_STAGE(PG8_SA(1, 0), a3, voffA);
            PG8_WAIT_V(8); PG8_WAIT_L(0); PG8_BAR; PG8_MMA(1, 0, At, B0); PG8_MMA(1, 1, At, B1); PG8_BAR; PG8_SCHED;
            } else {
            PG8_LDB(B0, 0, 0); PG8_SCHED; PG8_LDA(At, 0, 0); PG8_STAGE(PG8_SA(1, 1), a1 + hstep, voffA);
            PG8_WAIT_L(8); PG8_BAR; PG8_WAIT_L(0); PG8_MMA(0, 0, At, B0); PG8_BAR; PG8_SCHED;
            PG8_LDB(B1, 0, 1); PG8_STAGE(PG8_SB(0, 0), b2, voffB);
            PG8_BAR; PG8_WAIT_L(0); PG8_MMA(0, 1, At, B1); PG8_BAR;
            PG8_LDA(At, 0, 1); PG8_STAGE(PG8_SA(0, 0), a2, voffA);
            PG8_BAR; PG8_WAIT_L(0); PG8_MMA(1, 0, At, B0); PG8_BAR; PG8_SCHED;
            PG8_STAGE(PG8_SB(0, 1), b2 + hstep, voffB);
            PG8_WAIT_V(6); PG8_BAR; PG8_MMA(1, 1, At, B1); PG8_BAR;
            PG8_LDB(B0, 1, 0); PG8_SCHED; PG8_LDA(At, 1, 0); PG8_STAGE(PG8_SA(0, 1), a2 + hstep, voffA);
            PG8_WAIT_L(8); PG8_BAR; PG8_WAIT_L(0); PG8_MMA(0, 0, At, B0); PG8_BAR; PG8_SCHED;
            PG8_LDB(B1, 1, 1); PG8_STAGE(PG8_SB(1, 0), b3, voffB);
            PG8_BAR; PG8_WAIT_L(0); PG8_MMA(0, 1, At, B1); PG8_BAR;
            PG8_LDA(At, 1, 1); PG8_STAGE(PG8_SA(1, 0), a3, voffA);
            PG8_BAR; PG8_WAIT_L(0); PG8_MMA(1, 0, At, B0); PG8_BAR; PG8_SCHED;
            PG8_STAGE(PG8_SB(1, 1), b3 + hstep, voffB);
            PG8_WAIT_V(6); PG8_BAR; PG8_MMA(1, 1, At, B1); PG8_BAR;
            }
        }
        if constexpr (ALIGN_EPI) { if (wr == 0) PG8_BAR; }
        if constexpr (!Epi::AFTER_DRAIN) { E(acc, cur, wr, wc, fr, fq); S.done(cur); }
        if (!has_next) break;
#pragma unroll
        for (int a = 0; a < 2; ++a)
#pragma unroll
            for (int b = 0; b < 2; ++b)
#pragma unroll
                for (int m = 0; m < 4; ++m)
#pragma unroll
                    for (int n = 0; n < 2; ++n) acc[a][b][m][n] = (i32x4){0, 0, 0, 0};
        cur = nxt; cA = nA; cB = nB; ++ui;
        if constexpr (ALIGN_EPI) { if (wr == 1) PG8_BAR; }
    }
    PG8_WAIT_V(0);
    if constexpr (!ALIGN_EPI) { if (wr == 0) PG8_BAR; }
    PG8_BAR;
    if constexpr (Epi::AFTER_DRAIN) { E.fused(acc, cur, wr, wc, fr, fq, lds, wid, lane); S.done(cur); }
#undef PG8_SA
#undef PG8_SB
#undef PG8_STAGE
#undef PG8_LDA
#undef PG8_LDB
#undef PG8_MMA
#undef PG8_WAIT_V
#undef PG8_WAIT_L
#undef PG8_BAR
#undef PG8_SCHED
}

}
#define GAS __attribute__((address_space(1)))
#define LAS __attribute__((address_space(3)))
typedef unsigned short bf16;
typedef unsigned v4u __attribute__((ext_vector_type(4)));
typedef float f32x4 __attribute__((ext_vector_type(4)));
typedef short bf16x8 __attribute__((ext_vector_type(8)));
typedef GAS unsigned gu32;
typedef GAS unsigned long long gu64;
#define RLX_AGENT __ATOMIC_RELAXED, __HIP_MEMORY_SCOPE_AGENT
#define LDS_WAIT() asm volatile("s_waitcnt lgkmcnt(0)" ::: "memory")
#define VM_WAIT() asm volatile("s_waitcnt vmcnt(0)" ::: "memory")
__device__ __forceinline__ unsigned long long rt() { return __builtin_amdgcn_s_memrealtime(); }
__device__ __forceinline__ unsigned f2bf(float f) { unsigned u = __builtin_bit_cast(unsigned, f); return (u + 0x7fffu + ((u >> 16) & 1u)) >> 16; }
__device__ __forceinline__ unsigned pk2(float lo, float hi) { return f2bf(lo) | (f2bf(hi) << 16); }

#define XB_TMO      128
#define XB_XCNT(j)  (256  + 64 * (j))
#define XB_XSUB(j)  (1280 + 64 * (j))
#define XB_XGEN(j)  (2304 + 64 * (j))
#define XB_TOP      3328
#define XB_TOPGEN   3392
#define XCD_BAR_WORDS 3456
#define XB_SPIN_CAP (1u << 18)

__device__ __forceinline__ unsigned xb_ld(unsigned* p)              { return __hip_atomic_load(p, __ATOMIC_RELAXED, __HIP_MEMORY_SCOPE_AGENT); }
__device__ __forceinline__ unsigned xb_add(unsigned* p, unsigned v) { return __hip_atomic_fetch_add(p, v, __ATOMIC_RELAXED, __HIP_MEMORY_SCOPE_AGENT); }
__device__ __forceinline__ unsigned xb_xcc_id() { return (unsigned)__builtin_amdgcn_s_getreg((3 << 11) | 20) & 0xFu; }
#define XB_SPIN(cond, bar) do { unsigned _sp = 0; while (cond) { __builtin_amdgcn_s_sleep(1); \
    if ((++_sp & 255u) == 0u) { if (xb_ld(&(bar)[XB_TMO])) break; if (_sp > XB_SPIN_CAP) { atomicAdd(&(bar)[XB_TMO], 1u); break; } } } } while (0)

struct XcdBarrier {
    unsigned* bar; unsigned x;
    volatile LAS unsigned* st;
};

__device__ __forceinline__ XcdBarrier xcd_barrier_post(unsigned* bar, volatile LAS unsigned* st) {
    XcdBarrier b; b.bar = bar; b.x = xb_xcc_id(); b.st = st;
    if (threadIdx.x == 0) (void)xb_add(&bar[XB_XCNT(b.x)], 1u);
    return b;
}
__device__ __forceinline__ void xcd_barrier_complete(unsigned* bar, unsigned x, unsigned& nloc, unsigned& nx) {
    const unsigned G = gridDim.x * gridDim.y * gridDim.z;
    unsigned sum, cnt, mine, sp = 0u;
    for (;;) {
        sum = 0u; cnt = 0u; mine = 0u;
#pragma unroll
        for (unsigned j = 0; j < 16; ++j) { const unsigned c = xb_ld(&bar[XB_XCNT(j)]); sum += c; cnt += (c > 0u) ? 1u : 0u; mine = (j == x) ? c : mine; }
        if (sum == G) break;
        __builtin_amdgcn_s_sleep(1);
        if ((++sp & 255u) == 0u) { if (xb_ld(&bar[XB_TMO])) break; if (sp > XB_SPIN_CAP) { atomicAdd(&bar[XB_TMO], 1u); break; } }
    }
    nloc = mine > 0u ? mine : 1u; nx = cnt > 0u ? cnt : 1u;
}

__device__ __forceinline__ void xcd_barrier(const XcdBarrier& b) {
    asm volatile("s_waitcnt vmcnt(0)" ::: "memory");
    __syncthreads();
    if (threadIdx.x == 0) {
        unsigned* bar = b.bar;
        __builtin_amdgcn_s_waitcnt(0);
        unsigned nloc = b.st[0], nx = b.st[1];
        if (nloc == 0u) { xcd_barrier_complete(bar, b.x, nloc, nx); b.st[0] = nloc; b.st[1] = nx; }
        const unsigned old = xb_add(&bar[XB_XSUB(b.x)], 1u);
        const unsigned gen = old / nloc;
        if (old + 1u == (gen + 1u) * nloc) {
            __builtin_amdgcn_fence(__ATOMIC_RELEASE, "agent");
            asm volatile("s_waitcnt vmcnt(0)" ::: "memory");
            const unsigned og = xb_add(&bar[XB_TOP], 1u);
            const unsigned tg = og / nx;
            if (og + 1u == (tg + 1u) * nx) xb_add(&bar[XB_TOPGEN], 1u);
            else XB_SPIN(xb_ld(&bar[XB_TOPGEN]) == tg, bar);
            __builtin_amdgcn_fence(__ATOMIC_ACQUIRE, "agent");
            xb_add(&bar[XB_XGEN(b.x)], 1u);
            asm volatile("s_waitcnt vmcnt(0)" ::: "memory");
        } else {
            XB_SPIN(xb_ld(&bar[XB_XGEN(b.x)]) == gen, bar);
            __builtin_amdgcn_fence(__ATOMIC_ACQUIRE, "agent");
            asm volatile("s_waitcnt vmcnt(0)" ::: "memory");
        }
    }
    __syncthreads();
}

typedef float f32x16 __attribute__((ext_vector_type(16)));
typedef short v4i16_t __attribute__((ext_vector_type(4)));
typedef float f32x2_t __attribute__((ext_vector_type(2)));
typedef __bf16 bf16x2_t __attribute__((ext_vector_type(2)));
typedef int i32x4 __attribute__((ext_vector_type(4)));
typedef unsigned u32x2 __attribute__((ext_vector_type(2)));

constexpr int NWAVES = 8, NTHR = 512;
constexpr int BATCH = 32, SEQ = 2048, DM = 1024, NTOK = BATCH * SEQ;
constexpr int NIN = 3088, NPROJ = 3328, NQP = 2048, NMOD = 6144;
constexpr int C_DQ = 0, C_DK = 512, C_DV = 1024, C_GQ = 1536, C_GK = 1792, C_GV = 2048, C_GR = 2560, C_GG = 3072;
constexpr int NEXP = 16384;
constexpr float RMS_EPS = 1e-6f;
constexpr float LAMBDA_INIT = 0.2f;
constexpr float QSCALE = 0.125f * 1.4426950408889634f;

constexpr size_t MiB = 1u << 20;
constexpr size_t WS_CTL = 0, CTL_ZERO_BYTES = 1 * MiB;
constexpr size_t WS_WIN_T = 2 * MiB;
constexpr size_t WS_WOUT_T = 10 * MiB;
constexpr size_t WS_WQ_T = 12 * MiB;
constexpr size_t WS_KEYS = 16 * MiB;
constexpr size_t WS_MOD = 17 * MiB;
constexpr size_t WS_WEFF = 18 * MiB;
constexpr size_t WS_CS = 19 * MiB;
constexpr size_t WS_RS1 = 20 * MiB;
constexpr size_t WS_RS2 = 21 * MiB;
constexpr size_t WS_CSQ = 19 * MiB + 16384;
constexpr size_t WS_COS = 32 * MiB;
constexpr size_t WS_SIN = 40 * MiB;
constexpr size_t WS_EU = 64 * MiB;
constexpr size_t WS_EV = 80 * MiB;
constexpr size_t WS_ES = 96 * MiB;
constexpr size_t WS_H = 128 * MiB;
constexpr size_t WS_HN = 192 * MiB;
constexpr size_t WS_PROJ = 256 * MiB;
constexpr size_t WS_PD = 256 * MiB;
constexpr size_t WS_X1 = 512 * MiB;
constexpr size_t WS_Y = 864 * MiB;
constexpr size_t WS_ACT = 768 * MiB;
constexpr size_t WS_EIDX = 800 * MiB;
constexpr size_t WS_EG = 832 * MiB;
constexpr size_t WS_END = 992 * MiB;
constexpr int CW_TMO = 0, CW_Q = 64, CW_RANK = 1024, CW_BAR = 4096, CW_WMAX = 32768;

constexpr int LDS_BYTES = 163840;
constexpr int MISC_OFF = LDS_BYTES - 256;

struct Args { const void* in[25]; float* out; unsigned char* ws; int ph_lo, ph_hi, li, pad; };
struct Ctx {
    LAS unsigned char* lds;
    volatile LAS unsigned* MISC;
    gu32* ctl;
    int tid, lane, wave, vcu, G;
    int sx, sj;
    float* out; unsigned char* ws;
};

__device__ __forceinline__ float wave_sum(float v) {
#pragma unroll
    for (int o = 1; o < 64; o <<= 1) v += __shfl_xor(v, o);
    return v;
}
__device__ __forceinline__ float wave_sum_fast(float x) {
    x += __int_as_float(__builtin_amdgcn_update_dpp(0, __float_as_int(x), 0xb1, 0xf, 0xf, false));
    x += __int_as_float(__builtin_amdgcn_update_dpp(0, __float_as_int(x), 0x4e, 0xf, 0xf, false));
    x += __int_as_float(__builtin_amdgcn_update_dpp(0, __float_as_int(x), 0x124, 0xf, 0xf, false));
    x += __int_as_float(__builtin_amdgcn_update_dpp(0, __float_as_int(x), 0x128, 0xf, 0xf, false));
    { auto r = __builtin_amdgcn_permlane16_swap(__float_as_uint(x), __float_as_uint(x), false, false); x = __uint_as_float(r[0]) + __uint_as_float(r[1]); }
    { auto r = __builtin_amdgcn_permlane32_swap(__float_as_uint(x), __float_as_uint(x), false, false); x = __uint_as_float(r[0]) + __uint_as_float(r[1]); }
    return x;
}
__device__ __forceinline__ unsigned cvtpk(float lo, float hi) { f32x2_t v = {lo, hi}; bf16x2_t b = __builtin_convertvector(v, bf16x2_t); return __builtin_bit_cast(unsigned, b); }
__device__ __forceinline__ float bf_lo(unsigned w) { return __uint_as_float(w << 16); }
__device__ __forceinline__ float bf_hi(unsigned w) { return __uint_as_float(w & 0xffff0000u); }
__device__ __forceinline__ int crow(int r, int hi) { return (r & 3) + 8 * (r >> 2) + 4 * hi; }
__device__ __forceinline__ float pair_max(float m) { auto rr = __builtin_amdgcn_permlane32_swap(__float_as_uint(m), __float_as_uint(m), false, false); return fmaxf(__uint_as_float(rr[0]), __uint_as_float(rr[1])); }
__device__ __forceinline__ float pair_sum(float m) { auto rr = __builtin_amdgcn_permlane32_swap(__float_as_uint(m), __float_as_uint(m), false, false); return __uint_as_float(rr[0]) + __uint_as_float(rr[1]); }
__device__ __forceinline__ int pair_maxi(int m) { auto rr = __builtin_amdgcn_permlane32_swap((unsigned)m, (unsigned)m, false, false); const int a = (int)rr[0], b = (int)rr[1]; return a > b ? a : b; }
__device__ __forceinline__ v4i16_t tr16(LAS const unsigned char* p) { return __builtin_amdgcn_ds_read_tr16_b64_v4i16((LAS v4i16_t*)p); }
__device__ __forceinline__ bf16x8 mk8(v4i16_t a, v4i16_t b) { return (bf16x8){a[0], a[1], a[2], a[3], b[0], b[1], b[2], b[3]}; }
#define MFMA32(a, b, c) __builtin_amdgcn_mfma_f32_32x32x16_bf16((a), (b), (c), 0, 0, 0)

__device__ __forceinline__ void p0_transpose_item(const float* W, int K, int ldw, int nblk, bf16* WT, LAS float* scr, int item, int lane) {
    const int kb = item / nblk, nb = item % nblk, k0 = 64 * kb, n0 = 32 * nb;
#pragma unroll 8
    for (int i = 0; i < 32; ++i) { const int kk = 2 * i + (lane >> 5); scr[kk * 33 + (lane & 31)] = W[(size_t)(k0 + kk) * ldw + n0 + (lane & 31)]; }
    LDS_WAIT(); asm volatile("" ::: "memory");
    const int c = lane & 7;
#pragma unroll
    for (int j = 0; j < 4; ++j) { const int n = (lane >> 3) + 8 * j; const LAS float* s = scr + (8 * c) * 33 + n;
        v4u o; o.x = pk2(s[0 * 33], s[1 * 33]); o.y = pk2(s[2 * 33], s[3 * 33]); o.z = pk2(s[4 * 33], s[5 * 33]); o.w = pk2(s[6 * 33], s[7 * 33]);
        *(GAS v4u*)(WT + (size_t)(n0 + n) * K + k0 + 8 * c) = o; }
    LDS_WAIT(); asm volatile("" ::: "memory");
}

__device__ __forceinline__ void mod_gemv(Ctx& C, const Args& A) {
    const float* cc = ((const float*)A.in[1]); const float* w_ada = ((const float*)A.in[3]); const float* b_ada = ((const float*)A.in[4]); float* mod = (float*)(C.ws + WS_MOD);
    LAS float* sc = (LAS float*)C.lds;
    LAS float* red = (LAS float*)(C.lds + 32768);
    const int col0 = C.vcu * 32, col = C.tid & 31, ks = C.tid >> 5;
    float acc[32];
#pragma unroll
    for (int i = 0; i < 32; ++i) acc[i] = 0.f;
    for (int kt = 0; kt < 4; ++kt) {
        for (int idx = C.tid; idx < 8192; idx += NTHR) { const int kk = idx >> 5, b = idx & 31; const float v = cc[b * 1024 + kt * 256 + kk]; sc[idx] = v / (1.f + __expf(-v)); }
        __syncthreads();
#pragma unroll 4
        for (int k2 = 0; k2 < 16; ++k2) { const int k = ks * 16 + k2; const float w = w_ada[(size_t)(kt * 256 + k) * NMOD + col0 + col];
#pragma unroll
            for (int b4 = 0; b4 < 8; ++b4) { const f32x4 f = *(const LAS f32x4*)(sc + k * 32 + 4 * b4);
                acc[4 * b4 + 0] += w * f.x; acc[4 * b4 + 1] += w * f.y; acc[4 * b4 + 2] += w * f.z; acc[4 * b4 + 3] += w * f.w; } }
        __syncthreads();
    }
#pragma unroll
    for (int b = 0; b < 32; ++b) red[(ks * 32 + b) * 32 + col] = acc[b];
    __syncthreads();
#pragma unroll
    for (int oo = 0; oo < 2; ++oo) { const int o = C.tid + oo * NTHR, c_ = o & 31, b = o >> 5; float s = 0.f;
#pragma unroll
        for (int k = 0; k < 16; ++k) s += red[(k * 32 + b) * 32 + c_];
        mod[b * NMOD + col0 + c_] = s + b_ada[col0 + c_]; }
    __syncthreads();
}

__device__ __forceinline__ void phase0(Ctx& C, const Args& A) {
    if (C.vcu < 192) mod_gemv(C, A);
    bf16* WoutT = (bf16*)(C.ws + WS_WOUT_T);
    const float* w_in = ((const float*)A.in[6]);
    unsigned* wmax = (unsigned*)(C.ctl + CW_WMAX);
    {
        LAS float* scr = (LAS float*)(C.lds + C.wave * 16384);
        const int gw = C.vcu * NWAVES + C.wave, NGW = C.G * NWAVES;
        constexpr int I_OUT = 16 * 32;
        for (int it = gw; it < I_OUT; it += NGW) p0_transpose_item(((const float*)A.in[17]), 1024, 1024, 32, WoutT, scr, it, C.lane);
    }
    const int gt = C.vcu * NTHR + C.tid, NGT = C.G * NTHR;
    {
        for (int it = gt; it < 16 * 3072; it += NGT) { const int kb = it / 3072, n = it - kb * 3072; float mx = 0.f;
#pragma unroll 8
            for (int k = 0; k < 64; ++k) mx = fmaxf(mx, fabsf(w_in[(size_t)(64 * kb + k) * NIN + n]));
            atomicMax(wmax + n, __float_as_uint(mx)); }
        const float* w_q = ((const float*)A.in[19]);
        for (int it = gt; it < 16 * 2048; it += NGT) { const int kb = it >> 11, n = it & 2047; float mx = 0.f;
#pragma unroll 8
            for (int k = 0; k < 64; ++k) mx = fmaxf(mx, fabsf(w_q[(size_t)(64 * kb + k) * NQP + n]));
            atomicMax(wmax + NPROJ + n, __float_as_uint(mx)); }
    }
    {
        const float* wg2 = ((const float*)A.in[14]); float* WE = (float*)(C.ws + WS_WEFF);
        for (int it = gt; it < 256 * 128; it += NGT) { const int j = it >> 7, kc = it & 127; float g[16];
#pragma unroll
            for (int r = 0; r < 16; ++r) g[r] = wg2[r * 256 + j];
            float o[8], mx = 0.f;
#pragma unroll
            for (int i = 0; i < 8; ++i) { const float* wr = w_in + (size_t)(8 * kc + i) * NIN + 3072; float s_ = 0.f;
#pragma unroll
                for (int r4 = 0; r4 < 4; ++r4) { const f32x4 w4 = *(const f32x4*)(wr + 4 * r4); s_ += w4.x * g[4 * r4] + w4.y * g[4 * r4 + 1] + w4.z * g[4 * r4 + 2] + w4.w * g[4 * r4 + 3]; }
                o[i] = s_; mx = fmaxf(mx, fabsf(s_)); }
            *(f32x4*)(WE + (size_t)j * 1024 + 8 * kc) = (f32x4){o[0], o[1], o[2], o[3]}; *(f32x4*)(WE + (size_t)j * 1024 + 8 * kc + 4) = (f32x4){o[4], o[5], o[6], o[7]};
            atomicMax(wmax + 3072 + j, __float_as_uint(mx)); }
    }
    {
        bf16* KB = (bf16*)(C.ws + WS_KEYS);
        for (int it = gt; it < 4096; it += NGT) { const float* src = (it < 2048 ? ((const float*)A.in[21]) : ((const float*)A.in[22])) + (size_t)(it & 2047) * 8;
            const f32x4 a = *(const f32x4*)src, b = *(const f32x4*)(src + 4);
            v4u ov; ov.x = pk2(a.x, a.y); ov.y = pk2(a.z, a.w); ov.z = pk2(b.x, b.y); ov.w = pk2(b.z, b.w);
            *(GAS v4u*)(KB + (size_t)it * 8) = ov; }
    }
    {
        const float* eu = ((const float*)A.in[23]); const float* ev = ((const float*)A.in[24]);
        unsigned char* E8 = C.ws + WS_EU; float* ES = (float*)(C.ws + WS_ES);
        const int gw = C.vcu * NWAVES + C.wave, NGW = C.G * NWAVES;
        f32x4 nv[4];
        { const int row = gw < 2 * NEXP ? gw : 0; const float* src = (row < NEXP ? eu + (size_t)row * 1024 : ev + (size_t)(row - NEXP) * 1024) + 16 * C.lane;
#pragma unroll
          for (int i = 0; i < 4; ++i) nv[i] = *(const f32x4*)(src + 4 * i); }
        for (int row = gw; row < 2 * NEXP; row += NGW) {
            f32x4 v[4];
#pragma unroll
            for (int i = 0; i < 4; ++i) v[i] = nv[i];
            { const int rn = row + NGW < 2 * NEXP ? row + NGW : row; const float* src = (rn < NEXP ? eu + (size_t)rn * 1024 : ev + (size_t)(rn - NEXP) * 1024) + 16 * C.lane;
#pragma unroll
              for (int i = 0; i < 4; ++i) nv[i] = *(const f32x4*)(src + 4 * i); }
            {
                float ss = 0.f;
#pragma unroll
                for (int i = 0; i < 4; ++i) ss += (v[i].x * v[i].x + v[i].y * v[i].y) + (v[i].z * v[i].z + v[i].w * v[i].w);
                const float rms = sqrtf(wave_sum_fast(ss) * (1.f / 1024.f));
                const float step = rms > 0.f ? 0.335f * rms : 1.f, istep = 1.f / step;
                const int lofs = row < NEXP ? 0 : 8;
                u32x2 ow;
#pragma unroll
                for (int q = 0; q < 2; ++q) { unsigned w = 0u;
#pragma unroll
                    for (int jj = 0; jj < 4; ++jj) { const int nl = (int)fminf(fmaxf(floorf(v[2 * q][jj] * istep), -8.f), 7.f), nh = (int)fminf(fmaxf(floorf(v[2 * q + 1][jj] * istep), -8.f), 7.f);
                        w |= ((unsigned)((nl + lofs) & 15) | ((unsigned)(nh & 15) << 4)) << (8 * jj); }
                    ow[q] = w; }
                *(GAS u32x2*)(E8 + (size_t)(row >= NEXP ? 1 : 0) * (16u << 20) + (size_t)(C.lane >> 4) * (2u << 20) + (size_t)(row & (NEXP - 1)) * 128 + 8 * (C.lane & 15)) = ow;
                if (C.lane == 0) ES[row] = step;
            }
        }
    }
}

__device__ __forceinline__ void phase0b(Ctx& C, const Args& A) {
    const float* w_in = ((const float*)A.in[6]); const float* WE = (const float*)(C.ws + WS_WEFF); const unsigned* wmax = (const unsigned*)(C.ctl + CW_WMAX);
    unsigned char* W8 = C.ws + WS_WIN_T; float* CS = (float*)(C.ws + WS_CS);
    const int gt = C.vcu * NTHR + C.tid, NGT = C.G * NTHR;
    for (int n = gt; n < NPROJ; n += NGT) { const float mx = __uint_as_float(__hip_atomic_load(wmax + n, __ATOMIC_RELAXED, __HIP_MEMORY_SCOPE_AGENT)); CS[n] = mx > 0.f ? mx * (1.f / 127.f) : 1.f; }
    for (int it = gt; it < 64 * 3072; it += NGT) { const int kb = it / 3072, n = it - kb * 3072;
        const float mx = __uint_as_float(__hip_atomic_load(wmax + n, __ATOMIC_RELAXED, __HIP_MEMORY_SCOPE_AGENT)); const float sc = mx > 0.f ? 127.f / mx : 1.f;
        v4u ov;
#pragma unroll
        for (int q = 0; q < 4; ++q) { int b_[4];
#pragma unroll
            for (int i = 0; i < 4; ++i) b_[i] = (int)rintf(w_in[(size_t)(16 * kb + 4 * q + i) * NIN + n] * sc);
            ov[q] = (unsigned)(b_[0] & 0xff) | ((unsigned)(b_[1] & 0xff) << 8) | ((unsigned)(b_[2] & 0xff) << 16) | ((unsigned)(b_[3] & 0xff) << 24); }
        *(GAS v4u*)(W8 + (size_t)n * 1024 + 16 * kb) = ov; }
    {   const float* w_q = ((const float*)A.in[19]); unsigned char* Q8 = C.ws + WS_WQ_T; float* CSQ = (float*)(C.ws + WS_CSQ);
        for (int n = gt; n < NQP; n += NGT) { const float mx = __uint_as_float(__hip_atomic_load(wmax + NPROJ + n, __ATOMIC_RELAXED, __HIP_MEMORY_SCOPE_AGENT)); CSQ[n] = mx > 0.f ? mx * (1.f / 127.f) : 1.f; }
        for (int it = gt; it < 64 * 2048; it += NGT) { const int kb = it >> 11, n = it & 2047;
            const float mx = __uint_as_float(__hip_atomic_load(wmax + NPROJ + n, __ATOMIC_RELAXED, __HIP_MEMORY_SCOPE_AGENT)); const float sc = mx > 0.f ? 127.f / mx : 1.f;
            v4u ov;
#pragma unroll
            for (int q = 0; q < 4; ++q) { int b_[4];
#pragma unroll
                for (int i = 0; i < 4; ++i) b_[i] = (int)rintf(w_q[(size_t)(16 * kb + 4 * q + i) * NQP + n] * sc);
                ov[q] = (unsigned)(b_[0] & 0xff) | ((unsigned)(b_[1] & 0xff) << 8) | ((unsigned)(b_[2] & 0xff) << 16) | ((unsigned)(b_[3] & 0xff) << 24); }
            *(GAS v4u*)(Q8 + (size_t)n * 1024 + 16 * kb) = ov; }
    }
    for (int it = gt; it < 256 * 64; it += NGT) { const int j = it >> 6, kb = it & 63;
        const float mx = __uint_as_float(__hip_atomic_load(wmax + 3072 + j, __ATOMIC_RELAXED, __HIP_MEMORY_SCOPE_AGENT)); const float sc = mx > 0.f ? 127.f / mx : 1.f;
        v4u ov;
#pragma unroll
        for (int q = 0; q < 4; ++q) { const f32x4 w4 = *(const f32x4*)(WE + (size_t)j * 1024 + 16 * kb + 4 * q);
            const int b0 = (int)rintf(w4.x * sc), b1 = (int)rintf(w4.y * sc), b2 = (int)rintf(w4.z * sc), b3 = (int)rintf(w4.w * sc);
            ov[q] = (unsigned)(b0 & 0xff) | ((unsigned)(b1 & 0xff) << 8) | ((unsigned)(b2 & 0xff) << 16) | ((unsigned)(b3 & 0xff) << 24); }
        *(GAS v4u*)(W8 + (size_t)(3072 + j) * 1024 + 16 * kb) = ov; }
}

template <bool XBF, bool OUT8, bool PLANES = false> __device__ __forceinline__ void norm_mod_rows32(const float* X, const float* g, const float* sc, const float* sh, bf16* O, float* RS, int row0, int rstride, int lane,
                                                                   const int* pos, float* COS, float* SIN, float invf) {
    f32x4 gs[4], hs[4];
#pragma unroll
    for (int j = 0; j < 4; ++j) { const int cidx = 128 * (j >> 1) + 2 * lane + (j & 1); const f32x4 g4 = ((const f32x4*)g)[cidx], s4 = ((const f32x4*)sc)[cidx]; gs[j] = g4 * (s4 + 1.0f); hs[j] = ((const f32x4*)sh)[cidx]; }
    f32x4 nx[4], ny[4], nz[4];
#define NM_LOAD(dst, r) do { if (!XBF) { _Pragma("unroll") for (int j = 0; j < 4; ++j) dst[j] = ((const GAS f32x4*)(X + (size_t)(r) * DM))[128 * (j >> 1) + 2 * lane + (j & 1)]; } \
        else { _Pragma("unroll") for (int hf_ = 0; hf_ < 2; ++hf_) { const v4u w_ = ((const GAS v4u*)((const bf16*)X + (size_t)(r) * DM))[64 * hf_ + lane]; \
            dst[2 * hf_] = (f32x4){bf_lo(w_.x), bf_hi(w_.x), bf_lo(w_.y), bf_hi(w_.y)}; dst[2 * hf_ + 1] = (f32x4){bf_lo(w_.z), bf_hi(w_.z), bf_lo(w_.w), bf_hi(w_.w)}; } } } while (0)
    NM_LOAD(nx, row0); NM_LOAD(ny, row0 + rstride); NM_LOAD(nz, row0 + 2 * rstride);
#pragma unroll 1
    for (int i = 0; i < 32; ++i) {
        const int m = row0 + i * rstride, mn = row0 + (i < 29 ? i + 3 : 31) * rstride;
        f32x4 v[4];
#pragma unroll
        for (int j = 0; j < 4; ++j) { v[j] = nx[j]; nx[j] = ny[j]; ny[j] = nz[j]; }
        NM_LOAD(nz, mn);
        float s = 0.f;
#pragma unroll
        for (int j = 0; j < 4; ++j) s += (v[j].x * v[j].x + v[j].y * v[j].y) + (v[j].z * v[j].z + v[j].w * v[j].w);
        const float rinv = 1.0f / sqrtf(wave_sum_fast(s) * (1.f / 1024.f) + RMS_EPS);
        if (!OUT8) {
            GAS v4u* o16 = (GAS v4u*)(O + (size_t)m * DM) + lane;
#pragma unroll
            for (int hf = 0; hf < 2; ++hf) { const f32x4 y0 = v[2 * hf] * rinv * gs[2 * hf] + hs[2 * hf], y1 = v[2 * hf + 1] * rinv * gs[2 * hf + 1] + hs[2 * hf + 1];
                o16[64 * hf] = (v4u){cvtpk(y0.x, y0.y), cvtpk(y0.z, y0.w), cvtpk(y1.x, y1.y), cvtpk(y1.z, y1.w)}; }
        } else {
            f32x4 y[4]; float mx = 0.f;
#pragma unroll
            for (int j = 0; j < 4; ++j) { y[j] = v[j] * rinv * gs[j] + hs[j]; mx = fmaxf(mx, fmaxf(fmaxf(fabsf(y[j].x), fabsf(y[j].y)), fmaxf(fabsf(y[j].z), fabsf(y[j].w)))); }
            mx = fmaxf(mx, __int_as_float(__builtin_amdgcn_update_dpp(0, __float_as_int(mx), 0xb1, 0xf, 0xf, false)));
            mx = fmaxf(mx, __int_as_float(__builtin_amdgcn_update_dpp(0, __float_as_int(mx), 0x4e, 0xf, 0xf, false)));
            mx = fmaxf(mx, __int_as_float(__builtin_amdgcn_update_dpp(0, __float_as_int(mx), 0x124, 0xf, 0xf, false)));
            mx = fmaxf(mx, __int_as_float(__builtin_amdgcn_update_dpp(0, __float_as_int(mx), 0x128, 0xf, 0xf, false)));
            { auto r = __builtin_amdgcn_permlane16_swap(__float_as_uint(mx), __float_as_uint(mx), false, false); mx = fmaxf(__uint_as_float(r[0]), __uint_as_float(r[1])); }
            { auto r = __builtin_amdgcn_permlane32_swap(__float_as_uint(mx), __float_as_uint(mx), false, false); mx = fmaxf(__uint_as_float(r[0]), __uint_as_float(r[1])); }
            constexpr float QTOP = PLANES ? 119.f : 127.f;
            const float qs = mx > 0.f ? QTOP / mx : 1.f;
            GAS u32x2* o8 = (GAS u32x2*)((unsigned char*)O + (size_t)m * DM) + lane;
#pragma unroll
            for (int hf = 0; hf < 2; ++hf) { u32x2 w; unsigned pa = 0u, pb = 0u;
#pragma unroll
                for (int q = 0; q < 2; ++q) { const f32x4 yy = y[2 * hf + q]; const int b0 = (int)rintf(yy.x * qs), b1 = (int)rintf(yy.y * qs), b2 = (int)rintf(yy.z * qs), b3 = (int)rintf(yy.w * qs);
                    w[q] = (unsigned)(b0 & 0xff) | ((unsigned)(b1 & 0xff) << 8) | ((unsigned)(b2 & 0xff) << 16) | ((unsigned)(b3 & 0xff) << 24);
                    if (PLANES) { const int bb[4] = {b0, b1, b2, b3};
#pragma unroll
                        for (int jj = 0; jj < 4; ++jj) { pa |= (unsigned)(((bb[jj] + 8) >> 4) & 15) << (8 * jj + 4 * q); pb |= (unsigned)(bb[jj] & 15) << (8 * jj + 4 * q); } } }
                o8[64 * hf] = w;
                if (PLANES) {
                    GAS unsigned* hn = (GAS unsigned*)((unsigned char*)O + (WS_HN - WS_H) + (size_t)m * DM + 256 * (2 * hf + (lane >> 5)) + 32 * ((lane >> 2) & 7) + 4 * (lane & 3));
                    hn[0] = pa; hn[4] = pb; } }
            if (lane == 0) RS[m] = mx > 0.f ? mx * (1.f / QTOP) : 1.f;
        }
    }
#undef NM_LOAD
}
__device__ __forceinline__ void phase1(Ctx& C, const Args& A) {
    const float* x = ((const float*)A.in[0]); const int* pos = (const int*)((const float*)A.in[2]); const float* g = ((const float*)A.in[5]); const float* mod = (const float*)(C.ws + WS_MOD);
    bf16* H = (bf16*)(C.ws + WS_H); float* COS = (float*)(C.ws + WS_COS); float* SIN = (float*)(C.ws + WS_SIN);
    const int gw = C.vcu * NWAVES + C.wave, NGW = C.G * NWAVES;
    const float invf = __builtin_amdgcn_exp2f(-(float)(C.lane & 31) * 0.41524101186092029f);
    for (int ch = gw; ch < NTOK / 32; ch += NGW) { const int b = ch >> 6;
        norm_mod_rows32<false, true>(x, g, mod + b * NMOD + 1024, mod + b * NMOD, H, (float*)(C.ws + WS_RS1), 2048 * b + (ch & 63), 64, C.lane, pos, COS, SIN, invf); }
}
__device__ __forceinline__ void phase5(Ctx& C, const Args& A) {
    const float* x1 = (const float*)(C.ws + WS_X1); const float* g = ((const float*)A.in[18]); const float* mod = (const float*)(C.ws + WS_MOD); bf16* H = (bf16*)(C.ws + WS_H);
    const int gw = C.vcu * NWAVES + C.wave, NGW = C.G * NWAVES;
    for (int ch = gw; ch < NTOK / 32; ch += NGW) { const int b = ch >> 6;
        norm_mod_rows32<true, true, true>(x1, g, mod + b * NMOD + 4 * 1024, mod + b * NMOD + 3 * 1024, H, (float*)(C.ws + WS_RS2), 2048 * b + (ch & 63), 64, C.lane, nullptr, nullptr, nullptr, 0.f); }
}

__device__ __forceinline__ void phase2b(Ctx& C, const Args& A) {
    bf16* PROJ = (bf16*)(C.ws + WS_PROJ); const int* pos = (const int*)A.in[2];
    const float* qn = ((const float*)A.in[7]); const float* kn = ((const float*)A.in[8]);
    const int gw = C.vcu * NWAVES + C.wave, NGW = C.G * NWAVES, lane = C.lane;
    const int grp = lane >> 2, qd = lane & 3;
    float gain[16];
#pragma unroll
    for (int i = 0; i < 16; ++i) gain[i] = (grp < 8 ? qn : kn)[16 * qd + i] * (grp < 8 ? QSCALE : 1.0f);
    const float sgn = (qd < 2) ? -1.f : 1.f;
    float invf[16];
#pragma unroll
    for (int i = 0; i < 16; ++i) invf[i] = __builtin_amdgcn_exp2f(-(float)(16 * (qd & 1) + i) * 0.41524101186092029f);
    v4u n0, n1; int npos;
    { const int m0 = gw < NTOK ? gw : 0; const GAS v4u* p = (const GAS v4u*)(PROJ + (size_t)m0 * NPROJ + 16 * lane); n0 = p[0]; n1 = p[1]; npos = pos[m0]; }
    for (int m = gw; m < NTOK; m += NGW) {
        GAS v4u* p = (GAS v4u*)(PROJ + (size_t)m * NPROJ + 16 * lane);
        const v4u w0 = n0, w1 = n1; const int ipos = npos;
        { const int mn = m + NGW < NTOK ? m + NGW : m; const GAS v4u* pn = (const GAS v4u*)(PROJ + (size_t)mn * NPROJ + 16 * lane); n0 = pn[0]; n1 = pn[1]; npos = pos[mn]; }
        float xv[16];
        xv[0] = bf_lo(w0.x); xv[1] = bf_hi(w0.x); xv[2] = bf_lo(w0.y); xv[3] = bf_hi(w0.y); xv[4] = bf_lo(w0.z); xv[5] = bf_hi(w0.z); xv[6] = bf_lo(w0.w); xv[7] = bf_hi(w0.w);
        xv[8] = bf_lo(w1.x); xv[9] = bf_hi(w1.x); xv[10] = bf_lo(w1.y); xv[11] = bf_hi(w1.y); xv[12] = bf_lo(w1.z); xv[13] = bf_hi(w1.z); xv[14] = bf_lo(w1.w); xv[15] = bf_hi(w1.w);
        float ss = 0.f;
#pragma unroll
        for (int i = 0; i < 16; ++i) ss += xv[i] * xv[i];
        ss += __int_as_float(__builtin_amdgcn_update_dpp(0, __float_as_int(ss), 0xb1, 0xf, 0xf, false)); ss += __int_as_float(__builtin_amdgcn_update_dpp(0, __float_as_int(ss), 0x4e, 0xf, 0xf, false));
        const float rinv = 1.0f / sqrtf(ss * (1.f / 64.f) + RMS_EPS);
        const float fpos = (float)ipos;
        float cs[16], sn[16];
#pragma unroll
        for (int i = 0; i < 16; ++i) { const float ang = fpos * invf[i]; const float fr = __builtin_amdgcn_fractf(ang * 0.15915494309189535f);
            cs[i] = __builtin_amdgcn_cosf(fr); sn[i] = __builtin_amdgcn_sinf(fr); }
        float y[16];
#pragma unroll
        for (int i = 0; i < 16; ++i) { const float v = xv[i] * rinv * gain[i]; const float pv = __int_as_float(__builtin_amdgcn_update_dpp(0, __float_as_int(v), 0x4e, 0xf, 0xf, false)); y[i] = v * cs[i] + sgn * pv * sn[i]; }
        v4u o0, o1;
        o0.x = cvtpk(y[0], y[1]); o0.y = cvtpk(y[2], y[3]); o0.z = cvtpk(y[4], y[5]); o0.w = cvtpk(y[6], y[7]);
        o1.x = cvtpk(y[8], y[9]); o1.y = cvtpk(y[10], y[11]); o1.z = cvtpk(y[12], y[13]); o1.w = cvtpk(y[14], y[15]);
        p[0] = o0; p[1] = o1;
    }
}

constexpr int AT_K1 = 8192, AT_V = 16384, AT_STG = 32768;
constexpr int AT_XP = 129;
constexpr int AT_YST = 66048, AT_YP = 272;
static_assert(4 * AT_STG <= MISC_OFF && 128 * AT_XP * 4 <= AT_YST && AT_YST + 128 * AT_YP <= 4 * AT_STG, "attention LDS map");

template <int ABL> __device__ __forceinline__ void attn_unit(Ctx& C, const Args& A, int bh, int qb, float lam) {
    const int b = bh >> 2, h = bh & 3;
    int tid_ = C.tid; asm volatile("" : "+v"(tid_));
    const int tid = tid_, lane = tid & 63, w = C.wave, r32 = lane & 31, hi = lane >> 5, mp = w >> 2, wq = w & 3;
    const bf16* P = (const bf16*)(C.ws + WS_PROJ) + (size_t)(b * SEQ) * NPROJ;
    const int NT = 2 * qb + 2;
    const int krow = 8 * w + (lane >> 3), vrow = 8 * w + (lane >> 4);
    const bf16* gk = P + (size_t)krow * NPROJ + C_DK + h * 128 + 8 * ((lane & 7) ^ ((krow >> 1) & 7));
    const bf16* gv = P + (size_t)vrow * NPROJ + C_DV + h * 128 + 8 * ((lane & 15) ^ ((vrow & 3) << 2));
#define AT_GLDS(src, dst) __builtin_amdgcn_global_load_lds((const unsigned*)(src), (LAS unsigned*)(dst), 16, 0, 0)
#define AT_DMA(t, s) do { const size_t o_ = (size_t)(t) * 64 * NPROJ; LAS unsigned char* d_ = C.lds + (s) * AT_STG + w * 1024; \
        AT_GLDS(gk + o_, d_); AT_GLDS(gk + o_ + 64, d_ + AT_K1); AT_GLDS(gv + o_, d_ + AT_V + w * 1024); AT_GLDS(gv + o_ + (size_t)4 * NPROJ, d_ + AT_V + w * 1024 + 1024); } while (0)
    AT_DMA(0, 0);
    AT_DMA(1, 1);
    const int qrow = qb * 128 + wq * 32 + r32;
    bf16x8 qf[4];
#pragma unroll
    for (int kk = 0; kk < 4; ++kk) qf[kk] = *(const GAS bf16x8*)(P + (size_t)qrow * NPROJ + C_DQ + h * 128 + mp * 64 + 16 * kk + 8 * hi);
    f32x16 o[4];
#pragma unroll
    for (int e = 0; e < 4; ++e)
#pragma unroll
        for (int r = 0; r < 16; ++r) o[e][r] = 0.f;
    float mrun = -1e30f, lrun = 0.f;
    int koff[4], voff[4];
    { const int swz = (r32 >> 1) & 7, trq = (lane & 15) >> 2;
#pragma unroll
      for (int kk = 0; kk < 4; ++kk) koff[kk] = mp * AT_K1 + r32 * 128 + (((2 * kk + hi) ^ swz) << 4);
#pragma unroll
      for (int e = 0; e < 4; ++e) voff[e] = AT_V + (4 * hi + trq) * 256 + ((e ^ trq) << 6) + 32 * ((lane >> 4) & 1) + 8 * (lane & 3); }
    asm volatile("s_waitcnt vmcnt(0)" ::: "memory");
    __syncthreads();
#define AT_QKSM(t, stg, PW) do { \
        const LAS unsigned char* base = C.lds + (stg) * AT_STG; \
        f32x16 p0, p1; \
        _Pragma("unroll") for (int r = 0; r < 16; ++r) { p0[r] = 0.f; p1[r] = 0.f; } \
        _Pragma("unroll") for (int kk = 0; kk < 4; ++kk) { const bf16x8 a0 = *(const LAS bf16x8*)(base + koff[kk]), a1 = *(const LAS bf16x8*)(base + koff[kk] + 32 * 128); \
            p0 = MFMA32(a0, qf[kk], p0); p1 = MFMA32(a1, qf[kk], p1); } \
        if ((t) >= 2 * qb) { \
            _Pragma("unroll") for (int r = 0; r < 16; ++r) { const int key = 64 * (t) + crow(r, hi); if (key > qrow) p0[r] = -1e30f; if (key + 32 > qrow) p1[r] = -1e30f; } } \
        float mx = fmaxf(p0[0], p1[0]); \
        _Pragma("unroll") for (int r = 1; r < 16; ++r) mx = fmaxf(mx, fmaxf(p0[r], p1[r])); \
        mx = pair_max(mx); \
        const float mnew = fmaxf(mrun, mx); \
        if (__any(mnew > mrun)) { const float alpha = __builtin_amdgcn_exp2f(mrun - mnew); mrun = mnew; lrun *= alpha; \
            _Pragma("unroll") for (int e = 0; e < 4; ++e) _Pragma("unroll") for (int r = 0; r < 16; ++r) o[e][r] *= alpha; } \
        float rs = 0.f; \
        _Pragma("unroll") for (int r = 0; r < 16; ++r) { p0[r] = __builtin_amdgcn_exp2f(p0[r] - mrun); p1[r] = __builtin_amdgcn_exp2f(p1[r] - mrun); rs += p0[r] + p1[r]; } \
        lrun += rs; \
        { v4u t0, t1, t2, t3; \
          t0.x = cvtpk(p0[0], p0[1]); t0.y = cvtpk(p0[2], p0[3]); t0.z = cvtpk(p0[4], p0[5]); t0.w = cvtpk(p0[6], p0[7]); \
          t1.x = cvtpk(p0[8], p0[9]); t1.y = cvtpk(p0[10], p0[11]); t1.z = cvtpk(p0[12], p0[13]); t1.w = cvtpk(p0[14], p0[15]); \
          t2.x = cvtpk(p1[0], p1[1]); t2.y = cvtpk(p1[2], p1[3]); t2.z = cvtpk(p1[4], p1[5]); t2.w = cvtpk(p1[6], p1[7]); \
          t3.x = cvtpk(p1[8], p1[9]); t3.y = cvtpk(p1[10], p1[11]); t3.z = cvtpk(p1[12], p1[13]); t3.w = cvtpk(p1[14], p1[15]); \
          PW[0] = __builtin_bit_cast(bf16x8, t0); PW[1] = __builtin_bit_cast(bf16x8, t1); PW[2] = __builtin_bit_cast(bf16x8, t2); PW[3] = __builtin_bit_cast(bf16x8, t3); } \
    } while (0)
#define AT_PV(stage, PW) do { const LAS unsigned char* vb_ = C.lds + (stage) * AT_STG; \
        _Pragma("unroll") for (int e = 0; e < 4; ++e) { \
            v4i16_t lo[4], hi4[4]; \
            _Pragma("unroll") for (int s = 0; s < 4; ++s) { const LAS unsigned char* a_ = vb_ + voff[e] + (16 * s) * 256; lo[s] = tr16(a_); hi4[s] = tr16(a_ + 8 * 256); } \
            _Pragma("unroll") for (int s = 0; s < 4; ++s) o[e] = MFMA32(mk8(lo[s], hi4[s]), PW[s], o[e]); \
            __builtin_amdgcn_sched_barrier(0); \
        } } while (0)
    bf16x8 pw[4];
    for (int t = 0; t < NT; t += 2) {
        if (t + 2 < NT) { AT_DMA(t + 2, (t + 2) & 3); AT_DMA(t + 3, (t + 3) & 3); }
        AT_QKSM(t, t & 3, pw); __builtin_amdgcn_sched_barrier(0); AT_PV(t & 3, pw);
        AT_QKSM(t + 1, (t + 1) & 3, pw); __builtin_amdgcn_sched_barrier(0); AT_PV((t + 1) & 3, pw);
        asm volatile("s_waitcnt vmcnt(0)" ::: "memory");
        __syncthreads();
    }
    __syncthreads();
#undef AT_QKSM
#undef AT_PV
#undef AT_DMA
#undef AT_GLDS
    lrun = pair_sum(lrun);
    const float linv = 1.0f / lrun;
    LAS float* xch = (LAS float*)C.lds;
    if (mp == 1) {
#pragma unroll
        for (int e = 0; e < 4; ++e)
#pragma unroll
            for (int r = 0; r < 16; ++r) xch[(wq * 32 + r32) * AT_XP + 32 * e + crow(r, hi)] = o[e][r] * linv;
    }
    __syncthreads();
    if (mp == 0 && ABL != 0) { asm volatile("" :: "v"(o[0]), "v"(o[1]), "v"(o[2]), "v"(o[3]), "v"(lrun)); }
    if (mp == 0 && ABL == 0) {
        const float* sg = ((const float*)A.in[13]);
        float ss = 0.f;
#pragma unroll
        for (int e = 0; e < 4; ++e)
#pragma unroll
            for (int r = 0; r < 16; ++r) { const float v = o[e][r] * linv - lam * xch[(wq * 32 + r32) * AT_XP + 32 * e + crow(r, hi)]; o[e][r] = v; ss += v * v; }
        ss = pair_sum(ss);
        const float rinv = (1.0f - LAMBDA_INIT) / sqrtf(ss * (1.f / 128.f) + RMS_EPS);
        LAS unsigned char* yst = C.lds + AT_YST + (wq * 32 + r32) * AT_YP;
#pragma unroll
        for (int e = 0; e < 4; ++e)
#pragma unroll
            for (int g = 0; g < 4; ++g) { const int ec = 32 * e + 8 * g + 4 * hi; const f32x4 g4 = *(const f32x4*)(sg + ec);
                u32x2 ov; ov.x = cvtpk(o[e][4 * g] * rinv * g4.x, o[e][4 * g + 1] * rinv * g4.y); ov.y = cvtpk(o[e][4 * g + 2] * rinv * g4.z, o[e][4 * g + 3] * rinv * g4.w);
                *(LAS u32x2*)(yst + ec * 2) = ov; }
    }
    __syncthreads();
    if (ABL == 0) {
        bf16* Y = (bf16*)(C.ws + WS_Y) + (size_t)(b * SEQ + qb * 128) * DM + h * 128;
#pragma unroll
        for (int i = 0; i < 4; ++i) { const int idx = tid + i * NTHR, row = idx >> 4, ch = idx & 15;
            *(GAS v4u*)(Y + (size_t)row * DM + 8 * ch) = *(const LAS v4u*)(C.lds + AT_YST + row * AT_YP + ch * 16); }
    }
    __syncthreads();
}

constexpr int GL_BC = 0;
constexpr int GL_QE = 17408, GL_KE = GL_QE + 9216, GL_QS = GL_KE + 9216, GL_AM = GL_QS + 9216;
constexpr int GL_KD = GL_AM + 9216;
constexpr int GL_V = GL_KD + 12288;
constexpr int GL_SB = GL_V + 20480;
constexpr int GL_O = GL_SB + 20480;
constexpr int GL_SM = GL_O + 33792;
constexpr int GL_END = GL_SM + 768 + 2048;
static_assert(GL_END <= MISC_OFF, "GLA LDS map");

__device__ __forceinline__ void gla_unit(Ctx& C, const Args& A, int bh) {
    const int b = bh >> 2, h = bh & 3;
    int tid_ = C.tid; asm volatile("" : "+v"(tid_));
    const int tid = tid_, lane = tid & 63, w = C.wave, r32 = lane & 31, hi = lane >> 5;
    const bf16* P = (const bf16*)(C.ws + WS_PROJ) + (size_t)(b * SEQ) * NPROJ;
    bf16* Y = (bf16*)(C.ws + WS_Y) + (size_t)(b * SEQ) * DM + 512 + h * 128;
    LAS unsigned char* L = C.lds;
    LAS float* BC = (LAS float*)(L + GL_BC); LAS float* BMID = (LAS float*)(L + GL_SM); LAS float* BLAST = BMID + 64; LAS float* DEC = BMID + 128; LAS float* SEG = BMID + 192;
    LAS float* OI = (LAS float*)(L + GL_O);
    const float bg = ((const float*)A.in[15])[h * 64 + (tid & 63)];
    const int db = w & 1, eb = w >> 1;
    f32x16 S;
#pragma unroll
    for (int r = 0; r < 16; ++r) S[r] = 0.f;
    const int trq = (lane & 15) >> 2, trc = 16 * ((lane >> 4) & 1) + 4 * (lane & 3);
    unsigned short pre_n[8]; v4u q_n, k_n, v_n[2], r_n[2];
#define GL_FETCH(n_) do { const bf16* Pf_ = P + (size_t)((n_) * 64) * NPROJ; \
        _Pragma("unroll") for (int i = 0; i < 8; ++i) pre_n[i] = *(const GAS unsigned short*)(Pf_ + (size_t)(8 * (tid >> 6) + i) * NPROJ + C_GG + h * 64 + (tid & 63)); \
        q_n = *(const GAS v4u*)(Pf_ + (size_t)(tid >> 3) * NPROJ + C_GQ + h * 64 + 8 * (tid & 7)); k_n = *(const GAS v4u*)(Pf_ + (size_t)(tid >> 3) * NPROJ + C_GK + h * 64 + 8 * (tid & 7)); \
        _Pragma("unroll") for (int i = 0; i < 2; ++i) { const int idx_ = tid + i * NTHR; v_n[i] = *(const GAS v4u*)(Pf_ + (size_t)(idx_ >> 4) * NPROJ + C_GV + h * 128 + 8 * (idx_ & 15)); } \
        { const GAS v4u* rp_ = (const GAS v4u*)(Pf_ + (size_t)(tid >> 3) * NPROJ + C_GR + h * 128 + 16 * (tid & 7)); r_n[0] = rp_[0]; r_n[1] = rp_[1]; } } while (0)
    GL_FETCH(0);
    for (int n = 0; n < 32; ++n) {
        unsigned short pre_c[8]; v4u q_c = q_n, k_c = k_n, v_c[2] = {v_n[0], v_n[1]}, r_c[2] = {r_n[0], r_n[1]};
#pragma unroll
        for (int i = 0; i < 8; ++i) pre_c[i] = pre_n[i];
        GL_FETCH(n < 31 ? n + 1 : 31);
        {   const int d = tid & 63, seg = tid >> 6; float pre[8];
#pragma unroll
            for (int i = 0; i < 8; ++i) pre[i] = __uint_as_float((unsigned)pre_c[i] << 16);
            float run = 0.f;
#pragma unroll
            for (int i = 0; i < 8; ++i) { const float z = pre[i] + bg; const float ls = fminf(z, 0.f) - __logf(1.0f + __expf(-fabsf(z))); run += ls * (1.f / 16.f); pre[i] = run; }
            SEG[seg * 64 + d] = run;
            __syncthreads();
            float off = 0.f;
#pragma unroll
            for (int s = 0; s < 8; ++s) off += (s < seg) ? SEG[s * 64 + d] : 0.f;
#pragma unroll
            for (int i = 0; i < 8; ++i) { const float v = pre[i] + off; BC[(8 * seg + i) * 68 + d] = v;
                if (8 * seg + i == 32) BMID[d] = v;
                if (8 * seg + i == 63) { BLAST[d] = v; DEC[d] = __expf(v); } }
            __syncthreads();
        }
        {   const int c = tid >> 3, d8 = tid & 7;
            const v4u qw = q_c, kw = k_c;
            const unsigned qa[4] = {qw.x, qw.y, qw.z, qw.w}, ka[4] = {kw.x, kw.y, kw.z, kw.w};
            const f32x4 bc0 = *(const LAS f32x4*)(BC + c * 68 + 8 * d8), bc1 = *(const LAS f32x4*)(BC + c * 68 + 8 * d8 + 4);
            const f32x4 bm0 = *(const LAS f32x4*)(BMID + 8 * d8), bm1 = *(const LAS f32x4*)(BMID + 8 * d8 + 4);
            const f32x4 bl0 = *(const LAS f32x4*)(BLAST + 8 * d8), bl1 = *(const LAS f32x4*)(BLAST + 8 * d8 + 4);
            const float bcv[8] = {bc0.x, bc0.y, bc0.z, bc0.w, bc1.x, bc1.y, bc1.z, bc1.w}, bmv[8] = {bm0.x, bm0.y, bm0.z, bm0.w, bm1.x, bm1.y, bm1.z, bm1.w}, blv[8] = {bl0.x, bl0.y, bl0.z, bl0.w, bl1.x, bl1.y, bl1.z, bl1.w};
            float qe[8], ke[8], qs[8], kd[8];
#pragma unroll
            for (int i = 0; i < 8; ++i) { const float q = ((i & 1) ? bf_hi(qa[i >> 1]) : bf_lo(qa[i >> 1])) * 0.125f, k = (i & 1) ? bf_hi(ka[i >> 1]) : bf_lo(ka[i >> 1]);
                qe[i] = q * __expf(bcv[i] - bmv[i]); ke[i] = k * __expf(bmv[i] - bcv[i]); qs[i] = q * __expf(bcv[i]); kd[i] = k * __expf(blv[i] - bcv[i]); }
            v4u o_;
            o_.x = cvtpk(qe[0], qe[1]); o_.y = cvtpk(qe[2], qe[3]); o_.z = cvtpk(qe[4], qe[5]); o_.w = cvtpk(qe[6], qe[7]); *(LAS v4u*)(L + GL_QE + c * 144 + d8 * 16) = o_;
            o_.x = cvtpk(ke[0], ke[1]); o_.y = cvtpk(ke[2], ke[3]); o_.z = cvtpk(ke[4], ke[5]); o_.w = cvtpk(ke[6], ke[7]); *(LAS v4u*)(L + GL_KE + c * 144 + d8 * 16) = o_;
            o_.x = cvtpk(qs[0], qs[1]); o_.y = cvtpk(qs[2], qs[3]); o_.z = cvtpk(qs[4], qs[5]); o_.w = cvtpk(qs[6], qs[7]); *(LAS v4u*)(L + GL_QS + c * 144 + d8 * 16) = o_;
            o_.x = cvtpk(kd[0], kd[1]); o_.y = cvtpk(kd[2], kd[3]); o_.z = cvtpk(kd[4], kd[5]); o_.w = cvtpk(kd[6], kd[7]); *(LAS v4u*)(L + GL_KD + c * 192 + d8 * 16) = o_;
#pragma unroll
            for (int i = 0; i < 2; ++i) { const int idx = tid + i * NTHR, row = idx >> 4, ch = idx & 15;
                *(LAS v4u*)(L + GL_V + row * 320 + ch * 16) = v_c[i]; }
#pragma unroll
            for (int r = 0; r < 16; ++r) *(LAS unsigned short*)(L + GL_SB + (32 * db + crow(r, hi)) * 320 + (32 * eb + r32) * 2) = (unsigned short)(cvtpk(S[r], 0.f) & 0xffffu);
            __syncthreads();
        }
        if (w < 4) {
            const int cb = w & 1, jb = w >> 1; f32x16 a;
#pragma unroll
            for (int r = 0; r < 16; ++r) a[r] = 0.f;
#pragma unroll
            for (int kk = 0; kk < 4; ++kk) { const bf16x8 fa = *(const LAS bf16x8*)(L + GL_QE + (32 * cb + r32) * 144 + (16 * kk + 8 * hi) * 2), fb = *(const LAS bf16x8*)(L + GL_KE + (32 * jb + r32) * 144 + (16 * kk + 8 * hi) * 2);
                a = MFMA32(fa, fb, a); }
#pragma unroll
            for (int r = 0; r < 16; ++r) { const int cc = 32 * cb + crow(r, hi), jj = 32 * jb + r32; const float v = (jj <= cc) ? a[r] : 0.f;
                *(LAS unsigned short*)(L + GL_AM + cc * 144 + jj * 2) = (unsigned short)(cvtpk(v, 0.f) & 0xffffu); }
        }
        {
#pragma unroll
            for (int r = 0; r < 16; ++r) S[r] *= DEC[32 * db + crow(r, hi)];
#pragma unroll
            for (int kk = 0; kk < 4; ++kk) { const LAS unsigned char* pa = L + GL_KD + (16 * kk + 8 * hi + trq) * 192 + (32 * db + trc) * 2; const LAS unsigned char* pb = L + GL_V + (16 * kk + 8 * hi + trq) * 320 + (32 * eb + trc) * 2;
                const bf16x8 fa = mk8(tr16(pa), tr16(pa + 4 * 192)), fb = mk8(tr16(pb), tr16(pb + 4 * 320));
                S = MFMA32(fa, fb, S); }
        }
        __syncthreads();
        {   const int cb = w & 1; f32x16 a;
#pragma unroll
            for (int r = 0; r < 16; ++r) a[r] = 0.f;
#pragma unroll
            for (int kk = 0; kk < 4; ++kk) { const bf16x8 fa = *(const LAS bf16x8*)(L + GL_AM + (32 * cb + r32) * 144 + (16 * kk + 8 * hi) * 2);
                const LAS unsigned char* pb = L + GL_V + (16 * kk + 8 * hi + trq) * 320 + (32 * eb + trc) * 2;
                a = MFMA32(fa, mk8(tr16(pb), tr16(pb + 4 * 320)), a); }
#pragma unroll
            for (int kk = 0; kk < 4; ++kk) { const bf16x8 fa = *(const LAS bf16x8*)(L + GL_QS + (32 * cb + r32) * 144 + (16 * kk + 8 * hi) * 2);
                const LAS unsigned char* pb = L + GL_SB + (16 * kk + 8 * hi + trq) * 320 + (32 * eb + trc) * 2;
                a = MFMA32(fa, mk8(tr16(pb), tr16(pb + 4 * 320)), a); }
#pragma unroll
            for (int r = 0; r < 16; ++r) OI[(32 * cb + crow(r, hi)) * 132 + 32 * eb + r32] = a[r];
        }
        __syncthreads();
        {   const int c = tid >> 3, e8 = tid & 7; float ov[16];
#pragma unroll
            for (int i = 0; i < 4; ++i) { const f32x4 t4 = *(const LAS f32x4*)(OI + c * 132 + 16 * e8 + 4 * i); ov[4 * i] = t4.x; ov[4 * i + 1] = t4.y; ov[4 * i + 2] = t4.z; ov[4 * i + 3] = t4.w; }
            float ss = 0.f;
#pragma unroll
            for (int i = 0; i < 16; ++i) ss += ov[i] * ov[i];
            ss += __shfl_xor(ss, 1); ss += __shfl_xor(ss, 2); ss += __shfl_xor(ss, 4);
            const float rinv = 1.0f / sqrtf(ss * (1.f / 128.f) + RMS_EPS);
            const v4u r0 = r_c[0], r1 = r_c[1]; const unsigned ra[8] = {r0.x, r0.y, r0.z, r0.w, r1.x, r1.y, r1.z, r1.w};
            const float* gg = ((const float*)A.in[16]) + 16 * e8; float y[16];
#pragma unroll
            for (int i = 0; i < 16; ++i) { const float rv = (i & 1) ? bf_hi(ra[i >> 1]) : bf_lo(ra[i >> 1]); y[i] = ov[i] * rinv * gg[i] * (rv / (1.f + __expf(-rv))); }
            v4u o0, o1;
            o0.x = cvtpk(y[0], y[1]); o0.y = cvtpk(y[2], y[3]); o0.z = cvtpk(y[4], y[5]); o0.w = cvtpk(y[6], y[7]);
            o1.x = cvtpk(y[8], y[9]); o1.y = cvtpk(y[10], y[11]); o1.z = cvtpk(y[12], y[13]); o1.w = cvtpk(y[14], y[15]);
            GAS v4u* yp = (GAS v4u*)(Y + (size_t)(n * 64 + c) * DM + 16 * e8); yp[0] = o0; yp[1] = o1;
        }
    }
#undef GL_FETCH
    __syncthreads();
}

template <int ABL> __device__ __forceinline__ void phase3(Ctx& C, const Args& A, int rep) {
    float lam;
    {   const float a = ((const float*)A.in[9])[C.lane] * ((const float*)A.in[10])[C.lane], b2 = ((const float*)A.in[11])[C.lane] * ((const float*)A.in[12])[C.lane];
        lam = __expf(wave_sum(a)) - __expf(wave_sum(b2)) + LAMBDA_INIT; }
    constexpr int NITEM = 128 + 2048;
    for (;;) {
        if (C.tid == 0) C.MISC[0] = __hip_atomic_fetch_add(C.ctl + CW_Q + 64 * rep, 1u, __ATOMIC_RELAXED, __HIP_MEMORY_SCOPE_AGENT);
        __syncthreads();
        const int item = (int)C.MISC[0];
        __syncthreads();
        if (item >= NITEM) break;
        if (item < 128) { if (ABL == 0) gla_unit(C, A, item); }
        else { const int idx = item - 128; attn_unit<ABL>(C, A, idx & 127, 15 - (idx >> 7), lam); }
    }
}

constexpr int PK_P = 272;
constexpr int PK_BYTES = 128 * PK_P;
constexpr int PS_PITCH = 132, PS_EIDX = 2 * PK_BYTES, PS_EG = PS_EIDX + 64 * PS_PITCH * 4;
static_assert(PS_EG + 64 * PS_PITCH * 4 <= MISC_OFF, "PEER score LDS map");
#define CE_DESC(a, b) do { const float mx_ = fmaxf(a, b), mn_ = fminf(a, b); a = mx_; b = mn_; } while (0)
__device__ __forceinline__ void sort16_desc(float* v) {
#pragma unroll
    for (int k = 2; k <= 16; k *= 2)
#pragma unroll
        for (int j = k / 2; j > 0; j /= 2)
#pragma unroll
            for (int i = 0; i < 16; ++i) { const int l = i ^ j; if (l > i) { if ((i & k) == 0) CE_DESC(v[i], v[l]); else CE_DESC(v[l], v[i]); } }
}
__device__ __forceinline__ void bitonic_merge16_desc(float* v) {
#pragma unroll
    for (int j = 8; j > 0; j /= 2)
#pragma unroll
        for (int i = 0; i < 16; ++i) { const int l = i ^ j; if (l > i) CE_DESC(v[i], v[l]); }
}
__device__ __forceinline__ void merge_top16(float* a, const float* b) {
#pragma unroll
    for (int i = 0; i < 16; ++i) a[i] = fmaxf(a[i], b[15 - i]);
    bitonic_merge16_desc(a);
}
__device__ __forceinline__ void top16_pair64(float (&v)[64], float (&out)[16], int hi) {
    sort16_desc(v); sort16_desc(v + 16); sort16_desc(v + 32); sort16_desc(v + 48);
    merge_top16(v, v + 16); merge_top16(v + 32, v + 48); merge_top16(v, v + 32);
#pragma unroll
    for (int i = 0; i < 8; ++i) { const float p = v[i], q = v[15 - i]; v[i] = hi ? q : p; v[15 - i] = hi ? p : q; }
#pragma unroll
    for (int i = 0; i < 16; ++i) out[i] = pair_max(v[i]);
    bitonic_merge16_desc(out);
}

template <int SABL> __device__ __forceinline__ void peer_scores(Ctx& C, const Args& A, int t0) {
    const int lane = C.lane, w = C.wave, r32 = lane & 31, hi = lane >> 5;
    const bf16* QP = (const bf16*)(C.ws + WS_PROJ);
    int* EIDX = (int*)(C.ws + WS_EIDX); float* EG = (float*)(C.ws + WS_EG);
#pragma unroll 1
    for (int tb = 0; tb < 2; ++tb) {
        const int t = t0 + 32 * tb + r32;
        float tv[2][16];
#pragma unroll 1
        for (int half = 0; half < 2; ++half) {
            bf16x8 qf[8];
#pragma unroll
            for (int kk = 0; kk < 8; ++kk) qf[kk] = *(const GAS bf16x8*)(QP + (size_t)(SABL ? t0 : t) * NQP + w * 256 + half * 128 + 16 * kk + 8 * hi);
            float sv[64];
#pragma unroll
            for (int kb = 0; kb < 4; ++kb) { f32x16 s;
#pragma unroll
                for (int r = 0; r < 16; ++r) s[r] = 0.f;
#pragma unroll
                for (int kk = 0; kk < 8; ++kk) { const bf16x8 a = *(const LAS bf16x8*)(C.lds + half * PK_BYTES + (32 * kb + r32) * PK_P + (16 * kk + 8 * hi) * 2); s = MFMA32(a, qf[kk], s); }
#pragma unroll
                for (int r = 0; r < 16; ++r) sv[16 * kb + r] = __uint_as_float((__float_as_uint(s[r]) & ~127u) | (unsigned)(32 * kb + crow(r, hi))); }
            float to[16];
            if (SABL == 2) {
#pragma unroll
                for (int i = 0; i < 16; ++i) to[i] = sv[i] + sv[16 + i] + sv[32 + i] + sv[48 + i]; }
            else top16_pair64(sv, to, hi);
            if (half == 0) {
#pragma unroll
                for (int i = 0; i < 16; ++i) tv[0][i] = to[i];
            } else {
#pragma unroll
                for (int i = 0; i < 16; ++i) tv[1][i] = to[i];
            }
        }
        float cv[32];
#define PEER_CAND(k, a0, b0, a1, b1) do { const float s0_ = tv[0][a0] + tv[1][b0], s1_ = tv[0][a1] + tv[1][b1]; \
            const unsigned e0_ = ((__float_as_uint(tv[0][a0]) & 127u) << 7) | (__float_as_uint(tv[1][b0]) & 127u), e1_ = ((__float_as_uint(tv[0][a1]) & 127u) << 7) | (__float_as_uint(tv[1][b1]) & 127u); \
            const float s_ = hi ? s1_ : s0_; const unsigned e_ = hi ? e1_ : e0_; cv[k] = __uint_as_float((__float_as_uint(s_) & ~0x3FFFu) | e_); } while (0)
        PEER_CAND(0, 0, 0, 2, 1);
        PEER_CAND(1, 0, 1, 2, 2);
        PEER_CAND(2, 0, 2, 2, 3);
        PEER_CAND(3, 0, 3, 2, 4);
        PEER_CAND(4, 0, 4, 3, 0);
        PEER_CAND(5, 0, 5, 3, 1);
        PEER_CAND(6, 0, 6, 3, 2);
        PEER_CAND(7, 0, 7, 3, 3);
        PEER_CAND(8, 0, 8, 4, 0);
        PEER_CAND(9, 0, 9, 4, 1);
        PEER_CAND(10, 0, 10, 4, 2);
        PEER_CAND(11, 0, 11, 5, 0);
        PEER_CAND(12, 0, 12, 5, 1);
        PEER_CAND(13, 0, 13, 6, 0);
        PEER_CAND(14, 0, 14, 6, 1);
        PEER_CAND(15, 0, 15, 7, 0);
        PEER_CAND(16, 1, 0, 7, 1);
        PEER_CAND(17, 1, 1, 8, 0);
        PEER_CAND(18, 1, 2, 9, 0);
        PEER_CAND(19, 1, 3, 10, 0);
        PEER_CAND(20, 1, 4, 11, 0);
        PEER_CAND(21, 1, 5, 12, 0);
        PEER_CAND(22, 1, 6, 13, 0);
        PEER_CAND(23, 1, 7, 14, 0);
        PEER_CAND(24, 2, 0, 15, 0);
#undef PEER_CAND
#pragma unroll
        for (int k = 25; k < 32; ++k) cv[k] = -INFINITY;
        sort16_desc(cv); sort16_desc(cv + 16); merge_top16(cv, cv + 16);
#pragma unroll
        for (int i = 0; i < 8; ++i) { const float p = cv[i], q = cv[15 - i]; cv[i] = hi ? q : p; cv[15 - i] = hi ? p : q; }
        float selv[16]; int sele[16];
#pragma unroll
        for (int i = 0; i < 16; ++i) selv[i] = pair_max(cv[i]);
        bitonic_merge16_desc(selv);
#pragma unroll
        for (int k = 0; k < 16; ++k) { const unsigned b_ = __float_as_uint(selv[k]); sele[k] = (int)(b_ & 0x3FFFu); selv[k] = __uint_as_float(b_ & ~0x3FFFu); }
        float ex[16], sum = 0.f;
#pragma unroll
        for (int k = 0; k < 16; ++k) { ex[k] = __expf(selv[k] - selv[0]); sum += ex[k]; }
        const float inv = 1.0f / sum;
        if (hi == 0) { LAS int* p = (LAS int*)(C.lds + PS_EIDX) + (32 * tb + r32) * PS_PITCH + 2 * w;
#pragma unroll
            for (int kk = 0; kk < 16; ++kk) p[16 * (kk & 7) + (kk >> 3)] = sele[kk]; }
        else { LAS float* p = (LAS float*)(C.lds + PS_EG) + (32 * tb + r32) * PS_PITCH + 2 * w;
#pragma unroll
            for (int kk = 0; kk < 16; ++kk) p[16 * (kk & 7) + (kk >> 3)] = ex[kk] * inv; }
    }
}

__device__ __forceinline__ float gelu_erf(float v) {
    const float av = fabsf(v), t = __builtin_amdgcn_rcpf(av * 0.2316418882f + 1.0f);
    float q = t * 0.5307027145f + (-0.7265760135f); q = q * t + 0.7107068705f; q = q * t + (-0.142248368f); q = q * t + 0.127414796f; q = q * t;
    const float e = __builtin_amdgcn_exp2f((v * v) * (-0.72134752044f));
    const float m = v * (q * e);
    return v < 0.f ? m : v - m;
}
__device__ __forceinline__ void gather8(unsigned v, bool q1, unsigned (&out)[8]) {
    const unsigned m = (unsigned)__builtin_amdgcn_update_dpp(0, (int)v, 0x141, 0xf, 0xf, false);
    const unsigned v0 = (unsigned)__builtin_amdgcn_update_dpp(0, (int)v, 0x00, 0xf, 0xf, false), v1 = (unsigned)__builtin_amdgcn_update_dpp(0, (int)v, 0x55, 0xf, 0xf, false);
    const unsigned v2 = (unsigned)__builtin_amdgcn_update_dpp(0, (int)v, 0xaa, 0xf, 0xf, false), v3 = (unsigned)__builtin_amdgcn_update_dpp(0, (int)v, 0xff, 0xf, 0xf, false);
    const unsigned m0 = (unsigned)__builtin_amdgcn_update_dpp(0, (int)m, 0x00, 0xf, 0xf, false), m1 = (unsigned)__builtin_amdgcn_update_dpp(0, (int)m, 0x55, 0xf, 0xf, false);
    const unsigned m2 = (unsigned)__builtin_amdgcn_update_dpp(0, (int)m, 0xaa, 0xf, 0xf, false), m3 = (unsigned)__builtin_amdgcn_update_dpp(0, (int)m, 0xff, 0xf, 0xf, false);
    out[0] = q1 ? m3 : v0; out[1] = q1 ? m2 : v1; out[2] = q1 ? m1 : v2; out[3] = q1 ? m0 : v3;
    out[4] = q1 ? v0 : m3; out[5] = q1 ? v1 : m2; out[6] = q1 ? v2 : m1; out[7] = q1 ? v3 : m0;
}
__device__ __forceinline__ int dot8_z(int a, int b) { int r; asm("v_dot8_i32_i4 %0, %1, %2, 0" : "=v"(r) : "v"(a), "v"(b)); return r; }
__device__ __forceinline__ int dot4_z(int a, int b) { int r; asm("v_dot4_i32_i8 %0, %1, %2, 0" : "=v"(r) : "v"(a), "v"(b)); return r; }
__device__ __forceinline__ float dpp_sum8(float x) {
    x += __int_as_float(__builtin_amdgcn_update_dpp(0, __float_as_int(x), 0xb1, 0xf, 0xf, false));
    x += __int_as_float(__builtin_amdgcn_update_dpp(0, __float_as_int(x), 0x4e, 0xf, 0xf, false));
    x += __int_as_float(__builtin_amdgcn_update_dpp(0, __float_as_int(x), 0x141, 0xf, 0xf, false));
    return x;
}
#define PG_PIN16(a) asm volatile("" : "+v"(a[0]), "+v"(a[1]), "+v"(a[2]), "+v"(a[3]), "+v"(a[4]), "+v"(a[5]), "+v"(a[6]), "+v"(a[7]), "+v"(a[8]), "+v"(a[9]), "+v"(a[10]), "+v"(a[11]), "+v"(a[12]), "+v"(a[13]), "+v"(a[14]), "+v"(a[15]))
#define PG_CVT(w, f) do { _Pragma("unroll") for (int d_ = 0; d_ < 4; ++d_) { const f32x2_t lo_ = __builtin_amdgcn_cvt_pk_f32_fp8((int)(w)[d_], false), hi_ = __builtin_amdgcn_cvt_pk_f32_fp8((int)(w)[d_], true); \
        f[4 * d_] = lo_.x; f[4 * d_ + 1] = lo_.y; f[4 * d_ + 2] = hi_.x; f[4 * d_ + 3] = hi_.y; } } while (0)

template <int SABL> __device__ __forceinline__ void phase_peer_scores(Ctx& C, const Args& A) {
    {
        const bf16* KB = (const bf16*)(C.ws + WS_KEYS);
        for (int idx = C.tid; idx < 2 * 128 * 16; idx += NTHR) { const int set = idx >> 11, row = (idx >> 4) & 127, ch = idx & 15;
            *(LAS v4u*)(C.lds + set * PK_BYTES + row * PK_P + ch * 16) = *(const GAS v4u*)(KB + (size_t)set * 16384 + row * 128 + ch * 8); }
        __syncthreads();
    }
    for (int tile = C.vcu; tile < NTOK / 64; tile += C.G) {
        peer_scores<SABL>(C, A, tile * 64);
        __syncthreads();
        unsigned short* EIDX = (unsigned short*)(C.ws + WS_EIDX) + (size_t)tile * 64 * 128; float* EG = (float*)(C.ws + WS_EG) + (size_t)tile * 64 * 128;
#pragma unroll
        for (int i = 0; i < 2; ++i) { const int idx = C.tid + i * NTHR, row = idx >> 4, ch = idx & 15;
            const v4u a = *(const LAS v4u*)(C.lds + PS_EIDX + (row * PS_PITCH + 8 * ch) * 4), b = *(const LAS v4u*)(C.lds + PS_EIDX + (row * PS_PITCH + 8 * ch + 4) * 4);
            *(GAS v4u*)(EIDX + row * 128 + 8 * ch) = (v4u){a.x | (a.y << 16), a.z | (a.w << 16), b.x | (b.y << 16), b.z | (b.w << 16)}; }
#pragma unroll
        for (int i = 0; i < 4; ++i) { const int idx = C.tid + i * NTHR, row = idx >> 5, ch = idx & 31;
            *(GAS v4u*)(EG + row * 128 + 4 * ch) = *(const LAS v4u*)(C.lds + PS_EG + (row * PS_PITCH + 4 * ch) * 4); }
        __syncthreads();
    }
}

template <int MODE> __device__ __forceinline__ void phase_peer_u(Ctx& C, const Args& A) {
    int lane_ = C.lane; asm volatile("" : "+v"(lane_)); const int lane = lane_;
    const int x = C.sx >> 1, j = ((C.sx & 1) << 5) | C.sj, g = lane >> 3, c = lane & 7;
    const unsigned char* HN = C.ws + WS_HN + 256 * x + 32 * c + 4 * g;
    const bool q1 = (lane & 4) != 0; const int bpa = 4 * c;
    const float* RS = (const float*)(C.ws + WS_RS2);
    const unsigned short* EIDX = (const unsigned short*)(C.ws + WS_EIDX) + 16 * g + 2 * c;
    bf16* PD = (bf16*)(C.ws + WS_PD) + (size_t)x * NTOK * 128 + 16 * g;
    const __amdgpu_buffer_rsrc_t RU = __builtin_amdgcn_make_buffer_rsrc((void*)(C.ws + WS_EU + (size_t)x * (2u << 20)), 0, 2 << 20, 0x00020000);
    const int t0 = 1024 * j + 128 * C.wave, tlast = t0 + 127;
    const int kb_ = 8 * ((c >> 2) & 1) + 4 * ((c >> 1) & 1) + 2 * (c & 1);
    unsigned ewn, hwn, hwA, hwB; float h1n, hA1, hB1;
    v4u rA[16], rB[16];
#define PU_LDE(t) do { ewn = *(const GAS unsigned*)(EIDX + (size_t)(t) * 128); hwn = *(const GAS unsigned*)(HN + (size_t)(t) * DM); h1n = *(const GAS float*)(RS + (t)); } while (0)
#define PU_LDR(R) do { unsigned en[8]; gather8(ewn, q1, en); _Pragma("unroll") for (int k = 0; k < 16; ++k) { const unsigned w_ = en[k >> 1]; const int ek_ = (int)((k & 1) ? (w_ >> 16) : (w_ & 0xffffu)); \
        R[k] = __builtin_bit_cast(v4u, __builtin_amdgcn_raw_buffer_load_b128(RU, ek_ * 128 + 16 * c, 0, 0)); } } while (0)
#define PU_COMP(R, hw, h1, t) do { const float hinv = h1; int pa_[4], pb_[4]; \
        _Pragma("unroll") for (int d = 0; d < 4; ++d) { pa_[d] = __builtin_amdgcn_ds_bpermute(bpa + 32 * d, (int)hw); pb_[d] = __builtin_amdgcn_ds_bpermute(bpa + 32 * (4 + d), (int)hw); } \
        __builtin_amdgcn_sched_barrier(0); \
          \
        int sa_ = dot8_z(pa_[0], 0x11111111), sb_ = dot8_z(pb_[0], 0x11111111); \
        _Pragma("unroll") for (int d = 1; d < 4; ++d) { sa_ = __builtin_amdgcn_sdot8(pa_[d], 0x11111111, sa_, false); sb_ = __builtin_amdgcn_sdot8(pb_[d], 0x11111111, sb_, false); } \
        const float corr_ = dpp_sum8((float)((sa_ << 4) + sb_)) * (0.5f * hinv); \
        int ia_[16]; \
        _Pragma("unroll") for (int k = 0; k < 16; ++k) { asm volatile("" : "+v"(R[k])); int a_ = dot8_z((int)R[k][0], pa_[0]), b_ = dot8_z((int)R[k][0], pb_[0]); \
            _Pragma("unroll") for (int d = 1; d < 4; ++d) { a_ = __builtin_amdgcn_sdot8((int)R[k][d], pa_[d], a_, false); b_ = __builtin_amdgcn_sdot8((int)R[k][d], pb_[d], b_, false); } \
            ia_[k] = (a_ << 4) + b_; } \
          \
        int ib_[8], ic_[4], id0_, id1_; \
        { const bool b2 = (lane & 4) != 0, b1 = (lane & 2) != 0, b0 = (lane & 1) != 0; \
          _Pragma("unroll") for (int k = 0; k < 8; ++k) { const int keep = b2 ? ia_[k + 8] : ia_[k], send = b2 ? ia_[k] : ia_[k + 8]; ib_[k] = keep + __builtin_amdgcn_update_dpp(0, send, 0x141, 0xf, 0xf, false); } \
          _Pragma("unroll") for (int k = 0; k < 4; ++k) { const int keep = b1 ? ib_[k + 4] : ib_[k], send = b1 ? ib_[k] : ib_[k + 4]; ic_[k] = keep + __builtin_amdgcn_update_dpp(0, send, 0x1b, 0xf, 0xf, false); } \
          { const int keep = b0 ? ic_[2] : ic_[0], send = b0 ? ic_[0] : ic_[2]; id0_ = keep + __builtin_amdgcn_update_dpp(0, send, 0xb1, 0xf, 0xf, false); } \
          { const int keep = b0 ? ic_[3] : ic_[1], send = b0 ? ic_[1] : ic_[3]; id1_ = keep + __builtin_amdgcn_update_dpp(0, send, 0xb1, 0xf, 0xf, false); } } \
          \
        *(GAS unsigned*)(PD + (size_t)(t) * 128 + kb_) = cvtpk((float)id0_ * hinv + corr_, (float)id1_ * hinv + corr_); \
        __builtin_amdgcn_sched_barrier(0); } while (0)
    PU_LDE(t0);
    PU_LDR(rA); hwA = hwn; hA1 = h1n;
    PU_LDE(t0 + 1);
#pragma unroll 1
    for (int ti = 0; ti < 128; ti += 2) {
        const int t = t0 + ti;
        PU_LDR(rB); hwB = hwn; hB1 = h1n;
        PU_LDE(t + 2 < tlast ? t + 2 : tlast);
        __builtin_amdgcn_sched_barrier(0);
        PU_COMP(rA, hwA, hA1, t);
        PU_LDR(rA); hwA = hwn; hA1 = h1n;
        PU_LDE(t + 3 < tlast ? t + 3 : tlast);
        __builtin_amdgcn_sched_barrier(0);
        PU_COMP(rB, hwB, hB1, t + 1);
    }
#undef PU_LDE
#undef PU_LDR
#undef PU_COMP
}

__device__ __forceinline__ void phase_peer_act(Ctx& C, const Args& A) {
    const bf16* PD = (const bf16*)(C.ws + WS_PD); const unsigned short* EIDX = (const unsigned short*)(C.ws + WS_EIDX); const float* EG = (const float*)(C.ws + WS_EG);
    unsigned* ACT8 = (unsigned*)(C.ws + WS_ACT); float* ACTS = (float*)(C.ws + WS_ACT + (size_t)NTOK * 128);
    LAS float* SU = (LAS float*)C.lds; LAS float* SV = SU + NEXP;
    { const GAS v4u* src = (const GAS v4u*)(C.ws + WS_ES); for (int i = C.tid; i < 2 * NEXP / 4; i += NTHR) ((LAS v4u*)C.lds)[i] = src[i]; }
    __syncthreads();
    const int gt = C.vcu * NTHR + C.tid, NGT = C.G * NTHR;
    for (int it = gt; it < NTOK * 128 / 4; it += NGT) {
        f32x4 z = {0.f, 0.f, 0.f, 0.f};
#pragma unroll
        for (int xs = 0; xs < 4; ++xs) { const u32x2 w_ = *(const GAS u32x2*)(PD + (size_t)xs * NTOK * 128 + (size_t)it * 4); z += (f32x4){bf_lo(w_.x), bf_hi(w_.x), bf_lo(w_.y), bf_hi(w_.y)}; }
        const u32x2 ew = *(const GAS u32x2*)(EIDX + (size_t)it * 4); const f32x4 gg = *(const GAS f32x4*)(EG + (size_t)it * 4);
        const int e0 = ew.x & 0xffffu, e1 = ew.x >> 16, e2 = ew.y & 0xffffu, e3 = ew.y >> 16;
        f32x4 a;
        a.x = gelu_erf(z.x * SU[e0]) * gg.x * SV[e0]; a.y = gelu_erf(z.y * SU[e1]) * gg.y * SV[e1];
        a.z = gelu_erf(z.z * SU[e2]) * gg.z * SV[e2]; a.w = gelu_erf(z.w * SU[e3]) * gg.w * SV[e3];
        float amax = fmaxf(fmaxf(fabsf(a.x), fabsf(a.y)), fmaxf(fabsf(a.z), fabsf(a.w)));
        amax = fmaxf(amax, __int_as_float(__builtin_amdgcn_update_dpp(0, __float_as_int(amax), 0xb1, 0xf, 0xf, false)));
        amax = fmaxf(amax, __int_as_float(__builtin_amdgcn_update_dpp(0, __float_as_int(amax), 0x4e, 0xf, 0xf, false)));
        amax = fmaxf(amax, __int_as_float(__builtin_amdgcn_update_dpp(0, __float_as_int(amax), 0x124, 0xf, 0xf, false)));
        amax = fmaxf(amax, __int_as_float(__builtin_amdgcn_update_dpp(0, __float_as_int(amax), 0x128, 0xf, 0xf, false)));
        { auto r = __builtin_amdgcn_permlane16_swap(__float_as_uint(amax), __float_as_uint(amax), false, false); amax = fmaxf(__uint_as_float(r[0]), __uint_as_float(r[1])); }
        const float as_ = amax > 0.f ? 127.f / amax : 1.f;
        const int b0 = (int)rintf(a.x * as_), b1 = (int)rintf(a.y * as_), b2 = (int)rintf(a.z * as_), b3 = (int)rintf(a.w * as_);
        ACT8[it] = (unsigned)(b0 & 0xff) | ((unsigned)(b1 & 0xff) << 8) | ((unsigned)(b2 & 0xff) << 16) | ((unsigned)(b3 & 0xff) << 24);
        int bs = (b0 + b1) + (b2 + b3);
        bs += __builtin_amdgcn_update_dpp(0, bs, 0xb1, 0xf, 0xf, false); bs += __builtin_amdgcn_update_dpp(0, bs, 0x4e, 0xf, 0xf, false);
        bs += __builtin_amdgcn_update_dpp(0, bs, 0x124, 0xf, 0xf, false); bs += __builtin_amdgcn_update_dpp(0, bs, 0x128, 0xf, 0xf, false);
        { auto r = __builtin_amdgcn_permlane16_swap((unsigned)bs, (unsigned)bs, false, false); bs = (int)r[0] + (int)r[1]; }
        if ((it & 31) == 0) { ACTS[it >> 5] = amax > 0.f ? amax * (1.f / 127.f) : 1.f; ACTS[NTOK + (it >> 5)] = (float)bs; }
    }
}

template <int VABL> __device__ __forceinline__ void phase_peer_v(Ctx& C, const Args& A) {
    int lane_ = C.lane; asm volatile("" : "+v"(lane_)); const int lane = lane_;
    const int x = C.sx >> 1, j = ((C.sx & 1) << 5) | C.sj, g = lane >> 3, c = lane & 7;
    const unsigned short* EIDX = (const unsigned short*)(C.ws + WS_EIDX) + 16 * g + 2 * c; const unsigned char* ACT8 = (const unsigned char*)(C.ws + WS_ACT) + 16 * g + 4 * (c & 3); const float* ACTS = (const float*)(C.ws + WS_ACT + (size_t)NTOK * 128);
    const bool q1 = (lane & 4) != 0;
    const __amdgpu_buffer_rsrc_t RV = __builtin_amdgcn_make_buffer_rsrc((void*)(C.ws + WS_EV + (size_t)x * (2u << 20)), 0, 2 << 20, 0x00020000);
    const int t0 = 1024 * j + 128 * C.wave, tlast = t0 + 127;
    const int cc_ = 256 * x + 32 * c + 4 * g;
    const bf16* X1 = (const bf16*)(C.ws + WS_X1) + cc_;
    const f32x4 g2 = *(const f32x4*)((const float*)(C.ws + WS_MOD) + (size_t)(t0 >> 11) * NMOD + 5 * 1024 + cc_);
    const float mulc = (g & 1) ? 0.0625f : 1.f, addc = (g & 1) ? 0.5f : -7.5f;
    unsigned ewn, an, aA, aB; float sn, sA, sB, zn, zA, zB; u32x2 xn, xA, xB;
    v4u rA[16], rB[16];
#define PV_LDE(t) do { ewn = *(const GAS unsigned*)(EIDX + (size_t)(t) * 128); an = *(const GAS unsigned*)(ACT8 + (size_t)(t) * 128); \
        sn = *(const GAS float*)(ACTS + (t)); zn = *(const GAS float*)(ACTS + NTOK + (t)); xn = *(const GAS u32x2*)(X1 + (size_t)(t) * DM); } while (0)
#define PV_LDR(R, AV, SV_, ZV_, XV_) do { unsigned en[8]; gather8(ewn, q1, en); _Pragma("unroll") for (int k = 0; k < 16; ++k) { const unsigned w_ = en[k >> 1]; const int ek_ = (int)((k & 1) ? (w_ >> 16) : (w_ & 0xffffu)); \
        R[k] = __builtin_bit_cast(v4u, __builtin_amdgcn_raw_buffer_load_b128(RV, ek_ * 128 + 16 * c, 0, 0)); } \
        AV = an; SV_ = sn; ZV_ = zn; XV_ = xn; } while (0)
#define PV_COMP(R, AV, SV_, ZV_, XV_, t) do { const float ainv = SV_, asum = ZV_; \
        const int aq[4] = {__builtin_amdgcn_update_dpp(0, (int)AV, 0x00, 0xf, 0xf, false), __builtin_amdgcn_update_dpp(0, (int)AV, 0x55, 0xf, 0xf, false), __builtin_amdgcn_update_dpp(0, (int)AV, 0xaa, 0xf, 0xf, false), __builtin_amdgcn_update_dpp(0, (int)AV, 0xff, 0xf, 0xf, false)}; \
        __builtin_amdgcn_sched_barrier(0); \
        int iF[16], iH[16];         \
        _Pragma("unroll") for (int kk = 0; kk < 4; ++kk) { asm volatile("" : "+v"(R[4 * kk]), "+v"(R[4 * kk + 1]), "+v"(R[4 * kk + 2]), "+v"(R[4 * kk + 3])); \
            _Pragma("unroll") for (int d = 0; d < 4; ++d) { const unsigned r0 = R[4 * kk][d], r1 = R[4 * kk + 1][d], r2 = R[4 * kk + 2][d], r3 = R[4 * kk + 3][d]; \
                const unsigned p01l = __builtin_amdgcn_perm(r1, r0, 0x05010400u), p01h = __builtin_amdgcn_perm(r1, r0, 0x07030602u); \
                const unsigned p23l = __builtin_amdgcn_perm(r3, r2, 0x05010400u), p23h = __builtin_amdgcn_perm(r3, r2, 0x07030602u); \
                unsigned tt_[4]; \
                tt_[0] = __builtin_amdgcn_perm(p23l, p01l, 0x05040100u); tt_[1] = __builtin_amdgcn_perm(p23l, p01l, 0x07060302u); \
                tt_[2] = __builtin_amdgcn_perm(p23h, p01h, 0x05040100u); tt_[3] = __builtin_amdgcn_perm(p23h, p01h, 0x07060302u); \
                _Pragma("unroll") for (int b = 0; b < 4; ++b) { \
                    if (kk == 0) { iF[4 * d + b] = dot4_z((int)tt_[b], aq[0]); iH[4 * d + b] = dot4_z((int)(tt_[b] & 0xf0f0f0f0u), aq[0]); } \
                    else { iF[4 * d + b] = __builtin_amdgcn_sdot4((int)tt_[b], aq[kk], iF[4 * d + b], false); iH[4 * d + b] = __builtin_amdgcn_sdot4((int)(tt_[b] & 0xf0f0f0f0u), aq[kk], iH[4 * d + b], false); } } } } \
        int ia[32]; \
        _Pragma("unroll") for (int d = 0; d < 4; ++d) _Pragma("unroll") for (int b = 0; b < 4; ++b) { ia[8 * d + b] = iF[4 * d + b] - iH[4 * d + b]; ia[8 * d + 4 + b] = iH[4 * d + b]; } \
          \
        int ib[16], ic[8], id[4]; \
        _Pragma("unroll") for (int i = 0; i < 16; ++i) { auto r = __builtin_amdgcn_permlane32_swap((unsigned)ia[i], (unsigned)ia[i + 16], false, false); ib[i] = (int)r[0] + (int)r[1]; } \
        _Pragma("unroll") for (int i = 0; i < 8; ++i) { auto r = __builtin_amdgcn_permlane16_swap((unsigned)ib[i], (unsigned)ib[i + 8], false, false); ic[i] = (int)r[0] + (int)r[1]; } \
        { const bool b3 = (lane & 8) != 0; \
          _Pragma("unroll") for (int i = 0; i < 4; ++i) { const int k0 = b3 ? ic[i + 4] : ic[i], s0 = b3 ? ic[i] : ic[i + 4]; id[i] = k0 + __builtin_amdgcn_update_dpp(0, s0, 0x128, 0xf, 0xf, false); } } \
        { const float az = addc * asum; \
          const f32x4 xv = {bf_lo(XV_.x), bf_hi(XV_.x), bf_lo(XV_.y), bf_hi(XV_.y)}; \
          const f32x4 fv = {((float)id[0] * mulc + az) * ainv, ((float)id[1] * mulc + az) * ainv, ((float)id[2] * mulc + az) * ainv, ((float)id[3] * mulc + az) * ainv}; \
          *(GAS f32x4*)(C.out + (size_t)(t) * DM + cc_) = xv + g2 * fv; } \
        __builtin_amdgcn_sched_barrier(0); } while (0)
    PV_LDE(t0);
    PV_LDR(rA, aA, sA, zA, xA);
    PV_LDE(t0 + 1);
#pragma unroll 1
    for (int ti = 0; ti < 128; ti += 2) {
        const int t = t0 + ti;
        PV_LDR(rB, aB, sB, zB, xB);
        PV_LDE(t + 2 < tlast ? t + 2 : tlast);
        __builtin_amdgcn_sched_barrier(0);
        PV_COMP(rA, aA, sA, zA, xA, t);
        PV_LDR(rA, aA, sA, zA, xA);
        PV_LDE(t + 3 < tlast ? t + 3 : tlast);
        __builtin_amdgcn_sched_barrier(0);
        PV_COMP(rB, aB, sB, zB, xB, t + 1);
    }
#undef PV_LDE
#undef PV_LDR
#undef PV_COMP
}
#undef PG_PIN16
#undef PG_CVT

constexpr int NPHASE = 13;

__global__ void __launch_bounds__(NTHR, 2) fwd_kernel(Args args) {
    extern __shared__ __attribute__((aligned(16))) unsigned char lds[];
    Ctx C;
    C.lds = (LAS unsigned char*)lds; C.MISC = (volatile LAS unsigned*)(C.lds + MISC_OFF);
    C.tid = threadIdx.x; C.lane = C.tid & 63; C.wave = __builtin_amdgcn_readfirstlane(C.tid >> 6);
    C.G = gridDim.x; { const int bx = blockIdx.x; C.vcu = (C.G % 8 == 0) ? (bx % 8) * (C.G / 8) + bx / 8 : bx; }
    C.ws = args.ws; C.out = args.out; C.ctl = (gu32*)(args.ws + WS_CTL);
    if (C.tid < 64) ((LAS unsigned*)(C.lds + MISC_OFF))[C.tid] = 0u;
    __syncthreads();
    const int lo = args.ph_lo, hi = args.ph_hi;
    const bool multi = (hi - lo) > 1;
    XcdBarrier bar; bar.bar = (unsigned*)(C.ctl + CW_BAR); bar.x = 0; bar.st = nullptr;
    if (multi) bar = xcd_barrier_post((unsigned*)(C.ctl + CW_BAR), C.MISC + 8);
#ifndef PH_MASK
#define PH_MASK 0x1fff
#endif
#define IN(k) (((PH_MASK >> (k)) & 1) && lo <= (k) && (k) < hi)
#ifndef REP_MASK
#define REP_MASK 0
#endif
#ifndef ABL_MODE
#define ABL_MODE 0
#endif
#define SEAM(k) do { if (IN(k) && IN((k) + 1)) xcd_barrier(bar); } while (0)
#define NREP(k) (1 + ((REP_MASK >> (k)) & 1))
#define PFENCE() do { asm volatile("" : "+v"(C.tid) :: "memory"); C.lane = C.tid & 63; C.wave = __builtin_amdgcn_readfirstlane(C.tid >> 6); } while (0)
    for (int rp = 0; rp < NREP(0); ++rp) { if (rp) xcd_barrier(bar); PFENCE(); if (IN(0)) { phase0(C, args); } }
    if (IN(0) && (IN(12) || IN(1))) xcd_barrier(bar);
    if (IN(12)) { PFENCE(); phase0b(C, args); }
    for (int rp = 0; rp < NREP(1); ++rp) { if (rp) xcd_barrier(bar); PFENCE(); if (IN(1)) { phase1(C, args); } } SEAM(1);
    for (int rp = 0; rp < NREP(2); ++rp) { if (rp) xcd_barrier(bar); PFENCE();
    if (IN(2)) { pg8::Gemm g{(const pg8::bf16_t*)(C.ws + WS_H), (const pg8::bf16_t*)(C.ws + WS_WIN_T), NTOK, NPROJ, DM / 2}; pg8::StaticOrder S; S.init(NTOK, NPROJ, C.G, (int)blockIdx.x);
        pg8::EpiI8Bf16 E{(pg8::bf16_t*)(C.ws + WS_PROJ), NPROJ, (const float*)(C.ws + WS_RS1), (const float*)(C.ws + WS_CS), nullptr};
        pg8::gemm_phase_i8<pg8::EpiI8Bf16, pg8::StaticOrder, true, true>(C.lds, g, S, E); } } SEAM(2);
    if (IN(3)) { phase2b(C, args); } SEAM(3);
    for (int rp = 0; rp < NREP(4); ++rp) { if (rp) xcd_barrier(bar); PFENCE(); if (IN(4)) { if (rp + 1 < NREP(4)) phase3<ABL_MODE>(C, args, rp); else phase3<0>(C, args, rp); } } SEAM(4);
    for (int rp = 0; rp < NREP(5); ++rp) { if (rp) xcd_barrier(bar); PFENCE();
    if (IN(5)) { pg8::Gemm g{(const pg8::bf16_t*)(C.ws + WS_Y), (const pg8::bf16_t*)(C.ws + WS_WOUT_T), NTOK, DM, DM}; pg8::StaticOrder S; S.init(NTOK, DM, C.G, (int)blockIdx.x);
        pg8::EpiResidBf16 E{(const float*)args.in[0], (const float*)(C.ws + WS_MOD) + 2 * 1024, (pg8::bf16_t*)(C.ws + WS_X1)};
        pg8::gemm_phase<pg8::EpiResidBf16, pg8::StaticOrder, true, true>(C.lds, g, S, E); } } SEAM(5);
    for (int rp = 0; rp < NREP(6); ++rp) { if (rp) xcd_barrier(bar); PFENCE(); if (IN(6)) { phase5(C, args); } } SEAM(6);
    for (int rp = 0; rp < NREP(7); ++rp) { if (rp) xcd_barrier(bar); PFENCE();
    if (IN(7)) { pg8::Gemm g{(const pg8::bf16_t*)(C.ws + WS_H), (const pg8::bf16_t*)(C.ws + WS_WQ_T), NTOK, NQP, DM / 2}; pg8::StaticOrder S; S.init(NTOK, NQP, C.G, (int)blockIdx.x);
        pg8::EpiI8Bf16 E{(pg8::bf16_t*)(C.ws + WS_PROJ), NQP, (const float*)(C.ws + WS_RS2), (const float*)(C.ws + WS_CSQ), (const float*)args.in[20]};
        pg8::gemm_phase_i8<pg8::EpiI8Bf16, pg8::StaticOrder, true, true>(C.lds, g, S, E); } } SEAM(7);
    for (int rp = 0; rp < NREP(8); ++rp) { if (rp) xcd_barrier(bar); PFENCE(); if (IN(8)) { if (rp + 1 < NREP(8)) phase_peer_scores<ABL_MODE>(C, args); else phase_peer_scores<0>(C, args); } } SEAM(8);
    C.sx = C.vcu >> 5; C.sj = C.vcu & 31;
    if (multi && C.G == 256) {
        if (C.tid == 0) { unsigned* bw = (unsigned*)(C.ctl + CW_BAR); bool ok = true;
            for (int q = 0; q < 16; ++q) { const unsigned cnt = xb_ld(&bw[XB_XCNT(q)]); ok = ok && (q < 8 ? cnt == 32u : cnt == 0u); }
            unsigned code = 0xffffffffu;
            if (ok) { const unsigned xc = xb_xcc_id(); const unsigned r = __hip_atomic_fetch_add(C.ctl + CW_RANK + 64 * xc, 1u, __ATOMIC_RELAXED, __HIP_MEMORY_SCOPE_AGENT); code = (xc << 8) | (r & 31u); }
            C.MISC[1] = code; }
        __syncthreads();
        const unsigned code = C.MISC[1];
        if (code != 0xffffffffu) { C.sx = (int)(code >> 8); C.sj = (int)(code & 31u); }
    }
    for (int rp = 0; rp < NREP(9); ++rp) { if (rp) xcd_barrier(bar); PFENCE(); if (IN(9)) { if (rp + 1 < NREP(9)) phase_peer_u<ABL_MODE>(C, args); else phase_peer_u<0>(C, args); } } SEAM(9);
    for (int rp = 0; rp < NREP(10); ++rp) { if (rp) xcd_barrier(bar); PFENCE(); if (IN(10)) { phase_peer_act(C, args); } } SEAM(10);
    for (int rp = 0; rp < NREP(11); ++rp) { if (rp) xcd_barrier(bar); PFENCE(); if (IN(11)) { if (rp + 1 < NREP(11)) phase_peer_v<ABL_MODE>(C, args); else phase_peer_v<0>(C, args); } }
#undef IN
#undef SEAM
}

#ifndef MK_N_LAUNCHES
#define MK_N_LAUNCHES 1
#endif
extern "C" void kernel_launch(void* const* d_in, const int* in_sizes, int n_in, void* d_out, int out_size, void* d_ws, size_t ws_size, hipStream_t stream) {
    static int grid = 0;
    if (grid == 0) {
        if (n_in != 25 || in_sizes[0] != NTOK * DM || out_size != NTOK * DM || ws_size < WS_END) { fprintf(stderr, "kernel_launch: unexpected shapes (n_in %d, in0 %d, out %d, ws %zu)\n", n_in, n_in > 0 ? in_sizes[0] : -1, out_size, ws_size); grid = -1; return; }
        int dev = 0, cus = 0, per_cu = 0;
        if (hipGetDevice(&dev) != hipSuccess || hipDeviceGetAttribute(&cus, hipDeviceAttributeMultiprocessorCount, dev) != hipSuccess) { grid = -1; return; }
        if (hipFuncSetAttribute((const void*)fwd_kernel, hipFuncAttributeMaxDynamicSharedMemorySize, LDS_BYTES) != hipSuccess) { fprintf(stderr, "kernel_launch: hipFuncSetAttribute failed\n"); grid = -1; return; }
        if (hipOccupancyMaxActiveBlocksPerMultiprocessor(&per_cu, (const void*)fwd_kernel, NTHR, LDS_BYTES) != hipSuccess || per_cu < 1) fprintf(stderr, "kernel_launch: occupancy query says %d per CU\n", per_cu);
        (void)hipGetLastError();
        if (cus != 256) { fprintf(stderr, "kernel_launch: built for a 256-CU device (work maps assume 256 workgroups), found %d CUs; nothing launched\n", cus); grid = -1; return; }
        grid = cus;
    }
    if (grid < 0) return;
    if (hipMemsetAsync((char*)d_ws + WS_CTL, 0, CTL_ZERO_BYTES, stream) != hipSuccess) return;
    Args a{};
    for (int i = 0; i < 25; ++i) a.in[i] = d_in[i];
    a.out = (float*)d_out; a.ws = (unsigned char*)d_ws;
    if (MK_N_LAUNCHES == 1) { a.ph_lo = 0; a.ph_hi = NPHASE; a.li = 0; hipLaunchKernelGGL(fwd_kernel, dim3(grid), dim3(NTHR), LDS_BYTES, stream, a); }
    else { const int order[NPHASE] = {0, 12, 1, 2, 3, 4, 5, 6, 7, 8, 9, 10, 11}; for (int i = 0; i < NPHASE; ++i) { const int p = order[i]; a.ph_lo = p; a.ph_hi = p + 1; a.li = p; hipLaunchKernelGGL(fwd_kernel, dim3(grid), dim3(NTHR), LDS_BYTES, stream, a); } }
}
```

```cpp
#include <hip/hip_runtime.h>
#include <hip/hip_bf16.h>
#include <cstdio>
#include <cstdint>
#include <cmath>
namespace pg8 {
#define PG8_LAS __attribute__((address_space(3)))
typedef unsigned short bf16_t;
typedef short bf16x8 __attribute__((ext_vector_type(8)));
typedef float f32x4 __attribute__((ext_vector_type(4)));
typedef unsigned u32x4 __attribute__((ext_vector_type(4)));
constexpr int BM = 256, BK = 64, HALF = 128, HTB = HALF * BK * 2  , STAGE_BYTES = 8 * HTB, NXCD = 8, WGM = 8;

__host__ __device__ __forceinline__ int lds_byte(int r, int c) { const int st = (r >> 4) * 2 + (c >> 5), rr = r & 15, cc = c & 31, ob = rr * 64 + cc * 2; return st * 1024 + (ob ^ (((ob >> 9) & 1) << 5)); }
__host__ __device__ __forceinline__ void stage_rc(int b, int& R, int& C) { const int st = b / 1024, sb = b % 1024, swz = sb ^ (((sb >> 9) & 1) << 5); R = (st >> 1) * 16 + swz / 64; C = (st & 1) * 32 + (swz % 64) / 2; }
__host__ __device__ __forceinline__ int perm32(int rho) { const int n = rho >> 4, i = rho & 15; return 8 * (i >> 2) + 4 * n + (i & 3); }

struct Unit { int pm, pn; };
struct Gemm { const bf16_t* A; const bf16_t* Bt; int M, N, K; };

struct StaticOrder {
    int nM, nN, nwg, G, c;
    __host__ __device__ void init(int M, int N, int G_, int c_) { nM = M / BM; nN = N / BM; nwg = nM * nN; G = G_; c = c_; }
    __host__ __device__ bool next(int i, Unit& u) const {
        const long L = (long)i * G + c; if (L >= nwg) return false;
        int wgid = (int)L; { const int q = nwg / NXCD, r = nwg % NXCD, xcd = wgid % NXCD, off = wgid / NXCD; wgid = (xcd < r ? xcd * (q + 1) : r * (q + 1) + (xcd - r) * q) + off; }
        const int nig = WGM * nN, gid = wgid / nig, fm = gid * WGM, gsz = (nM - fm) < WGM ? (nM - fm) : WGM;
        u.pm = fm + ((wgid % nig) % gsz); u.pn = (wgid % nig) / gsz; return true;
    }
    __device__ __forceinline__ void a_ready(const Unit&) const {}
    __device__ __forceinline__ void done(const Unit&) const {}
};

__device__ __forceinline__ unsigned cvt_pk_bf16(float lo, float hi) { unsigned r; asm volatile("v_cvt_pk_bf16_f32 %0, %1, %2" : "=v"(r) : "v"(lo), "v"(hi)); return r; }
typedef float f32x2 __attribute__((ext_vector_type(2)));
__device__ __forceinline__ f32x2 gelu_pk(f32x2 v) {
    const f32x2 av = __builtin_elementwise_abs(v), d = av * 0.2316418882f + 1.0f;
    f32x2 t; t.x = __builtin_amdgcn_rcpf(d.x); t.y = __builtin_amdgcn_rcpf(d.y);
    f32x2 q = t * 0.5307027145f + (-0.7265760135f); q = q * t + 0.7107068705f; q = q * t + (-0.142248368f); q = q * t + 0.127414796f; q = q * t;
    const f32x2 s = (v * v) * (-0.72134752044f);
    f32x2 e; e.x = __builtin_amdgcn_exp2f(s.x); e.y = __builtin_amdgcn_exp2f(s.y);
    const f32x2 m = v * (q * e), r = v - m;
    f32x2 o; o.x = v.x < 0.f ? m.x : r.x; o.y = v.y < 0.f ? m.y : r.y; return o;
}

template <int ACT  > struct EpiBf16 {
    static constexpr bool PERM = true, AFTER_DRAIN = false; static_assert(ACT == 0 || ACT == 1, "EpiBf16: ACT is 0 (none) or 1 (gelu_pk)");
    bf16_t* O; int ldc; const float* bias; int split_cols; size_t split_stride; float scale0;
    __device__ __forceinline__ void operator()(const f32x4 (&acc)[2][2][4][2], const Unit& u, int wr, int wc, int fr, int fq) const {
        const int row0 = u.pm * BM + wr * 64 + fr; int colt = u.pn * BM; bf16_t* base = O;
        float sc = 1.f; if (split_cols) { const int t = colt / split_cols; base += (size_t)t * split_stride; colt -= t * split_cols; if (t == 0) sc = scale0; }
        const int col0 = colt + wc * 32 + 8 * fq, bcol0 = u.pn * BM + wc * 32 + 8 * fq;
        f32x4 bv[2][2];
#pragma unroll
        for (int bj = 0; bj < 2; ++bj)
#pragma unroll
            for (int n = 0; n < 2; ++n) bv[bj][n] = bias ? *(const f32x4*)(bias + bcol0 + bj * HALF + 4 * n) : (f32x4){0.f, 0.f, 0.f, 0.f};
#pragma unroll
        for (int ai = 0; ai < 2; ++ai)
#pragma unroll
            for (int m = 0; m < 4; ++m) { bf16_t* rowp = base + (size_t)(row0 + ai * HALF + m * 16) * ldc + col0;
#pragma unroll
                for (int bj = 0; bj < 2; ++bj) { f32x4 v0 = acc[ai][bj][m][0] + bv[bj][0], v1 = acc[ai][bj][m][1] + bv[bj][1];
                    if (ACT == 1) { f32x2 a = gelu_pk((f32x2){v0[0], v0[1]}), b = gelu_pk((f32x2){v0[2], v0[3]}), c = gelu_pk((f32x2){v1[0], v1[1]}), d = gelu_pk((f32x2){v1[2], v1[3]});
                        v0 = (f32x4){a.x, a.y, b.x, b.y}; v1 = (f32x4){c.x, c.y, d.x, d.y}; }
                    v0 = v0 * sc; v1 = v1 * sc; u32x4 w; w.x = cvt_pk_bf16(v0[0], v0[1]); w.y = cvt_pk_bf16(v0[2], v0[3]); w.z = cvt_pk_bf16(v1[0], v1[1]); w.w = cvt_pk_bf16(v1[2], v1[3]);
                    *(u32x4*)(rowp + bj * HALF) = w; } }
    }
};
struct EpiResid {
    static constexpr bool PERM = false, AFTER_DRAIN = false;
    const float* x; const float* gate; float* out;
    __device__ __forceinline__ void operator()(const f32x4 (&acc)[2][2][4][2], const Unit& u, int wr, int wc, int fr, int fq) const {
        const int b = (u.pm * BM) >> 11;
        const int col0 = u.pn * BM + wc * 32 + 4 * fq;
        f32x4 gv[2][2];
#pragma unroll
        for (int bj = 0; bj < 2; ++bj)
#pragma unroll
            for (int n = 0; n < 2; ++n) gv[bj][n] = *(const f32x4*)(gate + (size_t)b * 6144 + col0 + bj * HALF + n * 16);
#pragma unroll
        for (int ai = 0; ai < 2; ++ai)
#pragma unroll
            for (int m = 0; m < 4; ++m) { const size_t off = (size_t)(u.pm * BM + ai * HALF + wr * 64 + m * 16 + fr) * 1024 + col0;
#pragma unroll
                for (int bj = 0; bj < 2; ++bj)
#pragma unroll
                    for (int n = 0; n < 2; ++n) { const f32x4 xv = *(const f32x4*)(x + off + bj * HALF + n * 16);
                        *(f32x4*)(out + off + bj * HALF + n * 16) = xv + gv[bj][n] * acc[ai][bj][m][n]; } }
    }
};
struct EpiResidBf16 {
    static constexpr bool PERM = true, AFTER_DRAIN = false;
    const float* x; const float* gate; bf16_t* out;
    __device__ __forceinline__ void operator()(const f32x4 (&acc)[2][2][4][2], const Unit& u, int wr, int wc, int fr, int fq) const {
        const int b = (u.pm * BM) >> 11;
        const int col0 = u.pn * BM + wc * 32 + 8 * fq;
        f32x4 gv[2][2];
#pragma unroll
        for (int bj = 0; bj < 2; ++bj)
#pragma unroll
            for (int n = 0; n < 2; ++n) gv[bj][n] = *(const f32x4*)(gate + (size_t)b * 6144 + col0 + bj * HALF + 4 * n);
#pragma unroll
        for (int ai = 0; ai < 2; ++ai)
#pragma unroll
            for (int m = 0; m < 4; ++m) { const size_t off = (size_t)(u.pm * BM + ai * HALF + wr * 64 + m * 16 + fr) * 1024 + col0;
#pragma unroll
                for (int bj = 0; bj < 2; ++bj) { const f32x4 x0 = *(const f32x4*)(x + off + bj * HALF), x1 = *(const f32x4*)(x + off + bj * HALF + 4);
                    const f32x4 v0 = x0 + gv[bj][0] * acc[ai][bj][m][0], v1 = x1 + gv[bj][1] * acc[ai][bj][m][1];
                    u32x4 w; w.x = cvt_pk_bf16(v0[0], v0[1]); w.y = cvt_pk_bf16(v0[2], v0[3]); w.z = cvt_pk_bf16(v1[0], v1[1]); w.w = cvt_pk_bf16(v1[2], v1[3]);
                    *(u32x4*)(out + off + bj * HALF) = w; } }
    }
};
template <class Epi, class Sched, bool ALIGN_EPI = false, bool SP2 = false>
__device__ __forceinline__ void gemm_phase(PG8_LAS unsigned char* lds, const Gemm g, const Sched& S, const Epi& E) {
    int tid_ = threadIdx.x; asm volatile("" : "+v"(tid_));
    const int tid = tid_, wid = __builtin_amdgcn_readfirstlane(tid >> 6), lane = tid & 63, wr = wid >> 2, wc = wid & 3, fr = lane & 15, fq = lane >> 4;
    const int K = g.K, nt = K / BK;
    unsigned voffA[2], voffB[2];
#pragma unroll
    for (int i = 0; i < 2; ++i) { int R, C; stage_rc(tid * 16 + i * 8192, R, C); const int Rb = Epi::PERM ? ((R & ~31) + perm32(R & 31)) : R;
        voffA[i] = (unsigned)(R * K + C) * 2u; voffB[i] = (unsigned)(Rb * K + C) * 2u; }
    const size_t kstep = (size_t)(BK * 2);
    const size_t hstep = (size_t)HALF * K * 2;
    const size_t tstep = 2 * hstep;
    const unsigned ldsw = (unsigned)wid * 1024u;
    const int aoff = lds_byte(wr * 64 + fr, fq * 8), boff = lds_byte(wc * 32 + fr, fq * 8);
#define PG8_SA(b, h) (((b) * 2 + (h)) * HTB)
#define PG8_SB(b, h) ((4 + (b) * 2 + (h)) * HTB)
#define PG8_STAGE(bufoff, gbase, voff) do { _Pragma("unroll") for (int _i = 0; _i < 2; ++_i) \
        __builtin_amdgcn_global_load_lds((const unsigned*)((const char*)(gbase) + (voff)[_i]), (PG8_LAS unsigned*)(lds + (bufoff) + ldsw + _i * 8192), 16, 0, 0); } while (0)
#define PG8_LDA(dst, b, h) do { _Pragma("unroll") for (int m = 0; m < 4; ++m) _Pragma("unroll") for (int k = 0; k < 2; ++k) dst[m][k] = *(const PG8_LAS bf16x8*)(lds + PG8_SA(b, h) + aoff + m * 2048 + k * 1024); } while (0)
#define PG8_LDB(dst, b, h) do { _Pragma("unroll") for (int n = 0; n < 2; ++n) _Pragma("unroll") for (int k = 0; k < 2; ++k) dst[n][k] = *(const PG8_LAS bf16x8*)(lds + PG8_SB(b, h) + boff + n * 2048 + k * 1024); } while (0)
#define PG8_MMA(ai, bj, At, Bt) do { __builtin_amdgcn_s_setprio(1); _Pragma("unroll") for (int m = 0; m < 4; ++m) _Pragma("unroll") for (int n = 0; n < 2; ++n) _Pragma("unroll") for (int k = 0; k < 2; ++k) \
        acc[ai][bj][m][n] = __builtin_amdgcn_mfma_f32_16x16x32_bf16(Bt[n][k], At[m][k], acc[ai][bj][m][n], 0, 0, 0); __builtin_amdgcn_s_setprio(0); } while (0)
#define PG8_WAIT_V(n) asm volatile("s_waitcnt vmcnt(" #n ")" ::: "memory")
#define PG8_WAIT_L(n) asm volatile("s_waitcnt lgkmcnt(" #n ")" ::: "memory")
#define PG8_BAR __builtin_amdgcn_s_barrier()
#define PG8_SCHED __builtin_amdgcn_sched_barrier(0)
    Unit cur, nxt; int ui = 0;
    if (!S.next(0, cur)) return;
    f32x4 acc[2][2][4][2];
#pragma unroll
    for (int a = 0; a < 2; ++a)
#pragma unroll
        for (int b = 0; b < 2; ++b)
#pragma unroll
            for (int m = 0; m < 4; ++m)
#pragma unroll
                for (int n = 0; n < 2; ++n) acc[a][b][m][n] = (f32x4){0.f, 0.f, 0.f, 0.f};
    bf16x8 At[4][2], B0[2][2], B1[2][2];
    const char* cA = (const char*)g.A + (size_t)cur.pm * tstep; const char* cB = (const char*)g.Bt + (size_t)cur.pn * tstep;
    S.a_ready(cur);
    if constexpr (SP2) {
        PG8_STAGE(PG8_SB(0, 0), cB, voffB); PG8_STAGE(PG8_SB(0, 1), cB + hstep, voffB); PG8_STAGE(PG8_SA(0, 0), cA, voffA); PG8_STAGE(PG8_SA(0, 1), cA + hstep, voffA);
        if (wr == 1) PG8_BAR;
        PG8_WAIT_V(2); PG8_BAR;
        PG8_STAGE(PG8_SB(1, 0), cB + kstep, voffB); PG8_STAGE(PG8_SA(1, 0), cA + kstep, voffA); PG8_STAGE(PG8_SB(1, 1), cB + hstep + kstep, voffB);
        PG8_WAIT_V(6); PG8_BAR;
    } else {
        PG8_STAGE(PG8_SB(0, 0), cB, voffB); PG8_STAGE(PG8_SA(0, 0), cA, voffA); PG8_STAGE(PG8_SB(0, 1), cB + hstep, voffB); PG8_STAGE(PG8_SA(0, 1), cA + hstep, voffA);
        if (wr == 1) PG8_BAR;
        PG8_WAIT_V(4); PG8_BAR;
        PG8_STAGE(PG8_SB(1, 0), cB + kstep, voffB); PG8_STAGE(PG8_SA(1, 0), cA + kstep, voffA); PG8_STAGE(PG8_SB(1, 1), cB + hstep + kstep, voffB);
        PG8_WAIT_V(6); PG8_BAR;
    }
    for (;;) {
        const bool has_next = S.next(ui + 1, nxt);
        const char* nA = has_next ? (const char*)g.A + (size_t)nxt.pm * tstep : cA; const char* nB = has_next ? (const char*)g.Bt + (size_t)nxt.pn * tstep : cB;
        for (int t = 0; t < nt; t += 2) {
            const bool last = (t == nt - 2);
            const char* a1 = cA + (size_t)(t + 1) * kstep;
            const char* a2 = last ? nA : cA + (size_t)(t + 2) * kstep; const char* b2 = last ? nB : cB + (size_t)(t + 2) * kstep;
            const char* a3 = a2 + kstep; const char* b3 = b2 + kstep;
            if (last && has_next) S.a_ready(nxt);
            if constexpr (SP2) {
            PG8_LDB(B0, 0, 0); PG8_LDB(B1, 0, 1); PG8_SCHED; PG8_LDA(At, 0, 0); PG8_STAGE(PG8_SA(1, 1), a1 + hstep, voffA);
            PG8_WAIT_V(8); PG8_WAIT_L(0); PG8_BAR; PG8_MMA(0, 0, At, B0); PG8_MMA(0, 1, At, B1); PG8_BAR; PG8_SCHED;
            PG8_LDA(At, 0, 1); PG8_STAGE(PG8_SB(0, 0), b2, voffB); PG8_STAGE(PG8_SB(0, 1), b2 + hstep, voffB); PG8_STAGE(PG8_SA(0, 0), a2, voffA);
            PG8_WAIT_V(8); PG8_WAIT_L(0); PG8_BAR; PG8_MMA(1, 0, At, B0); PG8_MMA(1, 1, At, B1); PG8_BAR; PG8_SCHED;
            PG8_LDB(B0, 1, 0); PG8_LDB(B1, 1, 1); PG8_SCHED; PG8_LDA(At, 1, 0); PG8_STAGE(PG8_SA(0, 1), a2 + hstep, voffA);
            PG8_WAIT_V(8); PG8_WAIT_L(0); PG8_BAR; PG8_MMA(0, 0, At, B0); PG8_MMA(0, 1, At, B1); PG8_BAR; PG8_SCHED;
            PG8_LDA(At, 1, 1); PG8_STAGE(PG8_SB(1, 0), b3, voffB); PG8_STAGE(PG8_SB(1, 1), b3 + hstep, voffB); PG8_STAGE(PG8_SA(1, 0), a3, voffA);
            PG8_WAIT_V(8); PG8_WAIT_L(0); PG8_BAR; PG8_MMA(1, 0, At, B0); PG8_MMA(1, 1, At, B1); PG8_BAR; PG8_SCHED;
            } else {
            PG8_LDB(B0, 0, 0); PG8_SCHED; PG8_LDA(At, 0, 0); PG8_STAGE(PG8_SA(1, 1), a1 + hstep, voffA);
            PG8_WAIT_L(8); PG8_BAR; PG8_WAIT_L(0); PG8_MMA(0, 0, At, B0); PG8_BAR; PG8_SCHED;
            PG8_LDB(B1, 0, 1); PG8_STAGE(PG8_SB(0, 0), b2, voffB);
            PG8_BAR; PG8_WAIT_L(0); PG8_MMA(0, 1, At, B1); PG8_BAR;
            PG8_LDA(At, 0, 1); PG8_STAGE(PG8_SA(0, 0), a2, voffA);
            PG8_BAR; PG8_WAIT_L(0); PG8_MMA(1, 0, At, B0); PG8_BAR; PG8_SCHED;
            PG8_STAGE(PG8_SB(0, 1), b2 + hstep, voffB);
            PG8_WAIT_V(6); PG8_BAR; PG8_MMA(1, 1, At, B1); PG8_BAR;
            PG8_LDB(B0, 1, 0); PG8_SCHED; PG8_LDA(At, 1, 0); PG8_STAGE(PG8_SA(0, 1), a2 + hstep, voffA);
            PG8_WAIT_L(8); PG8_BAR; PG8_WAIT_L(0); PG8_MMA(0, 0, At, B0); PG8_BAR; PG8_SCHED;
            PG8_LDB(B1, 1, 1); PG8_STAGE(PG8_SB(1, 0), b3, voffB);
            PG8_BAR; PG8_WAIT_L(0); PG8_MMA(0, 1, At, B1); PG8_BAR;
            PG8_LDA(At, 1, 1); PG8_STAGE(PG8_SA(1, 0), a3, voffA);
            PG8_BAR; PG8_WAIT_L(0); PG8_MMA(1, 0, At, B0); PG8_BAR; PG8_SCHED;
            PG8_STAGE(PG8_SB(1, 1), b3 + hstep, voffB);
            PG8_WAIT_V(6); PG8_BAR; PG8_MMA(1, 1, At, B1); PG8_BAR;
            }
        }
        if constexpr (ALIGN_EPI) { if (wr == 0) PG8_BAR; }
        if constexpr (!Epi::AFTER_DRAIN) { E(acc, cur, wr, wc, fr, fq); S.done(cur); }
        if (!has_next) break;
#pragma unroll
        for (int a = 0; a < 2; ++a)
#pragma unroll
            for (int b = 0; b < 2; ++b)
#pragma unroll
                for (int m = 0; m < 4; ++m)
#pragma unroll
                    for (int n = 0; n < 2; ++n) acc[a][b][m][n] = (f32x4){0.f, 0.f, 0.f, 0.f};
        cur = nxt; cA = nA; cB = nB; ++ui;
        if constexpr (ALIGN_EPI) { if (wr == 1) PG8_BAR; }
    }
    PG8_WAIT_V(0);
    if constexpr (!ALIGN_EPI) { if (wr == 0) PG8_BAR; }
    PG8_BAR;
    if constexpr (Epi::AFTER_DRAIN) { E.fused(acc, cur, wr, wc, fr, fq, lds, wid, lane); S.done(cur); }
#undef PG8_SA
#undef PG8_SB
#undef PG8_STAGE
#undef PG8_LDA
#undef PG8_LDB
#undef PG8_MMA
#undef PG8_WAIT_V
#undef PG8_WAIT_L
#undef PG8_BAR
#undef PG8_SCHED
}

typedef int i32x4 __attribute__((ext_vector_type(4)));
struct EpiI8Bf16 {
    static constexpr bool PERM = true, AFTER_DRAIN = false;
    bf16_t* O; int ldc; const float* rs; const float* cs; const float* bias;
    const int* pos; const float* kn;
    __device__ __forceinline__ bool post_wanted(const Unit& u) const { return pos != nullptr && u.pn >= 2 && u.pn < 4; }
    __device__ __forceinline__ void post(const Unit& u, int wid, int lane) const {
        const int rsel = lane >> 4, l4 = lane & 15, qd = lane & 3;
        float gain[16], invf[16];
#pragma unroll
        for (int i = 0; i < 16; ++i) { gain[i] = kn[16 * qd + i]; invf[i] = __builtin_amdgcn_exp2f(-(float)(16 * (qd & 1) + i) * 0.41524101186092029f); }
        const float sgn = (qd < 2) ? -1.f : 1.f;
        bf16_t* base = O + (size_t)(u.pm * BM + 32 * wid + rsel) * ldc + u.pn * BM + 16 * l4;
        const int* pp = pos + u.pm * BM + 32 * wid + rsel;
#pragma unroll 1
        for (int bt = 0; bt < 2; ++bt) {
        u32x4 w0[4], w1[4]; int ip[4];
#pragma unroll
        for (int s4 = 0; s4 < 4; ++s4) { const int st = 4 * bt + s4; const u32x4* p = (const u32x4*)(base + (size_t)(4 * st) * ldc); w0[s4] = p[0]; w1[s4] = p[1]; ip[s4] = pp[4 * st]; }
#pragma unroll
        for (int s4 = 0; s4 < 4; ++s4) { const int st = 4 * bt + s4;
            float xv[16];
#pragma unroll
            for (int i = 0; i < 4; ++i) { xv[2 * i] = __uint_as_float(w0[s4][i] << 16); xv[2 * i + 1] = __uint_as_float(w0[s4][i] & 0xffff0000u); xv[8 + 2 * i] = __uint_as_float(w1[s4][i] << 16); xv[8 + 2 * i + 1] = __uint_as_float(w1[s4][i] & 0xffff0000u); }
            float ss = 0.f;
#pragma unroll
            for (int i = 0; i < 16; ++i) ss += xv[i] * xv[i];
            ss += __int_as_float(__builtin_amdgcn_update_dpp(0, __float_as_int(ss), 0xb1, 0xf, 0xf, false)); ss += __int_as_float(__builtin_amdgcn_update_dpp(0, __float_as_int(ss), 0x4e, 0xf, 0xf, false));
            const float rinv = 1.0f / sqrtf(ss * (1.f / 64.f) + 1e-6f);
            const float fpos = (float)ip[s4];
            float y[16];
#pragma unroll
            for (int i = 0; i < 16; ++i) { const float fr_ = __builtin_amdgcn_fractf(fpos * invf[i] * 0.15915494309189535f); const float cs_ = __builtin_amdgcn_cosf(fr_), sn_ = __builtin_amdgcn_sinf(fr_);
                const float v = xv[i] * rinv * gain[i]; const float pv = __int_as_float(__builtin_amdgcn_update_dpp(0, __float_as_int(v), 0x4e, 0xf, 0xf, false)); y[i] = v * cs_ + sgn * pv * sn_; }
            u32x4 o0, o1;
            o0.x = cvt_pk_bf16(y[0], y[1]); o0.y = cvt_pk_bf16(y[2], y[3]); o0.z = cvt_pk_bf16(y[4], y[5]); o0.w = cvt_pk_bf16(y[6], y[7]);
            o1.x = cvt_pk_bf16(y[8], y[9]); o1.y = cvt_pk_bf16(y[10], y[11]); o1.z = cvt_pk_bf16(y[12], y[13]); o1.w = cvt_pk_bf16(y[14], y[15]);
            u32x4* q = (u32x4*)(base + (size_t)(4 * st) * ldc); q[0] = o0; q[1] = o1;
        }
        }
    }
    __device__ __forceinline__ void operator()(const i32x4 (&acc)[2][2][4][2], const Unit& u, int wr, int wc, int fr, int fq) const {
        const int row0 = u.pm * BM + wr * 64 + fr, col0 = u.pn * BM + wc * 32 + 8 * fq;
        f32x4 cv[2][2], bv[2][2];
#pragma unroll
        for (int bj = 0; bj < 2; ++bj)
#pragma unroll
            for (int n = 0; n < 2; ++n) { cv[bj][n] = *(const f32x4*)(cs + col0 + bj * HALF + 4 * n); bv[bj][n] = bias ? *(const f32x4*)(bias + col0 + bj * HALF + 4 * n) : (f32x4){0.f, 0.f, 0.f, 0.f}; }
#pragma unroll
        for (int ai = 0; ai < 2; ++ai)
#pragma unroll
            for (int m = 0; m < 4; ++m) { const int row = row0 + ai * HALF + m * 16; const float r = rs[row]; bf16_t* rowp = O + (size_t)row * ldc + col0;
#pragma unroll
                for (int bj = 0; bj < 2; ++bj) { const i32x4 a0 = acc[ai][bj][m][0], a1 = acc[ai][bj][m][1];
                    const f32x4 v0 = (f32x4){(float)a0[0], (float)a0[1], (float)a0[2], (float)a0[3]} * cv[bj][0] * r + bv[bj][0], v1 = (f32x4){(float)a1[0], (float)a1[1], (float)a1[2], (float)a1[3]} * cv[bj][1] * r + bv[bj][1];
                    u32x4 w; w.x = cvt_pk_bf16(v0[0], v0[1]); w.y = cvt_pk_bf16(v0[2], v0[3]); w.z = cvt_pk_bf16(v1[0], v1[1]); w.w = cvt_pk_bf16(v1[2], v1[3]);
                    *(u32x4*)(rowp + bj * HALF) = w; } }
    }
};
template <class Epi, class Sched, bool ALIGN_EPI = false, bool SP2 = false>
__device__ __forceinline__ void gemm_phase_i8(PG8_LAS unsigned char* lds, const Gemm g, const Sched& S, const Epi& E) {
    int tid_ = threadIdx.x; asm volatile("" : "+v"(tid_));
    const int tid = tid_, wid = __builtin_amdgcn_readfirstlane(tid >> 6), lane = tid & 63, wr = wid >> 2, wc = wid & 3, fr = lane & 15, fq = lane >> 4;
    const int K = g.K, nt = K / BK;
    unsigned voffA[2], voffB[2];
#pragma unroll
    for (int i = 0; i < 2; ++i) { int R, C; stage_rc(tid * 16 + i * 8192, R, C); const int Rb = Epi::PERM ? ((R & ~31) + perm32(R & 31)) : R;
        voffA[i] = (unsigned)(R * K + C) * 2u; voffB[i] = (unsigned)(Rb * K + C) * 2u; }
    const size_t kstep = (size_t)(BK * 2);
    const size_t hstep = (size_t)HALF * K * 2;
    const size_t tstep = 2 * hstep;
    const unsigned ldsw = (unsigned)wid * 1024u;
    const int aoff = lds_byte(wr * 64 + fr, fq * 8), boff = lds_byte(wc * 32 + fr, fq * 8);
#define PG8_SA(b, h) (((b) * 2 + (h)) * HTB)
#define PG8_SB(b, h) ((4 + (b) * 2 + (h)) * HTB)
#define PG8_STAGE(bufoff, gbase, voff) do { _Pragma("unroll") for (int _i = 0; _i < 2; ++_i) \
        __builtin_amdgcn_global_load_lds((const unsigned*)((const char*)(gbase) + (voff)[_i]), (PG8_LAS unsigned*)(lds + (bufoff) + ldsw + _i * 8192), 16, 0, 0); } while (0)
#define PG8_LDA(dst, b, h) do { _Pragma("unroll") for (int m = 0; m < 4; ++m) _Pragma("unroll") for (int k = 0; k < 2; ++k) dst[m][k] = *(const PG8_LAS bf16x8*)(lds + PG8_SA(b, h) + aoff + m * 2048 + k * 1024); } while (0)
#define PG8_LDB(dst, b, h) do { _Pragma("unroll") for (int n = 0; n < 2; ++n) _Pragma("unroll") for (int k = 0; k < 2; ++k) dst[n][k] = *(const PG8_LAS bf16x8*)(lds + PG8_SB(b, h) + boff + n * 2048 + k * 1024); } while (0)
#define PG8_MMA(ai, bj, At, Bt) do { __builtin_amdgcn_s_setprio(1); _Pragma("unroll") for (int m = 0; m < 4; ++m) _Pragma("unroll") for (int n = 0; n < 2; ++n) _Pragma("unroll") for (int k = 0; k < 2; ++k) \
        acc[ai][bj][m][n] = __builtin_amdgcn_mfma_i32_16x16x64_i8(__builtin_bit_cast(i32x4, Bt[n][k]), __builtin_bit_cast(i32x4, At[m][k]), acc[ai][bj][m][n], 0, 0, 0); __builtin_amdgcn_s_setprio(0); } while (0)
#define PG8_WAIT_V(n) asm volatile("s_waitcnt vmcnt(" #n ")" ::: "memory")
#define PG8_WAIT_L(n) asm volatile("s_waitcnt lgkmcnt(" #n ")" ::: "memory")
#define PG8_BAR __builtin_amdgcn_s_barrier()
#define PG8_SCHED __builtin_amdgcn_sched_barrier(0)
    Unit cur, nxt; int ui = 0;
    if (!S.next(0, cur)) return;
    i32x4 acc[2][2][4][2];
#pragma unroll
    for (int a = 0; a < 2; ++a)
#pragma unroll
        for (int b = 0; b < 2; ++b)
#pragma unroll
            for (int m = 0; m < 4; ++m)
#pragma unroll
                for (int n = 0; n < 2; ++n) acc[a][b][m][n] = (i32x4){0, 0, 0, 0};
    bf16x8 At[4][2], B0[2][2], B1[2][2];
    const char* cA = (const char*)g.A + (size_t)cur.pm * tstep; const char* cB = (const char*)g.Bt + (size_t)cur.pn * tstep;
    S.a_ready(cur);
    if constexpr (SP2) {
        PG8_STAGE(PG8_SB(0, 0), cB, voffB); PG8_STAGE(PG8_SB(0, 1), cB + hstep, voffB); PG8_STAGE(PG8_SA(0, 0), cA, voffA); PG8_STAGE(PG8_SA(0, 1), cA + hstep, voffA);
        if (wr == 1) PG8_BAR;
        PG8_WAIT_V(2); PG8_BAR;
        PG8_STAGE(PG8_SB(1, 0), cB + kstep, voffB); PG8_STAGE(PG8_SA(1, 0), cA + kstep, voffA); PG8_STAGE(PG8_SB(1, 1), cB + hstep + kstep, voffB);
        PG8_WAIT_V(6); PG8_BAR;
    } else {
        PG8_STAGE(PG8_SB(0, 0), cB, voffB); PG8_STAGE(PG8_SA(0, 0), cA, voffA); PG8_STAGE(PG8_SB(0, 1), cB + hstep, voffB); PG8_STAGE(PG8_SA(0, 1), cA + hstep, voffA);
        if (wr == 1) PG8_BAR;
        PG8_WAIT_V(4); PG8_BAR;
        PG8_STAGE(PG8_SB(1, 0), cB + kstep, voffB); PG8_STAGE(PG8_SA(1, 0), cA + kstep, voffA); PG8_STAGE(PG8_SB(1, 1), cB + hstep + kstep, voffB);
        PG8_WAIT_V(6); PG8_BAR;
    }
    for (;;) {
        const bool has_next = S.next(ui + 1, nxt);
        const char* nA = has_next ? (const char*)g.A + (size_t)nxt.pm * tstep : cA; const char* nB = has_next ? (const char*)g.Bt + (size_t)nxt.pn * tstep : cB;
        for (int t = 0; t < nt; t += 2) {
            const bool last = (t == nt - 2);
            const char* a1 = cA + (size_t)(t + 1) * kstep;
            const char* a2 = last ? nA : cA + (size_t)(t + 2) * kstep; const char* b2 = last ? nB : cB + (size_t)(t + 2) * kstep;
            const char* a3 = a2 + kstep; const char* b3 = b2 + kstep;
            if (last && has_next) S.a_ready(nxt);
            if constexpr (SP2) {
            PG8_LDB(B0, 0, 0); PG8_LDB(B1, 0, 1); PG8_SCHED; PG8_LDA(At, 0, 0); PG8_STAGE(PG8_SA(1, 1), a1 + hstep, voffA);
            PG8_WAIT_V(8); PG8_WAIT_L(0); PG8_BAR; PG8_MMA(0, 0, At, B0); PG8_MMA(0, 1, At, B1); PG8_BAR; PG8_SCHED;
            PG8_LDA(At, 0, 1); PG8_STAGE(PG8_SB(0, 0), b2, voffB); PG8_STAGE(PG8_SB(0, 1), b2 + hstep, voffB); PG8_STAGE(PG8_SA(0, 0), a2, voffA);
            PG8_WAIT_V(8); PG8_WAIT_L(0); PG8_BAR; PG8_MMA(1, 0, At, B0); PG8_MMA(1, 1, At, B1); PG8_BAR; PG8_SCHED;
            PG8_LDB(B0, 1, 0); PG8_LDB(B1, 1, 1); PG8_SCHED; PG8_LDA(At, 1, 0); PG8_STAGE(PG8_SA(0, 1), a2 + hstep, voffA);
            PG8_WAIT_V(8); PG8_WAIT_L(0); PG8_BAR; PG8_MMA(0, 0, At, B0); PG8_MMA(0, 1, At, B1); PG8_BAR; PG8_SCHED;
            PG8_LDA(At, 1, 1); PG8_STAGE(PG8_SB(1, 0), b3, voffB); PG8_STAGE(PG8_SB(1, 1), b3 + hstep, voffB); PG8_STAGE(PG8_SA(1, 0), a3, voffA);
            PG8_WAIT_V(8); PG8_WAIT_L(0); PG8_BAR; PG8_MMA(1, 0, At, B0); PG8_MMA(1, 1, At, B1); PG8_BAR; PG8_SCHED;
            } else {
            PG8_LDB(B0, 0, 0); PG8_SCHED; PG8_LDA(At, 0, 0); PG8_STAGE(PG8_SA(1, 1), a1 + hstep, voffA);
            PG8_WAIT_L(8); PG8_BAR; PG8_WAIT_L(0); PG8_MMA(0, 0, At, B0); PG8_BAR; PG8_SCHED;
            PG8_LDB(B1, 0, 1); PG8_STAGE(PG8_SB(0, 0), b2, voffB);
            PG8_BAR; PG8_WAIT_L(0); PG8_MMA(0, 1, At, B1); PG8_BAR;
            PG8_LDA(At, 0, 1); PG8_STAGE(PG8_SA(0, 0), a2, voffA);
            PG8_BAR; PG8_WAIT_L(0); PG8_MMA(1, 0, At, B0); PG8_BAR; PG8_SCHED;
            PG8_STAGE(PG8_SB(0, 1), b2 + hstep, voffB);
            PG8_WAIT_V(6); PG8_BAR; PG8_MMA(1, 1, At, B1); PG8_BAR;
            PG8_LDB(B0, 1, 0); PG8_SCHED; PG8_LDA(At, 1, 0); PG8_STAGE(PG8_SA(0, 1), a2 + hstep, voffA);
            PG8_WAIT_L(8); PG8_BAR; PG8_WAIT_L(0); PG8_MMA(0, 0, At, B0); PG8_BAR; PG8_SCHED;
            PG8_LDB(B1, 1, 1); PG8_STAGE(PG8_SB(1, 0), b3, voffB);
            PG8_BAR; PG8_WAIT_L(0); PG8_MMA(0, 1, At, B1); PG8_BAR;
            PG8_LDA(At, 1, 1); PG8_STAGE(PG8_SA(1, 0), a3, voffA);
            PG8_BAR; PG8_WAIT_L(0); PG8_MMA(1, 0, At, B0); PG8_BAR; PG8_SCHED;
            PG8_STAGE(PG8_SB(1, 1), b3 + hstep, voffB);
            PG8_WAIT_V(6); PG8_BAR; PG8_MMA(1, 1, At, B1); PG8_BAR;
            }
        }
        if constexpr (ALIGN_EPI) { if (wr == 0) PG8_BAR; }
        if constexpr (!Epi::AFTER_DRAIN) { E(acc, cur, wr, wc, fr, fq);
            if (E.post_wanted(cur)) { asm volatile("s_waitcnt vmcnt(0)" ::: "memory"); PG8_BAR; asm volatile("" ::: "memory"); E.post(cur, wid, lane); }
            S.done(cur); }
        if (!has_next) break;
#pragma unroll
        for (int a = 0; a < 2; ++a)
#pragma unroll
            for (int b = 0; b < 2; ++b)
#pragma unroll
                for (int m = 0; m < 4; ++m)
#pragma unroll
                    for (int n = 0; n < 2; ++n) acc[a][b][m][n] = (i32x4){0, 0, 0, 0};
        cur = nxt; cA = nA; cB = nB; ++ui;
        if constexpr (ALIGN_EPI) { if (wr == 1) PG8_BAR; }
    }
    PG8_WAIT_V(0);
    if constexpr (!ALIGN_EPI) { if (wr == 0) PG8_BAR; }
    PG8_BAR;
    if constexpr (Epi::AFTER_DRAIN) { E.fused(acc, cur, wr, wc, fr, fq, lds, wid, lane); S.done(cur); }
#undef PG8_SA
#undef PG8_SB
#undef PG8_STAGE
#undef PG8_LDA
#undef PG8_LDB
#undef PG8_MMA
#undef PG8_WAIT_V
#undef PG8_WAIT_L
#undef PG8_BAR
#undef PG8_SCHED
}

}
#define GAS __attribute__((address_space(1)))
#define LAS __attribute__((address_space(3)))
typedef unsigned short bf16;
typedef unsigned v4u __attribute__((ext_vector_type(4)));
typedef float f32x4 __attribute__((ext_vector_type(4)));
typedef short bf16x8 __attribute__((ext_vector_type(8)));
typedef GAS unsigned gu32;
typedef GAS unsigned long long gu64;
#define RLX_AGENT __ATOMIC_RELAXED, __HIP_MEMORY_SCOPE_AGENT
#define LDS_WAIT() asm volatile("s_waitcnt lgkmcnt(0)" ::: "memory")
#define VM_WAIT() asm volatile("s_waitcnt vmcnt(0)" ::: "memory")
__device__ __forceinline__ unsigned long long rt() { return __builtin_amdgcn_s_memrealtime(); }
__device__ __forceinline__ unsigned f2bf(float f) { unsigned u = __builtin_bit_cast(unsigned, f); return (u + 0x7fffu + ((u >> 16) & 1u)) >> 16; }
__device__ __forceinline__ unsigned pk2(float lo, float hi) { return f2bf(lo) | (f2bf(hi) << 16); }

#define XB_TMO      128
#define XB_XCNT(j)  (256  + 64 * (j))
#define XB_XSUB(j)  (1280 + 64 * (j))
#define XB_XGEN(j)  (2304 + 64 * (j))
#define XB_TOP      3328
#define XB_TOPGEN   3392
#define XCD_BAR_WORDS 3456
#define XB_SPIN_CAP (1u << 18)

__device__ __forceinline__ unsigned xb_ld(unsigned* p)              { return __hip_atomic_load(p, __ATOMIC_RELAXED, __HIP_MEMORY_SCOPE_AGENT); }
__device__ __forceinline__ unsigned xb_add(unsigned* p, unsigned v) { return __hip_atomic_fetch_add(p, v, __ATOMIC_RELAXED, __HIP_MEMORY_SCOPE_AGENT); }
__device__ __forceinline__ unsigned xb_xcc_id() { return (unsigned)__builtin_amdgcn_s_getreg((3 << 11) | 20) & 0xFu; }
#define XB_SPIN(cond, bar) do { unsigned _sp = 0; while (cond) { __builtin_amdgcn_s_sleep(1); \
    if ((++_sp & 255u) == 0u) { if (xb_ld(&(bar)[XB_TMO])) break; if (_sp > XB_SPIN_CAP) { atomicAdd(&(bar)[XB_TMO], 1u); break; } } } } while (0)

struct XcdBarrier {
    unsigned* bar; unsigned x;
    volatile LAS unsigned* st;
};

__device__ __forceinline__ XcdBarrier xcd_barrier_post(unsigned* bar, volatile LAS unsigned* st) {
    XcdBarrier b; b.bar = bar; b.x = xb_xcc_id(); b.st = st;
    if (threadIdx.x == 0) (void)xb_add(&bar[XB_XCNT(b.x)], 1u);
    return b;
}
__device__ __forceinline__ void xcd_barrier_complete(unsigned* bar, unsigned x, unsigned& nloc, unsigned& nx) {
    const unsigned G = gridDim.x * gridDim.y * gridDim.z;
    unsigned sum, cnt, mine, sp = 0u;
    for (;;) {
        sum = 0u; cnt = 0u; mine = 0u;
#pragma unroll
        for (unsigned j = 0; j < 16; ++j) { const unsigned c = xb_ld(&bar[XB_XCNT(j)]); sum += c; cnt += (c > 0u) ? 1u : 0u; mine = (j == x) ? c : mine; }
        if (sum == G) break;
        __builtin_amdgcn_s_sleep(1);
        if ((++sp & 255u) == 0u) { if (xb_ld(&bar[XB_TMO])) break; if (sp > XB_SPIN_CAP) { atomicAdd(&bar[XB_TMO], 1u); break; } }
    }
    nloc = mine > 0u ? mine : 1u; nx = cnt > 0u ? cnt : 1u;
}

__device__ __forceinline__ void xcd_barrier(const XcdBarrier& b) {
    asm volatile("s_waitcnt vmcnt(0)" ::: "memory");
    __syncthreads();
    if (threadIdx.x == 0) {
        unsigned* bar = b.bar;
        __builtin_amdgcn_s_waitcnt(0);
        unsigned nloc = b.st[0], nx = b.st[1];
        if (nloc == 0u) { xcd_barrier_complete(bar, b.x, nloc, nx); b.st[0] = nloc; b.st[1] = nx; }
        const unsigned old = xb_add(&bar[XB_XSUB(b.x)], 1u);
        const unsigned gen = old / nloc;
        if (old + 1u == (gen + 1u) * nloc) {
            __builtin_amdgcn_fence(__ATOMIC_RELEASE, "agent");
            asm volatile("s_waitcnt vmcnt(0)" ::: "memory");
            const unsigned og = xb_add(&bar[XB_TOP], 1u);
            const unsigned tg = og / nx;
            __builtin_amdgcn_fence(__ATOMIC_ACQUIRE, "agent");
            if (og + 1u == (tg + 1u) * nx) xb_add(&bar[XB_TOPGEN], 1u);
            else XB_SPIN(xb_ld(&bar[XB_TOPGEN]) == tg, bar);
            xb_add(&bar[XB_XGEN(b.x)], 1u);
            asm volatile("s_waitcnt vmcnt(0)" ::: "memory");
        } else {
            __builtin_amdgcn_fence(__ATOMIC_ACQUIRE, "agent");
            XB_SPIN(xb_ld(&bar[XB_XGEN(b.x)]) == gen, bar);
            asm volatile("s_waitcnt vmcnt(0)" ::: "memory");
        }
    }
    __syncthreads();
}

typedef float f32x16 __attribute__((ext_vector_type(16)));
typedef short v4i16_t __attribute__((ext_vector_type(4)));
typedef float f32x2_t __attribute__((ext_vector_type(2)));
typedef __bf16 bf16x2_t __attribute__((ext_vector_type(2)));
typedef int i32x4 __attribute__((ext_vector_type(4)));
typedef unsigned u32x2 __attribute__((ext_vector_type(2)));

constexpr int NWAVES = 8, NTHR = 512;
constexpr int BATCH = 32, SEQ = 2048, DM = 1024, NTOK = BATCH * SEQ;
constexpr int NIN = 3088, NPROJ = 3328, NQP = 2048, NMOD = 6144;
constexpr int C_DQ = 0, C_DK = 512, C_DV = 1024, C_GQ = 1536, C_GK = 1792, C_GV = 2048, C_GR = 2560, C_GG = 3072;
constexpr int NEXP = 16384;
constexpr float RMS_EPS = 1e-6f;
constexpr float LAMBDA_INIT = 0.2f;
constexpr float QSCALE = 0.125f * 1.4426950408889634f;

constexpr size_t MiB = 1u << 20;
constexpr size_t WS_CTL = 0, CTL_ZERO_BYTES = 1 * MiB;
constexpr size_t WS_WIN_T = 2 * MiB;
constexpr size_t WS_WOUT_T = 10 * MiB;
constexpr size_t WS_WQ_T = 12 * MiB;
constexpr size_t WS_KEYS = 16 * MiB;
constexpr size_t WS_MOD = 17 * MiB;
constexpr size_t WS_WEFF = 18 * MiB;
constexpr size_t WS_CS = 19 * MiB;
constexpr size_t WS_RS1 = 20 * MiB;
constexpr size_t WS_RS2 = 21 * MiB;
constexpr size_t WS_CSQ = 19 * MiB + 16384;
constexpr size_t WS_COS = 32 * MiB;
constexpr size_t WS_SIN = 40 * MiB;
constexpr size_t WS_EU = 64 * MiB;
constexpr size_t WS_EV = 80 * MiB;
constexpr size_t WS_ES = 96 * MiB;
constexpr size_t WS_H = 128 * MiB;
constexpr size_t WS_HN = 192 * MiB;
constexpr size_t WS_PROJ = 256 * MiB;
constexpr size_t WS_PD = 256 * MiB;
constexpr size_t WS_X1 = 512 * MiB;
constexpr size_t WS_Y = 864 * MiB;
constexpr size_t WS_ACT = 768 * MiB;
constexpr size_t WS_EIDX = 800 * MiB;
constexpr size_t WS_EG = 832 * MiB;
constexpr size_t WS_END = 992 * MiB;
constexpr int CW_TMO = 0, CW_Q = 64, CW_RANK = 1024, CW_MODRDY = 2048, CW_BAR = 4096, CW_WMAX = 32768;

constexpr int LDS_BYTES = 163840;
constexpr int MISC_OFF = LDS_BYTES - 256;

struct Args { const void* in[25]; float* out; unsigned char* ws; int ph_lo, ph_hi, li, pad; };
struct Ctx {
    LAS unsigned char* lds;
    volatile LAS unsigned* MISC;
    gu32* ctl;
    int tid, lane, wave, vcu, G;
    int sx, sj;
    float* out; unsigned char* ws;
};

__device__ __forceinline__ float wave_sum(float v) {
#pragma unroll
    for (int o = 1; o < 64; o <<= 1) v += __shfl_xor(v, o);
    return v;
}
__device__ __forceinline__ float wave_sum_fast(float x) {
    x += __int_as_float(__builtin_amdgcn_update_dpp(0, __float_as_int(x), 0xb1, 0xf, 0xf, false));
    x += __int_as_float(__builtin_amdgcn_update_dpp(0, __float_as_int(x), 0x4e, 0xf, 0xf, false));
    x += __int_as_float(__builtin_amdgcn_update_dpp(0, __float_as_int(x), 0x124, 0xf, 0xf, false));
    x += __int_as_float(__builtin_amdgcn_update_dpp(0, __float_as_int(x), 0x128, 0xf, 0xf, false));
    { auto r = __builtin_amdgcn_permlane16_swap(__float_as_uint(x), __float_as_uint(x), false, false); x = __uint_as_float(r[0]) + __uint_as_float(r[1]); }
    { auto r = __builtin_amdgcn_permlane32_swap(__float_as_uint(x), __float_as_uint(x), false, false); x = __uint_as_float(r[0]) + __uint_as_float(r[1]); }
    return x;
}
__device__ __forceinline__ unsigned cvtpk(float lo, float hi) { f32x2_t v = {lo, hi}; bf16x2_t b = __builtin_convertvector(v, bf16x2_t); return __builtin_bit_cast(unsigned, b); }
__device__ __forceinline__ float bf_lo(unsigned w) { return __uint_as_float(w << 16); }
__device__ __forceinline__ float bf_hi(unsigned w) { return __uint_as_float(w & 0xffff0000u); }
__device__ __forceinline__ int crow(int r, int hi) { return (r & 3) + 8 * (r >> 2) + 4 * hi; }
__device__ __forceinline__ float pair_max(float m) { auto rr = __builtin_amdgcn_permlane32_swap(__float_as_uint(m), __float_as_uint(m), false, false); return fmaxf(__uint_as_float(rr[0]), __uint_as_float(rr[1])); }
__device__ __forceinline__ float pair_sum(float m) { auto rr = __builtin_amdgcn_permlane32_swap(__float_as_uint(m), __float_as_uint(m), false, false); return __uint_as_float(rr[0]) + __uint_as_float(rr[1]); }
__device__ __forceinline__ int pair_maxi(int m) { auto rr = __builtin_amdgcn_permlane32_swap((unsigned)m, (unsigned)m, false, false); const int a = (int)rr[0], b = (int)rr[1]; return a > b ? a : b; }
__device__ __forceinline__ v4i16_t tr16(LAS const unsigned char* p) { return __builtin_amdgcn_ds_read_tr16_b64_v4i16((LAS v4i16_t*)p); }
__device__ __forceinline__ bf16x8 mk8(v4i16_t a, v4i16_t b) { return (bf16x8){a[0], a[1], a[2], a[3], b[0], b[1], b[2], b[3]}; }
#define MFMA32(a, b, c) __builtin_amdgcn_mfma_f32_32x32x16_bf16((a), (b), (c), 0, 0, 0)

__device__ __forceinline__ void p0_transpose_item(const float* W, int K, int ldw, int nblk, bf16* WT, LAS float* scr, int item, int lane) {
    const int kb = item / nblk, nb = item % nblk, k0 = 64 * kb, n0 = 32 * nb;
#pragma unroll 8
    for (int i = 0; i < 32; ++i) { const int kk = 2 * i + (lane >> 5); scr[kk * 33 + (lane & 31)] = W[(size_t)(k0 + kk) * ldw + n0 + (lane & 31)]; }
    LDS_WAIT(); asm volatile("" ::: "memory");
    const int c = lane & 7;
#pragma unroll
    for (int j = 0; j < 4; ++j) { const int n = (lane >> 3) + 8 * j; const LAS float* s = scr + (8 * c) * 33 + n;
        v4u o; o.x = pk2(s[0 * 33], s[1 * 33]); o.y = pk2(s[2 * 33], s[3 * 33]); o.z = pk2(s[4 * 33], s[5 * 33]); o.w = pk2(s[6 * 33], s[7 * 33]);
        *(GAS v4u*)(WT + (size_t)(n0 + n) * K + k0 + 8 * c) = o; }
    LDS_WAIT(); asm volatile("" ::: "memory");
}

__device__ __forceinline__ void mod_gemv(Ctx& C, const Args& A) {
    const float* cc = ((const float*)A.in[1]); const float* w_ada = ((const float*)A.in[3]); const float* b_ada = ((const float*)A.in[4]); float* mod = (float*)(C.ws + WS_MOD);
    LAS float* sc = (LAS float*)C.lds;
    LAS float* red = (LAS float*)C.lds;
    const int col0 = C.vcu * 32, col = C.tid & 31, ks = C.tid >> 5;
    const float* wp = w_ada + (size_t)(64 * ks) * NMOD + col0 + col;
    float w0[32];
#pragma unroll
    for (int i = 0; i < 32; ++i) w0[i] = wp[(size_t)i * NMOD];
#pragma unroll 16
    for (int i = 0; i < 64; ++i) { const int idx = C.tid + i * NTHR, b = idx >> 10, kk = idx & 1023; const float v = cc[idx]; sc[kk * 32 + b] = v / (1.f + __expf(-v)); }
    __syncthreads();
    float acc[32];
#pragma unroll
    for (int i = 0; i < 32; ++i) acc[i] = 0.f;
#pragma unroll
    for (int hf = 0; hf < 2; ++hf) {
        float w1[32];
        if (hf == 0) {
#pragma unroll
            for (int i = 0; i < 32; ++i) w1[i] = wp[(size_t)(32 + i) * NMOD]; }
#pragma unroll
        for (int k2 = 0; k2 < 32; ++k2) { const int k = 64 * ks + 32 * hf + k2; const float w = w0[k2];
#pragma unroll
            for (int b4 = 0; b4 < 8; ++b4) { const f32x4 f = *(const LAS f32x4*)(sc + k * 32 + 4 * b4);
                acc[4 * b4 + 0] += w * f.x; acc[4 * b4 + 1] += w * f.y; acc[4 * b4 + 2] += w * f.z; acc[4 * b4 + 3] += w * f.w; } }
        if (hf == 0) {
#pragma unroll
            for (int i = 0; i < 32; ++i) w0[i] = w1[i]; }
    }
    __syncthreads();
#pragma unroll
    for (int b = 0; b < 32; ++b) red[(ks * 32 + b) * 32 + col] = acc[b];
    __syncthreads();
#pragma unroll
    for (int oo = 0; oo < 2; ++oo) { const int o = C.tid + oo * NTHR, c_ = o & 31, b = o >> 5; float s = 0.f;
#pragma unroll
        for (int k = 0; k < 16; ++k) s += red[(k * 32 + b) * 32 + c_];
        mod[b * NMOD + col0 + c_] = s + b_ada[col0 + c_]; }
    __syncthreads();
}
__device__ __forceinline__ void phase0(Ctx& C, const Args& A) {
    if (C.vcu < 192) mod_gemv(C, A);
    if (C.vcu < 64) {
        asm volatile("s_waitcnt vmcnt(0)" ::: "memory");
        __syncthreads();
        if (C.tid == 0) { __builtin_amdgcn_fence(__ATOMIC_RELEASE, "agent"); asm volatile("s_waitcnt vmcnt(0)" ::: "memory"); (void)xb_add((unsigned*)(C.ctl + CW_MODRDY), 1u); }
    }
    bf16* WoutT = (bf16*)(C.ws + WS_WOUT_T);
    const float* w_in = ((const float*)A.in[6]);
    unsigned* wmax = (unsigned*)(C.ctl + CW_WMAX);
    {
        LAS float* scr = (LAS float*)(C.lds + C.wave * 16384);
        const int gw = C.vcu * NWAVES + C.wave, NGW = C.G * NWAVES;
        constexpr int I_OUT = 16 * 32;
        for (int it = gw; it < I_OUT; it += NGW) p0_transpose_item(((const float*)A.in[17]), 1024, 1024, 32, WoutT, scr, it, C.lane);
    }
    const int gt = C.vcu * NTHR + C.tid, NGT = C.G * NTHR;
    {
        const float* w_q = ((const float*)A.in[19]);
        const int ab = C.vcu - 96;
        __syncthreads();
        if (ab >= 0) {
            const bool isq = ab >= 96; const float* W = isq ? w_q : w_in; const int ld = isq ? NQP : NIN, c0 = isq ? 32 * (ab - 96) : 32 * ab;
            const int cg = C.tid & 7, rg = C.tid >> 3;
            f32x4 v[16];
#pragma unroll
            for (int k = 0; k < 16; ++k) v[k] = *(const f32x4*)(W + (size_t)(16 * rg + k) * ld + c0 + 4 * cg);
            f32x4 m = {0.f, 0.f, 0.f, 0.f};
#pragma unroll
            for (int k = 0; k < 16; ++k) { m.x = fmaxf(m.x, fabsf(v[k].x)); m.y = fmaxf(m.y, fabsf(v[k].y)); m.z = fmaxf(m.z, fabsf(v[k].z)); m.w = fmaxf(m.w, fabsf(v[k].w)); }
            LAS float* red = (LAS float*)C.lds;
            *(LAS f32x4*)(red + rg * 32 + 4 * cg) = m;
            __syncthreads();
            LAS float* cmx = red + 64 * 32;
            if (C.tid < 32) { float mx = 0.f;
#pragma unroll 16
                for (int r = 0; r < 64; ++r) mx = fmaxf(mx, red[r * 32 + C.tid]);
                cmx[C.tid] = mx;
                ((float*)(C.ws + (isq ? WS_CSQ : WS_CS)))[c0 + C.tid] = mx > 0.f ? mx * (1.f / 127.f) : 1.f; }
            __syncthreads();
            {   const f32x4 m4 = *(const LAS f32x4*)(cmx + 4 * cg);
                const float s0 = m4.x > 0.f ? 127.f / m4.x : 1.f, s1 = m4.y > 0.f ? 127.f / m4.y : 1.f, s2 = m4.z > 0.f ? 127.f / m4.z : 1.f, s3 = m4.w > 0.f ? 127.f / m4.w : 1.f;
                unsigned char* WT = C.ws + (isq ? WS_WQ_T : WS_WIN_T) + (size_t)(c0 + 4 * cg) * 1024 + 16 * rg;
                v4u o0, o1, o2, o3;
#pragma unroll
                for (int q = 0; q < 4; ++q) { unsigned a0 = 0u, a1 = 0u, a2 = 0u, a3 = 0u;
#pragma unroll
                    for (int i = 0; i < 4; ++i) { const f32x4 t = v[4 * q + i];
                        a0 |= ((unsigned)(int)rintf(t.x * s0) & 0xffu) << (8 * i); a1 |= ((unsigned)(int)rintf(t.y * s1) & 0xffu) << (8 * i);
                        a2 |= ((unsigned)(int)rintf(t.z * s2) & 0xffu) << (8 * i); a3 |= ((unsigned)(int)rintf(t.w * s3) & 0xffu) << (8 * i); }
                    o0[q] = a0; o1[q] = a1; o2[q] = a2; o3[q] = a3; }
                *(GAS v4u*)(WT) = o0; *(GAS v4u*)(WT + 1024) = o1; *(GAS v4u*)(WT + 2048) = o2; *(GAS v4u*)(WT + 3072) = o3;
            }
            __syncthreads();
        }
    }
    {
        const float* wg2 = ((const float*)A.in[14]);
        const int gwv = C.vcu * NWAVES + C.wave;
        if (gwv < 256) { const int j = gwv; float g[16];
#pragma unroll
            for (int r = 0; r < 16; ++r) g[r] = wg2[r * 256 + j];
            float o[16], mx = 0.f;
#pragma unroll
            for (int i = 0; i < 16; ++i) { const float* wr = w_in + (size_t)(16 * C.lane + i) * NIN + 3072; float s_ = 0.f;
#pragma unroll
                for (int r4 = 0; r4 < 4; ++r4) { const f32x4 w4 = *(const f32x4*)(wr + 4 * r4); s_ += w4.x * g[4 * r4] + w4.y * g[4 * r4 + 1] + w4.z * g[4 * r4 + 2] + w4.w * g[4 * r4 + 3]; }
                o[i] = s_; mx = fmaxf(mx, fabsf(s_)); }
            mx = fmaxf(mx, __int_as_float(__builtin_amdgcn_update_dpp(0, __float_as_int(mx), 0xb1, 0xf, 0xf, false))); mx = fmaxf(mx, __int_as_float(__builtin_amdgcn_update_dpp(0, __float_as_int(mx), 0x4e, 0xf, 0xf, false)));
            mx = fmaxf(mx, __int_as_float(__builtin_amdgcn_update_dpp(0, __float_as_int(mx), 0x124, 0xf, 0xf, false))); mx = fmaxf(mx, __int_as_float(__builtin_amdgcn_update_dpp(0, __float_as_int(mx), 0x128, 0xf, 0xf, false)));
            { auto r_ = __builtin_amdgcn_permlane16_swap(__float_as_uint(mx), __float_as_uint(mx), false, false); mx = fmaxf(__uint_as_float(r_[0]), __uint_as_float(r_[1])); }
            { auto r_ = __builtin_amdgcn_permlane32_swap(__float_as_uint(mx), __float_as_uint(mx), false, false); mx = fmaxf(__uint_as_float(r_[0]), __uint_as_float(r_[1])); }
            const float sc = mx > 0.f ? 127.f / mx : 1.f;
            v4u ov;
#pragma unroll
            for (int q = 0; q < 4; ++q) { const int b0 = (int)rintf(o[4 * q] * sc), b1 = (int)rintf(o[4 * q + 1] * sc), b2 = (int)rintf(o[4 * q + 2] * sc), b3 = (int)rintf(o[4 * q + 3] * sc);
                ov[q] = (unsigned)(b0 & 0xff) | ((unsigned)(b1 & 0xff) << 8) | ((unsigned)(b2 & 0xff) << 16) | ((unsigned)(b3 & 0xff) << 24); }
            *(GAS v4u*)(C.ws + WS_WIN_T + (size_t)(3072 + j) * 1024 + 16 * C.lane) = ov;
            if (C.lane == 0) ((float*)(C.ws + WS_CS))[3072 + j] = mx > 0.f ? mx * (1.f / 127.f) : 1.f;
        }
    }
    {
        bf16* KB = (bf16*)(C.ws + WS_KEYS);
        for (int it = gt; it < 4096; it += NGT) { const float* src = (it < 2048 ? ((const float*)A.in[21]) : ((const float*)A.in[22])) + (size_t)(it & 2047) * 8;
            const f32x4 a = *(const f32x4*)src, b = *(const f32x4*)(src + 4);
            v4u ov; ov.x = pk2(a.x, a.y); ov.y = pk2(a.z, a.w); ov.z = pk2(b.x, b.y); ov.w = pk2(b.z, b.w);
            *(GAS v4u*)(KB + (size_t)it * 8) = ov; }
    }
    {
        const float* eu = ((const float*)A.in[23]); const float* ev = ((const float*)A.in[24]);
        unsigned char* E8 = C.ws + WS_EU; float* ES = (float*)(C.ws + WS_ES);
        const int gw = C.vcu * NWAVES + C.wave, NGW = C.G * NWAVES;
        f32x4 rb0[4], rb1[4], rb2[4], rb3[4];
#define P0_ROWLD(dst, r_) do { const int rr_ = (r_) < 2 * NEXP ? (r_) : gw; const float* src = (rr_ < NEXP ? eu + (size_t)rr_ * 1024 : ev + (size_t)(rr_ - NEXP) * 1024) + 16 * C.lane; \
            _Pragma("unroll") for (int i = 0; i < 4; ++i) dst[i] = *(const f32x4*)(src + 4 * i); } while (0)
        P0_ROWLD(rb0, gw); P0_ROWLD(rb1, gw + NGW); P0_ROWLD(rb2, gw + 2 * NGW); P0_ROWLD(rb3, gw + 3 * NGW);
        auto conv_row = [&](f32x4 (&rb)[4], const int row) {
            f32x4 v[4];
#pragma unroll
            for (int i = 0; i < 4; ++i) v[i] = rb[i];
            P0_ROWLD(rb, row + 4 * NGW);
            {
                float ss = 0.f;
#pragma unroll
                for (int i = 0; i < 4; ++i) ss += (v[i].x * v[i].x + v[i].y * v[i].y) + (v[i].z * v[i].z + v[i].w * v[i].w);
                const float rms = sqrtf(wave_sum_fast(ss) * (1.f / 1024.f));
                const float step = rms > 0.f ? 0.335f * rms : 1.f, istep = 1.f / step;
                const int lofs = row < NEXP ? 0 : 8;
                u32x2 ow;
#pragma unroll
                for (int q = 0; q < 2; ++q) { unsigned w = 0u;
#pragma unroll
                    for (int jj = 0; jj < 4; ++jj) { const int nl = (int)fminf(fmaxf(floorf(v[2 * q][jj] * istep), -8.f), 7.f), nh = (int)fminf(fmaxf(floorf(v[2 * q + 1][jj] * istep), -8.f), 7.f);
                        w |= ((unsigned)((nl + lofs) & 15) | ((unsigned)(nh & 15) << 4)) << (8 * jj); }
                    ow[q] = w; }
                *(GAS u32x2*)(E8 + (size_t)(row >= NEXP ? 1 : 0) * (16u << 20) + (size_t)(C.lane >> 4) * (2u << 20) + (size_t)(row & (NEXP - 1)) * 128 + 8 * (C.lane & 15)) = ow;
                if (C.lane == 0) ES[row] = step;
            }
        };
        for (int row = gw; row < 2 * NEXP; row += 4 * NGW) { conv_row(rb0, row); if (row + NGW < 2 * NEXP) conv_row(rb1, row + NGW); if (row + 2 * NGW < 2 * NEXP) conv_row(rb2, row + 2 * NGW); if (row + 3 * NGW < 2 * NEXP) conv_row(rb3, row + 3 * NGW); }
#undef P0_ROWLD
    }
}

__device__ __forceinline__ void phase0b(Ctx& C, const Args& A) {
    const float* w_in = ((const float*)A.in[6]); const float* WE = (const float*)(C.ws + WS_WEFF); const unsigned* wmax = (const unsigned*)(C.ctl + CW_WMAX);
    unsigned char* W8 = C.ws + WS_WIN_T; float* CS = (float*)(C.ws + WS_CS);
    const int gt = C.vcu * NTHR + C.tid, NGT = C.G * NTHR;
    for (int n = 3072 + gt; n < NPROJ; n += NGT) { const float mx = __uint_as_float(wmax[n]); CS[n] = mx > 0.f ? mx * (1.f / 127.f) : 1.f; }
    for (int it = gt; it < 256 * 64; it += NGT) { const int j = it >> 6, kb = it & 63;
        const float mx = __uint_as_float(wmax[3072 + j]); const float sc = mx > 0.f ? 127.f / mx : 1.f;
        v4u ov;
#pragma unroll
        for (int q = 0; q < 4; ++q) { const f32x4 w4 = *(const f32x4*)(WE + (size_t)j * 1024 + 16 * kb + 4 * q);
            const int b0 = (int)rintf(w4.x * sc), b1 = (int)rintf(w4.y * sc), b2 = (int)rintf(w4.z * sc), b3 = (int)rintf(w4.w * sc);
            ov[q] = (unsigned)(b0 & 0xff) | ((unsigned)(b1 & 0xff) << 8) | ((unsigned)(b2 & 0xff) << 16) | ((unsigned)(b3 & 0xff) << 24); }
        *(GAS v4u*)(W8 + (size_t)(3072 + j) * 1024 + 16 * kb) = ov; }
}

template <bool XBF, bool OUT8, bool PLANES = false> __device__ __forceinline__ void norm_mod_rows32(const float* X, const float* g, const float* sc, const float* sh, bf16* O, float* RS, int row0, int rstride, int lane,
                                                                   const int* pos, float* COS, float* SIN, float invf) {
    f32x4 gs[4], hs[4];
#pragma unroll
    for (int j = 0; j < 4; ++j) { const int cidx = 128 * (j >> 1) + 2 * lane + (j & 1); const f32x4 g4 = ((const f32x4*)g)[cidx], s4 = ((const f32x4*)sc)[cidx]; gs[j] = g4 * (s4 + 1.0f); hs[j] = ((const f32x4*)sh)[cidx]; }
    struct Raw { f32x4 f[4]; };
    Raw bA, bB, bC, bD;
#define NM_LOAD(dst, r) do { if (!XBF) { _Pragma("unroll") for (int j = 0; j < 4; ++j) dst.f[j] = ((const GAS f32x4*)(X + (size_t)(r) * DM))[128 * (j >> 1) + 2 * lane + (j & 1)]; } \
        else { _Pragma("unroll") for (int hf_ = 0; hf_ < 2; ++hf_) dst.f[hf_] = __builtin_bit_cast(f32x4, ((const GAS v4u*)((const bf16*)X + (size_t)(r) * DM))[64 * hf_ + lane]); } } while (0)
    auto proc = [&](Raw& buf, const int i) {
        const int m = row0 + i * rstride, mn = row0 + (i + 4 < 32 ? i + 4 : 31) * rstride;
        f32x4 v[4];
        if (!XBF) {
#pragma unroll
            for (int j = 0; j < 4; ++j) v[j] = buf.f[j];
        } else {
#pragma unroll
            for (int hf_ = 0; hf_ < 2; ++hf_) { const v4u w_ = __builtin_bit_cast(v4u, buf.f[hf_]);
                v[2 * hf_] = (f32x4){bf_lo(w_.x), bf_hi(w_.x), bf_lo(w_.y), bf_hi(w_.y)}; v[2 * hf_ + 1] = (f32x4){bf_lo(w_.z), bf_hi(w_.z), bf_lo(w_.w), bf_hi(w_.w)}; }
        }
        NM_LOAD(buf, mn);
        float s = 0.f;
#pragma unroll
        for (int j = 0; j < 4; ++j) s += (v[j].x * v[j].x + v[j].y * v[j].y) + (v[j].z * v[j].z + v[j].w * v[j].w);
        const float rinv = 1.0f / sqrtf(wave_sum_fast(s) * (1.f / 1024.f) + RMS_EPS);
        if (!OUT8) {
            GAS v4u* o16 = (GAS v4u*)(O + (size_t)m * DM) + lane;
#pragma unroll
            for (int hf = 0; hf < 2; ++hf) { const f32x4 y0 = v[2 * hf] * rinv * gs[2 * hf] + hs[2 * hf], y1 = v[2 * hf + 1] * rinv * gs[2 * hf + 1] + hs[2 * hf + 1];
                o16[64 * hf] = (v4u){cvtpk(y0.x, y0.y), cvtpk(y0.z, y0.w), cvtpk(y1.x, y1.y), cvtpk(y1.z, y1.w)}; }
        } else {
            f32x4 y[4]; float mx = 0.f;
#pragma unroll
            for (int j = 0; j < 4; ++j) { y[j] = v[j] * rinv * gs[j] + hs[j]; mx = fmaxf(mx, fmaxf(fmaxf(fabsf(y[j].x), fabsf(y[j].y)), fmaxf(fabsf(y[j].z), fabsf(y[j].w)))); }
            mx = fmaxf(mx, __int_as_float(__builtin_amdgcn_update_dpp(0, __float_as_int(mx), 0xb1, 0xf, 0xf, false)));
            mx = fmaxf(mx, __int_as_float(__builtin_amdgcn_update_dpp(0, __float_as_int(mx), 0x4e, 0xf, 0xf, false)));
            mx = fmaxf(mx, __int_as_float(__builtin_amdgcn_update_dpp(0, __float_as_int(mx), 0x124, 0xf, 0xf, false)));
            mx = fmaxf(mx, __int_as_float(__builtin_amdgcn_update_dpp(0, __float_as_int(mx), 0x128, 0xf, 0xf, false)));
            { auto r = __builtin_amdgcn_permlane16_swap(__float_as_uint(mx), __float_as_uint(mx), false, false); mx = fmaxf(__uint_as_float(r[0]), __uint_as_float(r[1])); }
            { auto r = __builtin_amdgcn_permlane32_swap(__float_as_uint(mx), __float_as_uint(mx), false, false); mx = fmaxf(__uint_as_float(r[0]), __uint_as_float(r[1])); }
            constexpr float QTOP = PLANES ? 119.f : 127.f;
            const float qs = mx > 0.f ? QTOP / mx : 1.f;
            GAS u32x2* o8 = (GAS u32x2*)((unsigned char*)O + (size_t)m * DM) + lane;
#pragma unroll
            for (int hf = 0; hf < 2; ++hf) { u32x2 w;
#pragma unroll
                for (int q = 0; q < 2; ++q) { const f32x4 yy = y[2 * hf + q]; const int b0 = (int)rintf(yy.x * qs), b1 = (int)rintf(yy.y * qs), b2 = (int)rintf(yy.z * qs), b3 = (int)rintf(yy.w * qs);
                    w[q] = (unsigned)(b0 & 0xff) | ((unsigned)(b1 & 0xff) << 8) | ((unsigned)(b2 & 0xff) << 16) | ((unsigned)(b3 & 0xff) << 24);
                }
                o8[64 * hf] = w;
            }
            if (lane == 0) RS[m] = mx > 0.f ? mx * (1.f / QTOP) : 1.f;
        }
    };
    NM_LOAD(bA, row0); NM_LOAD(bB, row0 + rstride); NM_LOAD(bC, row0 + 2 * rstride); NM_LOAD(bD, row0 + 3 * rstride);
#pragma unroll 1
    for (int i = 0; i < 32; i += 4) { proc(bA, i); proc(bB, i + 1); proc(bC, i + 2); proc(bD, i + 3); }
#undef NM_LOAD
}
__device__ __forceinline__ void phase1(Ctx& C, const Args& A) {
    const float* x = ((const float*)A.in[0]); const int* pos = (const int*)((const float*)A.in[2]); const float* g = ((const float*)A.in[5]); const float* mod = (const float*)(C.ws + WS_MOD);
    bf16* H = (bf16*)(C.ws + WS_H); float* COS = (float*)(C.ws + WS_COS); float* SIN = (float*)(C.ws + WS_SIN);
    const int gw = C.vcu * NWAVES + C.wave, NGW = C.G * NWAVES;
    const float invf = __builtin_amdgcn_exp2f(-(float)(C.lane & 31) * 0.41524101186092029f);
    for (int ch = gw; ch < NTOK / 32; ch += NGW) { const int b = ch >> 6;
        norm_mod_rows32<false, true>(x, g, mod + b * NMOD + 1024, mod + b * NMOD, H, (float*)(C.ws + WS_RS1), 2048 * b + (ch & 63), 64, C.lane, pos, COS, SIN, invf); }
}
__device__ __forceinline__ void phase5(Ctx& C, const Args& A) {
    const float* x1 = (const float*)(C.ws + WS_X1); const float* g = ((const float*)A.in[18]); const float* mod = (const float*)(C.ws + WS_MOD); bf16* H = (bf16*)(C.ws + WS_H);
    const int gw = C.vcu * NWAVES + C.wave, NGW = C.G * NWAVES;
    for (int ch = gw; ch < NTOK / 32; ch += NGW) { const int b = ch >> 6;
        norm_mod_rows32<true, true, true>(x1, g, mod + b * NMOD + 4 * 1024, mod + b * NMOD + 3 * 1024, H, (float*)(C.ws + WS_RS2), 2048 * b + (ch & 63), 64, C.lane, nullptr, nullptr, nullptr, 0.f); }
}

__device__ __forceinline__ void phase2b(Ctx& C, const Args& A) {
    bf16* PROJ = (bf16*)(C.ws + WS_PROJ) + C_DK; const int* pos = (const int*)A.in[2];
    const float* kn = ((const float*)A.in[8]);
    const int gw = C.vcu * NWAVES + C.wave, NGW = C.G * NWAVES, lane = C.lane;
    const int l5 = lane & 31, rsel = lane >> 5, qd = lane & 3;
    float gain[16];
#pragma unroll
    for (int i = 0; i < 16; ++i) gain[i] = kn[16 * qd + i];
    const float sgn = (qd < 2) ? -1.f : 1.f;
    float invf[16];
#pragma unroll
    for (int i = 0; i < 16; ++i) invf[i] = __builtin_amdgcn_exp2f(-(float)(16 * (qd & 1) + i) * 0.41524101186092029f);
    v4u n0, n1; int npos;
    { const int m0 = 2 * (gw < NTOK / 2 ? gw : 0) + rsel; const GAS v4u* p = (const GAS v4u*)(PROJ + (size_t)m0 * NPROJ + 16 * l5); n0 = p[0]; n1 = p[1]; npos = pos[m0]; }
    for (int mi = gw; mi < NTOK / 2; mi += NGW) {
        const int m = 2 * mi + rsel;
        GAS v4u* p = (GAS v4u*)(PROJ + (size_t)m * NPROJ + 16 * l5);
        const v4u w0 = n0, w1 = n1; const int ipos = npos;
        { const int mn = 2 * (mi + NGW < NTOK / 2 ? mi + NGW : mi) + rsel; const GAS v4u* pn = (const GAS v4u*)(PROJ + (size_t)mn * NPROJ + 16 * l5); n0 = pn[0]; n1 = pn[1]; npos = pos[mn]; }
        float xv[16];
        xv[0] = bf_lo(w0.x); xv[1] = bf_hi(w0.x); xv[2] = bf_lo(w0.y); xv[3] = bf_hi(w0.y); xv[4] = bf_lo(w0.z); xv[5] = bf_hi(w0.z); xv[6] = bf_lo(w0.w); xv[7] = bf_hi(w0.w);
        xv[8] = bf_lo(w1.x); xv[9] = bf_hi(w1.x); xv[10] = bf_lo(w1.y); xv[11] = bf_hi(w1.y); xv[12] = bf_lo(w1.z); xv[13] = bf_hi(w1.z); xv[14] = bf_lo(w1.w); xv[15] = bf_hi(w1.w);
        float ss = 0.f;
#pragma unroll
        for (int i = 0; i < 16; ++i) ss += xv[i] * xv[i];
        ss += __int_as_float(__builtin_amdgcn_update_dpp(0, __float_as_int(ss), 0xb1, 0xf, 0xf, false)); ss += __int_as_float(__builtin_amdgcn_update_dpp(0, __float_as_int(ss), 0x4e, 0xf, 0xf, false));
        const float rinv = 1.0f / sqrtf(ss * (1.f / 64.f) + RMS_EPS);
        const float fpos = (float)ipos;
        float cs[16], sn[16];
#pragma unroll
        for (int i = 0; i < 16; ++i) { const float ang = fpos * invf[i]; const float fr = __builtin_amdgcn_fractf(ang * 0.15915494309189535f);
            cs[i] = __builtin_amdgcn_cosf(fr); sn[i] = __builtin_amdgcn_sinf(fr); }
        float y[16];
#pragma unroll
        for (int i = 0; i < 16; ++i) { const float v = xv[i] * rinv * gain[i]; const float pv = __int_as_float(__builtin_amdgcn_update_dpp(0, __float_as_int(v), 0x4e, 0xf, 0xf, false)); y[i] = v * cs[i] + sgn * pv * sn[i]; }
        v4u o0, o1;
        o0.x = cvtpk(y[0], y[1]); o0.y = cvtpk(y[2], y[3]); o0.z = cvtpk(y[4], y[5]); o0.w = cvtpk(y[6], y[7]);
        o1.x = cvtpk(y[8], y[9]); o1.y = cvtpk(y[10], y[11]); o1.z = cvtpk(y[12], y[13]); o1.w = cvtpk(y[14], y[15]);
        p[0] = o0; p[1] = o1;
    }
}

constexpr int AT_K1 = 8192, AT_V = 16384, AT_STG = 32768;
constexpr int AT_XP = 129;
constexpr int AT_YST = 66048, AT_YP = 272;
static_assert(4 * AT_STG <= MISC_OFF && 128 * AT_XP * 4 <= AT_YST && AT_YST + 128 * AT_YP <= 4 * AT_STG, "attention LDS map");

template <int ABL> __device__ __forceinline__ void attn_unit(Ctx& C, const Args& A, int bh, int qb, float lam) {
    const int b = bh >> 2, h = bh & 3;
    int tid_ = C.tid; asm volatile("" : "+v"(tid_));
    const int tid = tid_, lane = tid & 63, w = C.wave, r32 = lane & 31, hi = lane >> 5, mp = w >> 2, wq = w & 3;
    const bf16* P = (const bf16*)(C.ws + WS_PROJ) + (size_t)(b * SEQ) * NPROJ;
    const int NT = 2 * qb + 2;
    const int krow = 8 * w + (lane >> 3), vrow = 8 * w + (lane >> 4);
    const bf16* gk = P + (size_t)krow * NPROJ + C_DK + h * 128 + 8 * ((lane & 7) ^ ((krow >> 1) & 7));
    const bf16* gv = P + (size_t)vrow * NPROJ + C_DV + h * 128 + 8 * ((lane & 15) ^ ((vrow & 3) << 2));
#define AT_GLDS(src, dst) __builtin_amdgcn_global_load_lds((const unsigned*)(src), (LAS unsigned*)(dst), 16, 0, 0)
#define AT_DMA(t, s) do { const size_t o_ = (size_t)(t) * 64 * NPROJ; LAS unsigned char* d_ = C.lds + (s) * AT_STG + w * 1024; \
        AT_GLDS(gk + o_, d_); AT_GLDS(gk + o_ + 64, d_ + AT_K1); AT_GLDS(gv + o_, d_ + AT_V + w * 1024); AT_GLDS(gv + o_ + (size_t)4 * NPROJ, d_ + AT_V + w * 1024 + 1024); } while (0)
    AT_DMA(0, 0);
    AT_DMA(1, 1);
    const int qrow = qb * 128 + wq * 32 + r32;
    bf16x8 qf[4];
#pragma unroll
    for (int kk = 0; kk < 4; ++kk) qf[kk] = *(const GAS bf16x8*)(P + (size_t)qrow * NPROJ + C_DQ + h * 128 + mp * 64 + 16 * kk + 8 * hi);
    {
        const float* qn_ = ((const float*)A.in[7]) + 8 * hi;
        const float fpos = (float)((const int*)A.in[2])[b * SEQ + qrow];
        float xq[4][8];
#pragma unroll
        for (int kk = 0; kk < 4; ++kk) { const v4u w_ = __builtin_bit_cast(v4u, qf[kk]);
            xq[kk][0] = bf_lo(w_.x); xq[kk][1] = bf_hi(w_.x); xq[kk][2] = bf_lo(w_.y); xq[kk][3] = bf_hi(w_.y); xq[kk][4] = bf_lo(w_.z); xq[kk][5] = bf_hi(w_.z); xq[kk][6] = bf_lo(w_.w); xq[kk][7] = bf_hi(w_.w); }
        float ss = 0.f;
#pragma unroll
        for (int kk = 0; kk < 4; ++kk)
#pragma unroll
            for (int i = 0; i < 8; ++i) ss += xq[kk][i] * xq[kk][i];
        ss = pair_sum(ss);
        const float rinv = QSCALE / sqrtf(ss * (1.f / 64.f) + RMS_EPS);
        float yq[4][8];
#pragma unroll
        for (int k2 = 0; k2 < 2; ++k2) { const f32x4 ga = *(const f32x4*)(qn_ + 16 * k2), gb = *(const f32x4*)(qn_ + 16 * k2 + 4), gc = *(const f32x4*)(qn_ + 16 * k2 + 32), gd = *(const f32x4*)(qn_ + 16 * k2 + 36);
            const float glo[8] = {ga.x, ga.y, ga.z, ga.w, gb.x, gb.y, gb.z, gb.w}, ghi[8] = {gc.x, gc.y, gc.z, gc.w, gd.x, gd.y, gd.z, gd.w};
#pragma unroll
            for (int i = 0; i < 8; ++i) { const float invf = __builtin_amdgcn_exp2f(-(float)(16 * k2 + 8 * hi + i) * 0.41524101186092029f);
                const float fr = __builtin_amdgcn_fractf(fpos * invf * 0.15915494309189535f); const float cs = __builtin_amdgcn_cosf(fr), sn = __builtin_amdgcn_sinf(fr);
                const float vl = xq[k2][i] * rinv * glo[i], vh = xq[k2 + 2][i] * rinv * ghi[i];
                yq[k2][i] = vl * cs - vh * sn; yq[k2 + 2][i] = vh * cs + vl * sn; } }
#pragma unroll
        for (int kk = 0; kk < 4; ++kk) { v4u w_; w_.x = cvtpk(yq[kk][0], yq[kk][1]); w_.y = cvtpk(yq[kk][2], yq[kk][3]); w_.z = cvtpk(yq[kk][4], yq[kk][5]); w_.w = cvtpk(yq[kk][6], yq[kk][7]); qf[kk] = __builtin_bit_cast(bf16x8, w_); }
    }
    f32x16 o[4];
#pragma unroll
    for (int e = 0; e < 4; ++e)
#pragma unroll
        for (int r = 0; r < 16; ++r) o[e][r] = 0.f;
    float mrun = -1e30f, lrun = 0.f;
    int koff[4], voff[4];
    { const int swz = (r32 >> 1) & 7, trq = (lane & 15) >> 2;
#pragma unroll
      for (int kk = 0; kk < 4; ++kk) koff[kk] = mp * AT_K1 + r32 * 128 + (((2 * kk + hi) ^ swz) << 4);
#pragma unroll
      for (int e = 0; e < 4; ++e) voff[e] = AT_V + (4 * hi + trq) * 256 + ((e ^ trq) << 6) + 32 * ((lane >> 4) & 1) + 8 * (lane & 3); }
    asm volatile("s_waitcnt vmcnt(0)" ::: "memory");
    __syncthreads();
#define AT_KLD(KF, stg) do { const LAS unsigned char* base = C.lds + (stg) * AT_STG; \
        _Pragma("unroll") for (int kk = 0; kk < 4; ++kk) { KF[kk] = *(const LAS bf16x8*)(base + koff[kk]); KF[4 + kk] = *(const LAS bf16x8*)(base + koff[kk] + 32 * 128); } } while (0)
#define AT_QKSM(t, KF, PW) do { \
        f32x16 p0, p1; \
        _Pragma("unroll") for (int r = 0; r < 16; ++r) { p0[r] = 0.f; p1[r] = 0.f; } \
        __builtin_amdgcn_sched_barrier(0); \
        _Pragma("unroll") for (int kk = 0; kk < 4; ++kk) { p0 = MFMA32(KF[kk], qf[kk], p0); p1 = MFMA32(KF[4 + kk], qf[kk], p1); } \
        if ((t) >= 2 * qb) { \
            _Pragma("unroll") for (int r = 0; r < 16; ++r) { const int key = 64 * (t) + crow(r, hi); if (key > qrow) p0[r] = -1e30f; if (key + 32 > qrow) p1[r] = -1e30f; } } \
        float mx = fmaxf(p0[0], p1[0]); \
        _Pragma("unroll") for (int r = 1; r < 16; ++r) mx = fmaxf(mx, fmaxf(p0[r], p1[r])); \
        mx = pair_max(mx); \
        const float mnew = mx > mrun + 8.f ? mx : mrun;        \
        if (__any(mnew > mrun)) { const float alpha = __builtin_amdgcn_exp2f(mrun - mnew); mrun = mnew; lrun *= alpha; \
            _Pragma("unroll") for (int e = 0; e < 4; ++e) _Pragma("unroll") for (int r = 0; r < 16; ++r) o[e][r] *= alpha; } \
        float rs = 0.f; \
        _Pragma("unroll") for (int r = 0; r < 16; ++r) { p0[r] = __builtin_amdgcn_exp2f(p0[r] - mrun); p1[r] = __builtin_amdgcn_exp2f(p1[r] - mrun); rs += p0[r] + p1[r]; } \
        lrun += rs; \
        { v4u t0, t1, t2, t3; \
          t0.x = cvtpk(p0[0], p0[1]); t0.y = cvtpk(p0[2], p0[3]); t0.z = cvtpk(p0[4], p0[5]); t0.w = cvtpk(p0[6], p0[7]); \
          t1.x = cvtpk(p0[8], p0[9]); t1.y = cvtpk(p0[10], p0[11]); t1.z = cvtpk(p0[12], p0[13]); t1.w = cvtpk(p0[14], p0[15]); \
          t2.x = cvtpk(p1[0], p1[1]); t2.y = cvtpk(p1[2], p1[3]); t2.z = cvtpk(p1[4], p1[5]); t2.w = cvtpk(p1[6], p1[7]); \
          t3.x = cvtpk(p1[8], p1[9]); t3.y = cvtpk(p1[10], p1[11]); t3.z = cvtpk(p1[12], p1[13]); t3.w = cvtpk(p1[14], p1[15]); \
          PW[0] = __builtin_bit_cast(bf16x8, t0); PW[1] = __builtin_bit_cast(bf16x8, t1); PW[2] = __builtin_bit_cast(bf16x8, t2); PW[3] = __builtin_bit_cast(bf16x8, t3); } \
    } while (0)
#define AT_PVLD(F, e) do { _Pragma("unroll") for (int s = 0; s < 4; ++s) { const LAS unsigned char* a_ = vb_ + voff[e] + (16 * s) * 256; F[2 * s] = tr16(a_); F[2 * s + 1] = tr16(a_ + 8 * 256); } } while (0)
      \
#define AT_PV(stage, PW) do { const LAS unsigned char* vb_ = C.lds + (stage) * AT_STG; \
        v4i16_t fa_[8], fb_[8]; \
        AT_PVLD(fa_, 0); AT_PVLD(fb_, 1); __builtin_amdgcn_sched_barrier(0); \
        _Pragma("unroll") for (int s = 0; s < 4; ++s) o[0] = MFMA32(mk8(fa_[2 * s], fa_[2 * s + 1]), PW[s], o[0]); \
        AT_PVLD(fa_, 2); __builtin_amdgcn_sched_barrier(0); \
        _Pragma("unroll") for (int s = 0; s < 4; ++s) o[1] = MFMA32(mk8(fb_[2 * s], fb_[2 * s + 1]), PW[s], o[1]); \
        AT_PVLD(fb_, 3); __builtin_amdgcn_sched_barrier(0); \
        _Pragma("unroll") for (int s = 0; s < 4; ++s) o[2] = MFMA32(mk8(fa_[2 * s], fa_[2 * s + 1]), PW[s], o[2]); \
        _Pragma("unroll") for (int s = 0; s < 4; ++s) o[3] = MFMA32(mk8(fb_[2 * s], fb_[2 * s + 1]), PW[s], o[3]); \
        __builtin_amdgcn_sched_barrier(0); \
        } while (0)
    bf16x8 pw[4], kfA[8], kfB[8];
    for (int t = 0; t < NT; t += 2) {
        if (t + 2 < NT) { AT_DMA(t + 2, (t + 2) & 3); AT_DMA(t + 3, (t + 3) & 3); }
        AT_KLD(kfA, t & 3);
        AT_QKSM(t, kfA, pw); __builtin_amdgcn_sched_barrier(0); AT_KLD(kfB, (t + 1) & 3); __builtin_amdgcn_sched_barrier(0); AT_PV(t & 3, pw);
        AT_QKSM(t + 1, kfB, pw); __builtin_amdgcn_sched_barrier(0); AT_PV((t + 1) & 3, pw);
        asm volatile("s_waitcnt vmcnt(0)" ::: "memory");
        __syncthreads();
    }
    __syncthreads();
#undef AT_QKSM
#undef AT_KLD
#undef AT_PV
#undef AT_PVLD
#undef AT_DMA
#undef AT_GLDS
    lrun = pair_sum(lrun);
    const float linv = 1.0f / lrun;
    LAS float* xch = (LAS float*)C.lds;
    if (mp == 1) {
#pragma unroll
        for (int e = 0; e < 4; ++e)
#pragma unroll
            for (int r = 0; r < 16; ++r) xch[(wq * 32 + r32) * AT_XP + 32 * e + crow(r, hi)] = o[e][r] * linv;
    }
    __syncthreads();
    if (mp == 0 && ABL != 0) { asm volatile("" :: "v"(o[0]), "v"(o[1]), "v"(o[2]), "v"(o[3]), "v"(lrun)); }
    if (mp == 0 && ABL == 0) {
        const float* sg = ((const float*)A.in[13]);
        float ss = 0.f;
#pragma unroll
        for (int e = 0; e < 4; ++e)
#pragma unroll
            for (int r = 0; r < 16; ++r) { const float v = o[e][r] * linv - lam * xch[(wq * 32 + r32) * AT_XP + 32 * e + crow(r, hi)]; o[e][r] = v; ss += v * v; }
        ss = pair_sum(ss);
        const float rinv = (1.0f - LAMBDA_INIT) / sqrtf(ss * (1.f / 128.f) + RMS_EPS);
        LAS unsigned char* yst = C.lds + AT_YST + (wq * 32 + r32) * AT_YP;
#pragma unroll
        for (int e = 0; e < 4; ++e)
#pragma unroll
            for (int g = 0; g < 4; ++g) { const int ec = 32 * e + 8 * g + 4 * hi; const f32x4 g4 = *(const f32x4*)(sg + ec);
                u32x2 ov; ov.x = cvtpk(o[e][4 * g] * rinv * g4.x, o[e][4 * g + 1] * rinv * g4.y); ov.y = cvtpk(o[e][4 * g + 2] * rinv * g4.z, o[e][4 * g + 3] * rinv * g4.w);
                *(LAS u32x2*)(yst + ec * 2) = ov; }
    }
    __syncthreads();
    if (ABL == 0) {
        bf16* Y = (bf16*)(C.ws + WS_Y) + (size_t)(b * SEQ + qb * 128) * DM + h * 128;
#pragma unroll
        for (int i = 0; i < 4; ++i) { const int idx = tid + i * NTHR, row = idx >> 4, ch = idx & 15;
            *(GAS v4u*)(Y + (size_t)row * DM + 8 * ch) = *(const LAS v4u*)(C.lds + AT_YST + row * AT_YP + ch * 16); }
    }
    __syncthreads();
}

constexpr int GL_BC = 0;
constexpr int GL_QE = 17408, GL_KE = GL_QE + 9216, GL_QS = GL_KE + 9216, GL_AM = GL_QS + 9216;
constexpr int GL_KD = GL_AM + 9216;
constexpr int GL_V = GL_KD + 12288;
constexpr int GL_SB = GL_V + 20480;
constexpr int GL_O = GL_SB + 20480;
constexpr int GL_SM = GL_O + 33792;
constexpr int GL_END = GL_SM + 768 + 2048;
static_assert(GL_END <= MISC_OFF, "GLA LDS map");

__device__ __forceinline__ void gla_unit(Ctx& C, const Args& A, int bh) {
    const int b = bh >> 2, h = bh & 3;
    int tid_ = C.tid; asm volatile("" : "+v"(tid_));
    const int tid = tid_, lane = tid & 63, w = C.wave, r32 = lane & 31, hi = lane >> 5;
    const bf16* P = (const bf16*)(C.ws + WS_PROJ) + (size_t)(b * SEQ) * NPROJ;
    bf16* Y = (bf16*)(C.ws + WS_Y) + (size_t)(b * SEQ) * DM + 512 + h * 128;
    LAS unsigned char* L = C.lds;
    LAS float* BC = (LAS float*)(L + GL_BC); LAS float* BMID = (LAS float*)(L + GL_SM); LAS float* BLAST = BMID + 64; LAS float* DEC = BMID + 128; LAS float* SEG = BMID + 192;
    LAS float* OI = (LAS float*)(L + GL_O);
    const float bg = ((const float*)A.in[15])[h * 64 + (tid & 63)];
    const int db = w & 1, eb = w >> 1;
    f32x16 S;
#pragma unroll
    for (int r = 0; r < 16; ++r) S[r] = 0.f;
    const int trq = (lane & 15) >> 2, trc = 16 * ((lane >> 4) & 1) + 4 * (lane & 3);
    unsigned short pre_n[8]; v4u q_n, k_n, v_n[2], r_n[2];
#define GL_FETCH(n_) do { const bf16* Pf_ = P + (size_t)((n_) * 64) * NPROJ; \
        _Pragma("unroll") for (int i = 0; i < 8; ++i) pre_n[i] = *(const GAS unsigned short*)(Pf_ + (size_t)(8 * (tid >> 6) + i) * NPROJ + C_GG + h * 64 + (tid & 63)); \
        q_n = *(const GAS v4u*)(Pf_ + (size_t)(tid >> 3) * NPROJ + C_GQ + h * 64 + 8 * (tid & 7)); k_n = *(const GAS v4u*)(Pf_ + (size_t)(tid >> 3) * NPROJ + C_GK + h * 64 + 8 * (tid & 7)); \
        _Pragma("unroll") for (int i = 0; i < 2; ++i) { const int idx_ = tid + i * NTHR; v_n[i] = *(const GAS v4u*)(Pf_ + (size_t)(idx_ >> 4) * NPROJ + C_GV + h * 128 + 8 * (idx_ & 15)); } \
        { const GAS v4u* rp_ = (const GAS v4u*)(Pf_ + (size_t)(tid >> 3) * NPROJ + C_GR + h * 128 + 16 * (tid & 7)); r_n[0] = rp_[0]; r_n[1] = rp_[1]; } } while (0)
    GL_FETCH(0);
    for (int n = 0; n < 32; ++n) {
        unsigned short pre_c[8]; v4u q_c = q_n, k_c = k_n, v_c[2] = {v_n[0], v_n[1]}, r_c[2] = {r_n[0], r_n[1]};
#pragma unroll
        for (int i = 0; i < 8; ++i) pre_c[i] = pre_n[i];
        GL_FETCH(n < 31 ? n + 1 : 31);
        {   const int d = tid & 63, seg = tid >> 6; float pre[8];
#pragma unroll
            for (int i = 0; i < 8; ++i) pre[i] = __uint_as_float((unsigned)pre_c[i] << 16);
            float run = 0.f;
#pragma unroll
            for (int i = 0; i < 8; ++i) { const float z = pre[i] + bg; const float ls = fminf(z, 0.f) - __logf(1.0f + __expf(-fabsf(z))); run += ls * (1.f / 16.f); pre[i] = run; }
            SEG[seg * 64 + d] = run;
            __syncthreads();
            float off = 0.f;
#pragma unroll
            for (int s = 0; s < 8; ++s) off += (s < seg) ? SEG[s * 64 + d] : 0.f;
#pragma unroll
            for (int i = 0; i < 8; ++i) { const float v = pre[i] + off; BC[(8 * seg + i) * 68 + d] = v;
                if (8 * seg + i == 32) BMID[d] = v;
                if (8 * seg + i == 63) { BLAST[d] = v; DEC[d] = __expf(v); } }
            __syncthreads();
        }
        {   const int c = tid >> 3, d8 = tid & 7;
            const v4u qw = q_c, kw = k_c;
            const unsigned qa[4] = {qw.x, qw.y, qw.z, qw.w}, ka[4] = {kw.x, kw.y, kw.z, kw.w};
            const f32x4 bc0 = *(const LAS f32x4*)(BC + c * 68 + 8 * d8), bc1 = *(const LAS f32x4*)(BC + c * 68 + 8 * d8 + 4);
            const f32x4 bm0 = *(const LAS f32x4*)(BMID + 8 * d8), bm1 = *(const LAS f32x4*)(BMID + 8 * d8 + 4);
            const f32x4 bl0 = *(const LAS f32x4*)(BLAST + 8 * d8), bl1 = *(const LAS f32x4*)(BLAST + 8 * d8 + 4);
            const float bcv[8] = {bc0.x, bc0.y, bc0.z, bc0.w, bc1.x, bc1.y, bc1.z, bc1.w}, bmv[8] = {bm0.x, bm0.y, bm0.z, bm0.w, bm1.x, bm1.y, bm1.z, bm1.w}, blv[8] = {bl0.x, bl0.y, bl0.z, bl0.w, bl1.x, bl1.y, bl1.z, bl1.w};
            float qe[8], ke[8], qs[8], kd[8];
#pragma unroll
            for (int i = 0; i < 8; ++i) { const float q = ((i & 1) ? bf_hi(qa[i >> 1]) : bf_lo(qa[i >> 1])) * 0.125f, k = (i & 1) ? bf_hi(ka[i >> 1]) : bf_lo(ka[i >> 1]);
                qe[i] = q * __expf(bcv[i] - bmv[i]); ke[i] = k * __expf(bmv[i] - bcv[i]); qs[i] = q * __expf(bcv[i]); kd[i] = k * __expf(blv[i] - bcv[i]); }
            v4u o_;
            o_.x = cvtpk(qe[0], qe[1]); o_.y = cvtpk(qe[2], qe[3]); o_.z = cvtpk(qe[4], qe[5]); o_.w = cvtpk(qe[6], qe[7]); *(LAS v4u*)(L + GL_QE + c * 144 + d8 * 16) = o_;
            o_.x = cvtpk(ke[0], ke[1]); o_.y = cvtpk(ke[2], ke[3]); o_.z = cvtpk(ke[4], ke[5]); o_.w = cvtpk(ke[6], ke[7]); *(LAS v4u*)(L + GL_KE + c * 144 + d8 * 16) = o_;
            o_.x = cvtpk(qs[0], qs[1]); o_.y = cvtpk(qs[2], qs[3]); o_.z = cvtpk(qs[4], qs[5]); o_.w = cvtpk(qs[6], qs[7]); *(LAS v4u*)(L + GL_QS + c * 144 + d8 * 16) = o_;
            o_.x = cvtpk(kd[0], kd[1]); o_.y = cvtpk(kd[2], kd[3]); o_.z = cvtpk(kd[4], kd[5]); o_.w = cvtpk(kd[6], kd[7]); *(LAS v4u*)(L + GL_KD + c * 192 + d8 * 16) = o_;
#pragma unroll
            for (int i = 0; i < 2; ++i) { const int idx = tid + i * NTHR, row = idx >> 4, ch = idx & 15;
                *(LAS v4u*)(L + GL_V + row * 320 + ch * 16) = v_c[i]; }
#pragma unroll
            for (int r = 0; r < 16; ++r) *(LAS unsigned short*)(L + GL_SB + (32 * db + crow(r, hi)) * 320 + (32 * eb + r32) * 2) = (unsigned short)(cvtpk(S[r], 0.f) & 0xffffu);
            __syncthreads();
        }
        if (w < 4) {
            const int cb = w & 1, jb = w >> 1; f32x16 a;
#pragma unroll
            for (int r = 0; r < 16; ++r) a[r] = 0.f;
#pragma unroll
            for (int kk = 0; kk < 4; ++kk) { const bf16x8 fa = *(const LAS bf16x8*)(L + GL_QE + (32 * cb + r32) * 144 + (16 * kk + 8 * hi) * 2), fb = *(const LAS bf16x8*)(L + GL_KE + (32 * jb + r32) * 144 + (16 * kk + 8 * hi) * 2);
                a = MFMA32(fa, fb, a); }
#pragma unroll
            for (int r = 0; r < 16; ++r) { const int cc = 32 * cb + crow(r, hi), jj = 32 * jb + r32; const float v = (jj <= cc) ? a[r] : 0.f;
                *(LAS unsigned short*)(L + GL_AM + cc * 144 + jj * 2) = (unsigned short)(cvtpk(v, 0.f) & 0xffffu); }
        }
        {
#pragma unroll
            for (int r = 0; r < 16; ++r) S[r] *= DEC[32 * db + crow(r, hi)];
#pragma unroll
            for (int kk = 0; kk < 4; ++kk) { const LAS unsigned char* pa = L + GL_KD + (16 * kk + 8 * hi + trq) * 192 + (32 * db + trc) * 2; const LAS unsigned char* pb = L + GL_V + (16 * kk + 8 * hi + trq) * 320 + (32 * eb + trc) * 2;
                const bf16x8 fa = mk8(tr16(pa), tr16(pa + 4 * 192)), fb = mk8(tr16(pb), tr16(pb + 4 * 320));
                S = MFMA32(fa, fb, S); }
        }
        __syncthreads();
        {   const int cb = w & 1; f32x16 a;
#pragma unroll
            for (int r = 0; r < 16; ++r) a[r] = 0.f;
#pragma unroll
            for (int kk = 0; kk < 4; ++kk) { const bf16x8 fa = *(const LAS bf16x8*)(L + GL_AM + (32 * cb + r32) * 144 + (16 * kk + 8 * hi) * 2);
                const LAS unsigned char* pb = L + GL_V + (16 * kk + 8 * hi + trq) * 320 + (32 * eb + trc) * 2;
                a = MFMA32(fa, mk8(tr16(pb), tr16(pb + 4 * 320)), a); }
#pragma unroll
            for (int kk = 0; kk < 4; ++kk) { const bf16x8 fa = *(const LAS bf16x8*)(L + GL_QS + (32 * cb + r32) * 144 + (16 * kk + 8 * hi) * 2);
                const LAS unsigned char* pb = L + GL_SB + (16 * kk + 8 * hi + trq) * 320 + (32 * eb + trc) * 2;
                a = MFMA32(fa, mk8(tr16(pb), tr16(pb + 4 * 320)), a); }
#pragma unroll
            for (int r = 0; r < 16; ++r) OI[(32 * cb + crow(r, hi)) * 132 + 32 * eb + r32] = a[r];
        }
        __syncthreads();
        {   const int c = tid >> 3, e8 = tid & 7; float ov[16];
#pragma unroll
            for (int i = 0; i < 4; ++i) { const f32x4 t4 = *(const LAS f32x4*)(OI + c * 132 + 16 * e8 + 4 * i); ov[4 * i] = t4.x; ov[4 * i + 1] = t4.y; ov[4 * i + 2] = t4.z; ov[4 * i + 3] = t4.w; }
            float ss = 0.f;
#pragma unroll
            for (int i = 0; i < 16; ++i) ss += ov[i] * ov[i];
            ss += __shfl_xor(ss, 1); ss += __shfl_xor(ss, 2); ss += __shfl_xor(ss, 4);
            const float rinv = 1.0f / sqrtf(ss * (1.f / 128.f) + RMS_EPS);
            const v4u r0 = r_c[0], r1 = r_c[1]; const unsigned ra[8] = {r0.x, r0.y, r0.z, r0.w, r1.x, r1.y, r1.z, r1.w};
            const float* gg = ((const float*)A.in[16]) + 16 * e8; float y[16];
#pragma unroll
            for (int i = 0; i < 16; ++i) { const float rv = (i & 1) ? bf_hi(ra[i >> 1]) : bf_lo(ra[i >> 1]); y[i] = ov[i] * rinv * gg[i] * (rv / (1.f + __expf(-rv))); }
            v4u o0, o1;
            o0.x = cvtpk(y[0], y[1]); o0.y = cvtpk(y[2], y[3]); o0.z = cvtpk(y[4], y[5]); o0.w = cvtpk(y[6], y[7]);
            o1.x = cvtpk(y[8], y[9]); o1.y = cvtpk(y[10], y[11]); o1.z = cvtpk(y[12], y[13]); o1.w = cvtpk(y[14], y[15]);
            GAS v4u* yp = (GAS v4u*)(Y + (size_t)(n * 64 + c) * DM + 16 * e8); yp[0] = o0; yp[1] = o1;
        }
    }
#undef GL_FETCH
    __syncthreads();
}

template <int ABL> __device__ __forceinline__ void phase3(Ctx& C, const Args& A, int rep) {
    float lam;
    {   const float a = ((const float*)A.in[9])[C.lane] * ((const float*)A.in[10])[C.lane], b2 = ((const float*)A.in[11])[C.lane] * ((const float*)A.in[12])[C.lane];
        lam = __expf(wave_sum(a)) - __expf(wave_sum(b2)) + LAMBDA_INIT; }
    constexpr int NITEM = 128 + 2048;
    if (C.tid == 0) C.MISC[0] = __hip_atomic_fetch_add(C.ctl + CW_Q + 64 * rep, 1u, __ATOMIC_RELAXED, __HIP_MEMORY_SCOPE_AGENT);
    __syncthreads();
    int item = (int)C.MISC[0];
    __syncthreads();
    while (item < NITEM) {
        if (C.tid == 0) C.MISC[1] = __hip_atomic_fetch_add(C.ctl + CW_Q + 64 * rep, 1u, __ATOMIC_RELAXED, __HIP_MEMORY_SCOPE_AGENT);
        if (item < 128) { if (ABL == 0) gla_unit(C, A, item); }
        else { const int idx = item - 128; attn_unit<ABL>(C, A, idx & 127, 15 - (idx >> 7), lam); }
        __syncthreads();
        item = (int)C.MISC[1];
        __syncthreads();
    }
}

constexpr int PK_P = 272;
constexpr int PK_BYTES = 128 * PK_P;
constexpr int PS_PITCH = 132, PS_EIDX = 2 * PK_BYTES, PS_EG = PS_EIDX + 64 * PS_PITCH * 4;
static_assert(PS_EG + 64 * PS_PITCH * 4 <= MISC_OFF, "PEER score LDS map");
#define CE_DESC(a, b) do { const float mx_ = fmaxf(a, b), mn_ = fminf(a, b); a = mx_; b = mn_; } while (0)
__device__ __forceinline__ void sort16_desc(float* v) {
    CE_DESC(v[0], v[13]); CE_DESC(v[1], v[12]); CE_DESC(v[2], v[15]); CE_DESC(v[3], v[14]); CE_DESC(v[4], v[8]); CE_DESC(v[5], v[6]); CE_DESC(v[7], v[11]); CE_DESC(v[9], v[10]);
    CE_DESC(v[0], v[5]); CE_DESC(v[1], v[7]); CE_DESC(v[2], v[9]); CE_DESC(v[3], v[4]); CE_DESC(v[6], v[13]); CE_DESC(v[8], v[14]); CE_DESC(v[10], v[15]); CE_DESC(v[11], v[12]);
    CE_DESC(v[0], v[1]); CE_DESC(v[2], v[3]); CE_DESC(v[4], v[5]); CE_DESC(v[6], v[8]); CE_DESC(v[7], v[9]); CE_DESC(v[10], v[11]); CE_DESC(v[12], v[13]); CE_DESC(v[14], v[15]);
    CE_DESC(v[0], v[2]); CE_DESC(v[1], v[3]); CE_DESC(v[4], v[10]); CE_DESC(v[5], v[11]); CE_DESC(v[6], v[7]); CE_DESC(v[8], v[9]); CE_DESC(v[12], v[14]); CE_DESC(v[13], v[15]);
    CE_DESC(v[1], v[2]); CE_DESC(v[3], v[12]); CE_DESC(v[4], v[6]); CE_DESC(v[5], v[7]); CE_DESC(v[8], v[10]); CE_DESC(v[9], v[11]); CE_DESC(v[13], v[14]);
    CE_DESC(v[1], v[4]); CE_DESC(v[2], v[6]); CE_DESC(v[5], v[8]); CE_DESC(v[7], v[10]); CE_DESC(v[9], v[13]); CE_DESC(v[11], v[14]);
    CE_DESC(v[2], v[4]); CE_DESC(v[3], v[6]); CE_DESC(v[9], v[12]); CE_DESC(v[11], v[13]);
    CE_DESC(v[3], v[5]); CE_DESC(v[6], v[8]); CE_DESC(v[7], v[9]); CE_DESC(v[10], v[12]);
    CE_DESC(v[3], v[4]); CE_DESC(v[5], v[6]); CE_DESC(v[7], v[8]); CE_DESC(v[9], v[10]); CE_DESC(v[11], v[12]);
    CE_DESC(v[6], v[7]); CE_DESC(v[8], v[9]);
}
__device__ __forceinline__ void bitonic_merge16_desc(float* v) {
#pragma unroll
    for (int j = 8; j > 0; j /= 2)
#pragma unroll
        for (int i = 0; i < 16; ++i) { const int l = i ^ j; if (l > i) CE_DESC(v[i], v[l]); }
}
__device__ __forceinline__ void merge_top16(float* a, const float* b) {
#pragma unroll
    for (int i = 0; i < 16; ++i) a[i] = fmaxf(a[i], b[15 - i]);
    bitonic_merge16_desc(a);
}
__device__ __forceinline__ void top16_pair64(float (&v)[64], float (&out)[16], int hi) {
    sort16_desc(v); sort16_desc(v + 16); sort16_desc(v + 32); sort16_desc(v + 48);
    merge_top16(v, v + 16); merge_top16(v + 32, v + 48); merge_top16(v, v + 32);
#pragma unroll
    for (int i = 0; i < 8; ++i) { const float p = v[i], q = v[15 - i]; v[i] = hi ? q : p; v[15 - i] = hi ? p : q; }
#pragma unroll
    for (int i = 0; i < 16; ++i) out[i] = pair_max(v[i]);
    bitonic_merge16_desc(out);
}

template <int SABL> __device__ __forceinline__ void peer_scores(Ctx& C, const Args& A, int t0) {
    const int lane = C.lane, w = C.wave, r32 = lane & 31, hi = lane >> 5;
    const bf16* QP = (const bf16*)(C.ws + WS_PROJ);
    int* EIDX = (int*)(C.ws + WS_EIDX); float* EG = (float*)(C.ws + WS_EG);
    bf16x8 qA[8], qB[8];
#define PS_QLD(Q, tb_, half_) do { int r_ = r32; asm volatile("" : "+v"(r_));        \
        const bf16* qp_ = (const bf16*)(C.ws + WS_PROJ) + (size_t)(SABL ? t0 : t0 + 32 * (tb_) + r_) * NQP + w * 256 + (half_) * 128 + 8 * hi; \
        _Pragma("unroll") for (int kk = 0; kk < 8; ++kk) Q[kk] = *(const GAS bf16x8*)(qp_ + 16 * kk); } while (0)
#define PS_HALF(Q, half, NEXTLD, TV) do { \
            float sv[64]; \
            _Pragma("unroll") for (int kb = 0; kb < 4; ++kb) { f32x16 s; \
                _Pragma("unroll") for (int r = 0; r < 16; ++r) s[r] = 0.f; \
                _Pragma("unroll") for (int kk = 0; kk < 8; ++kk) { const bf16x8 a = *(const LAS bf16x8*)(C.lds + (half) * PK_BYTES + (32 * kb + r32) * PK_P + (16 * kk + 8 * hi) * 2); s = MFMA32(a, Q[kk], s); } \
                _Pragma("unroll") for (int r = 0; r < 16; ++r) sv[16 * kb + r] = __uint_as_float((__float_as_uint(s[r]) & ~127u) | (unsigned)(32 * kb + crow(r, hi))); } \
            NEXTLD; \
            if (SABL == 2) { _Pragma("unroll") for (int i = 0; i < 16; ++i) TV[i] = sv[i] + sv[16 + i] + sv[32 + i] + sv[48 + i]; } \
            else top16_pair64(sv, TV, hi); } while (0)
    PS_QLD(qA, 0, 0);
#pragma unroll 1
    for (int tb = 0; tb < 2; ++tb) {
        float tv[2][16];
        PS_HALF(qA, 0, PS_QLD(qB, tb, 1), tv[0]);
        PS_HALF(qB, 1, do { if (tb == 0) PS_QLD(qA, 1, 0); } while (0), tv[1]);
        float cv[32];
#define PEER_CAND(k, a0, b0, a1, b1) do { const float s0_ = tv[0][a0] + tv[1][b0], s1_ = tv[0][a1] + tv[1][b1]; \
            const unsigned e0_ = ((__float_as_uint(tv[0][a0]) & 127u) << 7) | (__float_as_uint(tv[1][b0]) & 127u), e1_ = ((__float_as_uint(tv[0][a1]) & 127u) << 7) | (__float_as_uint(tv[1][b1]) & 127u); \
            const float s_ = hi ? s1_ : s0_; const unsigned e_ = hi ? e1_ : e0_; cv[k] = __uint_as_float((__float_as_uint(s_) & ~0x3FFFu) | e_); } while (0)
        PEER_CAND(0, 0, 0, 2, 1);
        PEER_CAND(1, 0, 1, 2, 2);
        PEER_CAND(2, 0, 2, 2, 3);
        PEER_CAND(3, 0, 3, 2, 4);
        PEER_CAND(4, 0, 4, 3, 0);
        PEER_CAND(5, 0, 5, 3, 1);
        PEER_CAND(6, 0, 6, 3, 2);
        PEER_CAND(7, 0, 7, 3, 3);
        PEER_CAND(8, 0, 8, 4, 0);
        PEER_CAND(9, 0, 9, 4, 1);
        PEER_CAND(10, 0, 10, 4, 2);
        PEER_CAND(11, 0, 11, 5, 0);
        PEER_CAND(12, 0, 12, 5, 1);
        PEER_CAND(13, 0, 13, 6, 0);
        PEER_CAND(14, 0, 14, 6, 1);
        PEER_CAND(15, 0, 15, 7, 0);
        PEER_CAND(16, 1, 0, 7, 1);
        PEER_CAND(17, 1, 1, 8, 0);
        PEER_CAND(18, 1, 2, 9, 0);
        PEER_CAND(19, 1, 3, 10, 0);
        PEER_CAND(20, 1, 4, 11, 0);
        PEER_CAND(21, 1, 5, 12, 0);
        PEER_CAND(22, 1, 6, 13, 0);
        PEER_CAND(23, 1, 7, 14, 0);
        PEER_CAND(24, 2, 0, 15, 0);
#undef PEER_CAND
#pragma unroll
        for (int k = 25; k < 32; ++k) cv[k] = -INFINITY;
        sort16_desc(cv); sort16_desc(cv + 16); merge_top16(cv, cv + 16);
#pragma unroll
        for (int i = 0; i < 8; ++i) { const float p = cv[i], q = cv[15 - i]; cv[i] = hi ? q : p; cv[15 - i] = hi ? p : q; }
        float selv[16]; int sele[16];
#pragma unroll
        for (int i = 0; i < 16; ++i) selv[i] = pair_max(cv[i]);
        bitonic_merge16_desc(selv);
#pragma unroll
        for (int k = 0; k < 16; ++k) { const unsigned b_ = __float_as_uint(selv[k]); sele[k] = (int)(b_ & 0x3FFFu); selv[k] = __uint_as_float(b_ & ~0x3FFFu); }
        float ex[16], sum = 0.f;
#pragma unroll
        for (int k = 0; k < 16; ++k) { ex[k] = __expf(selv[k] - selv[0]); sum += ex[k]; }
        const float inv = 1.0f / sum;
        if (hi == 0) { LAS int* p = (LAS int*)(C.lds + PS_EIDX) + (32 * tb + r32) * PS_PITCH + 2 * w;
#pragma unroll
            for (int kk = 0; kk < 16; ++kk) p[16 * (kk & 7) + (kk >> 3)] = sele[kk]; }
        else { LAS float* p = (LAS float*)(C.lds + PS_EG) + (32 * tb + r32) * PS_PITCH + 2 * w;
#pragma unroll
            for (int kk = 0; kk < 16; ++kk) p[16 * (kk & 7) + (kk >> 3)] = ex[kk] * inv; }
    }
#undef PS_QLD
#undef PS_HALF
}

__device__ __forceinline__ float gelu_erf(float v) {
    const float av = fabsf(v), t = __builtin_amdgcn_rcpf(av * 0.2316418882f + 1.0f);
    float q = t * 0.5307027145f + (-0.7265760135f); q = q * t + 0.7107068705f; q = q * t + (-0.142248368f); q = q * t + 0.127414796f; q = q * t;
    const float e = __builtin_amdgcn_exp2f((v * v) * (-0.72134752044f));
    const float m = v * (q * e);
    return v < 0.f ? m : v - m;
}
__device__ __forceinline__ void gather8(unsigned v, bool q1, unsigned (&out)[8]) {
    const unsigned m = (unsigned)__builtin_amdgcn_update_dpp(0, (int)v, 0x141, 0xf, 0xf, false);
    const unsigned v0 = (unsigned)__builtin_amdgcn_update_dpp(0, (int)v, 0x00, 0xf, 0xf, false), v1 = (unsigned)__builtin_amdgcn_update_dpp(0, (int)v, 0x55, 0xf, 0xf, false);
    const unsigned v2 = (unsigned)__builtin_amdgcn_update_dpp(0, (int)v, 0xaa, 0xf, 0xf, false), v3 = (unsigned)__builtin_amdgcn_update_dpp(0, (int)v, 0xff, 0xf, 0xf, false);
    const unsigned m0 = (unsigned)__builtin_amdgcn_update_dpp(0, (int)m, 0x00, 0xf, 0xf, false), m1 = (unsigned)__builtin_amdgcn_update_dpp(0, (int)m, 0x55, 0xf, 0xf, false);
    const unsigned m2 = (unsigned)__builtin_amdgcn_update_dpp(0, (int)m, 0xaa, 0xf, 0xf, false), m3 = (unsigned)__builtin_amdgcn_update_dpp(0, (int)m, 0xff, 0xf, 0xf, false);
    out[0] = q1 ? m3 : v0; out[1] = q1 ? m2 : v1; out[2] = q1 ? m1 : v2; out[3] = q1 ? m0 : v3;
    out[4] = q1 ? v0 : m3; out[5] = q1 ? v1 : m2; out[6] = q1 ? v2 : m1; out[7] = q1 ? v3 : m0;
}
__device__ __forceinline__ int dot8_z(int a, int b) { int r; asm("v_dot8_i32_i4 %0, %1, %2, 0" : "=v"(r) : "v"(a), "v"(b)); return r; }
__device__ __forceinline__ int dot4_z(int a, int b) { int r; asm("v_dot4_i32_i8 %0, %1, %2, 0" : "=v"(r) : "v"(a), "v"(b)); return r; }
__device__ __forceinline__ float dpp_sum8(float x) {
    x += __int_as_float(__builtin_amdgcn_update_dpp(0, __float_as_int(x), 0xb1, 0xf, 0xf, false));
    x += __int_as_float(__builtin_amdgcn_update_dpp(0, __float_as_int(x), 0x4e, 0xf, 0xf, false));
    x += __int_as_float(__builtin_amdgcn_update_dpp(0, __float_as_int(x), 0x141, 0xf, 0xf, false));
    return x;
}
#define PG_PIN16(a) asm volatile("" : "+v"(a[0]), "+v"(a[1]), "+v"(a[2]), "+v"(a[3]), "+v"(a[4]), "+v"(a[5]), "+v"(a[6]), "+v"(a[7]), "+v"(a[8]), "+v"(a[9]), "+v"(a[10]), "+v"(a[11]), "+v"(a[12]), "+v"(a[13]), "+v"(a[14]), "+v"(a[15]))
#define PG_CVT(w, f) do { _Pragma("unroll") for (int d_ = 0; d_ < 4; ++d_) { const f32x2_t lo_ = __builtin_amdgcn_cvt_pk_f32_fp8((int)(w)[d_], false), hi_ = __builtin_amdgcn_cvt_pk_f32_fp8((int)(w)[d_], true); \
        f[4 * d_] = lo_.x; f[4 * d_ + 1] = lo_.y; f[4 * d_ + 2] = hi_.x; f[4 * d_ + 3] = hi_.y; } } while (0)

template <int SABL> __device__ __forceinline__ void phase_peer_scores(Ctx& C, const Args& A) {
    {
        const bf16* KB = (const bf16*)(C.ws + WS_KEYS);
        v4u tv[8];
#pragma unroll
        for (int i = 0; i < 8; ++i) { const int idx = C.tid + i * NTHR, set = idx >> 11, row = (idx >> 4) & 127, ch = idx & 15; tv[i] = *(const GAS v4u*)(KB + (size_t)set * 16384 + row * 128 + ch * 8); }
#pragma unroll
        for (int i = 0; i < 8; ++i) { const int idx = C.tid + i * NTHR, set = idx >> 11, row = (idx >> 4) & 127, ch = idx & 15; *(LAS v4u*)(C.lds + set * PK_BYTES + row * PK_P + ch * 16) = tv[i]; }
        __syncthreads();
    }
    for (int tile = C.vcu; tile < NTOK / 64; tile += C.G) {
        peer_scores<SABL>(C, A, tile * 64);
        __syncthreads();
        unsigned short* EIDX = (unsigned short*)(C.ws + WS_EIDX) + (size_t)tile * 64 * 128; float* EG = (float*)(C.ws + WS_EG) + (size_t)tile * 64 * 128;
#pragma unroll
        for (int i = 0; i < 2; ++i) { const int idx = C.tid + i * NTHR, row = idx >> 4, ch = idx & 15;
            const v4u a = *(const LAS v4u*)(C.lds + PS_EIDX + (row * PS_PITCH + 8 * ch) * 4), b = *(const LAS v4u*)(C.lds + PS_EIDX + (row * PS_PITCH + 8 * ch + 4) * 4);
            *(GAS v4u*)(EIDX + row * 128 + 8 * ch) = (v4u){a.x | (a.y << 16), a.z | (a.w << 16), b.x | (b.y << 16), b.z | (b.w << 16)}; }
#pragma unroll
        for (int i = 0; i < 4; ++i) { const int idx = C.tid + i * NTHR, row = idx >> 5, ch = idx & 31;
            *(GAS v4u*)(EG + row * 128 + 4 * ch) = *(const LAS v4u*)(C.lds + PS_EG + (row * PS_PITCH + 4 * ch) * 4); }
        __syncthreads();
    }
}

template <int MODE> __device__ __forceinline__ void phase_peer_u(Ctx& C, const Args& A) {
    int lane_ = C.lane; asm volatile("" : "+v"(lane_)); const int lane = lane_;
    const int x = C.sx >> 1, j = ((C.sx & 1) << 5) | C.sj, g = lane >> 3, c = lane & 7;
    const unsigned char* HN = C.ws + WS_H + 256 * x + 32 * c + 4 * g;
    const bool q1 = (lane & 4) != 0; const int bpa = 4 * c;
    const unsigned short* EIDX = (const unsigned short*)(C.ws + WS_EIDX) + 16 * g + 2 * c;
    bf16* PD = (bf16*)(C.ws + WS_PD) + (size_t)x * NTOK * 128 + 16 * g;
    const __amdgpu_buffer_rsrc_t RU = __builtin_amdgcn_make_buffer_rsrc((void*)(C.ws + WS_EU + (size_t)x * (2u << 20)), 0, 2 << 20, 0x00020000);
    const int t0 = 1024 * j + 128 * C.wave, tlast = t0 + 127;
    const int kb_ = 8 * ((c >> 2) & 1) + 4 * ((c >> 1) & 1) + 2 * (c & 1);
    unsigned ewn, hwn, hwA, hwB;
    v4u rA[16], rB[16];
#define PU_LDE(t) do { ewn = *(const GAS unsigned*)(EIDX + (size_t)(t) * 128); hwn = *(const GAS unsigned*)(HN + (size_t)(t) * DM); } while (0)
#define PU_LDR(R) do { unsigned en[8]; gather8(ewn, q1, en); _Pragma("unroll") for (int k = 0; k < 16; ++k) { const unsigned w_ = en[k >> 1]; const int ek_ = (int)((k & 1) ? (w_ >> 16) : (w_ & 0xffffu)); \
        R[k] = __builtin_bit_cast(v4u, __builtin_amdgcn_raw_buffer_load_b128(RU, ek_ * 128 + 16 * c, 0, 0)); } } while (0)
#define PU_COMP(R, hw, t) do { int pa_[4], pb_[4]; unsigned wq_[8]; \
          \
        _Pragma("unroll") for (int j_ = 0; j_ < 8; ++j_) wq_[j_] = (unsigned)__builtin_amdgcn_ds_bpermute(bpa + 32 * j_, (int)hw); \
        _Pragma("unroll") for (int d = 0; d < 4; ++d) { const unsigned w0_ = wq_[2 * d], w1_ = wq_[2 * d + 1]; \
            const unsigned u0_ = (w0_ ^ 0x80808080u) + 0x08080808u, u1_ = (w1_ ^ 0x80808080u) + 0x08080808u; \
            pa_[d] = (int)((((u0_ >> 4) & 0x0f0f0f0fu) ^ 0x08080808u) | ((u1_ & 0xf0f0f0f0u) ^ 0x80808080u)); \
            pb_[d] = (int)((w0_ & 0x0f0f0f0fu) | ((w1_ & 0x0f0f0f0fu) << 4)); } \
        __builtin_amdgcn_sched_barrier(0); \
          \
        int sh_ = dot4_z((int)wq_[0], 0x01010101); \
        _Pragma("unroll") for (int j_ = 1; j_ < 8; ++j_) sh_ = __builtin_amdgcn_sdot4((int)wq_[j_], 0x01010101, sh_, false); \
        const float corr_ = dpp_sum8((float)sh_) * 0.5f; \
        int ia_[16]; \
        _Pragma("unroll") for (int k = 0; k < 16; ++k) { asm volatile("" : "+v"(R[k])); int a_ = dot8_z((int)R[k][0], pa_[0]), b_ = dot8_z((int)R[k][0], pb_[0]); \
            _Pragma("unroll") for (int d = 1; d < 4; ++d) { a_ = __builtin_amdgcn_sdot8((int)R[k][d], pa_[d], a_, false); b_ = __builtin_amdgcn_sdot8((int)R[k][d], pb_[d], b_, false); } \
            ia_[k] = (a_ << 4) + b_; } \
          \
        int ib_[8], ic_[4], id0_, id1_; \
        { const bool b2 = (lane & 4) != 0, b1 = (lane & 2) != 0, b0 = (lane & 1) != 0; \
          _Pragma("unroll") for (int k = 0; k < 8; ++k) { const int keep = b2 ? ia_[k + 8] : ia_[k], send = b2 ? ia_[k] : ia_[k + 8]; ib_[k] = keep + __builtin_amdgcn_update_dpp(0, send, 0x141, 0xf, 0xf, false); } \
          _Pragma("unroll") for (int k = 0; k < 4; ++k) { const int keep = b1 ? ib_[k + 4] : ib_[k], send = b1 ? ib_[k] : ib_[k + 4]; ic_[k] = keep + __builtin_amdgcn_update_dpp(0, send, 0x1b, 0xf, 0xf, false); } \
          { const int keep = b0 ? ic_[2] : ic_[0], send = b0 ? ic_[0] : ic_[2]; id0_ = keep + __builtin_amdgcn_update_dpp(0, send, 0xb1, 0xf, 0xf, false); } \
          { const int keep = b0 ? ic_[3] : ic_[1], send = b0 ? ic_[1] : ic_[3]; id1_ = keep + __builtin_amdgcn_update_dpp(0, send, 0xb1, 0xf, 0xf, false); } } \
          \
        *(GAS unsigned*)(PD + (size_t)(t) * 128 + kb_) = cvtpk((float)id0_ + corr_, (float)id1_ + corr_); \
        __builtin_amdgcn_sched_barrier(0); } while (0)
    PU_LDE(t0);
    PU_LDR(rA); hwA = hwn;
    PU_LDE(t0 + 1);
#pragma unroll 1
    for (int ti = 0; ti < 128; ti += 2) {
        const int t = t0 + ti;
        PU_LDR(rB); hwB = hwn;
        PU_LDE(t + 2 < tlast ? t + 2 : tlast);
        __builtin_amdgcn_sched_barrier(0);
        PU_COMP(rA, hwA, t);
        PU_LDR(rA); hwA = hwn;
        PU_LDE(t + 3 < tlast ? t + 3 : tlast);
        __builtin_amdgcn_sched_barrier(0);
        PU_COMP(rB, hwB, t + 1);
    }
#undef PU_LDE
#undef PU_LDR
#undef PU_COMP
}

__device__ __forceinline__ void phase_peer_act(Ctx& C, const Args& A) {
    const bf16* PD = (const bf16*)(C.ws + WS_PD); const unsigned short* EIDX = (const unsigned short*)(C.ws + WS_EIDX); const float* EG = (const float*)(C.ws + WS_EG);
    unsigned* ACT8 = (unsigned*)(C.ws + WS_ACT); float* ACTS = (float*)(C.ws + WS_ACT + (size_t)NTOK * 128);
    LAS float* SU = (LAS float*)C.lds; LAS float* SV = SU + NEXP;
    { const GAS v4u* src = (const GAS v4u*)(C.ws + WS_ES) + C.tid; v4u tv[16];
#pragma unroll
      for (int i = 0; i < 16; ++i) tv[i] = src[i * NTHR];
#pragma unroll
      for (int i = 0; i < 16; ++i) ((LAS v4u*)C.lds)[C.tid + i * NTHR] = tv[i]; }
    __syncthreads();
    const int gt = C.vcu * NTHR + C.tid, NGT = C.G * NTHR;
    struct Ops { u32x2 p[4]; u32x2 ew; f32x4 gg; float hs; };
    const float* RS2 = (const float*)(C.ws + WS_RS2);
    Ops oA, oB;
    constexpr int NIT = NTOK * 128 / 4;
#define PA_LOAD(o_, i_) do { const int ii_ = (i_) < NIT ? (i_) : gt; _Pragma("unroll") for (int xs = 0; xs < 4; ++xs) o_.p[xs] = *(const GAS u32x2*)(PD + (size_t)xs * NTOK * 128 + (size_t)ii_ * 4); \
        o_.ew = *(const GAS u32x2*)(EIDX + (size_t)ii_ * 4); o_.gg = *(const GAS f32x4*)(EG + (size_t)ii_ * 4); o_.hs = *(const GAS float*)(RS2 + (ii_ >> 5)); } while (0)
    auto act_iter = [&](Ops& o_, const int it) {
        f32x4 z = {0.f, 0.f, 0.f, 0.f};
#pragma unroll
        for (int xs = 0; xs < 4; ++xs) { const u32x2 w_ = o_.p[xs]; z += (f32x4){bf_lo(w_.x), bf_hi(w_.x), bf_lo(w_.y), bf_hi(w_.y)}; }
        const u32x2 ew = o_.ew; const f32x4 gg = o_.gg; z *= o_.hs;
        PA_LOAD(o_, it + 2 * NGT);
        const int e0 = ew.x & 0xffffu, e1 = ew.x >> 16, e2 = ew.y & 0xffffu, e3 = ew.y >> 16;
        f32x4 a;
        a.x = gelu_erf(z.x * SU[e0]) * gg.x * SV[e0]; a.y = gelu_erf(z.y * SU[e1]) * gg.y * SV[e1];
        a.z = gelu_erf(z.z * SU[e2]) * gg.z * SV[e2]; a.w = gelu_erf(z.w * SU[e3]) * gg.w * SV[e3];
        float amax = fmaxf(fmaxf(fabsf(a.x), fabsf(a.y)), fmaxf(fabsf(a.z), fabsf(a.w)));
        amax = fmaxf(amax, __int_as_float(__builtin_amdgcn_update_dpp(0, __float_as_int(amax), 0xb1, 0xf, 0xf, false)));
        amax = fmaxf(amax, __int_as_float(__builtin_amdgcn_update_dpp(0, __float_as_int(amax), 0x4e, 0xf, 0xf, false)));
        amax = fmaxf(amax, __int_as_float(__builtin_amdgcn_update_dpp(0, __float_as_int(amax), 0x124, 0xf, 0xf, false)));
        amax = fmaxf(amax, __int_as_float(__builtin_amdgcn_update_dpp(0, __float_as_int(amax), 0x128, 0xf, 0xf, false)));
        { auto r = __builtin_amdgcn_permlane16_swap(__float_as_uint(amax), __float_as_uint(amax), false, false); amax = fmaxf(__uint_as_float(r[0]), __uint_as_float(r[1])); }
        const float as_ = amax > 0.f ? 127.f / amax : 1.f;
        const int b0 = (int)rintf(a.x * as_), b1 = (int)rintf(a.y * as_), b2 = (int)rintf(a.z * as_), b3 = (int)rintf(a.w * as_);
        ACT8[it] = (unsigned)(b0 & 0xff) | ((unsigned)(b1 & 0xff) << 8) | ((unsigned)(b2 & 0xff) << 16) | ((unsigned)(b3 & 0xff) << 24);
        int bs = (b0 + b1) + (b2 + b3);
        bs += __builtin_amdgcn_update_dpp(0, bs, 0xb1, 0xf, 0xf, false); bs += __builtin_amdgcn_update_dpp(0, bs, 0x4e, 0xf, 0xf, false);
        bs += __builtin_amdgcn_update_dpp(0, bs, 0x124, 0xf, 0xf, false); bs += __builtin_amdgcn_update_dpp(0, bs, 0x128, 0xf, 0xf, false);
        { auto r = __builtin_amdgcn_permlane16_swap((unsigned)bs, (unsigned)bs, false, false); bs = (int)r[0] + (int)r[1]; }
        if ((it & 31) == 0) *(GAS f32x2_t*)(ACTS + 2 * (it >> 5)) = (f32x2_t){amax > 0.f ? amax * (1.f / 127.f) : 1.f, (float)bs};
    };
    PA_LOAD(oA, gt); PA_LOAD(oB, gt + NGT);
    for (int it = gt; it < NIT; it += 2 * NGT) { act_iter(oA, it); if (it + NGT < NIT) act_iter(oB, it + NGT); }
#undef PA_LOAD
}

template <int VABL> __device__ __forceinline__ void phase_peer_v(Ctx& C, const Args& A) {
    int lane_ = C.lane; asm volatile("" : "+v"(lane_)); const int lane = lane_;
    const int x = C.sx >> 1, j = ((C.sx & 1) << 5) | C.sj, g = lane >> 3, c = lane & 7;
    const unsigned short* EIDX = (const unsigned short*)(C.ws + WS_EIDX) + 16 * g + 2 * c; const unsigned char* ACT8 = (const unsigned char*)(C.ws + WS_ACT) + 16 * g + 4 * (c & 3); const float* ACTS = (const float*)(C.ws + WS_ACT + (size_t)NTOK * 128);
    const bool q1 = (lane & 4) != 0;
    const __amdgpu_buffer_rsrc_t RV = __builtin_amdgcn_make_buffer_rsrc((void*)(C.ws + WS_EV + (size_t)x * (2u << 20)), 0, 2 << 20, 0x00020000);
    const int t0 = 1024 * j + 128 * C.wave, tlast = t0 + 127;
    const int cc_ = 256 * x + 32 * c + 4 * g;
    const bf16* X1 = (const bf16*)(C.ws + WS_X1) + cc_;
    const f32x4 g2 = *(const f32x4*)((const float*)(C.ws + WS_MOD) + (size_t)(t0 >> 11) * NMOD + 5 * 1024 + cc_);
    const float mulc = (g & 1) ? 0.0625f : 1.f, addc = (g & 1) ? 0.5f : -7.5f;
    unsigned ewn, an, aA, aB; float sn, sA, sB, zn, zA, zB; u32x2 xn, xA, xB;
    v4u rA[16], rB[16];
#define PV_LDE(t) do { ewn = *(const GAS unsigned*)(EIDX + (size_t)(t) * 128); an = *(const GAS unsigned*)(ACT8 + (size_t)(t) * 128); \
        { const f32x2_t q_ = *(const GAS f32x2_t*)(ACTS + 2 * (size_t)(t)); sn = q_.x; zn = q_.y; } xn = *(const GAS u32x2*)(X1 + (size_t)(t) * DM); } while (0)
#define PV_LDR(R, AV, SV_, ZV_, XV_) do { unsigned en[8]; gather8(ewn, q1, en); _Pragma("unroll") for (int k = 0; k < 16; ++k) { const unsigned w_ = en[k >> 1]; const int ek_ = (int)((k & 1) ? (w_ >> 16) : (w_ & 0xffffu)); \
        R[k] = __builtin_bit_cast(v4u, __builtin_amdgcn_raw_buffer_load_b128(RV, ek_ * 128 + 16 * c, 0, 0)); } \
        AV = an; SV_ = sn; ZV_ = zn; XV_ = xn; } while (0)
#define PV_COMP(R, AV, SV_, ZV_, XV_, t) do { const float ainv = SV_, asum = ZV_; \
        const int aq[4] = {__builtin_amdgcn_update_dpp(0, (int)AV, 0x00, 0xf, 0xf, false), __builtin_amdgcn_update_dpp(0, (int)AV, 0x55, 0xf, 0xf, false), __builtin_amdgcn_update_dpp(0, (int)AV, 0xaa, 0xf, 0xf, false), __builtin_amdgcn_update_dpp(0, (int)AV, 0xff, 0xf, 0xf, false)}; \
        __builtin_amdgcn_sched_barrier(0); \
        int iF[16], iH[16];         \
        _Pragma("unroll") for (int kk = 0; kk < 4; ++kk) { asm volatile("" : "+v"(R[4 * kk]), "+v"(R[4 * kk + 1]), "+v"(R[4 * kk + 2]), "+v"(R[4 * kk + 3])); \
            _Pragma("unroll") for (int d = 0; d < 4; ++d) { const unsigned r0 = R[4 * kk][d], r1 = R[4 * kk + 1][d], r2 = R[4 * kk + 2][d], r3 = R[4 * kk + 3][d]; \
                const unsigned p01l = __builtin_amdgcn_perm(r1, r0, 0x05010400u), p01h = __builtin_amdgcn_perm(r1, r0, 0x07030602u); \
                const unsigned p23l = __builtin_amdgcn_perm(r3, r2, 0x05010400u), p23h = __builtin_amdgcn_perm(r3, r2, 0x07030602u); \
                unsigned tt_[4]; \
                tt_[0] = __builtin_amdgcn_perm(p23l, p01l, 0x05040100u); tt_[1] = __builtin_amdgcn_perm(p23l, p01l, 0x07060302u); \
                tt_[2] = __builtin_amdgcn_perm(p23h, p01h, 0x05040100u); tt_[3] = __builtin_amdgcn_perm(p23h, p01h, 0x07060302u); \
                _Pragma("unroll") for (int b = 0; b < 4; ++b) { \
                    if (kk == 0) { iF[4 * d + b] = dot4_z((int)tt_[b], aq[0]); iH[4 * d + b] = dot4_z((int)(tt_[b] & 0xf0f0f0f0u), aq[0]); } \
                    else { iF[4 * d + b] = __builtin_amdgcn_sdot4((int)tt_[b], aq[kk], iF[4 * d + b], false); iH[4 * d + b] = __builtin_amdgcn_sdot4((int)(tt_[b] & 0xf0f0f0f0u), aq[kk], iH[4 * d + b], false); } } } } \
        int ia[32]; \
        _Pragma("unroll") for (int d = 0; d < 4; ++d) _Pragma("unroll") for (int b = 0; b < 4; ++b) { ia[8 * d + b] = iF[4 * d + b] - iH[4 * d + b]; ia[8 * d + 4 + b] = iH[4 * d + b]; } \
          \
        int ib[16], ic[8], id[4]; \
        _Pragma("unroll") for (int i = 0; i < 16; ++i) { auto r = __builtin_amdgcn_permlane32_swap((unsigned)ia[i], (unsigned)ia[i + 16], false, false); ib[i] = (int)r[0] + (int)r[1]; } \
        _Pragma("unroll") for (int i = 0; i < 8; ++i) { auto r = __builtin_amdgcn_permlane16_swap((unsigned)ib[i], (unsigned)ib[i + 8], false, false); ic[i] = (int)r[0] + (int)r[1]; } \
        { const bool b3 = (lane & 8) != 0; \
          _Pragma("unroll") for (int i = 0; i < 4; ++i) { const int k0 = b3 ? ic[i + 4] : ic[i], s0 = b3 ? ic[i] : ic[i + 4]; id[i] = k0 + __builtin_amdgcn_update_dpp(0, s0, 0x128, 0xf, 0xf, false); } } \
        { const float az = addc * asum; \
          const f32x4 xv = {bf_lo(XV_.x), bf_hi(XV_.x), bf_lo(XV_.y), bf_hi(XV_.y)}; \
          const f32x4 fv = {((float)id[0] * mulc + az) * ainv, ((float)id[1] * mulc + az) * ainv, ((float)id[2] * mulc + az) * ainv, ((float)id[3] * mulc + az) * ainv}; \
          *(GAS f32x4*)(C.out + (size_t)(t) * DM + cc_) = xv + g2 * fv; } \
        __builtin_amdgcn_sched_barrier(0); } while (0)
    PV_LDE(t0);
    PV_LDR(rA, aA, sA, zA, xA);
    PV_LDE(t0 + 1);
#pragma unroll 1
    for (int ti = 0; ti < 128; ti += 2) {
        const int t = t0 + ti;
        PV_LDR(rB, aB, sB, zB, xB);
        PV_LDE(t + 2 < tlast ? t + 2 : tlast);
        __builtin_amdgcn_sched_barrier(0);
        PV_COMP(rA, aA, sA, zA, xA, t);
        PV_LDR(rA, aA, sA, zA, xA);
        PV_LDE(t + 3 < tlast ? t + 3 : tlast);
        __builtin_amdgcn_sched_barrier(0);
        PV_COMP(rB, aB, sB, zB, xB, t + 1);
    }
#undef PV_LDE
#undef PV_LDR
#undef PV_COMP
}
#undef PG_PIN16
#undef PG_CVT

constexpr int NPHASE = 13;

__global__ void __launch_bounds__(NTHR, 2) fwd_kernel(Args args) {
    extern __shared__ __attribute__((aligned(16))) unsigned char lds[];
    Ctx C;
    C.lds = (LAS unsigned char*)lds; C.MISC = (volatile LAS unsigned*)(C.lds + MISC_OFF);
    C.tid = threadIdx.x; C.lane = C.tid & 63; C.wave = __builtin_amdgcn_readfirstlane(C.tid >> 6);
    C.G = gridDim.x; { const int bx = blockIdx.x; C.vcu = (C.G % 8 == 0) ? (bx % 8) * (C.G / 8) + bx / 8 : bx; }
    C.ws = args.ws; C.out = args.out; C.ctl = (gu32*)(args.ws + WS_CTL);
    if (C.tid < 64) ((LAS unsigned*)(C.lds + MISC_OFF))[C.tid] = 0u;
    __syncthreads();
    const int lo = args.ph_lo, hi = args.ph_hi;
    const bool multi = (hi - lo) > 1;
    XcdBarrier bar; bar.bar = (unsigned*)(C.ctl + CW_BAR); bar.x = 0; bar.st = nullptr;
    if (multi) bar = xcd_barrier_post((unsigned*)(C.ctl + CW_BAR), C.MISC + 8);
#ifndef PH_MASK
#define PH_MASK 0x1fff
#endif
#define IN(k) (((PH_MASK >> (k)) & 1) && lo <= (k) && (k) < hi)
#ifndef REP_MASK
#define REP_MASK 0
#endif
#ifndef ABL_MODE
#define ABL_MODE 0
#endif
#define SEAM(k) do { if (IN(k) && IN((k) + 1)) xcd_barrier(bar); } while (0)
#define NREP(k) (1 + ((REP_MASK >> (k)) & 1))
#define PFENCE() do { asm volatile("" : "+v"(C.tid) :: "memory"); C.lane = C.tid & 63; C.wave = __builtin_amdgcn_readfirstlane(C.tid >> 6); } while (0)
    for (int rp = 0; rp < NREP(0); ++rp) { if (rp) xcd_barrier(bar); PFENCE(); if (IN(0)) { phase0(C, args); } }
    if (IN(0) && IN(1)) {
        if (C.tid == 0) { unsigned* bw_ = (unsigned*)(C.ctl + CW_BAR);
            XB_SPIN(xb_ld((unsigned*)(C.ctl + CW_MODRDY)) < 64u, bw_);
            __builtin_amdgcn_fence(__ATOMIC_ACQUIRE, "agent"); asm volatile("s_waitcnt vmcnt(0)" ::: "memory"); }
        __syncthreads();
    }
    for (int rp = 0; rp < NREP(1); ++rp) { if (rp) xcd_barrier(bar); PFENCE(); if (IN(1)) { phase1(C, args); } } SEAM(1);
    for (int rp = 0; rp < NREP(2); ++rp) { if (rp) xcd_barrier(bar); PFENCE();
    if (IN(2)) { pg8::Gemm g{(const pg8::bf16_t*)(C.ws + WS_H), (const pg8::bf16_t*)(C.ws + WS_WIN_T), NTOK, NPROJ, DM / 2}; pg8::StaticOrder S; S.init(NTOK, NPROJ, C.G, (int)blockIdx.x);
        pg8::EpiI8Bf16 E{(pg8::bf16_t*)(C.ws + WS_PROJ), NPROJ, (const float*)(C.ws + WS_RS1), (const float*)(C.ws + WS_CS), nullptr, (const int*)args.in[2], (const float*)args.in[8]};
        pg8::gemm_phase_i8<pg8::EpiI8Bf16, pg8::StaticOrder, true, true>(C.lds, g, S, E); } } SEAM(2);
    for (int rp = 0; rp < NREP(4); ++rp) { if (rp) xcd_barrier(bar); PFENCE(); if (IN(4)) { if (rp + 1 < NREP(4)) phase3<ABL_MODE>(C, args, rp); else phase3<0>(C, args, rp); } } SEAM(4);
    for (int rp = 0; rp < NREP(5); ++rp) { if (rp) xcd_barrier(bar); PFENCE();
    if (IN(5)) { pg8::Gemm g{(const pg8::bf16_t*)(C.ws + WS_Y), (const pg8::bf16_t*)(C.ws + WS_WOUT_T), NTOK, DM, DM}; pg8::StaticOrder S; S.init(NTOK, DM, C.G, (int)blockIdx.x);
        pg8::EpiResidBf16 E{(const float*)args.in[0], (const float*)(C.ws + WS_MOD) + 2 * 1024, (pg8::bf16_t*)(C.ws + WS_X1)};
        pg8::gemm_phase<pg8::EpiResidBf16, pg8::StaticOrder, true, true>(C.lds, g, S, E); } } SEAM(5);
    for (int rp = 0; rp < NREP(6); ++rp) { if (rp) xcd_barrier(bar); PFENCE(); if (IN(6)) { phase5(C, args); } } SEAM(6);
    for (int rp = 0; rp < NREP(7); ++rp) { if (rp) xcd_barrier(bar); PFENCE();
    if (IN(7)) { pg8::Gemm g{(const pg8::bf16_t*)(C.ws + WS_H), (const pg8::bf16_t*)(C.ws + WS_WQ_T), NTOK, NQP, DM / 2}; pg8::StaticOrder S; S.init(NTOK, NQP, C.G, (int)blockIdx.x);
        pg8::EpiI8Bf16 E{(pg8::bf16_t*)(C.ws + WS_PROJ), NQP, (const float*)(C.ws + WS_RS2), (const float*)(C.ws + WS_CSQ), (const float*)args.in[20], nullptr, nullptr};
        pg8::gemm_phase_i8<pg8::EpiI8Bf16, pg8::StaticOrder, true, true>(C.lds, g, S, E); } } SEAM(7);
    for (int rp = 0; rp < NREP(8); ++rp) { if (rp) xcd_barrier(bar); PFENCE(); if (IN(8)) { if (rp + 1 < NREP(8)) phase_peer_scores<ABL_MODE>(C, args); else phase_peer_scores<0>(C, args); } } SEAM(8);
    C.sx = C.vcu >> 5; C.sj = C.vcu & 31;
    if (multi && C.G == 256) {
        if (C.tid == 0) { unsigned* bw = (unsigned*)(C.ctl + CW_BAR); bool ok = true;
            for (int q = 0; q < 16; ++q) { const unsigned cnt = xb_ld(&bw[XB_XCNT(q)]); ok = ok && (q < 8 ? cnt == 32u : cnt == 0u); }
            unsigned code = 0xffffffffu;
            if (ok) { const unsigned xc = xb_xcc_id(); const unsigned r = __hip_atomic_fetch_add(C.ctl + CW_RANK + 64 * xc, 1u, __ATOMIC_RELAXED, __HIP_MEMORY_SCOPE_AGENT); code = (xc << 8) | (r & 31u); }
            C.MISC[1] = code; }
        __syncthreads();
        const unsigned code = C.MISC[1];
        if (code != 0xffffffffu) { C.sx = (int)(code >> 8); C.sj = (int)(code & 31u); }
    }
    for (int rp = 0; rp < NREP(9); ++rp) { if (rp) xcd_barrier(bar); PFENCE(); if (IN(9)) { if (rp + 1 < NREP(9)) phase_peer_u<ABL_MODE>(C, args); else phase_peer_u<0>(C, args); } } SEAM(9);
    for (int rp = 0; rp < NREP(10); ++rp) { if (rp) xcd_barrier(bar); PFENCE(); if (IN(10)) { phase_peer_act(C, args); } } SEAM(10);
    for (int rp = 0; rp < NREP(11); ++rp) { if (rp) xcd_barrier(bar); PFENCE(); if (IN(11)) { if (rp + 1 < NREP(11)) phase_peer_v<ABL_MODE>(C, args); else phase_peer_v<0>(C, args); } }
#undef IN
#undef SEAM
}

#ifndef MK_N_LAUNCHES
#define MK_N_LAUNCHES 1
#endif
extern "C" void kernel_launch(void* const* d_in, const int* in_sizes, int n_in, void* d_out, int out_size, void* d_ws, size_t ws_size, hipStream_t stream) {
    static int grid = 0;
    if (grid == 0) {
        if (n_in != 25 || in_sizes[0] != NTOK * DM || out_size != NTOK * DM || ws_size < WS_END) { fprintf(stderr, "kernel_launch: unexpected shapes (n_in %d, in0 %d, out %d, ws %zu)\n", n_in, n_in > 0 ? in_sizes[0] : -1, out_size, ws_size); grid = -1; return; }
        int dev = 0, cus = 0, per_cu = 0;
        if (hipGetDevice(&dev) != hipSuccess || hipDeviceGetAttribute(&cus, hipDeviceAttributeMultiprocessorCount, dev) != hipSuccess) { grid = -1; return; }
        if (hipFuncSetAttribute((const void*)fwd_kernel, hipFuncAttributeMaxDynamicSharedMemorySize, LDS_BYTES) != hipSuccess) { fprintf(stderr, "kernel_launch: hipFuncSetAttribute failed\n"); grid = -1; return; }
        if (hipOccupancyMaxActiveBlocksPerMultiprocessor(&per_cu, (const void*)fwd_kernel, NTHR, LDS_BYTES) != hipSuccess || per_cu < 1) fprintf(stderr, "kernel_launch: occupancy query says %d per CU\n", per_cu);
        (void)hipGetLastError();
        if (cus != 256) { fprintf(stderr, "kernel_launch: built for a 256-CU device (work maps assume 256 workgroups), found %d CUs; nothing launched\n", cus); grid = -1; return; }
        grid = cus;
    }
    if (grid < 0) return;
    if (hipMemsetAsync((char*)d_ws + WS_CTL, 0, CTL_ZERO_BYTES, stream) != hipSuccess) return;
    Args a{};
    for (int i = 0; i < 25; ++i) a.in[i] = d_in[i];
    a.out = (float*)d_out; a.ws = (unsigned char*)d_ws;
    if (MK_N_LAUNCHES == 1) { a.ph_lo = 0; a.ph_hi = NPHASE; a.li = 0; hipLaunchKernelGGL(fwd_kernel, dim3(grid), dim3(NTHR), LDS_BYTES, stream, a); }
    else { const int order[NPHASE] = {0, 12, 1, 2, 3, 4, 5, 6, 7, 8, 9, 10, 11}; for (int i = 0; i < NPHASE; ++i) { const int p = order[i]; a.ph_lo = p; a.ph_hi = p + 1; a.li = p; hipLaunchKernelGGL(fwd_kernel, dim3(grid), dim3(NTHR), LDS_BYTES, stream, a); } }
}
```
